# Optimizing an MI355X kernel written in HIP

```python
import math
import jax, jax.numpy as jnp
from jax import lax
import numpy as np

D_MODEL = 1024
BATCH = 16
SEQ = 2048
DEPTH = 2

CHUNK = 64
Q_BLOCK = 128
HEAD_DIM = 64
D_MIX = D_MODEL
SB_HEADS = (D_MIX // 2) // HEAD_DIM
SB_WIDTH = SB_HEADS * HEAD_DIM
DA_VDIM = 2 * HEAD_DIM
DA_HEADS = (D_MIX // 2) // DA_VDIM
DA_QK_WIDTH = DA_HEADS * 2 * HEAD_DIM
DA_WIDTH = DA_HEADS * DA_VDIM
PROJ_WIDTH = 4 * SB_WIDTH + 2 * DA_QK_WIDTH + 2 * DA_WIDTH
RMS_EPS = 1e-6

kernel_name = 'hybrid_stickbreak_diffattn_block'


def _rmsnorm(x, g):
    xf = x.astype(jnp.float32)
    y = xf * lax.rsqrt(jnp.mean(xf * xf, axis=-1, keepdims=True) + RMS_EPS)
    return (y * g.astype(jnp.float32)).astype(x.dtype)


def _lambda_init(layer_idx):
    return 0.8 - 0.6 * math.exp(-0.3 * layer_idx)


def _stick_breaking(q, k, v):
    S, Dh = q.shape[1], q.shape[-1]
    scale = Dh ** -0.5
    outs = []
    for i in range(S // Q_BLOCK):
        q0 = i * Q_BLOCK
        kend = q0 + Q_BLOCK
        z = jnp.einsum('bqhd,bkhd->bhqk', q[:, q0:kend], k[:, :kend]).astype(jnp.float32) * scale
        tpos = q0 + jnp.arange(Q_BLOCK)[:, None]
        spos = jnp.arange(kend)[None, :]
        mask = spos < tpos
        log_beta = jax.nn.log_sigmoid(z)
        log_1m = jnp.where(mask, jax.nn.log_sigmoid(-z), 0.0)
        tail = lax.cumsum(log_1m, axis=3, reverse=True) - log_1m
        a = jnp.where(mask, jnp.exp(log_beta + tail), 0.0)
        outs.append(jnp.einsum('bhqk,bkhd->bqhd', a.astype(v.dtype), v[:, :kend]))
    return jnp.concatenate(outs, axis=1)


def _diff_attention(q, k, v, lam, slopes):
    S, Dh = q.shape[1], q.shape[-1]
    scale = Dh ** -0.5
    outs = []
    for i in range(S // Q_BLOCK):
        q0 = i * Q_BLOCK
        kend = q0 + Q_BLOCK
        s12 = jnp.einsum('bqhcd,bkhcd->bhcqk', q[:, q0:kend], k[:, :kend]).astype(jnp.float32) * scale
        tpos = q0 + jnp.arange(Q_BLOCK)[:, None]
        spos = jnp.arange(kend)[None, :]
        mask = (spos // CHUNK) <= (tpos // CHUNK)
        dist = jnp.abs(tpos - spos).astype(jnp.float32)
        alibi = -slopes[:, None, None] * dist[None]
        logits = jnp.where(mask, s12 + alibi[None, :, None], -jnp.inf)
        p = jax.nn.softmax(logits, axis=-1)
        a = p[:, :, 0] - lam * p[:, :, 1]
        outs.append(jnp.einsum('bhqk,bkhe->bqhe', a.astype(v.dtype), v[:, :kend]))
    return jnp.concatenate(outs, axis=1)


def _layer(x, norm_g, w_in, w_out, q_norm_g, k_norm_g, lq1, lk1, lq2, lk2, subln_g, layer_idx):
    B, S, _ = x.shape
    h = _rmsnorm(x, norm_g)
    proj = h @ w_in
    sizes = [SB_WIDTH] * 4 + [DA_QK_WIDTH, DA_QK_WIDTH, DA_WIDTH, DA_WIDTH]
    offsets = [int(o) for o in np.cumsum(sizes)[:-1]]
    sb_q, sb_k, sb_v, sb_g, da_q, da_k, da_v, da_g = jnp.split(proj, offsets, axis=-1)

    shp = (B, S, SB_HEADS, HEAD_DIM)
    sb_o = _stick_breaking(sb_q.reshape(shp), sb_k.reshape(shp), sb_v.reshape(shp))
    sb_o = sb_o.reshape(B, S, SB_WIDTH) * jax.nn.silu(sb_g)

    qk_shp = (B, S, DA_HEADS, 2, HEAD_DIM)
    dq = _rmsnorm(da_q.reshape(qk_shp), q_norm_g)
    dk = _rmsnorm(da_k.reshape(qk_shp), k_norm_g)
    dv = da_v.reshape(B, S, DA_HEADS, DA_VDIM)
    lam_init = _lambda_init(layer_idx)
    lam = (jnp.exp(jnp.sum(lq1.astype(jnp.float32) * lk1.astype(jnp.float32)))
           - jnp.exp(jnp.sum(lq2.astype(jnp.float32) * lk2.astype(jnp.float32))) + lam_init)
    slopes = jnp.asarray(2.0 ** (-8.0 * np.arange(1, DA_HEADS + 1) / DA_HEADS), dtype=jnp.float32)
    da_o = _diff_attention(dq, dk, dv, lam, slopes)
    da_o = _rmsnorm(da_o, subln_g) * (1.0 - lam_init)
    da_o = da_o.reshape(B, S, DA_WIDTH) * jax.nn.silu(da_g)

    mixed = jnp.concatenate([sb_o, da_o], axis=-1)
    return x + mixed @ w_out


def setup_inputs(seed: int = 0) -> dict:
    key = jax.random.key(seed)
    ks = jax.random.split(key, 12)
    f32 = jnp.float32
    x = jax.random.normal(ks[0], (BATCH, SEQ, D_MODEL), f32)
    norm_g = 1.0 + 0.02 * jax.random.normal(ks[1], (DEPTH, D_MODEL), f32)
    w_in = jax.random.normal(ks[2], (DEPTH, D_MODEL, PROJ_WIDTH), f32) * D_MODEL ** -0.5
    w_out = jax.random.normal(ks[3], (DEPTH, D_MIX, D_MODEL), f32) * (D_MIX ** -0.5) * 0.5
    q_norm_g = 1.0 + 0.02 * jax.random.normal(ks[4], (DEPTH, HEAD_DIM), f32)
    k_norm_g = 1.0 + 0.02 * jax.random.normal(ks[5], (DEPTH, HEAD_DIM), f32)
    lambda_q1 = 0.1 * jax.random.normal(ks[6], (DEPTH, HEAD_DIM), f32)
    lambda_k1 = 0.1 * jax.random.normal(ks[7], (DEPTH, HEAD_DIM), f32)
    lambda_q2 = 0.1 * jax.random.normal(ks[8], (DEPTH, HEAD_DIM), f32)
    lambda_k2 = 0.1 * jax.random.normal(ks[9], (DEPTH, HEAD_DIM), f32)
    subln_g = 1.0 + 0.02 * jax.random.normal(ks[10], (DEPTH, DA_VDIM), f32)
    return {'x': x, 'norm_g': norm_g, 'w_in': w_in, 'w_out': w_out,
            'q_norm_g': q_norm_g, 'k_norm_g': k_norm_g,
            'lambda_q1': lambda_q1, 'lambda_k1': lambda_k1,
            'lambda_q2': lambda_q2, 'lambda_k2': lambda_k2, 'subln_g': subln_g}


def reference(x, norm_g, w_in, w_out, q_norm_g, k_norm_g, lambda_q1, lambda_k1, lambda_q2, lambda_k2, subln_g):
    for l in range(DEPTH):
        x = _layer(x, norm_g[l], w_in[l], w_out[l], q_norm_g[l], k_norm_g[l],
                   lambda_q1[l], lambda_k1[l], lambda_q2[l], lambda_k2[l], subln_g[l], l)
    return x
```

```cpp
#include <hip/hip_runtime.h>
#include <cstdio>
#include <cstdint>

#ifndef SB_EARLY_EXIT
#define SB_EARLY_EXIT 0
#endif

#define LAS __attribute__((address_space(3)))
#define GAS __attribute__((address_space(1)))
typedef _Float16 f16;
typedef _Float16 h8 __attribute__((ext_vector_type(8)));
typedef _Float16 h4 __attribute__((ext_vector_type(4)));
typedef _Float16 h2 __attribute__((ext_vector_type(2)));
typedef float f32x4 __attribute__((ext_vector_type(4)));
typedef float f32x16 __attribute__((ext_vector_type(16)));
typedef unsigned u32x4 __attribute__((ext_vector_type(4)));
typedef unsigned u32x2 __attribute__((ext_vector_type(2)));

constexpr int BATCH = 16, SEQ = 2048, DM = 1024, MROWS = BATCH * SEQ, PW = 4096, DEPTH = 2;
constexpr float RMS_EPS = 1e-6f;
constexpr float LOG2E = 1.4426950408889634f;
constexpr float QS = 0.125f * LOG2E;
constexpr int C_SBQ = 0, C_SBK = 512, C_SBV = 1024, C_SBG = 1536, C_DAQ = 2048, C_DAK = 2560, C_DAV = 3072, C_DAG = 3584;

__device__ __forceinline__ unsigned pkh(float lo, float hi) { h2 v = {(f16)lo, (f16)hi}; return __builtin_bit_cast(unsigned, v); }
__device__ __forceinline__ unsigned pkh_rtz(float lo, float hi) { return __builtin_bit_cast(unsigned, __builtin_amdgcn_cvt_pkrtz(lo, hi)); }
__device__ __forceinline__ float silu_f(float v) { return v * __builtin_amdgcn_rcpf(1.0f + __builtin_amdgcn_exp2f(-v * LOG2E)); }

namespace pg8 {
constexpr int BM = 256, BK = 64, HALF = 128, HTB = HALF * BK * 2, STAGE_BYTES = 8 * HTB, NXCD = 8, WGM = 8;
__host__ __device__ __forceinline__ int lds_byte(int r, int c) { const int st = (r >> 4) * 2 + (c >> 5), rr = r & 15, cc = c & 31, ob = rr * 64 + cc * 2; return st * 1024 + (ob ^ (((ob >> 9) & 1) << 5)); }
__host__ __device__ __forceinline__ void stage_rc(int b, int& R, int& C) { const int st = b / 1024, sb = b % 1024, swz = sb ^ (((sb >> 9) & 1) << 5); R = (st >> 1) * 16 + swz / 64; C = (st & 1) * 32 + (swz % 64) / 2; }
__host__ __device__ __forceinline__ int perm32(int rho) { const int n = rho >> 4, i = rho & 15; return 8 * (i >> 2) + 4 * n + (i & 3); }

struct Unit { int pm, pn; };
struct Gemm { const f16* A; const f16* Bt; int M, N, K; };

struct StaticOrder {
    int nM, nN, nwg, G, c;
    __host__ __device__ void init(int M, int N, int G_, int c_) { nM = M / BM; nN = N / BM; nwg = nM * nN; G = G_; c = c_; }
    __host__ __device__ bool next(int i, Unit& u) const {
        const long L = (long)i * G + c; if (L >= nwg) return false;
        int wgid = (int)L; { const int q = nwg / NXCD, r = nwg % NXCD, xcd = wgid % NXCD, off = wgid / NXCD; wgid = (xcd < r ? xcd * (q + 1) : r * (q + 1) + (xcd - r) * q) + off; }
        const int nig = WGM * nN, gid = wgid / nig, fm = gid * WGM, gsz = (nM - fm) < WGM ? (nM - fm) : WGM;
        u.pm = fm + ((wgid % nig) % gsz); u.pn = (wgid % nig) / gsz; return true;
    }
};


struct EpiProj {
    f16* P; const float* part; const float* gq; const float* gk;
    __device__ __forceinline__ void operator()(const f32x4 (&acc)[2][2][4][2], const Unit& u, int wr, int wc, int fr, int fq) const {
        const int sec = u.pn >> 1;
        const int row0 = u.pm * BM + wr * 64 + fr;
        const int colw = u.pn * BM + wc * 64 + 8 * fq;
        f32x4 gain[2][2];
        if (sec == 4 || sec == 5) {
            const float* g = (sec == 4) ? gq : gk;
#pragma unroll
            for (int bj = 0; bj < 2; ++bj)
#pragma unroll
                for (int n = 0; n < 2; ++n) gain[bj][n] = *(const f32x4*)(g + 32 * bj + 8 * fq + 4 * n);
        }
#pragma unroll
        for (int ai = 0; ai < 2; ++ai)
#pragma unroll
            for (int m = 0; m < 4; ++m) {
                const int row = row0 + ai * HALF + m * 16;
                const f32x4 pv = *(const f32x4*)(part + (size_t)row * 16 + fq * 4);
                float s = (pv[0] + pv[1]) + (pv[2] + pv[3]);
                s += __shfl_xor(s, 16); s += __shfl_xor(s, 32);
                const float rs = __builtin_amdgcn_rsqf(s * (1.0f / DM) + RMS_EPS);
                f32x4 v[2][2];
#pragma unroll
                for (int bj = 0; bj < 2; ++bj)
#pragma unroll
                    for (int n = 0; n < 2; ++n) v[bj][n] = acc[ai][bj][m][n] * rs;
                if (sec == 4 || sec == 5) {
                    float ss = 0.f;
#pragma unroll
                    for (int bj = 0; bj < 2; ++bj)
#pragma unroll
                        for (int n = 0; n < 2; ++n) { const f32x4 x = v[bj][n]; ss += (x[0] * x[0] + x[1] * x[1]) + (x[2] * x[2] + x[3] * x[3]); }
                    ss += __shfl_xor(ss, 16); ss += __shfl_xor(ss, 32);
                    float rn = __builtin_amdgcn_rsqf(ss * (1.0f / 64.0f) + RMS_EPS);
                    if (sec == 4) rn *= QS;
#pragma unroll
                    for (int bj = 0; bj < 2; ++bj)
#pragma unroll
                        for (int n = 0; n < 2; ++n) v[bj][n] = v[bj][n] * rn * gain[bj][n];
                } else if (sec == 0) {
#pragma unroll
                    for (int bj = 0; bj < 2; ++bj)
#pragma unroll
                        for (int n = 0; n < 2; ++n) v[bj][n] = v[bj][n] * QS;
                } else if (sec == 3 || sec == 7) {
#pragma unroll
                    for (int bj = 0; bj < 2; ++bj)
#pragma unroll
                        for (int n = 0; n < 2; ++n)
#pragma unroll
                            for (int e = 0; e < 4; ++e) v[bj][n][e] = silu_f(v[bj][n][e]);
                }
                f16* rowp = P + (size_t)row * PW + colw;
#pragma unroll
                for (int bj = 0; bj < 2; ++bj) {
                    u32x4 w; w.x = pkh(v[bj][0][0], v[bj][0][1]); w.y = pkh(v[bj][0][2], v[bj][0][3]); w.z = pkh(v[bj][1][0], v[bj][1][1]); w.w = pkh(v[bj][1][2], v[bj][1][3]);
                    *(u32x4*)(rowp + 32 * bj) = w;
                }
            }
    }
};

struct EpiOut {
    const float* base; float* out; f16* xb; float* part; int next;
    __device__ __forceinline__ void operator()(const f32x4 (&acc)[2][2][4][2], const Unit& u, int wr, int wc, int fr, int fq) const {
        const int row0 = u.pm * BM + wr * 64 + fr;
        const int colw = u.pn * BM + wc * 64 + 8 * fq;
#pragma unroll
        for (int ai = 0; ai < 2; ++ai)
#pragma unroll
            for (int m = 0; m < 4; ++m) {
                const int row = row0 + ai * HALF + m * 16;
                const size_t off = (size_t)row * DM + colw;
                float ss = 0.f;
#pragma unroll
                for (int bj = 0; bj < 2; ++bj) {
                    const f32x4 b0 = *(const f32x4*)(base + off + 32 * bj), b1 = *(const f32x4*)(base + off + 32 * bj + 4);
                    const f32x4 o0 = b0 + acc[ai][bj][m][0], o1 = b1 + acc[ai][bj][m][1];
                    *(f32x4*)(out + off + 32 * bj) = o0; *(f32x4*)(out + off + 32 * bj + 4) = o1;
                    if (next) {
                        ss += (o0[0] * o0[0] + o0[1] * o0[1]) + (o0[2] * o0[2] + o0[3] * o0[3]) + (o1[0] * o1[0] + o1[1] * o1[1]) + (o1[2] * o1[2] + o1[3] * o1[3]);
                        u32x4 w; w.x = pkh(o0[0], o0[1]); w.y = pkh(o0[2], o0[3]); w.z = pkh(o1[0], o1[1]); w.w = pkh(o1[2], o1[3]);
                        *(u32x4*)(xb + off + 32 * bj) = w;
                    }
                }
                if (next) {
                    ss += __shfl_xor(ss, 16); ss += __shfl_xor(ss, 32);
                    if (fq == 0) part[(size_t)row * 16 + u.pn * 4 + wc] = ss;
                }
            }
    }
};

template <class Epi>
__device__ __forceinline__ void gemm_phase(LAS unsigned char* lds, const Gemm g, const StaticOrder& S, const Epi& E) {
    int tid_ = threadIdx.x; asm volatile("" : "+v"(tid_));
    const int tid = tid_, wid = __builtin_amdgcn_readfirstlane(tid >> 6), lane = tid & 63, wr = wid >> 2, wc = wid & 3, fr = lane & 15, fq = lane >> 4;
    const int K = g.K, nt = K / BK;
    unsigned voffA[2], voffB[2];
#pragma unroll
    for (int i = 0; i < 2; ++i) { int R, C; stage_rc(tid * 16 + i * 8192, R, C);
        const int Rb = (R >> 5) * 64 + perm32(R & 31);
        voffA[i] = (unsigned)(R * K + C) * 2u; voffB[i] = (unsigned)(Rb * K + C) * 2u; }
    const size_t kstep = (size_t)(BK * 2);
    const size_t hstep = (size_t)HALF * K * 2;
    const size_t hstepB = (size_t)32 * K * 2;
    const size_t tstep = 2 * hstep;
    const unsigned ldsw = (unsigned)wid * 1024u;
    const int aoff = lds_byte(wr * 64 + fr, fq * 8), boff = lds_byte(wc * 32 + fr, fq * 8);
#define PG8_SA(b, h) (((b) * 2 + (h)) * HTB)
#define PG8_SB(b, h) ((4 + (b) * 2 + (h)) * HTB)
#define PG8_STAGE(bufoff, gbase, voff) do { _Pragma("unroll") for (int _i = 0; _i < 2; ++_i) \
        __builtin_amdgcn_global_load_lds((const unsigned*)((const char*)(gbase) + (voff)[_i]), (LAS unsigned*)(lds + (bufoff) + ldsw + _i * 8192), 16, 0, 0); } while (0)
#define PG8_LDA(dst, b, h) do { _Pragma("unroll") for (int m = 0; m < 4; ++m) _Pragma("unroll") for (int k = 0; k < 2; ++k) dst[m][k] = *(const LAS h8*)(lds + PG8_SA(b, h) + aoff + m * 2048 + k * 1024); } while (0)
#define PG8_LDB(dst, b, h) do { _Pragma("unroll") for (int n = 0; n < 2; ++n) _Pragma("unroll") for (int k = 0; k < 2; ++k) dst[n][k] = *(const LAS h8*)(lds + PG8_SB(b, h) + boff + n * 2048 + k * 1024); } while (0)
#define PG8_MMA(ai, bj, At, Bt) do { __builtin_amdgcn_s_setprio(1); _Pragma("unroll") for (int m = 0; m < 4; ++m) _Pragma("unroll") for (int n = 0; n < 2; ++n) _Pragma("unroll") for (int k = 0; k < 2; ++k) \
        acc[ai][bj][m][n] = __builtin_amdgcn_mfma_f32_16x16x32_f16(Bt[n][k], At[m][k], acc[ai][bj][m][n], 0, 0, 0); __builtin_amdgcn_s_setprio(0); } while (0)
#define PG8_WAIT_V(n) asm volatile("s_waitcnt vmcnt(" #n ")" ::: "memory")
#define PG8_WAIT_L(n) asm volatile("s_waitcnt lgkmcnt(" #n ")" ::: "memory")
#define PG8_BAR __builtin_amdgcn_s_barrier()
#define PG8_SCHED __builtin_amdgcn_sched_barrier(0)
    Unit cur, nxt; int ui = 0;
    if (!S.next(0, cur)) return;
    f32x4 acc[2][2][4][2];
#pragma unroll
    for (int a = 0; a < 2; ++a)
#pragma unroll
        for (int b = 0; b < 2; ++b)
#pragma unroll
            for (int m = 0; m < 4; ++m)
#pragma unroll
                for (int n = 0; n < 2; ++n) acc[a][b][m][n] = (f32x4){0.f, 0.f, 0.f, 0.f};
    h8 At[4][2], B0[2][2], B1[2][2];
    const char* cA = (const char*)g.A + (size_t)cur.pm * tstep; const char* cB = (const char*)g.Bt + (size_t)cur.pn * tstep;
    PG8_STAGE(PG8_SB(0, 0), cB, voffB); PG8_STAGE(PG8_SB(0, 1), cB + hstepB, voffB); PG8_STAGE(PG8_SA(0, 0), cA, voffA); PG8_STAGE(PG8_SA(0, 1), cA + hstep, voffA);
    if (wr == 1) PG8_BAR;
    PG8_WAIT_V(2); PG8_BAR;
    PG8_STAGE(PG8_SB(1, 0), cB + kstep, voffB); PG8_STAGE(PG8_SA(1, 0), cA + kstep, voffA); PG8_STAGE(PG8_SB(1, 1), cB + hstepB + kstep, voffB);
    PG8_WAIT_V(6); PG8_BAR;
    for (;;) {
        const bool has_next = S.next(ui + 1, nxt);
        const char* nA = has_next ? (const char*)g.A + (size_t)nxt.pm * tstep : cA; const char* nB = has_next ? (const char*)g.Bt + (size_t)nxt.pn * tstep : cB;
        for (int t = 0; t < nt; t += 2) {
            const bool last = (t == nt - 2);
            const char* a1 = cA + (size_t)(t + 1) * kstep;
            const char* a2 = last ? nA : cA + (size_t)(t + 2) * kstep; const char* b2 = last ? nB : cB + (size_t)(t + 2) * kstep;
            const char* a3 = a2 + kstep; const char* b3 = b2 + kstep;
            PG8_LDB(B0, 0, 0); PG8_LDB(B1, 0, 1); PG8_SCHED; PG8_LDA(At, 0, 0); PG8_STAGE(PG8_SA(1, 1), a1 + hstep, voffA);
            PG8_WAIT_V(8); PG8_WAIT_L(0); PG8_BAR; PG8_MMA(0, 0, At, B0); PG8_MMA(0, 1, At, B1); PG8_BAR; PG8_SCHED;
            PG8_LDA(At, 0, 1); PG8_STAGE(PG8_SB(0, 0), b2, voffB); PG8_STAGE(PG8_SB(0, 1), b2 + hstepB, voffB); PG8_STAGE(PG8_SA(0, 0), a2, voffA);
            PG8_WAIT_V(8); PG8_WAIT_L(0); PG8_BAR; PG8_MMA(1, 0, At, B0); PG8_MMA(1, 1, At, B1); PG8_BAR; PG8_SCHED;
            PG8_LDB(B0, 1, 0); PG8_LDB(B1, 1, 1); PG8_SCHED; PG8_LDA(At, 1, 0); PG8_STAGE(PG8_SA(0, 1), a2 + hstep, voffA);
            PG8_WAIT_V(8); PG8_WAIT_L(0); PG8_BAR; PG8_MMA(0, 0, At, B0); PG8_MMA(0, 1, At, B1); PG8_BAR; PG8_SCHED;
            PG8_LDA(At, 1, 1); PG8_STAGE(PG8_SB(1, 0), b3, voffB); PG8_STAGE(PG8_SB(1, 1), b3 + hstepB, voffB); PG8_STAGE(PG8_SA(1, 0), a3, voffA);
            PG8_WAIT_V(8); PG8_WAIT_L(0); PG8_BAR; PG8_MMA(1, 0, At, B0); PG8_MMA(1, 1, At, B1); PG8_BAR; PG8_SCHED;
        }
        if (wr == 0) PG8_BAR;
        E(acc, cur, wr, wc, fr, fq);
        if (!has_next) break;
#pragma unroll
        for (int a = 0; a < 2; ++a)
#pragma unroll
            for (int b = 0; b < 2; ++b)
#pragma unroll
                for (int m = 0; m < 4; ++m)
#pragma unroll
                    for (int n = 0; n < 2; ++n) acc[a][b][m][n] = (f32x4){0.f, 0.f, 0.f, 0.f};
        cur = nxt; cA = nA; cB = nB; ++ui;
        if (wr == 1) PG8_BAR;
    }
    PG8_WAIT_V(0);
    PG8_BAR;
#undef PG8_SA
#undef PG8_SB
#undef PG8_STAGE
#undef PG8_LDA
#undef PG8_LDB
#undef PG8_MMA
#undef PG8_WAIT_V
#undef PG8_WAIT_L
#undef PG8_BAR
#undef PG8_SCHED
}
}

namespace att {
typedef short v4i16_t __attribute__((ext_vector_type(4)));
__device__ __forceinline__ int crow(int r, int hi) { return (r & 3) + 8 * (r >> 2) + 4 * hi; }
__device__ __forceinline__ int keyrow(int i) { return 32 * ((i >> 2) & 1) + (i & 3) + 4 * (i >> 3); }
__device__ __forceinline__ h4 vtr(const LAS unsigned char* p) { return __builtin_bit_cast(h4, __builtin_amdgcn_ds_read_tr16_b64_v4i16((LAS v4i16_t*)p)); }
__device__ __forceinline__ h8 cat8(h4 a, h4 b) { return (h8){a[0], a[1], a[2], a[3], b[0], b[1], b[2], b[3]}; }
#define MFMA32(a, b, c) __builtin_amdgcn_mfma_f32_32x32x16_f16(a, b, c, 0, 0, 0)
__device__ __forceinline__ h8 pack8(const f32x16& p, int b) {
    u32x4 w; w.x = pkh_rtz(p[b], p[b + 1]); w.y = pkh_rtz(p[b + 2], p[b + 3]); w.z = pkh_rtz(p[b + 4], p[b + 5]); w.w = pkh_rtz(p[b + 6], p[b + 7]);
    return __builtin_bit_cast(h8, w);
}
__device__ __forceinline__ float wave_sum(float v) {
#pragma unroll
    for (int o = 1; o < 64; o <<= 1) v += __shfl_xor(v, o);
    return v;
}
__device__ __forceinline__ float wave_max(float v) {
#pragma unroll
    for (int o = 1; o < 64; o <<= 1) v = fmaxf(v, __shfl_xor(v, o));
    return v;
}

constexpr int SB_K = 0, SB_V = 16384, SB_FLG = 32768, SB_STG = 36864, SB_STG_W = 8704;
__device__ __forceinline__ void sb_unit(LAS unsigned char* lds, const f16* __restrict__ proj, f16* __restrict__ mixed, int b, int h, int qb) {
    int tid_ = threadIdx.x; asm volatile("" : "+v"(tid_));
    const int tid = tid_, lane = tid & 63, l31 = lane & 31, hi = lane >> 5; const int w = __builtin_amdgcn_readfirstlane(tid >> 6);
    const size_t rowbase = (size_t)b * SEQ;
    const int q0 = qb * 256, qw = q0 + 32 * w, t = qw + l31, diag = qw >> 6, kt_hi = (q0 + 255) >> 6;
    const f16* Qg = proj + (rowbase + qw + l31) * PW + C_SBQ + h * 64 + 8 * hi;
    const f16* ksrc = proj + (rowbase + lane) * PW + C_SBK + h * 64 + w * 8;
    const f16* vsrc = proj + (rowbase + 16 * (w & 3) + (lane >> 2)) * PW + C_SBV + h * 64 + (w >> 2) * 32 + (lane & 3) * 8;
    const int sdst = w * 1024 + lane * 16;
    const int kbase = hi * 1024 + keyrow(l31) * 16;
    const int vbase = (32 * hi + ((lane & 15) >> 2)) * 64 + ((lane >> 4) & 1) * 32 + (lane & 3) * 8;
    h8 qr[4];
#pragma unroll
    for (int d0 = 0; d0 < 4; ++d0) qr[d0] = *(const h8*)(Qg + 16 * d0);
    f32x16 o[2]; o[0] = f32x16{}; o[1] = f32x16{};
    float carry = 1.f; int done = 0;
    int kt = kt_hi, cur = 0, it = 0;
    LAS unsigned* flags = (LAS unsigned*)(lds + SB_FLG);
    {
        const u32x4 kreg = *(const u32x4*)(ksrc + (size_t)kt * 64 * PW), vreg = *(const u32x4*)(vsrc + (size_t)kt * 64 * PW);
        *(LAS u32x4*)(lds + SB_K + sdst) = kreg; *(LAS u32x4*)(lds + SB_V + sdst) = vreg;
    }
    __syncthreads();
    for (;;) {
        const bool has_next = kt > 0;
        u32x4 kreg, vreg;
        if (has_next) { kreg = *(const u32x4*)(ksrc + (size_t)(kt - 1) * 64 * PW); vreg = *(const u32x4*)(vsrc + (size_t)(kt - 1) * 64 * PW); }
        if (kt <= diag && !done) {
            const LAS unsigned char* Kb = lds + SB_K + cur * 8192 + kbase; const LAS unsigned char* Vb = lds + SB_V + cur * 8192 + vbase;
            f32x16 p0 = f32x16{}, p1 = f32x16{};
#pragma unroll
            for (int d0 = 0; d0 < 4; ++d0) { const h8 k0 = *(const LAS h8*)(Kb + d0 * 2048), k1 = *(const LAS h8*)(Kb + d0 * 2048 + 256); p0 = MFMA32(k0, qr[d0], p0); p1 = MFMA32(k1, qr[d0], p1); }
#pragma unroll
            for (int r = 0; r < 16; ++r) { p0[r] = __builtin_amdgcn_rcpf(1.0f + __builtin_amdgcn_exp2f(-p0[r])); p1[r] = __builtin_amdgcn_rcpf(1.0f + __builtin_amdgcn_exp2f(-p1[r])); }
            if (kt == diag) {
                const int key0 = 64 * kt + 32 * hi;
#pragma unroll
                for (int r = 0; r < 16; ++r) { if (key0 + r >= t) p0[r] = 0.f; if (key0 + 16 + r >= t) p1[r] = 0.f; }
            }
            float run = 1.f;
#pragma unroll
            for (int r = 15; r >= 0; --r) { const float a = run * p1[r]; run -= a; p1[r] = a; }
#pragma unroll
            for (int r = 15; r >= 0; --r) { const float a = run * p0[r]; run -= a; p0[r] = a; }
            const auto rr = __builtin_amdgcn_permlane32_swap(__float_as_uint(run), __float_as_uint(run), false, false);
            const float T0 = __uint_as_float(rr[0]), T1 = __uint_as_float(rr[1]);
            const float E = carry * (hi ? 1.0f : T1);
            carry = carry * (T0 * T1);
#pragma unroll
            for (int r = 0; r < 16; ++r) { p0[r] *= E; p1[r] *= E; }
            const h8 pa0 = pack8(p0, 0), pa1 = pack8(p0, 8), pa2 = pack8(p1, 0), pa3 = pack8(p1, 8);
#pragma unroll
            for (int d0 = 0; d0 < 2; ++d0) {
                const h8 v0 = cat8(vtr(Vb + d0 * 4096), vtr(Vb + d0 * 4096 + 256));
                const h8 v1 = cat8(vtr(Vb + d0 * 4096 + 512), vtr(Vb + d0 * 4096 + 768));
                const h8 v2 = cat8(vtr(Vb + d0 * 4096 + 1024), vtr(Vb + d0 * 4096 + 1280));
                const h8 v3 = cat8(vtr(Vb + d0 * 4096 + 1536), vtr(Vb + d0 * 4096 + 1792));
                o[d0] = MFMA32(pa0, v0, o[d0]); o[d0] = MFMA32(pa1, v1, o[d0]); o[d0] = MFMA32(pa2, v2, o[d0]); o[d0] = MFMA32(pa3, v3, o[d0]);
            }
#if SB_EARLY_EXIT
            done = __builtin_amdgcn_readfirstlane(__all(carry < 1.0e-37f) ? 1 : 0);
#endif
        }
        if (has_next) { *(LAS u32x4*)(lds + SB_K + (cur ^ 1) * 8192 + sdst) = kreg; *(LAS u32x4*)(lds + SB_V + (cur ^ 1) * 8192 + sdst) = vreg; }
        if (lane == 0) flags[(it & 1) * 8 + w] = done ? 0u : 1u;
        __syncthreads();
        const u32x4 f0 = *(const LAS u32x4*)(flags + (it & 1) * 8), f1 = *(const LAS u32x4*)(flags + (it & 1) * 8 + 4);
        const unsigned any = (f0.x | f0.y | f0.z | f0.w) | (f1.x | f1.y | f1.z | f1.w);
        if (!has_next || !__builtin_amdgcn_readfirstlane(any)) break;
        --kt; cur ^= 1; ++it;
    }
    {
        LAS float* stg = (LAS float*)(lds + SB_STG + w * SB_STG_W);
#pragma unroll
        for (int d0 = 0; d0 < 2; ++d0)
#pragma unroll
            for (int r = 0; r < 16; ++r) stg[crow(r, hi) * 68 + 32 * d0 + l31] = o[d0][r];
        asm volatile("s_waitcnt lgkmcnt(0)" ::: "memory");
        const size_t grow = rowbase + qw + l31;
        const f16* Gp = proj + grow * PW + C_SBG + h * 64 + 32 * hi;
        f16* Op = mixed + grow * DM + h * 64 + 32 * hi;
#pragma unroll
        for (int i = 0; i < 4; ++i) {
            const f32x4 a = *(const LAS f32x4*)(stg + l31 * 68 + 32 * hi + 8 * i), c = *(const LAS f32x4*)(stg + l31 * 68 + 32 * hi + 8 * i + 4);
            const h8 g = *(const h8*)(Gp + 8 * i);
            u32x4 wv; wv.x = pkh(a[0] * (float)g[0], a[1] * (float)g[1]); wv.y = pkh(a[2] * (float)g[2], a[3] * (float)g[3]);
            wv.z = pkh(c[0] * (float)g[4], c[1] * (float)g[5]); wv.w = pkh(c[2] * (float)g[6], c[3] * (float)g[7]);
            *(u32x4*)(Op + 8 * i) = wv;
        }
    }
    __syncthreads();
}

constexpr int DA_K = 0, DA_V = 32768, DA_STG = 0, DA_STG_W = 16896, DA_LSC = 67584;
__device__ __forceinline__ void da_unit(LAS unsigned char* lds, const f16* __restrict__ proj, f16* __restrict__ mixed, int b, int h, int qt,
                                        float lam, float mref, float cslope, const float* __restrict__ subg, float osc) {
    int tid_ = threadIdx.x; asm volatile("" : "+v"(tid_));
    const int tid = tid_, lane = tid & 63, l31 = lane & 31, hi = lane >> 5; const int w = __builtin_amdgcn_readfirstlane(tid >> 6);
    const int c = w >> 2, rg = w & 3;
    const size_t rowbase = (size_t)b * SEQ;
    const int qw = qt * 128 + 32 * rg, t = qw + l31, lastt = qw >> 6, NT = 2 * qt + 2;
    const f16* Qg = proj + (rowbase + qw + l31) * PW + C_DAQ + h * 128 + c * 64 + 8 * hi;
    const f16* ksrc = proj + (rowbase + lane) * PW + C_DAK + h * 128 + w * 8;
    const f16* vsrc = proj + (rowbase + 16 * (w & 3) + (lane >> 2)) * PW + C_DAV + h * 128 + (w >> 2) * 32 + (lane & 3) * 8;
    const int sdst = w * 1024 + lane * 16;
    const int kbase = (8 * c + hi) * 1024 + keyrow(l31) * 16;
    const int vbase = (32 * hi + ((lane & 15) >> 2)) * 64 + ((lane >> 4) & 1) * 32 + (lane & 3) * 8;
    h8 qr[4];
#pragma unroll
    for (int d0 = 0; d0 < 4; ++d0) qr[d0] = *(const h8*)(Qg + 16 * d0);
    f32x16 o[4]; o[0] = f32x16{}; o[1] = f32x16{}; o[2] = f32x16{}; o[3] = f32x16{};
    float lsum = 0.f;
    {
        const u32x4 k0 = *(const u32x4*)(ksrc), k1 = *(const u32x4*)(ksrc + 64), v0 = *(const u32x4*)(vsrc), v1 = *(const u32x4*)(vsrc + 64);
        *(LAS u32x4*)(lds + DA_K + sdst) = k0; *(LAS u32x4*)(lds + DA_K + 8192 + sdst) = k1; *(LAS u32x4*)(lds + DA_V + sdst) = v0; *(LAS u32x4*)(lds + DA_V + 8192 + sdst) = v1;
    }
    __syncthreads();
    int cur = 0;
    for (int kt = 0; kt < NT; ++kt) {
        const bool has_next = kt + 1 < NT;
        u32x4 k0, k1, v0, v1;
        if (has_next) { const size_t go = (size_t)(kt + 1) * 64 * PW; k0 = *(const u32x4*)(ksrc + go); k1 = *(const u32x4*)(ksrc + go + 64); v0 = *(const u32x4*)(vsrc + go); v1 = *(const u32x4*)(vsrc + go + 64); }
        if (kt <= lastt) {
            const LAS unsigned char* Kb = lds + DA_K + cur * 16384 + kbase; const LAS unsigned char* Vb = lds + DA_V + cur * 16384 + vbase;
            const float d0f = (float)(t - (64 * kt + 32 * hi));
            f32x16 p0, p1;
#pragma unroll
            for (int r = 0; r < 16; ++r) { p0[r] = __builtin_fmaf(-cslope, __builtin_fabsf(d0f - (float)r), -mref); p1[r] = __builtin_fmaf(-cslope, __builtin_fabsf(d0f - (float)(16 + r)), -mref); }
#pragma unroll
            for (int d0 = 0; d0 < 4; ++d0) { const h8 ka = *(const LAS h8*)(Kb + d0 * 2048), kb = *(const LAS h8*)(Kb + d0 * 2048 + 256); p0 = MFMA32(ka, qr[d0], p0); p1 = MFMA32(kb, qr[d0], p1); }
            float s = 0.f;
#pragma unroll
            for (int r = 0; r < 16; ++r) { p0[r] = __builtin_amdgcn_exp2f(p0[r]); p1[r] = __builtin_amdgcn_exp2f(p1[r]); s += p0[r] + p1[r]; }
            lsum += s;
            const h8 pa0 = pack8(p0, 0), pa1 = pack8(p0, 8), pa2 = pack8(p1, 0), pa3 = pack8(p1, 8);
#pragma unroll
            for (int d0 = 0; d0 < 4; ++d0) {
                const h8 f0 = cat8(vtr(Vb + d0 * 4096), vtr(Vb + d0 * 4096 + 256));
                const h8 f1 = cat8(vtr(Vb + d0 * 4096 + 512), vtr(Vb + d0 * 4096 + 768));
                const h8 f2 = cat8(vtr(Vb + d0 * 4096 + 1024), vtr(Vb + d0 * 4096 + 1280));
                const h8 f3 = cat8(vtr(Vb + d0 * 4096 + 1536), vtr(Vb + d0 * 4096 + 1792));
                o[d0] = MFMA32(pa0, f0, o[d0]); o[d0] = MFMA32(pa1, f1, o[d0]); o[d0] = MFMA32(pa2, f2, o[d0]); o[d0] = MFMA32(pa3, f3, o[d0]);
            }
        }
        if (has_next) { const int nb = (cur ^ 1) * 16384; *(LAS u32x4*)(lds + DA_K + nb + sdst) = k0; *(LAS u32x4*)(lds + DA_K + nb + 8192 + sdst) = k1; *(LAS u32x4*)(lds + DA_V + nb + sdst) = v0; *(LAS u32x4*)(lds + DA_V + nb + 8192 + sdst) = v1; }
        __syncthreads();
        cur ^= 1;
    }
    { const auto rr = __builtin_amdgcn_permlane32_swap(__float_as_uint(lsum), __float_as_uint(lsum), false, false); lsum = __uint_as_float(rr[0]) + __uint_as_float(rr[1]); }
    LAS float* lsc = (LAS float*)(lds + DA_LSC);
    if (hi == 0) lsc[w * 32 + l31] = lsum;
    __syncthreads();
    LAS float* stg = (LAS float*)(lds + DA_STG + rg * DA_STG_W);
    if (c == 1) {
#pragma unroll
        for (int d0 = 0; d0 < 4; ++d0)
#pragma unroll
            for (int r = 0; r < 16; ++r) stg[crow(r, hi) * 132 + 32 * d0 + l31] = o[d0][r];
        asm volatile("s_waitcnt lgkmcnt(0)" ::: "memory");
        const float f = lam * lsc[rg * 32 + l31] / lsum;
#pragma unroll
        for (int i = 0; i < 16; ++i) { LAS f32x4* p = (LAS f32x4*)(stg + l31 * 132 + 64 * hi + 4 * i); f32x4 v = *p; v = v * f; *p = v; }
    }
    __syncthreads();
    if (c == 0) {
#pragma unroll
        for (int d0 = 0; d0 < 4; ++d0)
#pragma unroll
            for (int r = 0; r < 16; ++r) { LAS float* p = stg + crow(r, hi) * 132 + 32 * d0 + l31; *p = o[d0][r] - *p; }
        asm volatile("s_waitcnt lgkmcnt(0)" ::: "memory");
        float ss = 0.f;
#pragma unroll
        for (int i = 0; i < 16; ++i) { const f32x4 v = *(const LAS f32x4*)(stg + l31 * 132 + 64 * hi + 4 * i); ss += (v[0] * v[0] + v[1] * v[1]) + (v[2] * v[2] + v[3] * v[3]); }
        { const auto rr = __builtin_amdgcn_permlane32_swap(__float_as_uint(ss), __float_as_uint(ss), false, false); ss = __uint_as_float(rr[0]) + __uint_as_float(rr[1]); }
        const float il = 1.0f / lsum;
        const float rn = __builtin_amdgcn_rsqf(ss * (1.0f / 128.0f) * il * il + RMS_EPS) * il * osc;
        const size_t grow = rowbase + qw + l31;
        const f16* Gp = proj + grow * PW + C_DAG + h * 128 + 64 * hi;
        f16* Op = mixed + grow * DM + 512 + h * 128 + 64 * hi;
        const float* sg = subg + 64 * hi;
#pragma unroll
        for (int i = 0; i < 8; ++i) {
            const f32x4 a = *(const LAS f32x4*)(stg + l31 * 132 + 64 * hi + 8 * i), cc = *(const LAS f32x4*)(stg + l31 * 132 + 64 * hi + 8 * i + 4);
            const f32x4 ga = *(const f32x4*)(sg + 8 * i), gb = *(const f32x4*)(sg + 8 * i + 4);
            const h8 g = *(const h8*)(Gp + 8 * i);
            u32x4 wv;
            wv.x = pkh(a[0] * rn * ga[0] * (float)g[0], a[1] * rn * ga[1] * (float)g[1]); wv.y = pkh(a[2] * rn * ga[2] * (float)g[2], a[3] * rn * ga[3] * (float)g[3]);
            wv.z = pkh(cc[0] * rn * gb[0] * (float)g[4], cc[1] * rn * gb[1] * (float)g[5]); wv.w = pkh(cc[2] * rn * gb[2] * (float)g[6], cc[3] * rn * gb[3] * (float)g[7]);
            *(u32x4*)(Op + 8 * i) = wv;
        }
    }
    __syncthreads();
}
}

constexpr size_t MiB = 1u << 20;
constexpr size_t WS_CTL = 0, CTL_ZERO_BYTES = 64 * 1024;
constexpr size_t WS_WIN = 2 * MiB;
constexpr size_t WS_WOUT = 18 * MiB;
constexpr size_t WS_PART = 22 * MiB;
constexpr size_t WS_XB = 32 * MiB;
constexpr size_t WS_MIX = 96 * MiB;
constexpr size_t WS_PROJ = 160 * MiB;
constexpr size_t WS_END = 416 * MiB;
constexpr int CW_BAR = 4096;

constexpr int RING_OFF = 0, RING_BYTES = 131072;
constexpr int LDSCTL_OFF = RING_BYTES, MISC_OFF = LDSCTL_OFF + 320;
constexpr int LDS_BYTES = 147456;
constexpr int NWAVES = 8;

typedef GAS unsigned gu32;
#define LDS_WAIT() asm volatile("s_waitcnt lgkmcnt(0)" ::: "memory")

#define XB_TMO      128
#define XB_XCNT(j)  (256  + 64 * (j))
#define XB_XSUB(j)  (1280 + 64 * (j))
#define XB_XGEN(j)  (2304 + 64 * (j))
#define XB_TOP      3328
#define XB_TOPGEN   3392
#define XCD_BAR_WORDS 3456
#define XB_SPIN_CAP (1u << 18)
__device__ __forceinline__ unsigned xb_ld(unsigned* p)              { return __hip_atomic_load(p, __ATOMIC_RELAXED, __HIP_MEMORY_SCOPE_AGENT); }
__device__ __forceinline__ unsigned xb_add(unsigned* p, unsigned v) { return __hip_atomic_fetch_add(p, v, __ATOMIC_RELAXED, __HIP_MEMORY_SCOPE_AGENT); }
__device__ __forceinline__ unsigned xb_xcc_id() { return (unsigned)__builtin_amdgcn_s_getreg((3 << 11) | 20) & 0xFu; }
#define XB_SPIN(cond, bar) do { unsigned _sp = 0; while (cond) { __builtin_amdgcn_s_sleep(1); \
    if ((++_sp & 255u) == 0u) { if (xb_ld(&(bar)[XB_TMO])) break; if (_sp > XB_SPIN_CAP) { atomicAdd(&(bar)[XB_TMO], 1u); break; } } } } while (0)
struct XcdBarrier { unsigned* bar; unsigned x; volatile LAS unsigned* st; };
__device__ __forceinline__ XcdBarrier xcd_barrier_post(unsigned* bar, volatile LAS unsigned* st) {
    XcdBarrier b; b.bar = bar; b.x = xb_xcc_id(); b.st = st;
    if (threadIdx.x == 0) (void)xb_add(&bar[XB_XCNT(b.x)], 1u);
    return b;
}
__device__ __forceinline__ void xcd_barrier_complete(unsigned* bar, unsigned x, unsigned& nloc, unsigned& nx) {
    const unsigned G = gridDim.x * gridDim.y * gridDim.z;
    unsigned sum, cnt, mine, sp = 0u;
    for (;;) {
        sum = 0u; cnt = 0u; mine = 0u;
#pragma unroll
        for (unsigned j = 0; j < 16; ++j) { const unsigned c = xb_ld(&bar[XB_XCNT(j)]); sum += c; cnt += (c > 0u) ? 1u : 0u; mine = (j == x) ? c : mine; }
        if (sum == G) break;
        __builtin_amdgcn_s_sleep(1);
        if ((++sp & 255u) == 0u) { if (xb_ld(&bar[XB_TMO])) break; if (sp > XB_SPIN_CAP) { atomicAdd(&bar[XB_TMO], 1u); break; } }
    }
    nloc = mine > 0u ? mine : 1u; nx = cnt > 0u ? cnt : 1u;
}
__device__ __forceinline__ void xcd_barrier(const XcdBarrier& b) {
    asm volatile("s_waitcnt vmcnt(0)" ::: "memory");
    __syncthreads();
    if (threadIdx.x == 0) {
        unsigned* bar = b.bar;
        __builtin_amdgcn_s_waitcnt(0);
        unsigned nloc = b.st[0], nx = b.st[1];
        if (nloc == 0u) { xcd_barrier_complete(bar, b.x, nloc, nx); b.st[0] = nloc; b.st[1] = nx; }
        const unsigned old = xb_add(&bar[XB_XSUB(b.x)], 1u);
        const unsigned gen = old / nloc;
        if (old + 1u == (gen + 1u) * nloc) {
            __builtin_amdgcn_fence(__ATOMIC_RELEASE, "agent");
            asm volatile("s_waitcnt vmcnt(0)" ::: "memory");
            const unsigned og = xb_add(&bar[XB_TOP], 1u);
            const unsigned tg = og / nx;
            if (og + 1u == (tg + 1u) * nx) xb_add(&bar[XB_TOPGEN], 1u);
            else XB_SPIN(xb_ld(&bar[XB_TOPGEN]) == tg, bar);
            __builtin_amdgcn_fence(__ATOMIC_ACQUIRE, "agent");
            xb_add(&bar[XB_XGEN(b.x)], 1u);
            asm volatile("s_waitcnt vmcnt(0)" ::: "memory");
        } else {
            XB_SPIN(xb_ld(&bar[XB_XGEN(b.x)]) == gen, bar);
            __builtin_amdgcn_fence(__ATOMIC_ACQUIRE, "agent");
            asm volatile("s_waitcnt vmcnt(0)" ::: "memory");
        }
    }
    __syncthreads();
}

__device__ __forceinline__ void p0_transpose_item(const float* W, const float* g, int K, int N, f16* WT, LAS float* scr, int item, int lane) {
    const int nblk = N / 32, kb = item / nblk, nb = item % nblk, k0 = 64 * kb, n0 = 32 * nb;
#pragma unroll 8
    for (int i = 0; i < 32; ++i) { const int kk = 2 * i + (lane >> 5); const float gg = g ? g[k0 + kk] : 1.0f; scr[kk * 33 + (lane & 31)] = W[(size_t)(k0 + kk) * N + n0 + (lane & 31)] * gg; }
    LDS_WAIT(); asm volatile("" ::: "memory");
    const int c = lane & 7;
#pragma unroll
    for (int j = 0; j < 4; ++j) { const int n = (lane >> 3) + 8 * j; const LAS float* s = scr + (8 * c) * 33 + n;
        u32x4 o; o.x = pkh(s[0 * 33], s[1 * 33]); o.y = pkh(s[2 * 33], s[3 * 33]); o.z = pkh(s[4 * 33], s[5 * 33]); o.w = pkh(s[6 * 33], s[7 * 33]);
        *(GAS u32x4*)(WT + (size_t)(n0 + n) * K + k0 + 8 * c) = o; }
    LDS_WAIT(); asm volatile("" ::: "memory");
}
__device__ __forceinline__ void x_row(const float* xrow, f16* orow, float* prow, int lane) {
    const GAS f32x4* xr = (const GAS f32x4*)xrow + lane;
    f32x4 v[4]; float s = 0.f;
#pragma unroll
    for (int j = 0; j < 4; ++j) { v[j] = xr[64 * j]; s += (v[j][0] * v[j][0] + v[j][1] * v[j][1]) + (v[j][2] * v[j][2] + v[j][3] * v[j][3]); }
    s = att::wave_sum(s);
    GAS u32x2* o8 = (GAS u32x2*)orow + lane;
#pragma unroll
    for (int j = 0; j < 4; ++j) { u32x2 w; w.x = pkh(v[j][0], v[j][1]); w.y = pkh(v[j][2], v[j][3]); o8[64 * j] = w; }
    if (lane < 16) prow[lane] = (lane == 0) ? s : 0.f;
}

struct Args { const float* in[11]; float* out; unsigned char* ws; };
__global__ void __launch_bounds__(NWAVES * 64, 2) hybrid_fwd(Args args) {
    extern __shared__ __attribute__((aligned(16))) unsigned char lds_raw[];
    LAS unsigned char* lds = (LAS unsigned char*)lds_raw;
    volatile LAS unsigned* MISC = (volatile LAS unsigned*)(lds + MISC_OFF);
    const int tid = threadIdx.x, lane = tid & 63, wave = __builtin_amdgcn_readfirstlane(tid >> 6);
    const int G = gridDim.x; const int bx = blockIdx.x; const int vcu = (G % 8 == 0) ? (bx % 8) * (G / 8) + bx / 8 : bx;
    unsigned char* ws = args.ws;
    gu32* ctl = (gu32*)(ws + WS_CTL);
    const float* x = args.in[0]; const float* norm_g = args.in[1]; const float* w_in = args.in[2]; const float* w_out = args.in[3];
    const float* q_norm_g = args.in[4]; const float* k_norm_g = args.in[5];
    const float* lq1 = args.in[6]; const float* lk1 = args.in[7]; const float* lq2 = args.in[8]; const float* lk2 = args.in[9]; const float* subln_g = args.in[10];
    float* out = args.out;
    f16* WIN = (f16*)(ws + WS_WIN); f16* WOUT = (f16*)(ws + WS_WOUT); float* PART = (float*)(ws + WS_PART);
    f16* XB = (f16*)(ws + WS_XB); f16* MIX = (f16*)(ws + WS_MIX); f16* PROJ = (f16*)(ws + WS_PROJ);

    for (int u = tid; u < (LDS_BYTES - LDSCTL_OFF) / 4; u += NWAVES * 64) ((LAS unsigned*)(lds + LDSCTL_OFF))[u] = 0u;
    __syncthreads();
    XcdBarrier bar = xcd_barrier_post((unsigned*)(ctl + CW_BAR), MISC + 8);

    {
        LAS float* scr = (LAS float*)(lds + RING_OFF + wave * 16384);
        const int gw = vcu * NWAVES + wave, NGW = G * NWAVES;
        constexpr int I_IN = (DM / 64) * (PW / 32), I_OUT = (DM / 64) * (DM / 32);
        constexpr int NITEMS = DEPTH * (I_IN + I_OUT);
        for (int it = gw; it < NITEMS; it += NGW) {
            int r = it; const int l = r / (I_IN + I_OUT); r -= l * (I_IN + I_OUT);
            if (r < I_IN) p0_transpose_item(w_in + (size_t)l * DM * PW, norm_g + l * DM, DM, PW, WIN + (size_t)l * PW * DM, scr, r, lane);
            else p0_transpose_item(w_out + (size_t)l * DM * DM, nullptr, DM, DM, WOUT + (size_t)l * DM * DM, scr, r - I_IN, lane);
        }
        for (int m = gw; m < MROWS; m += NGW) x_row(x + (size_t)m * DM, XB + (size_t)m * DM, PART + (size_t)m * 16, lane);
    }
    xcd_barrier(bar);

    for (int l = 0; l < DEPTH; ++l) {
        { unsigned char* wsl = ws; asm volatile("" : "+s"(wsl)); WIN = (f16*)(wsl + WS_WIN); WOUT = (f16*)(wsl + WS_WOUT); PART = (float*)(wsl + WS_PART); XB = (f16*)(wsl + WS_XB); MIX = (f16*)(wsl + WS_MIX); PROJ = (f16*)(wsl + WS_PROJ);
          asm volatile("" : "+s"(out)); asm volatile("" : "+s"(x)); asm volatile("" : "+s"(subln_g)); asm volatile("" : "+s"(q_norm_g)); asm volatile("" : "+s"(k_norm_g)); asm volatile("" : "+s"(bar.bar)); }
        {
            pg8::Gemm g{XB, WIN + (size_t)l * PW * DM, MROWS, PW, DM}; pg8::StaticOrder S; S.init(MROWS, PW, G, bx);
            pg8::EpiProj E{PROJ, PART, q_norm_g + l * 64, k_norm_g + l * 64};
            pg8::gemm_phase<pg8::EpiProj>(lds + RING_OFF, g, S, E);
        }
        xcd_barrier(bar);
        {
            const float sa = att::wave_sum(lq1[l * 64 + lane] * lk1[l * 64 + lane]), sb = att::wave_sum(lq2[l * 64 + lane] * lk2[l * 64 + lane]);
            const float lam_init = 0.8f - 0.6f * __expf(-0.3f * (float)l);
            const float lam = __expf(sa) - __expf(sb) + lam_init;
            const float mgq = att::wave_max(fabsf(q_norm_g[l * 64 + lane])), mgk = att::wave_max(fabsf(k_norm_g[l * 64 + lane]));
            const float mref = 8.0f * LOG2E * mgq * mgk * 1.001f - 10.0f;
            for (int u = vcu; u < 1024; u += G) {
                const int i = u >> 8, v = u & 255, bh = v >> 2, j = v & 3;
                const int qt = (i == 0) ? j : (i == 1) ? 7 - j : (i == 2) ? 8 + j : 15 - j;
                const int hh = bh & 3;
                const float cslope = exp2f(-2.0f * (float)(hh + 1)) * LOG2E;
                att::da_unit(lds + RING_OFF, PROJ, MIX, bh >> 2, hh, qt, lam, mref, cslope, subln_g + l * 128, 1.0f - lam_init);
            }
            for (int u = vcu; u < 1024; u += G) {
                const int i = u >> 8, v = u & 255, bh = v >> 1, j = v & 1;
                const int qb = (i == 0) ? j : (i == 1) ? 3 - j : (i == 2) ? 4 + j : 7 - j;
                att::sb_unit(lds + RING_OFF, PROJ, MIX, bh >> 3, bh & 7, qb);
            }
        }
        xcd_barrier(bar);
        {
            pg8::Gemm g{MIX, WOUT + (size_t)l * DM * DM, MROWS, DM, DM}; pg8::StaticOrder S; S.init(MROWS, DM, G, bx);
            pg8::EpiOut E{(l == 0) ? x : (const float*)out, out, XB, PART, (l + 1 < DEPTH) ? 1 : 0};
            pg8::gemm_phase<pg8::EpiOut>(lds + RING_OFF, g, S, E);
        }
        if (l + 1 < DEPTH) xcd_barrier(bar);
    }
}

extern "C" void kernel_launch(void* const* d_in, const int* in_sizes, int n_in, void* d_out, int out_size, void* d_ws, size_t ws_size, hipStream_t stream) {
    static int grid = 0;
    if (grid == 0) {
        if (n_in != 11 || in_sizes[0] != MROWS * DM || out_size != MROWS * DM || ws_size < WS_END) {
            fprintf(stderr, "kernel_launch: unexpected problem shape (n_in %d, in0 %d, out %d, ws %zu); nothing launched\n", n_in, n_in > 0 ? in_sizes[0] : -1, out_size, ws_size); grid = -1; return; }
        int dev = 0, cus = 0, per_cu = 0;
        if (hipGetDevice(&dev) != hipSuccess || hipDeviceGetAttribute(&cus, hipDeviceAttributeMultiprocessorCount, dev) != hipSuccess) { grid = -1; return; }
        if (hipFuncSetAttribute((const void*)hybrid_fwd, hipFuncAttributeMaxDynamicSharedMemorySize, LDS_BYTES) != hipSuccess) { fprintf(stderr, "kernel_launch: hipFuncSetAttribute failed\n"); grid = -1; return; }
        if (hipOccupancyMaxActiveBlocksPerMultiprocessor(&per_cu, (const void*)hybrid_fwd, NWAVES * 64, LDS_BYTES) != hipSuccess || per_cu < 1) {
            fprintf(stderr, "kernel_launch: occupancy query reports %d workgroups per CU; nothing launched\n", per_cu); (void)hipGetLastError(); grid = -1; return; }
        grid = cus;
    }
    if (grid < 0) return;
    if (hipMemsetAsync((char*)d_ws + WS_CTL, 0, CTL_ZERO_BYTES, stream) != hipSuccess) { fprintf(stderr, "kernel_launch: hipMemsetAsync failed\n"); return; }
    Args a{};
    for (int i = 0; i < 11; ++i) a.in[i] = (const float*)d_in[i];
    a.out = (float*)d_out; a.ws = (unsigned char*)d_ws;
    hipLaunchKernelGGL(hybrid_fwd, dim3(grid), dim3(NWAVES * 64), LDS_BYTES, stream, a);
    const hipError_t le = hipPeekAtLastError();
    if (le != hipSuccess) fprintf(stderr, "kernel_launch: launch failed: %s\n", hipGetErrorName(le));
}
```

```cpp
#include <hip/hip_runtime.h>
#include <cstdio>
#include <cstdint>

#ifndef SB_EARLY_EXIT
#define SB_EARLY_EXIT 1
#endif
#define SW_ID 0
#define SW_K 4
#define REP_PRO 1
#define REP_G1 1
#define REP_DA 1
#define REP_SB 1
#define REP_G2 1

#if SW_ID
#define SW_BEGIN(id) unsigned long long sw_t0_##id = 0; if (SW_ID == (id)) sw_t0_##id = __builtin_amdgcn_s_memtime()
#define SW_END(id) do { if (SW_ID == (id)) sw_acc += __builtin_amdgcn_s_memtime() - sw_t0_##id; } while (0)
#else
#define SW_BEGIN(id) do {} while (0)
#define SW_END(id) do {} while (0)
#endif
#define LAS __attribute__((address_space(3)))
#define GAS __attribute__((address_space(1)))
typedef _Float16 f16;
typedef _Float16 h8 __attribute__((ext_vector_type(8)));
typedef _Float16 h4 __attribute__((ext_vector_type(4)));
typedef _Float16 h2 __attribute__((ext_vector_type(2)));
typedef float f32x4 __attribute__((ext_vector_type(4)));
typedef float f32x16 __attribute__((ext_vector_type(16)));
typedef unsigned u32x4 __attribute__((ext_vector_type(4)));
typedef unsigned u32x2 __attribute__((ext_vector_type(2)));

constexpr int BATCH = 16, SEQ = 2048, DM = 1024, MROWS = BATCH * SEQ, PW = 4096, DEPTH = 2;
constexpr float RMS_EPS = 1e-6f;
constexpr float LOG2E = 1.4426950408889634f;
constexpr float QS = 0.125f * LOG2E;
constexpr int C_SBQ = 0, C_SBK = 512, C_SBV = 1024, C_SBG = 1536, C_DAQ = 2048, C_DAK = 2560, C_DAV = 3072, C_DAG = 3584;

__device__ __forceinline__ unsigned pkh(float lo, float hi) { h2 v = {(f16)lo, (f16)hi}; return __builtin_bit_cast(unsigned, v); }
__device__ __forceinline__ unsigned pkh_rtz(float lo, float hi) { return __builtin_bit_cast(unsigned, __builtin_amdgcn_cvt_pkrtz(lo, hi)); }
__device__ __forceinline__ float silu_f(float v) { return v * __builtin_amdgcn_rcpf(1.0f + __builtin_amdgcn_exp2f(-v * LOG2E)); }

namespace pg8 {
constexpr int BM = 256, BK = 64, HALF = 128, HTB = HALF * BK * 2, STAGE_BYTES = 8 * HTB, NXCD = 8, WGM = 8;
__host__ __device__ __forceinline__ int lds_byte(int r, int c) { const int st = (r >> 4) * 2 + (c >> 5), rr = r & 15, cc = c & 31, ob = rr * 64 + cc * 2; return st * 1024 + (ob ^ (((ob >> 9) & 1) << 5)); }
__host__ __device__ __forceinline__ void stage_rc(int b, int& R, int& C) { const int st = b / 1024, sb = b % 1024, swz = sb ^ (((sb >> 9) & 1) << 5); R = (st >> 1) * 16 + swz / 64; C = (st & 1) * 32 + (swz % 64) / 2; }
__host__ __device__ __forceinline__ int perm32(int rho) { const int n = rho >> 4, i = rho & 15; return 8 * (i >> 2) + 4 * n + (i & 3); }

struct Unit { int pm, pn; };
struct Gemm { const f16* A; const f16* Bt; int M, N, K; };

struct StaticOrder {
    int nM, nN, nwg, G, c;
    __host__ __device__ void init(int M, int N, int G_, int c_) { nM = M / BM; nN = N / BM; nwg = nM * nN; G = G_; c = c_; }
    __host__ __device__ bool next(int i, Unit& u) const {
        const long L = (long)i * G + c; if (L >= nwg) return false;
        int wgid = (int)L; { const int q = nwg / NXCD, r = nwg % NXCD, xcd = wgid % NXCD, off = wgid / NXCD; wgid = (xcd < r ? xcd * (q + 1) : r * (q + 1) + (xcd - r) * q) + off; }
        const int nig = WGM * nN, gid = wgid / nig, fm = gid * WGM, gsz = (nM - fm) < WGM ? (nM - fm) : WGM;
        u.pm = fm + ((wgid % nig) % gsz); u.pn = (wgid % nig) / gsz; return true;
    }
};


struct EpiProj {
    f16* P; const float* part; const float* gq; const float* gk;
    __device__ __forceinline__ void operator()(const f32x4 (&acc)[2][2][4][2], const Unit& u, int wr, int wc, int fr, int fq) const {
        const int sec = u.pn >> 1;
        const int row0 = u.pm * BM + wr * 64 + fr;
        const int colw = u.pn * BM + wc * 64 + 8 * fq;
        f32x4 gain[2][2];
        if (sec == 4 || sec == 5) {
            const float* g = (sec == 4) ? gq : gk;
#pragma unroll
            for (int bj = 0; bj < 2; ++bj)
#pragma unroll
                for (int n = 0; n < 2; ++n) gain[bj][n] = *(const f32x4*)(g + 32 * bj + 8 * fq + 4 * n);
        }
#pragma unroll
        for (int ai = 0; ai < 2; ++ai)
#pragma unroll
            for (int m = 0; m < 4; ++m) {
                const int row = row0 + ai * HALF + m * 16;
                const f32x4 pv = *(const f32x4*)(part + (size_t)row * 16 + fq * 4);
                float s = (pv[0] + pv[1]) + (pv[2] + pv[3]);
                s += __shfl_xor(s, 16); s += __shfl_xor(s, 32);
                const float rs = __builtin_amdgcn_rsqf(s * (1.0f / DM) + RMS_EPS);
                f32x4 v[2][2];
#pragma unroll
                for (int bj = 0; bj < 2; ++bj)
#pragma unroll
                    for (int n = 0; n < 2; ++n) v[bj][n] = acc[ai][bj][m][n] * rs;
                if (sec == 4 || sec == 5) {
                    float ss = 0.f;
#pragma unroll
                    for (int bj = 0; bj < 2; ++bj)
#pragma unroll
                        for (int n = 0; n < 2; ++n) { const f32x4 x = v[bj][n]; ss += (x[0] * x[0] + x[1] * x[1]) + (x[2] * x[2] + x[3] * x[3]); }
                    ss += __shfl_xor(ss, 16); ss += __shfl_xor(ss, 32);
                    float rn = __builtin_amdgcn_rsqf(ss * (1.0f / 64.0f) + RMS_EPS);
                    if (sec == 4) rn *= QS;
#pragma unroll
                    for (int bj = 0; bj < 2; ++bj)
#pragma unroll
                        for (int n = 0; n < 2; ++n) v[bj][n] = v[bj][n] * rn * gain[bj][n];
                } else if (sec == 0) {
#pragma unroll
                    for (int bj = 0; bj < 2; ++bj)
#pragma unroll
                        for (int n = 0; n < 2; ++n) v[bj][n] = v[bj][n] * QS;
                } else if (sec == 3 || sec == 7) {
#pragma unroll
                    for (int bj = 0; bj < 2; ++bj)
#pragma unroll
                        for (int n = 0; n < 2; ++n)
#pragma unroll
                            for (int e = 0; e < 4; ++e) v[bj][n][e] = silu_f(v[bj][n][e]);
                }
                f16* rowp = P + (size_t)row * PW + colw;
#pragma unroll
                for (int bj = 0; bj < 2; ++bj) {
                    u32x4 w; w.x = pkh(v[bj][0][0], v[bj][0][1]); w.y = pkh(v[bj][0][2], v[bj][0][3]); w.z = pkh(v[bj][1][0], v[bj][1][1]); w.w = pkh(v[bj][1][2], v[bj][1][3]);
                    *(u32x4*)(rowp + 32 * bj) = w;
                }
            }
    }
};

struct EpiOut {
    const float* base; float* out; f16* xb; float* part; int next;
    __device__ __forceinline__ void operator()(const f32x4 (&acc)[2][2][4][2], const Unit& u, int wr, int wc, int fr, int fq) const {
        const int row0 = u.pm * BM + wr * 64 + fr;
        const int colw = u.pn * BM + wc * 64 + 8 * fq;
#pragma unroll
        for (int ai = 0; ai < 2; ++ai)
#pragma unroll
            for (int m = 0; m < 4; ++m) {
                const int row = row0 + ai * HALF + m * 16;
                const size_t off = (size_t)row * DM + colw;
                float ss = 0.f;
#pragma unroll
                for (int bj = 0; bj < 2; ++bj) {
                    const f32x4 b0 = *(const f32x4*)(base + off + 32 * bj), b1 = *(const f32x4*)(base + off + 32 * bj + 4);
                    const f32x4 o0 = b0 + acc[ai][bj][m][0], o1 = b1 + acc[ai][bj][m][1];
                    *(f32x4*)(out + off + 32 * bj) = o0; *(f32x4*)(out + off + 32 * bj + 4) = o1;
                    if (next) {
                        ss += (o0[0] * o0[0] + o0[1] * o0[1]) + (o0[2] * o0[2] + o0[3] * o0[3]) + (o1[0] * o1[0] + o1[1] * o1[1]) + (o1[2] * o1[2] + o1[3] * o1[3]);
                        u32x4 w; w.x = pkh(o0[0], o0[1]); w.y = pkh(o0[2], o0[3]); w.z = pkh(o1[0], o1[1]); w.w = pkh(o1[2], o1[3]);
                        *(u32x4*)(xb + off + 32 * bj) = w;
                    }
                }
                if (next) {
                    ss += __shfl_xor(ss, 16); ss += __shfl_xor(ss, 32);
                    if (fq == 0) part[(size_t)row * 16 + u.pn * 4 + wc] = ss;
                }
            }
    }
};

template <class Epi>
__device__ __forceinline__ void gemm_phase(LAS unsigned char* lds, const Gemm g, const StaticOrder& S, const Epi& E) {
    int tid_ = threadIdx.x; asm volatile("" : "+v"(tid_));
    const int tid = tid_, wid = __builtin_amdgcn_readfirstlane(tid >> 6), lane = tid & 63, wr = wid >> 2, wc = wid & 3, fr = lane & 15, fq = lane >> 4;
    const int K = g.K, nt = K / BK;
    unsigned voffA[2], voffB[2];
#pragma unroll
    for (int i = 0; i < 2; ++i) { int R, C; stage_rc(tid * 16 + i * 8192, R, C);
        const int Rb = (R >> 5) * 64 + perm32(R & 31);
        voffA[i] = (unsigned)(R * K + C) * 2u; voffB[i] = (unsigned)(Rb * K + C) * 2u; }
    const size_t kstep = (size_t)(BK * 2);
    const size_t hstep = (size_t)HALF * K * 2;
    const size_t hstepB = (size_t)32 * K * 2;
    const size_t tstep = 2 * hstep;
    const unsigned ldsw = (unsigned)wid * 1024u;
    const int aoff = lds_byte(wr * 64 + fr, fq * 8), boff = lds_byte(wc * 32 + fr, fq * 8);
#define PG8_SA(b, h) (((b) * 2 + (h)) * HTB)
#define PG8_SB(b, h) ((4 + (b) * 2 + (h)) * HTB)
#define PG8_STAGE(bufoff, gbase, voff) do { _Pragma("unroll") for (int _i = 0; _i < 2; ++_i) \
        __builtin_amdgcn_global_load_lds((const unsigned*)((const char*)(gbase) + (voff)[_i]), (LAS unsigned*)(lds + (bufoff) + ldsw + _i * 8192), 16, 0, 0); } while (0)
#define PG8_LDA(dst, b, h) do { _Pragma("unroll") for (int m = 0; m < 4; ++m) _Pragma("unroll") for (int k = 0; k < 2; ++k) dst[m][k] = *(const LAS h8*)(lds + PG8_SA(b, h) + aoff + m * 2048 + k * 1024); } while (0)
#define PG8_LDB(dst, b, h) do { _Pragma("unroll") for (int n = 0; n < 2; ++n) _Pragma("unroll") for (int k = 0; k < 2; ++k) dst[n][k] = *(const LAS h8*)(lds + PG8_SB(b, h) + boff + n * 2048 + k * 1024); } while (0)
#define PG8_MMA(ai, bj, At, Bt) do { __builtin_amdgcn_s_setprio(1); _Pragma("unroll") for (int m = 0; m < 4; ++m) _Pragma("unroll") for (int n = 0; n < 2; ++n) _Pragma("unroll") for (int k = 0; k < 2; ++k) \
        acc[ai][bj][m][n] = __builtin_amdgcn_mfma_f32_16x16x32_f16(Bt[n][k], At[m][k], acc[ai][bj][m][n], 0, 0, 0); __builtin_amdgcn_s_setprio(0); } while (0)
#define PG8_WAIT_V(n) asm volatile("s_waitcnt vmcnt(" #n ")" ::: "memory")
#define PG8_WAIT_L(n) asm volatile("s_waitcnt lgkmcnt(" #n ")" ::: "memory")
#define PG8_BAR __builtin_amdgcn_s_barrier()
#define PG8_SCHED __builtin_amdgcn_sched_barrier(0)
    Unit cur, nxt; int ui = 0;
    if (!S.next(0, cur)) return;
    f32x4 acc[2][2][4][2];
#pragma unroll
    for (int a = 0; a < 2; ++a)
#pragma unroll
        for (int b = 0; b < 2; ++b)
#pragma unroll
            for (int m = 0; m < 4; ++m)
#pragma unroll
                for (int n = 0; n < 2; ++n) acc[a][b][m][n] = (f32x4){0.f, 0.f, 0.f, 0.f};
    h8 At[4][2], B0[2][2], B1[2][2];
    const char* cA = (const char*)g.A + (size_t)cur.pm * tstep; const char* cB = (const char*)g.Bt + (size_t)cur.pn * tstep;
    PG8_STAGE(PG8_SB(0, 0), cB, voffB); PG8_STAGE(PG8_SB(0, 1), cB + hstepB, voffB); PG8_STAGE(PG8_SA(0, 0), cA, voffA); PG8_STAGE(PG8_SA(0, 1), cA + hstep, voffA);
    if (wr == 1) PG8_BAR;
    PG8_WAIT_V(2); PG8_BAR;
    PG8_STAGE(PG8_SB(1, 0), cB + kstep, voffB); PG8_STAGE(PG8_SA(1, 0), cA + kstep, voffA); PG8_STAGE(PG8_SB(1, 1), cB + hstepB + kstep, voffB);
    PG8_WAIT_V(6); PG8_BAR;
    for (;;) {
        const bool has_next = S.next(ui + 1, nxt);
        const char* nA = has_next ? (const char*)g.A + (size_t)nxt.pm * tstep : cA; const char* nB = has_next ? (const char*)g.Bt + (size_t)nxt.pn * tstep : cB;
        for (int t = 0; t < nt; t += 2) {
            const bool last = (t == nt - 2);
            const char* a1 = cA + (size_t)(t + 1) * kstep;
            const char* a2 = last ? nA : cA + (size_t)(t + 2) * kstep; const char* b2 = last ? nB : cB + (size_t)(t + 2) * kstep;
            const char* a3 = a2 + kstep; const char* b3 = b2 + kstep;
            PG8_LDB(B0, 0, 0); PG8_LDB(B1, 0, 1); PG8_SCHED; PG8_LDA(At, 0, 0); PG8_STAGE(PG8_SA(1, 1), a1 + hstep, voffA);
            PG8_WAIT_V(8); PG8_WAIT_L(0); PG8_BAR; PG8_MMA(0, 0, At, B0); PG8_MMA(0, 1, At, B1); PG8_BAR; PG8_SCHED;
            PG8_LDA(At, 0, 1); PG8_STAGE(PG8_SB(0, 0), b2, voffB); PG8_STAGE(PG8_SB(0, 1), b2 + hstepB, voffB); PG8_STAGE(PG8_SA(0, 0), a2, voffA);
            PG8_WAIT_V(8); PG8_WAIT_L(0); PG8_BAR; PG8_MMA(1, 0, At, B0); PG8_MMA(1, 1, At, B1); PG8_BAR; PG8_SCHED;
            PG8_LDB(B0, 1, 0); PG8_LDB(B1, 1, 1); PG8_SCHED; PG8_LDA(At, 1, 0); PG8_STAGE(PG8_SA(0, 1), a2 + hstep, voffA);
            PG8_WAIT_V(8); PG8_WAIT_L(0); PG8_BAR; PG8_MMA(0, 0, At, B0); PG8_MMA(0, 1, At, B1); PG8_BAR; PG8_SCHED;
            PG8_LDA(At, 1, 1); PG8_STAGE(PG8_SB(1, 0), b3, voffB); PG8_STAGE(PG8_SB(1, 1), b3 + hstepB, voffB); PG8_STAGE(PG8_SA(1, 0), a3, voffA);
            PG8_WAIT_V(8); PG8_WAIT_L(0); PG8_BAR; PG8_MMA(1, 0, At, B0); PG8_MMA(1, 1, At, B1); PG8_BAR; PG8_SCHED;
        }
        if (wr == 0) PG8_BAR;
        E(acc, cur, wr, wc, fr, fq);
        if (!has_next) break;
#pragma unroll
        for (int a = 0; a < 2; ++a)
#pragma unroll
            for (int b = 0; b < 2; ++b)
#pragma unroll
                for (int m = 0; m < 4; ++m)
#pragma unroll
                    for (int n = 0; n < 2; ++n) acc[a][b][m][n] = (f32x4){0.f, 0.f, 0.f, 0.f};
        cur = nxt; cA = nA; cB = nB; ++ui;
        if (wr == 1) PG8_BAR;
    }
    PG8_WAIT_V(0);
    PG8_BAR;
#undef PG8_SA
#undef PG8_SB
#undef PG8_STAGE
#undef PG8_LDA
#undef PG8_LDB
#undef PG8_MMA
#undef PG8_WAIT_V
#undef PG8_WAIT_L
#undef PG8_BAR
#undef PG8_SCHED
}
}

namespace att {
typedef short v4i16_t __attribute__((ext_vector_type(4)));
__device__ __forceinline__ int crow(int r, int hi) { return (r & 3) + 8 * (r >> 2) + 4 * hi; }
__device__ __forceinline__ int keyrow(int i) { return 32 * ((i >> 2) & 1) + (i & 3) + 4 * (i >> 3); }
__device__ __forceinline__ h4 vtr(const LAS unsigned char* p) { return __builtin_bit_cast(h4, __builtin_amdgcn_ds_read_tr16_b64_v4i16((LAS v4i16_t*)p)); }
__device__ __forceinline__ h8 cat8(h4 a, h4 b) { return (h8){a[0], a[1], a[2], a[3], b[0], b[1], b[2], b[3]}; }
#define MFMA32(a, b, c) __builtin_amdgcn_mfma_f32_32x32x16_f16(a, b, c, 0, 0, 0)
__device__ __forceinline__ h8 pack8(const f32x16& p, int b) {
    u32x4 w; w.x = pkh_rtz(p[b], p[b + 1]); w.y = pkh_rtz(p[b + 2], p[b + 3]); w.z = pkh_rtz(p[b + 4], p[b + 5]); w.w = pkh_rtz(p[b + 6], p[b + 7]);
    return __builtin_bit_cast(h8, w);
}
__device__ __forceinline__ float wave_sum(float v) {
#pragma unroll
    for (int o = 1; o < 64; o <<= 1) v += __shfl_xor(v, o);
    return v;
}
__device__ __forceinline__ float wave_max(float v) {
#pragma unroll
    for (int o = 1; o < 64; o <<= 1) v = fmaxf(v, __shfl_xor(v, o));
    return v;
}

__device__ __forceinline__ void glds16(const void* g, unsigned lds_base) {
    unsigned sv; asm volatile("s_mov_b32 %0, m0\n\ts_mov_b32 m0, %2\n\ts_nop 0\n\tglobal_load_lds_dwordx4 %1, off\n\ts_mov_b32 m0, %0" : "=&s"(sv) : "v"(g), "s"(lds_base) : "memory"); }
#define WAIT_BAR(N) asm volatile("s_waitcnt vmcnt(" #N ") lgkmcnt(0)\n\ts_barrier" ::: "memory")
__device__ __forceinline__ void wait_bar_n(int n) {
    switch (n) { case 0: WAIT_BAR(0); break; case 2: WAIT_BAR(2); break; case 4: WAIT_BAR(4); break; case 6: WAIT_BAR(6); break; case 8: WAIT_BAR(8); break; default: WAIT_BAR(0); break; }
}

constexpr int SB_NS = 6, SB_SLOT = 16384, SB_FLG = 131072 + 2048;
struct SbUnit { int b, h, qb; };
__device__ __forceinline__ bool sb_decode(int u, SbUnit& U) {
    if (u >= 1024) return false;
    const int i = u >> 8, v = u & 255, bh = v >> 1, j = v & 1;
    U.qb = (i == 0) ? j : (i == 1) ? 3 - j : (i == 2) ? 4 + j : 7 - j; U.b = bh >> 3; U.h = bh & 7; return true;
}
__device__ __forceinline__ void sb_phase(LAS unsigned char* lds, const f16* __restrict__ proj, f16* __restrict__ mixed, int vcu, int G) {
    int tid_ = threadIdx.x; asm volatile("" : "+v"(tid_));
    const int tid = tid_, lane = tid & 63, l31 = lane & 31, hi = lane >> 5; const int w = __builtin_amdgcn_readfirstlane(tid >> 6);
    const unsigned lds0 = (unsigned)(uintptr_t)lds;
    const unsigned kdst = lds0 + w * 1024, vdst = lds0 + 8192 + w * 1024;
    int kfo[4];
    { const int kr = keyrow(l31), fz = (kr >> 1) & 7;
#pragma unroll
      for (int d0 = 0; d0 < 4; ++d0) kfo[d0] = kr * 128 + (((2 * d0 + hi) ^ fz) * 16); }
    int vfo[2];
    { const int q_ = (lane & 15) >> 2, qb1 = (q_ >> 1) & 1;
#pragma unroll
      for (int d0 = 0; d0 < 2; ++d0) vfo[d0] = 8192 + (32 * hi + q_) * 128 + ((d0 ^ qb1) * 64) + ((lane >> 4) & 1) * 32 + (lane & 3) * 8; }
    LAS unsigned* flags = (LAS unsigned*)(lds + SB_FLG);
    const int srow = 8 * w + (lane >> 3);
    const size_t koff = (size_t)srow * PW + C_SBK + (((lane & 7) ^ ((srow >> 1) & 7)) * 8);
    const size_t voff = (size_t)srow * PW + C_SBV + ((((lane & 7) >> 2) ^ ((srow >> 1) & 1)) * 32) + (lane & 3) * 8;
    const size_t qoff = (size_t)(32 * w + l31) * PW;
#define SB_DMA(ks_, vs_, kt_, slot) do { const size_t go_ = (size_t)(kt_) * 64 * PW; glds16((ks_) + go_, (unsigned)__builtin_amdgcn_readfirstlane(kdst + (slot))); glds16((vs_) + go_, (unsigned)__builtin_amdgcn_readfirstlane(vdst + (slot))); } while (0)
#define SB_NEXT_SLOT(s) ((s) == (SB_NS - 1) * SB_SLOT ? 0 : (s) + SB_SLOT)
    SbUnit U, Un; int ui = vcu;
    if (!sb_decode(ui, U)) return;
    int islot = 0, cslot = 0, issued = 0;
    const f16* ksrc = proj + ((size_t)U.b * SEQ) * PW + U.h * 64 + koff; const f16* vsrc = proj + ((size_t)U.b * SEQ) * PW + U.h * 64 + voff;
    h8 qn[4];
    { const f16* Qg = proj + ((size_t)U.b * SEQ + U.qb * 256) * PW + qoff + C_SBQ + U.h * 64 + 8 * hi;
#pragma unroll
      for (int d0 = 0; d0 < 4; ++d0) qn[d0] = *(const h8*)(Qg + 16 * d0); }
    asm volatile("" : "+v"(qn[0]), "+v"(qn[1]), "+v"(qn[2]), "+v"(qn[3]));
    { const int kth = (U.qb * 256 + 255) >> 6, NT0 = kth + 1; for (; issued < 5 && issued < NT0; ++issued) { SB_DMA(ksrc, vsrc, kth - issued, islot); islot = SB_NEXT_SLOT(islot); } }
    for (;;) {
        const size_t rowbase = (size_t)U.b * SEQ;
        const int q0 = U.qb * 256, qw = q0 + 32 * w, t = qw + l31, diag = qw >> 6, kt_hi = (q0 + 255) >> 6, NT = kt_hi + 1;
        h8 qr[4];
#pragma unroll
        for (int d0 = 0; d0 < 4; ++d0) qr[d0] = qn[d0];
        const size_t grow = rowbase + qw + l31;
        u32x2 gv[8];
        { const f16* Gp = proj + grow * PW + C_SBG + U.h * 64 + 4 * hi;
#pragma unroll
          for (int i = 0; i < 8; ++i) gv[i] = *(const u32x2*)(Gp + 8 * i); }
        const bool has_next = sb_decode(ui + G, Un);
        if (has_next) { const f16* Qg = proj + ((size_t)Un.b * SEQ + Un.qb * 256) * PW + qoff + C_SBQ + Un.h * 64 + 8 * hi;
#pragma unroll
            for (int d0 = 0; d0 < 4; ++d0) qn[d0] = *(const h8*)(Qg + 16 * d0); }
        f32x16 o[2]; o[0] = f32x16{}; o[1] = f32x16{};
        float carry = 1.f; int done = 0;
        for (int j = 0; j < NT; ++j) {
            wait_bar_n(2 * (issued - (j + 1)));
            if (j > 0) {
                const u32x4 f0 = *(const LAS u32x4*)(flags + ((j - 1) & 1) * 8), f1 = *(const LAS u32x4*)(flags + ((j - 1) & 1) * 8 + 4);
                const unsigned any = (f0.x | f0.y | f0.z | f0.w) | (f1.x | f1.y | f1.z | f1.w);
                if (!__builtin_amdgcn_readfirstlane(any)) break;
            }
            if (issued < NT) { SB_DMA(ksrc, vsrc, kt_hi - issued, islot); ++issued; islot = SB_NEXT_SLOT(islot); }
            const int kt = kt_hi - j;
            if (kt <= diag && !done) {
                const LAS unsigned char* Sb = lds + cslot;
                f32x16 p0 = f32x16{}, p1 = f32x16{};
#pragma unroll
                for (int d0 = 0; d0 < 4; ++d0) { const h8 k0 = *(const LAS h8*)(Sb + kfo[d0]), k1 = *(const LAS h8*)(Sb + kfo[d0] + 2048); p0 = MFMA32(k0, qr[d0], p0); p1 = MFMA32(k1, qr[d0], p1); }
#pragma unroll
                for (int r = 0; r < 16; ++r) { p0[r] = __builtin_amdgcn_rcpf(1.0f + __builtin_amdgcn_exp2f(-p0[r])); p1[r] = __builtin_amdgcn_rcpf(1.0f + __builtin_amdgcn_exp2f(-p1[r])); }
                if (kt == diag) {
                    const int key0 = 64 * kt + 32 * hi;
#pragma unroll
                    for (int r = 0; r < 16; ++r) { if (key0 + r >= t) p0[r] = 0.f; if (key0 + 16 + r >= t) p1[r] = 0.f; }
                }
                float run = 1.f;
#pragma unroll
                for (int r = 15; r >= 0; --r) { const float a = run * p1[r]; run -= a; p1[r] = a; }
#pragma unroll
                for (int r = 15; r >= 0; --r) { const float a = run * p0[r]; run -= a; p0[r] = a; }
                const auto rr = __builtin_amdgcn_permlane32_swap(__float_as_uint(run), __float_as_uint(run), false, false);
                const float T0 = __uint_as_float(rr[0]), T1 = __uint_as_float(rr[1]);
                const float E = carry * (hi ? 1.0f : T1);
                carry = carry * (T0 * T1);
#pragma unroll
                for (int r = 0; r < 16; ++r) { p0[r] *= E; p1[r] *= E; }
                const h8 pa0 = pack8(p0, 0), pa1 = pack8(p0, 8), pa2 = pack8(p1, 0), pa3 = pack8(p1, 8);
#pragma unroll
                for (int d0 = 0; d0 < 2; ++d0) {
                    const LAS unsigned char* Vb = Sb + vfo[d0];
                    const h8 v0 = cat8(vtr(Vb), vtr(Vb + 512));
                    const h8 v1 = cat8(vtr(Vb + 1024), vtr(Vb + 1536));
                    const h8 v2 = cat8(vtr(Vb + 2048), vtr(Vb + 2560));
                    const h8 v3 = cat8(vtr(Vb + 3072), vtr(Vb + 3584));
                    o[d0] = MFMA32(v0, pa0, o[d0]); o[d0] = MFMA32(v1, pa1, o[d0]); o[d0] = MFMA32(v2, pa2, o[d0]); o[d0] = MFMA32(v3, pa3, o[d0]);
                }
#if SB_EARLY_EXIT
                done = __builtin_amdgcn_readfirstlane(__all(carry < 1.0e-37f) ? 1 : 0);
#endif
            }
            if (lane == 0) flags[(j & 1) * 8 + w] = done ? 0u : 1u;
            cslot = SB_NEXT_SLOT(cslot);
        }
        cslot = islot; issued = 0;
        if (has_next) {
            ksrc = proj + ((size_t)Un.b * SEQ) * PW + Un.h * 64 + koff; vsrc = proj + ((size_t)Un.b * SEQ) * PW + Un.h * 64 + voff;
            const int kth = (Un.qb * 256 + 255) >> 6, NTn = kth + 1;
            for (; issued < 5 && issued < NTn; ++issued) { SB_DMA(ksrc, vsrc, kth - issued, islot); islot = SB_NEXT_SLOT(islot); }
        }
        {
            f16* Op = mixed + grow * DM + U.h * 64 + 4 * hi;
#pragma unroll
            for (int d0 = 0; d0 < 2; ++d0)
#pragma unroll
                for (int rg4 = 0; rg4 < 4; ++rg4) {
                    const h4 g = __builtin_bit_cast(h4, gv[d0 * 4 + rg4]);
                    u32x2 wv; wv.x = pkh(o[d0][4 * rg4] * (float)g[0], o[d0][4 * rg4 + 1] * (float)g[1]); wv.y = pkh(o[d0][4 * rg4 + 2] * (float)g[2], o[d0][4 * rg4 + 3] * (float)g[3]);
                    *(u32x2*)(Op + 32 * d0 + 8 * rg4) = wv;
                }
        }
        if (!has_next) break;
        U = Un; ui += G;
        asm volatile("" : "+v"(qn[0]), "+v"(qn[1]), "+v"(qn[2]), "+v"(qn[3]));
    }
#undef SB_DMA
#undef SB_NEXT_SLOT
    WAIT_BAR(0);
}

constexpr int DA_NS = 3, DA_SLOT = 32768, DA_XCH = 98304, DA_SUBG = 131072 + 1024, DA_SSX = 131072 + 3072;
struct DaUnit { int b, h, qt; };
__device__ __forceinline__ bool da_decode(int u, DaUnit& U) {
    if (u >= 1024) return false;
    const int i = u >> 8, v = u & 255, bh = v >> 2, j = v & 3;
    U.qt = (i == 0) ? j : (i == 1) ? 7 - j : (i == 2) ? 8 + j : 15 - j; U.b = bh >> 2; U.h = bh & 3; return true;
}
__device__ __forceinline__ void da_phase(LAS unsigned char* lds, const f16* __restrict__ proj, f16* __restrict__ mixed, int vcu, int G,
                                         float lam, float mref, const float* __restrict__ subg, float osc) {
    int tid_ = threadIdx.x; asm volatile("" : "+v"(tid_));
    const int tid = tid_, lane = tid & 63, l31 = lane & 31, hi = lane >> 5; const int w = __builtin_amdgcn_readfirstlane(tid >> 6);
    const int c = w >> 2, rg = w & 3;
    const unsigned lds0 = (unsigned)(uintptr_t)lds;
    const unsigned kdst = lds0 + w * 1024, vdst = lds0 + 16384 + w * 1024;
    int kfo[4];
    { const int kr = keyrow(l31);
#pragma unroll
      for (int d0 = 0; d0 < 4; ++d0) kfo[d0] = kr * 256 + (((8 * c + 2 * d0 + hi) ^ (kr & 15)) * 16); }
    int vfo[4];
    { const int q_ = (lane & 15) >> 2;
#pragma unroll
      for (int d0 = 0; d0 < 4; ++d0) vfo[d0] = 16384 + (32 * hi + q_) * 256 + ((d0 ^ q_) * 64) + ((lane >> 4) & 1) * 32 + (lane & 3) * 8; }
    const int srow = 4 * w + (lane >> 4);
    const size_t koff = (size_t)srow * PW + C_DAK + (((lane & 15) ^ (srow & 15)) * 8);
    const size_t voff = (size_t)srow * PW + C_DAV + (((((lane & 15) >> 2) ^ (srow & 3)) * 4 + (lane & 3)) * 8);
    const size_t qoff = (size_t)(32 * rg + l31) * PW + C_DAQ + c * 64 + 8 * hi;
    if (tid < 128) ((LAS float*)(lds + DA_SUBG))[tid] = subg[tid];
    LAS unsigned* xch = (LAS unsigned*)(lds + DA_XCH + rg * 8192);
#define DA_DMA(ks_, vs_, kt_, slot) do { const size_t go_ = (size_t)(kt_) * 64 * PW; const unsigned kd_ = (unsigned)__builtin_amdgcn_readfirstlane(kdst + (slot)), vd_ = (unsigned)__builtin_amdgcn_readfirstlane(vdst + (slot)); \
        glds16((ks_) + go_, kd_); glds16((ks_) + go_ + (size_t)32 * PW, kd_ + 8192); glds16((vs_) + go_, vd_); glds16((vs_) + go_ + (size_t)32 * PW, vd_ + 8192); } while (0)
#define DA_NEXT_SLOT(s) ((s) == (DA_NS - 1) * DA_SLOT ? 0 : (s) + DA_SLOT)
    DaUnit U, Un; int ui = vcu;
    if (!da_decode(ui, U)) return;
    const f16* ksrc = proj + ((size_t)U.b * SEQ) * PW + U.h * 128 + koff; const f16* vsrc = proj + ((size_t)U.b * SEQ) * PW + U.h * 128 + voff;
    h8 qn[4];
    { const f16* Qg = proj + ((size_t)U.b * SEQ + U.qt * 128) * PW + qoff + U.h * 128;
#pragma unroll
      for (int d0 = 0; d0 < 4; ++d0) qn[d0] = *(const h8*)(Qg + 16 * d0); }
    asm volatile("" : "+v"(qn[0]), "+v"(qn[1]), "+v"(qn[2]), "+v"(qn[3]));
    DA_DMA(ksrc, vsrc, 0, 0); DA_DMA(ksrc, vsrc, 1, DA_SLOT);
    int islot = 2 * DA_SLOT, cslot = 0;
    for (;;) {
        const size_t rowbase = (size_t)U.b * SEQ;
        const int qw = U.qt * 128 + 32 * rg, t = qw + l31, lastt = qw >> 6, NT = 2 * U.qt + 2;
        const float cslope = exp2f(-2.0f * (float)(U.h + 1)) * LOG2E;
        h8 qr[4];
#pragma unroll
        for (int d0 = 0; d0 < 4; ++d0) qr[d0] = qn[d0];
        const size_t grow = rowbase + qw + l31;
        const bool has_next = da_decode(ui + G, Un);
        const f16* ksn = ksrc; const f16* vsn = vsrc;
        if (has_next) { ksn = proj + ((size_t)Un.b * SEQ) * PW + Un.h * 128 + koff; vsn = proj + ((size_t)Un.b * SEQ) * PW + Un.h * 128 + voff; }
        f32x16 o[4]; o[0] = f32x16{}; o[1] = f32x16{}; o[2] = f32x16{}; o[3] = f32x16{};
        float lsum = 0.f;
        for (int kt = 0; kt < NT; ++kt) {
            if (kt + 1 < NT || has_next) WAIT_BAR(4); else WAIT_BAR(0);
            if (kt + 2 < NT) { DA_DMA(ksrc, vsrc, kt + 2, islot); islot = DA_NEXT_SLOT(islot); }
            else if (has_next) { DA_DMA(ksn, vsn, kt + 2 - NT, islot); islot = DA_NEXT_SLOT(islot); }
            if (kt <= lastt) {
                const LAS unsigned char* Sb = lds + cslot;
                const float d0f = (float)(t - (64 * kt + 32 * hi));
                f32x16 p0, p1;
#pragma unroll
                for (int r = 0; r < 16; ++r) { p0[r] = __builtin_fmaf(-cslope, __builtin_fabsf(d0f - (float)r), -mref); p1[r] = __builtin_fmaf(-cslope, __builtin_fabsf(d0f - (float)(16 + r)), -mref); }
#pragma unroll
                for (int d0 = 0; d0 < 4; ++d0) { const h8 ka = *(const LAS h8*)(Sb + kfo[d0]), kb = *(const LAS h8*)(Sb + kfo[d0] + 4096); p0 = MFMA32(ka, qr[d0], p0); p1 = MFMA32(kb, qr[d0], p1); }
                float s = 0.f;
#pragma unroll
                for (int r = 0; r < 16; ++r) { p0[r] = __builtin_amdgcn_exp2f(p0[r]); p1[r] = __builtin_amdgcn_exp2f(p1[r]); s += p0[r] + p1[r]; }
                lsum += s;
                const h8 pa0 = pack8(p0, 0), pa1 = pack8(p0, 8), pa2 = pack8(p1, 0), pa3 = pack8(p1, 8);
#pragma unroll
                for (int d0 = 0; d0 < 4; ++d0) {
                    const LAS unsigned char* Vb = Sb + vfo[d0];
                    const h8 f0 = cat8(vtr(Vb), vtr(Vb + 1024));
                    const h8 f1 = cat8(vtr(Vb + 2048), vtr(Vb + 3072));
                    const h8 f2 = cat8(vtr(Vb + 4096), vtr(Vb + 5120));
                    const h8 f3 = cat8(vtr(Vb + 6144), vtr(Vb + 7168));
                    o[d0] = MFMA32(f0, pa0, o[d0]); o[d0] = MFMA32(f1, pa1, o[d0]); o[d0] = MFMA32(f2, pa2, o[d0]); o[d0] = MFMA32(f3, pa3, o[d0]);
                }
            }
            cslot = DA_NEXT_SLOT(cslot);
        }
        const int dlo = 2 * c;
        u32x2 gv[8];
        { const GAS f16* Gp = (const GAS f16*)proj + grow * PW + C_DAG + U.h * 128 + 32 * dlo + 4 * hi;
#pragma unroll
          for (int i = 0; i < 8; ++i) gv[i] = *(const GAS u32x2*)(Gp + 8 * i); }
        if (has_next) { const GAS f16* Qg = (const GAS f16*)proj + ((size_t)Un.b * SEQ + Un.qt * 128) * PW + qoff + Un.h * 128;
#pragma unroll
            for (int d0 = 0; d0 < 4; ++d0) qn[d0] = *(const GAS h8*)(Qg + 16 * d0); }
        asm volatile("" ::: "memory");
        { const auto rr = __builtin_amdgcn_permlane32_swap(__float_as_uint(lsum), __float_as_uint(lsum), false, false); lsum = __uint_as_float(rr[0]) + __uint_as_float(rr[1]); }
        const float f = (c == 0 ? 1.0f : lam) / lsum;
        LAS unsigned* xw = xch + (c ^ 1) * 1024;
        LAS unsigned* xr = xch + c * 1024;
        f32x16 ya, yb;
        if (c == 0) {
#pragma unroll
            for (int r2 = 0; r2 < 8; ++r2) { xw[r2 * 64 + lane] = pkh(o[2][2 * r2] * f, o[2][2 * r2 + 1] * f); xw[(8 + r2) * 64 + lane] = pkh(o[3][2 * r2] * f, o[3][2 * r2 + 1] * f); }
            ya = o[0] * f; yb = o[1] * f;
        } else {
#pragma unroll
            for (int r2 = 0; r2 < 8; ++r2) { xw[r2 * 64 + lane] = pkh(o[0][2 * r2] * f, o[0][2 * r2 + 1] * f); xw[(8 + r2) * 64 + lane] = pkh(o[1][2 * r2] * f, o[1][2 * r2 + 1] * f); }
            ya = o[2] * f; yb = o[3] * f;
        }
        asm volatile("s_waitcnt lgkmcnt(0)\n\ts_barrier" ::: "memory");
        const float sgn = (c == 0) ? 1.0f : -1.0f;
        float ss = 0.f;
#pragma unroll
        for (int r2 = 0; r2 < 8; ++r2) {
            const h2 pa = __builtin_bit_cast(h2, xr[r2 * 64 + lane]), pb = __builtin_bit_cast(h2, xr[(8 + r2) * 64 + lane]);
            const float a0 = (ya[2 * r2] - (float)pa[0]) * sgn, a1 = (ya[2 * r2 + 1] - (float)pa[1]) * sgn, b0 = (yb[2 * r2] - (float)pb[0]) * sgn, b1 = (yb[2 * r2 + 1] - (float)pb[1]) * sgn;
            ya[2 * r2] = a0; ya[2 * r2 + 1] = a1; yb[2 * r2] = b0; yb[2 * r2 + 1] = b1; ss += (a0 * a0 + a1 * a1) + (b0 * b0 + b1 * b1);
        }
        { const auto rr = __builtin_amdgcn_permlane32_swap(__float_as_uint(ss), __float_as_uint(ss), false, false); ss = __uint_as_float(rr[0]) + __uint_as_float(rr[1]); }
        LAS float* ssx = (LAS float*)(lds + DA_SSX + rg * 256);
        if (hi == 0) ssx[c * 32 + l31] = ss;
        asm volatile("s_waitcnt lgkmcnt(0)\n\ts_barrier" ::: "memory");
        ss += ssx[(c ^ 1) * 32 + l31];
        const float rn = __builtin_amdgcn_rsqf(ss * (1.0f / 128.0f) + RMS_EPS) * osc;
        {
            const LAS float* sgl = (const LAS float*)(lds + DA_SUBG) + 32 * dlo + 4 * hi;
            GAS f16* Op = (GAS f16*)mixed + grow * DM + 512 + U.h * 128 + 32 * dlo + 4 * hi;
#pragma unroll
            for (int rg4 = 0; rg4 < 4; ++rg4) {
                const h4 g = __builtin_bit_cast(h4, gv[rg4]);
                const f32x4 sg = *(const LAS f32x4*)(sgl + 8 * rg4);
                u32x2 wv;
                wv.x = pkh(ya[4 * rg4] * rn * sg[0] * (float)g[0], ya[4 * rg4 + 1] * rn * sg[1] * (float)g[1]);
                wv.y = pkh(ya[4 * rg4 + 2] * rn * sg[2] * (float)g[2], ya[4 * rg4 + 3] * rn * sg[3] * (float)g[3]);
                *(GAS u32x2*)(Op + 8 * rg4) = wv;
            }
#pragma unroll
            for (int rg4 = 0; rg4 < 4; ++rg4) {
                const h4 g = __builtin_bit_cast(h4, gv[4 + rg4]);
                const f32x4 sg = *(const LAS f32x4*)(sgl + 32 + 8 * rg4);
                u32x2 wv;
                wv.x = pkh(yb[4 * rg4] * rn * sg[0] * (float)g[0], yb[4 * rg4 + 1] * rn * sg[1] * (float)g[1]);
                wv.y = pkh(yb[4 * rg4 + 2] * rn * sg[2] * (float)g[2], yb[4 * rg4 + 3] * rn * sg[3] * (float)g[3]);
                *(GAS u32x2*)(Op + 32 + 8 * rg4) = wv;
            }
        }
        if (!has_next) break;
        U = Un; ui += G; ksrc = ksn; vsrc = vsn;
        asm volatile("" : "+v"(qn[0]), "+v"(qn[1]), "+v"(qn[2]), "+v"(qn[3]));
    }
#undef DA_DMA
#undef DA_NEXT_SLOT
    WAIT_BAR(0);
}
}

constexpr size_t MiB = 1u << 20;
constexpr size_t WS_CTL = 0, CTL_ZERO_BYTES = 64 * 1024;
constexpr size_t WS_WIN = 2 * MiB;
constexpr size_t WS_WOUT = 18 * MiB;
constexpr size_t WS_PART = 22 * MiB;
constexpr size_t WS_XB = 32 * MiB;
constexpr size_t WS_MIX = 96 * MiB;
constexpr size_t WS_PROJ = 160 * MiB;
constexpr size_t WS_END = 416 * MiB;
constexpr int CW_BAR = 4096;

constexpr int RING_OFF = 0, RING_BYTES = 131072;
constexpr int LDSCTL_OFF = RING_BYTES, MISC_OFF = LDSCTL_OFF + 320;
constexpr int LDS_BYTES = 147456;
constexpr int NWAVES = 8;

typedef GAS unsigned gu32;
#define LDS_WAIT() asm volatile("s_waitcnt lgkmcnt(0)" ::: "memory")

#define XB_TMO      128
#define XB_XCNT(j)  (256  + 64 * (j))
#define XB_XSUB(j)  (1280 + 64 * (j))
#define XB_XGEN(j)  (2304 + 64 * (j))
#define XB_TOP      3328
#define XB_TOPGEN   3392
#define XCD_BAR_WORDS 3456
#define XB_SPIN_CAP (1u << 18)
__device__ __forceinline__ unsigned xb_ld(unsigned* p)              { return __hip_atomic_load(p, __ATOMIC_RELAXED, __HIP_MEMORY_SCOPE_AGENT); }
__device__ __forceinline__ unsigned xb_add(unsigned* p, unsigned v) { return __hip_atomic_fetch_add(p, v, __ATOMIC_RELAXED, __HIP_MEMORY_SCOPE_AGENT); }
__device__ __forceinline__ unsigned xb_xcc_id() { return (unsigned)__builtin_amdgcn_s_getreg((3 << 11) | 20) & 0xFu; }
#define XB_SPIN(cond, bar) do { unsigned _sp = 0; while (cond) { __builtin_amdgcn_s_sleep(1); \
    if ((++_sp & 255u) == 0u) { if (xb_ld(&(bar)[XB_TMO])) break; if (_sp > XB_SPIN_CAP) { atomicAdd(&(bar)[XB_TMO], 1u); break; } } } } while (0)
struct XcdBarrier { unsigned* bar; unsigned x; volatile LAS unsigned* st; };
__device__ __forceinline__ XcdBarrier xcd_barrier_post(unsigned* bar, volatile LAS unsigned* st) {
    XcdBarrier b; b.bar = bar; b.x = xb_xcc_id(); b.st = st;
    if (threadIdx.x == 0) (void)xb_add(&bar[XB_XCNT(b.x)], 1u);
    return b;
}
__device__ __forceinline__ void xcd_barrier_complete(unsigned* bar, unsigned x, unsigned& nloc, unsigned& nx) {
    const unsigned G = gridDim.x * gridDim.y * gridDim.z;
    unsigned sum, cnt, mine, sp = 0u;
    for (;;) {
        sum = 0u; cnt = 0u; mine = 0u;
#pragma unroll
        for (unsigned j = 0; j < 16; ++j) { const unsigned c = xb_ld(&bar[XB_XCNT(j)]); sum += c; cnt += (c > 0u) ? 1u : 0u; mine = (j == x) ? c : mine; }
        if (sum == G) break;
        __builtin_amdgcn_s_sleep(1);
        if ((++sp & 255u) == 0u) { if (xb_ld(&bar[XB_TMO])) break; if (sp > XB_SPIN_CAP) { atomicAdd(&bar[XB_TMO], 1u); break; } }
    }
    nloc = mine > 0u ? mine : 1u; nx = cnt > 0u ? cnt : 1u;
}
__device__ __forceinline__ void xcd_barrier(const XcdBarrier& b) {
    asm volatile("s_waitcnt vmcnt(0)" ::: "memory");
    __syncthreads();
    if (threadIdx.x == 0) {
        unsigned* bar = b.bar;
        __builtin_amdgcn_s_waitcnt(0);
        unsigned nloc = b.st[0], nx = b.st[1];
        if (nloc == 0u) { xcd_barrier_complete(bar, b.x, nloc, nx); b.st[0] = nloc; b.st[1] = nx; }
        const unsigned old = xb_add(&bar[XB_XSUB(b.x)], 1u);
        const unsigned gen = old / nloc;
        if (old + 1u == (gen + 1u) * nloc) {
            __builtin_amdgcn_fence(__ATOMIC_RELEASE, "agent");
            asm volatile("s_waitcnt vmcnt(0)" ::: "memory");
            const unsigned og = xb_add(&bar[XB_TOP], 1u);
            const unsigned tg = og / nx;
            if (og + 1u == (tg + 1u) * nx) xb_add(&bar[XB_TOPGEN], 1u);
            else XB_SPIN(xb_ld(&bar[XB_TOPGEN]) == tg, bar);
            __builtin_amdgcn_fence(__ATOMIC_ACQUIRE, "agent");
            xb_add(&bar[XB_XGEN(b.x)], 1u);
            asm volatile("s_waitcnt vmcnt(0)" ::: "memory");
        } else {
            XB_SPIN(xb_ld(&bar[XB_XGEN(b.x)]) == gen, bar);
            __builtin_amdgcn_fence(__ATOMIC_ACQUIRE, "agent");
            asm volatile("s_waitcnt vmcnt(0)" ::: "memory");
        }
    }
    __syncthreads();
}

__device__ __forceinline__ void p0_transpose_item(const float* W, const float* g, int K, int N, f16* WT, LAS float* scr, int item, int lane) {
    const int nblk = N / 32, kb = item / nblk, nb = item % nblk, k0 = 32 * kb, n0 = 32 * nb;
    float v[16];
#pragma unroll
    for (int i = 0; i < 16; ++i) { const int kk = 2 * i + (lane >> 5); v[i] = W[(size_t)(k0 + kk) * N + n0 + (lane & 31)]; }
    if (g) {
#pragma unroll
        for (int i = 0; i < 16; ++i) v[i] *= g[k0 + 2 * i + (lane >> 5)];
    }
#pragma unroll
    for (int i = 0; i < 16; ++i) scr[(2 * i + (lane >> 5)) * 33 + (lane & 31)] = v[i];
    LDS_WAIT(); asm volatile("" ::: "memory");
    const int c = lane & 3;
#pragma unroll
    for (int j = 0; j < 2; ++j) { const int n = (lane >> 2) + 16 * j; const LAS float* sp = scr + (8 * c) * 33 + n;
        u32x4 o; o.x = pkh(sp[0 * 33], sp[1 * 33]); o.y = pkh(sp[2 * 33], sp[3 * 33]); o.z = pkh(sp[4 * 33], sp[5 * 33]); o.w = pkh(sp[6 * 33], sp[7 * 33]);
        *(GAS u32x4*)(WT + (size_t)(n0 + n) * K + k0 + 8 * c) = o; }
    LDS_WAIT(); asm volatile("" ::: "memory");
}
__device__ __forceinline__ void x_rows4(const float* x, f16* xb, float* part, int m0, int stride, int lane) {
    f32x4 v[4][4];
#pragma unroll
    for (int r = 0; r < 4; ++r) { const GAS f32x4* xr = (const GAS f32x4*)(x + (size_t)(m0 + r * stride) * DM) + lane;
#pragma unroll
        for (int j = 0; j < 4; ++j) v[r][j] = xr[64 * j]; }
#pragma unroll
    for (int r = 0; r < 4; ++r) {
        float s = 0.f;
#pragma unroll
        for (int j = 0; j < 4; ++j) s += (v[r][j][0] * v[r][j][0] + v[r][j][1] * v[r][j][1]) + (v[r][j][2] * v[r][j][2] + v[r][j][3] * v[r][j][3]);
        s = att::wave_sum(s);
        const size_t row = (size_t)(m0 + r * stride);
        GAS u32x2* o8 = (GAS u32x2*)(xb + row * DM) + lane;
#pragma unroll
        for (int j = 0; j < 4; ++j) { u32x2 w; w.x = pkh(v[r][j][0], v[r][j][1]); w.y = pkh(v[r][j][2], v[r][j][3]); o8[64 * j] = w; }
        if (lane < 16) part[row * 16 + lane] = (lane == 0) ? s : 0.f;
    }
}

__device__ __forceinline__ void x_row1(const float* x, f16* xb, float* part, int m, int lane) {
    const GAS f32x4* xr = (const GAS f32x4*)(x + (size_t)m * DM) + lane;
    f32x4 v[4]; float s = 0.f;
#pragma unroll
    for (int j = 0; j < 4; ++j) { v[j] = xr[64 * j]; s += (v[j][0] * v[j][0] + v[j][1] * v[j][1]) + (v[j][2] * v[j][2] + v[j][3] * v[j][3]); }
    s = att::wave_sum(s);
    GAS u32x2* o8 = (GAS u32x2*)(xb + (size_t)m * DM) + lane;
#pragma unroll
    for (int j = 0; j < 4; ++j) { u32x2 w; w.x = pkh(v[j][0], v[j][1]); w.y = pkh(v[j][2], v[j][3]); o8[64 * j] = w; }
    if (lane < 16) part[(size_t)m * 16 + lane] = (lane == 0) ? s : 0.f;
}

struct Args { const float* in[11]; float* out; unsigned char* ws; };
__global__ void __launch_bounds__(NWAVES * 64, 2) hybrid_fwd(Args args) {
    extern __shared__ __attribute__((aligned(16))) unsigned char lds_raw[];
    LAS unsigned char* lds = (LAS unsigned char*)lds_raw;
    volatile LAS unsigned* MISC = (volatile LAS unsigned*)(lds + MISC_OFF);
    const int tid = threadIdx.x, lane = tid & 63, wave = __builtin_amdgcn_readfirstlane(tid >> 6);
    const int G = gridDim.x; const int bx = blockIdx.x; const int vcu = (G % 8 == 0) ? (bx % 8) * (G / 8) + bx / 8 : bx;
    unsigned char* ws = args.ws;
    gu32* ctl = (gu32*)(ws + WS_CTL);
    const float* x = args.in[0]; const float* norm_g = args.in[1]; const float* w_in = args.in[2]; const float* w_out = args.in[3];
    const float* q_norm_g = args.in[4]; const float* k_norm_g = args.in[5];
    const float* lq1 = args.in[6]; const float* lk1 = args.in[7]; const float* lq2 = args.in[8]; const float* lk2 = args.in[9]; const float* subln_g = args.in[10];
    float* out = args.out;
    f16* WIN = (f16*)(ws + WS_WIN); f16* WOUT = (f16*)(ws + WS_WOUT); float* PART = (float*)(ws + WS_PART);
    f16* XB = (f16*)(ws + WS_XB); f16* MIX = (f16*)(ws + WS_MIX); f16* PROJ = (f16*)(ws + WS_PROJ);

    unsigned long long sw_acc = 0;
    for (int u = tid; u < (LDS_BYTES - LDSCTL_OFF) / 4; u += NWAVES * 64) ((LAS unsigned*)(lds + LDSCTL_OFF))[u] = 0u;
    __syncthreads();
    XcdBarrier bar = xcd_barrier_post((unsigned*)(ctl + CW_BAR), MISC + 8);

    SW_BEGIN(6);
    for (int rep = 0; rep < REP_PRO; ++rep) {
        LAS float* scr = (LAS float*)(lds + RING_OFF + wave * 16384);
        const int gw = vcu * NWAVES + wave, NGW = G * NWAVES;
        constexpr int I_IN = (DM / 32) * (PW / 32), I_OUT = (DM / 32) * (DM / 32);
        constexpr int NITEMS = DEPTH * (I_IN + I_OUT);
        SW_BEGIN(9);
        for (int it = gw; it < NITEMS; it += NGW) {
            int r = it; const int l = r / (I_IN + I_OUT); r -= l * (I_IN + I_OUT);
            if (r < I_IN) p0_transpose_item(w_in + (size_t)l * DM * PW, norm_g + l * DM, DM, PW, WIN + (size_t)l * PW * DM, scr, r, lane);
            else p0_transpose_item(w_out + (size_t)l * DM * DM, nullptr, DM, DM, WOUT + (size_t)l * DM * DM, scr, r - I_IN, lane);
        }
        SW_END(9);
        SW_BEGIN(10);
        { int m = gw; for (; m + 3 * NGW < MROWS; m += 4 * NGW) x_rows4(x, XB, PART, m, NGW, lane); for (; m < MROWS; m += NGW) x_row1(x, XB, PART, m, lane); }
        SW_END(10);
    }
    SW_END(6);
    { SW_BEGIN(7); xcd_barrier(bar); SW_END(7); }

    for (int l = 0; l < DEPTH; ++l) {
        { unsigned char* wsl = ws; asm volatile("" : "+s"(wsl)); WIN = (f16*)(wsl + WS_WIN); WOUT = (f16*)(wsl + WS_WOUT); PART = (float*)(wsl + WS_PART); XB = (f16*)(wsl + WS_XB); MIX = (f16*)(wsl + WS_MIX); PROJ = (f16*)(wsl + WS_PROJ);
          asm volatile("" : "+s"(out)); asm volatile("" : "+s"(x)); asm volatile("" : "+s"(subln_g)); asm volatile("" : "+s"(q_norm_g)); asm volatile("" : "+s"(k_norm_g)); asm volatile("" : "+s"(bar.bar)); }
        for (int rep = 0; rep < REP_G1; ++rep) {
            pg8::Gemm g{XB, WIN + (size_t)l * PW * DM, MROWS, PW, DM}; pg8::StaticOrder S; S.init(MROWS, PW, G, bx);
            pg8::EpiProj E{PROJ, PART, q_norm_g + l * 64, k_norm_g + l * 64};
            SW_BEGIN(5);
            pg8::gemm_phase<pg8::EpiProj>(lds + RING_OFF, g, S, E);
            SW_END(5);
        }
        { SW_BEGIN(7); xcd_barrier(bar); SW_END(7); }
        {
            const float sa = att::wave_sum(lq1[l * 64 + lane] * lk1[l * 64 + lane]), sb = att::wave_sum(lq2[l * 64 + lane] * lk2[l * 64 + lane]);
            const float lam_init = 0.8f - 0.6f * __expf(-0.3f * (float)l);
            const float lam = __expf(sa) - __expf(sb) + lam_init;
            const float mgq = att::wave_max(fabsf(q_norm_g[l * 64 + lane])), mgk = att::wave_max(fabsf(k_norm_g[l * 64 + lane]));
            const float mref = 8.0f * LOG2E * mgq * mgk * 1.001f - 10.0f;
            __syncthreads();
            for (int rep = 0; rep < REP_DA; ++rep) { SW_BEGIN(1); att::da_phase(lds + RING_OFF, PROJ, MIX, vcu, G, lam, mref, subln_g + l * 128, 1.0f - lam_init); SW_END(1); }
            for (int rep = 0; rep < REP_SB; ++rep) { SW_BEGIN(4); att::sb_phase(lds + RING_OFF, PROJ, MIX, vcu, G); SW_END(4); }
        }
        { SW_BEGIN(7); xcd_barrier(bar); SW_END(7); }
        for (int rep = 0; rep < ((l == 0) ? REP_G2 : 1); ++rep) {
            pg8::Gemm g{MIX, WOUT + (size_t)l * DM * DM, MROWS, DM, DM}; pg8::StaticOrder S; S.init(MROWS, DM, G, bx);
            pg8::EpiOut E{(l == 0) ? x : (const float*)out, out, XB, PART, (l + 1 < DEPTH) ? 1 : 0};
            SW_BEGIN(8);
            pg8::gemm_phase<pg8::EpiOut>(lds + RING_OFF, g, S, E);
            SW_END(8);
        }
        if (l + 1 < DEPTH) { SW_BEGIN(7); xcd_barrier(bar); SW_END(7); }
    }
#if SW_ID
    if (wave == 0) { const unsigned long long t0 = __builtin_amdgcn_s_memtime(), span = (unsigned long long)SW_K * sw_acc; while (__builtin_amdgcn_s_memtime() - t0 < span) __builtin_amdgcn_s_sleep(8); }
#endif
}

extern "C" void kernel_launch(void* const* d_in, const int* in_sizes, int n_in, void* d_out, int out_size, void* d_ws, size_t ws_size, hipStream_t stream) {
    static int grid = 0;
    if (grid == 0) {
        if (n_in != 11 || in_sizes[0] != MROWS * DM || out_size != MROWS * DM || ws_size < WS_END) {
            fprintf(stderr, "kernel_launch: unexpected problem shape (n_in %d, in0 %d, out %d, ws %zu); nothing launched\n", n_in, n_in > 0 ? in_sizes[0] : -1, out_size, ws_size); grid = -1; return; }
        int dev = 0, cus = 0, per_cu = 0;
        if (hipGetDevice(&dev) != hipSuccess || hipDeviceGetAttribute(&cus, hipDeviceAttributeMultiprocessorCount, dev) != hipSuccess) { grid = -1; return; }
        if (hipFuncSetAttribute((const void*)hybrid_fwd, hipFuncAttributeMaxDynamicSharedMemorySize, LDS_BYTES) != hipSuccess) { fprintf(stderr, "kernel_launch: hipFuncSetAttribute failed\n"); grid = -1; return; }
        if (hipOccupancyMaxActiveBlocksPerMultiprocessor(&per_cu, (const void*)hybrid_fwd, NWAVES * 64, LDS_BYTES) != hipSuccess || per_cu < 1) {
            fprintf(stderr, "kernel_launch: occupancy query reports %d workgroups per CU; nothing launched\n", per_cu); (void)hipGetLastError(); grid = -1; return; }
        grid = cus;
    }
    if (grid < 0) return;
    if (hipMemsetAsync((char*)d_ws + WS_CTL, 0, CTL_ZERO_BYTES, stream) != hipSuccess) { fprintf(stderr, "kernel_launch: hipMemsetAsync failed\n"); return; }
    Args a{};
    for (int i = 0; i < 11; ++i) a.in[i] = (const float*)d_in[i];
    a.out = (float*)d_out; a.ws = (unsigned char*)d_ws;
    hipLaunchKernelGGL(hybrid_fwd, dim3(grid), dim3(NWAVES * 64), LDS_BYTES, stream, a);
    const hipError_t le = hipPeekAtLastError();
    if (le != hipSuccess) fprintf(stderr, "kernel_launch: launch failed: %s\n", hipGetErrorName(le));
}
```

```cpp
#include <hip/hip_runtime.h>
#include <cstdio>
#include <cstdint>

#ifndef SB_EARLY_EXIT
#define SB_EARLY_EXIT 1
#endif
#define SW_ID 0
#define SW_K 4
#define REP_PRO 1
#define REP_G1 1
#define REP_DA 1
#define REP_SB 1
#define REP_G2 1

#if SW_ID
#define SW_BEGIN(id) unsigned long long sw_t0_##id = 0; if (SW_ID == (id)) sw_t0_##id = __builtin_amdgcn_s_memrealtime()
#define SW_END(id) do { if (SW_ID == (id)) sw_acc += __builtin_amdgcn_s_memrealtime() - sw_t0_##id; } while (0)
#else
#define SW_BEGIN(id) do {} while (0)
#define SW_END(id) do {} while (0)
#endif
#define LAS __attribute__((address_space(3)))
#define GAS __attribute__((address_space(1)))
typedef _Float16 f16;
typedef _Float16 h8 __attribute__((ext_vector_type(8)));
typedef _Float16 h4 __attribute__((ext_vector_type(4)));
typedef _Float16 h2 __attribute__((ext_vector_type(2)));
typedef float f32x4 __attribute__((ext_vector_type(4)));
typedef float f32x16 __attribute__((ext_vector_type(16)));
typedef unsigned u32x4 __attribute__((ext_vector_type(4)));
typedef unsigned u32x2 __attribute__((ext_vector_type(2)));

constexpr int BATCH = 16, SEQ = 2048, DM = 1024, MROWS = BATCH * SEQ, PW = 4096, DEPTH = 2;
constexpr float RMS_EPS = 1e-6f;
constexpr float LOG2E = 1.4426950408889634f;
constexpr float QS = 0.125f * LOG2E;
constexpr int C_SBQ = 0, C_SBK = 512, C_SBV = 1024, C_SBG = 1536, C_DAQ = 2048, C_DAK = 2560, C_DAV = 3072, C_DAG = 3584;

__device__ __forceinline__ unsigned pkh(float lo, float hi) { h2 v = {(f16)lo, (f16)hi}; return __builtin_bit_cast(unsigned, v); }
__device__ __forceinline__ unsigned pkh_rtz(float lo, float hi) { return __builtin_bit_cast(unsigned, __builtin_amdgcn_cvt_pkrtz(lo, hi)); }
__device__ __forceinline__ float silu_f(float v) { return v * __builtin_amdgcn_rcpf(1.0f + __builtin_amdgcn_exp2f(-v * LOG2E)); }

namespace pg8 {
constexpr int BM = 256, BK = 64, HALF = 128, HTB = HALF * BK * 2, STAGE_BYTES = 8 * HTB, NXCD = 8, WGM = 8;
__host__ __device__ __forceinline__ int lds_byte(int r, int c) { const int st = (r >> 4) * 2 + (c >> 5), rr = r & 15, cc = c & 31, ob = rr * 64 + cc * 2; return st * 1024 + (ob ^ (((ob >> 9) & 1) << 5)); }
__host__ __device__ __forceinline__ void stage_rc(int b, int& R, int& C) { const int st = b / 1024, sb = b % 1024, swz = sb ^ (((sb >> 9) & 1) << 5); R = (st >> 1) * 16 + swz / 64; C = (st & 1) * 32 + (swz % 64) / 2; }
__host__ __device__ __forceinline__ int perm32(int rho) { const int n = rho >> 4, i = rho & 15; return 8 * (i >> 2) + 4 * n + (i & 3); }

struct Unit { int pm, pn; };
struct Gemm { const f16* A; const f16* Bt; int M, N, K; };

struct StaticOrder {
    int nM, nN, nwg, G, c;
    __host__ __device__ void init(int M, int N, int G_, int c_) { nM = M / BM; nN = N / BM; nwg = nM * nN; G = G_; c = c_; }
    __host__ __device__ bool next(int i, Unit& u) const {
        const long L = (long)i * G + c; if (L >= nwg) return false;
        int wgid = (int)L; { const int q = nwg / NXCD, r = nwg % NXCD, xcd = wgid % NXCD, off = wgid / NXCD; wgid = (xcd < r ? xcd * (q + 1) : r * (q + 1) + (xcd - r) * q) + off; }
        const int nig = WGM * nN, gid = wgid / nig, fm = gid * WGM, gsz = (nM - fm) < WGM ? (nM - fm) : WGM;
        u.pm = fm + ((wgid % nig) % gsz); u.pn = (wgid % nig) / gsz; return true;
    }
};


struct EpiProj {
    f16* P; const float* part; const float* gq; const float* gk;
    __device__ __forceinline__ void operator()(const f32x4 (&acc)[2][2][4][2], const Unit& u, int wr, int wc, int fr, int fq) const {
        const int sec = u.pn >> 1;
        const int row0 = u.pm * BM + wr * 64 + fr;
        const int colw = u.pn * BM + wc * 64 + 8 * fq;
        f32x4 gain[2][2];
        if (sec == 4 || sec == 5) {
            const float* g = (sec == 4) ? gq : gk;
#pragma unroll
            for (int bj = 0; bj < 2; ++bj)
#pragma unroll
                for (int n = 0; n < 2; ++n) gain[bj][n] = *(const f32x4*)(g + 32 * bj + 8 * fq + 4 * n);
        }
#pragma unroll
        for (int ai = 0; ai < 2; ++ai)
#pragma unroll
            for (int m = 0; m < 4; ++m) {
                const int row = row0 + ai * HALF + m * 16;
                const f32x4 pv = *(const f32x4*)(part + (size_t)row * 16 + fq * 4);
                float s = (pv[0] + pv[1]) + (pv[2] + pv[3]);
                s += __shfl_xor(s, 16); s += __shfl_xor(s, 32);
                const float rs = __builtin_amdgcn_rsqf(s * (1.0f / DM) + RMS_EPS);
                f32x4 v[2][2];
#pragma unroll
                for (int bj = 0; bj < 2; ++bj)
#pragma unroll
                    for (int n = 0; n < 2; ++n) v[bj][n] = acc[ai][bj][m][n] * rs;
                if (sec == 4 || sec == 5) {
                    float ss = 0.f;
#pragma unroll
                    for (int bj = 0; bj < 2; ++bj)
#pragma unroll
                        for (int n = 0; n < 2; ++n) { const f32x4 x = v[bj][n]; ss += (x[0] * x[0] + x[1] * x[1]) + (x[2] * x[2] + x[3] * x[3]); }
                    ss += __shfl_xor(ss, 16); ss += __shfl_xor(ss, 32);
                    float rn = __builtin_amdgcn_rsqf(ss * (1.0f / 64.0f) + RMS_EPS);
                    if (sec == 4) rn *= QS;
#pragma unroll
                    for (int bj = 0; bj < 2; ++bj)
#pragma unroll
                        for (int n = 0; n < 2; ++n) v[bj][n] = v[bj][n] * rn * gain[bj][n];
                } else if (sec == 0) {
#pragma unroll
                    for (int bj = 0; bj < 2; ++bj)
#pragma unroll
                        for (int n = 0; n < 2; ++n) v[bj][n] = v[bj][n] * QS;
                } else if (sec == 3 || sec == 7) {
#pragma unroll
                    for (int bj = 0; bj < 2; ++bj)
#pragma unroll
                        for (int n = 0; n < 2; ++n)
#pragma unroll
                            for (int e = 0; e < 4; ++e) v[bj][n][e] = silu_f(v[bj][n][e]);
                }
                f16* rowp = P + (size_t)row * PW + colw;
#pragma unroll
                for (int bj = 0; bj < 2; ++bj) {
                    u32x4 w; w.x = pkh(v[bj][0][0], v[bj][0][1]); w.y = pkh(v[bj][0][2], v[bj][0][3]); w.z = pkh(v[bj][1][0], v[bj][1][1]); w.w = pkh(v[bj][1][2], v[bj][1][3]);
                    *(u32x4*)(rowp + 32 * bj) = w;
                }
            }
    }
};

struct EpiOut {
    float* out; f16* xb; float* part; int last;
    __device__ __forceinline__ void operator()(const f32x4 (&acc)[2][2][4][2], const Unit& u, int wr, int wc, int fr, int fq) const {
        const int row0 = u.pm * BM + wr * 64 + fr;
        const int colw = u.pn * BM + wc * 64 + 8 * fq;
#pragma unroll
        for (int ai = 0; ai < 2; ++ai) {
            h8 bs[4][2];
#pragma unroll
            for (int m = 0; m < 4; ++m)
#pragma unroll
                for (int bj = 0; bj < 2; ++bj) bs[m][bj] = *(const h8*)(xb + (size_t)(row0 + ai * HALF + m * 16) * DM + colw + 32 * bj);
#pragma unroll
            for (int m = 0; m < 4; ++m) {
                const int row = row0 + ai * HALF + m * 16;
                const size_t off = (size_t)row * DM + colw;
                float ss = 0.f;
#pragma unroll
                for (int bj = 0; bj < 2; ++bj) {
                    const h8 b = bs[m][bj];
                    f32x4 o0 = acc[ai][bj][m][0], o1 = acc[ai][bj][m][1];
                    o0[0] += (float)b[0]; o0[1] += (float)b[1]; o0[2] += (float)b[2]; o0[3] += (float)b[3];
                    o1[0] += (float)b[4]; o1[1] += (float)b[5]; o1[2] += (float)b[6]; o1[3] += (float)b[7];
                    if (last) { *(f32x4*)(out + off + 32 * bj) = o0; *(f32x4*)(out + off + 32 * bj + 4) = o1; }
                    else {
                        ss += (o0[0] * o0[0] + o0[1] * o0[1]) + (o0[2] * o0[2] + o0[3] * o0[3]) + (o1[0] * o1[0] + o1[1] * o1[1]) + (o1[2] * o1[2] + o1[3] * o1[3]);
                        u32x4 w; w.x = pkh(o0[0], o0[1]); w.y = pkh(o0[2], o0[3]); w.z = pkh(o1[0], o1[1]); w.w = pkh(o1[2], o1[3]);
                        *(u32x4*)(xb + off + 32 * bj) = w;
                    }
                }
                if (!last) {
                    ss += __shfl_xor(ss, 16); ss += __shfl_xor(ss, 32);
                    if (fq == 0) part[(size_t)row * 16 + u.pn * 4 + wc] = ss;
                }
            }
        }
    }
};

template <class Epi>
__device__ __forceinline__ void gemm_phase(LAS unsigned char* lds, const Gemm g, const StaticOrder& S, const Epi& E) {
    int tid_ = threadIdx.x; asm volatile("" : "+v"(tid_));
    const int tid = tid_, wid = __builtin_amdgcn_readfirstlane(tid >> 6), lane = tid & 63, wr = wid >> 2, wc = wid & 3, fr = lane & 15, fq = lane >> 4;
    const int K = g.K, nt = K / BK;
    unsigned voffA[2], voffB[2];
#pragma unroll
    for (int i = 0; i < 2; ++i) { int R, C; stage_rc(tid * 16 + i * 8192, R, C);
        const int Rb = (R >> 5) * 64 + perm32(R & 31);
        voffA[i] = (unsigned)(R * K + C) * 2u; voffB[i] = (unsigned)(Rb * K + C) * 2u; }
    const size_t kstep = (size_t)(BK * 2);
    const size_t hstep = (size_t)HALF * K * 2;
    const size_t hstepB = (size_t)32 * K * 2;
    const size_t tstep = 2 * hstep;
    const unsigned ldsw = (unsigned)wid * 1024u;
    const int aoff = lds_byte(wr * 64 + fr, fq * 8), boff = lds_byte(wc * 32 + fr, fq * 8);
#define PG8_SA(b, h) (((b) * 2 + (h)) * HTB)
#define PG8_SB(b, h) ((4 + (b) * 2 + (h)) * HTB)
#define PG8_STAGE(bufoff, gbase, voff) do { _Pragma("unroll") for (int _i = 0; _i < 2; ++_i) \
        __builtin_amdgcn_global_load_lds((const unsigned*)((const char*)(gbase) + (voff)[_i]), (LAS unsigned*)(lds + (bufoff) + ldsw + _i * 8192), 16, 0, 0); } while (0)
#define PG8_LDA(dst, b, h) do { _Pragma("unroll") for (int m = 0; m < 4; ++m) _Pragma("unroll") for (int k = 0; k < 2; ++k) dst[m][k] = *(const LAS h8*)(lds + PG8_SA(b, h) + aoff + m * 2048 + k * 1024); } while (0)
#define PG8_LDB(dst, b, h) do { _Pragma("unroll") for (int n = 0; n < 2; ++n) _Pragma("unroll") for (int k = 0; k < 2; ++k) dst[n][k] = *(const LAS h8*)(lds + PG8_SB(b, h) + boff + n * 2048 + k * 1024); } while (0)
#define PG8_MMA(ai, bj, At, Bt) do { __builtin_amdgcn_s_setprio(1); _Pragma("unroll") for (int m = 0; m < 4; ++m) _Pragma("unroll") for (int n = 0; n < 2; ++n) _Pragma("unroll") for (int k = 0; k < 2; ++k) \
        acc[ai][bj][m][n] = __builtin_amdgcn_mfma_f32_16x16x32_f16(Bt[n][k], At[m][k], acc[ai][bj][m][n], 0, 0, 0); __builtin_amdgcn_s_setprio(0); } while (0)
#define PG8_WAIT_V(n) asm volatile("s_waitcnt vmcnt(" #n ")" ::: "memory")
#define PG8_WAIT_L(n) asm volatile("s_waitcnt lgkmcnt(" #n ")" ::: "memory")
#define PG8_BAR __builtin_amdgcn_s_barrier()
#define PG8_SCHED __builtin_amdgcn_sched_barrier(0)
    Unit cur, nxt; int ui = 0;
    if (!S.next(0, cur)) return;
    f32x4 acc[2][2][4][2];
#pragma unroll
    for (int a = 0; a < 2; ++a)
#pragma unroll
        for (int b = 0; b < 2; ++b)
#pragma unroll
            for (int m = 0; m < 4; ++m)
#pragma unroll
                for (int n = 0; n < 2; ++n) acc[a][b][m][n] = (f32x4){0.f, 0.f, 0.f, 0.f};
    h8 At[4][2], B0[2][2], B1[2][2];
    const char* cA = (const char*)g.A + (size_t)cur.pm * tstep; const char* cB = (const char*)g.Bt + (size_t)cur.pn * tstep;
    PG8_STAGE(PG8_SB(0, 0), cB, voffB); PG8_STAGE(PG8_SB(0, 1), cB + hstepB, voffB); PG8_STAGE(PG8_SA(0, 0), cA, voffA); PG8_STAGE(PG8_SA(0, 1), cA + hstep, voffA);
    if (wr == 1) PG8_BAR;
    PG8_WAIT_V(2); PG8_BAR;
    PG8_STAGE(PG8_SB(1, 0), cB + kstep, voffB); PG8_STAGE(PG8_SA(1, 0), cA + kstep, voffA); PG8_STAGE(PG8_SB(1, 1), cB + hstepB + kstep, voffB);
    PG8_WAIT_V(6); PG8_BAR;
    for (;;) {
        const bool has_next = S.next(ui + 1, nxt);
        const char* nA = has_next ? (const char*)g.A + (size_t)nxt.pm * tstep : cA; const char* nB = has_next ? (const char*)g.Bt + (size_t)nxt.pn * tstep : cB;
        for (int t = 0; t < nt; t += 2) {
            const bool last = (t == nt - 2);
            const char* a1 = cA + (size_t)(t + 1) * kstep;
            const char* a2 = last ? nA : cA + (size_t)(t + 2) * kstep; const char* b2 = last ? nB : cB + (size_t)(t + 2) * kstep;
            const char* a3 = a2 + kstep; const char* b3 = b2 + kstep;
            PG8_LDB(B0, 0, 0); PG8_LDB(B1, 0, 1); PG8_SCHED; PG8_LDA(At, 0, 0); PG8_STAGE(PG8_SA(1, 1), a1 + hstep, voffA);
            PG8_WAIT_V(8); PG8_WAIT_L(0); PG8_BAR; PG8_MMA(0, 0, At, B0); PG8_MMA(0, 1, At, B1); PG8_BAR; PG8_SCHED;
            PG8_LDA(At, 0, 1); PG8_STAGE(PG8_SB(0, 0), b2, voffB); PG8_STAGE(PG8_SB(0, 1), b2 + hstepB, voffB); PG8_STAGE(PG8_SA(0, 0), a2, voffA);
            PG8_WAIT_V(8); PG8_WAIT_L(0); PG8_BAR; PG8_MMA(1, 0, At, B0); PG8_MMA(1, 1, At, B1); PG8_BAR; PG8_SCHED;
            PG8_LDB(B0, 1, 0); PG8_LDB(B1, 1, 1); PG8_SCHED; PG8_LDA(At, 1, 0); PG8_STAGE(PG8_SA(0, 1), a2 + hstep, voffA);
            PG8_WAIT_V(8); PG8_WAIT_L(0); PG8_BAR; PG8_MMA(0, 0, At, B0); PG8_MMA(0, 1, At, B1); PG8_BAR; PG8_SCHED;
            PG8_LDA(At, 1, 1); PG8_STAGE(PG8_SB(1, 0), b3, voffB); PG8_STAGE(PG8_SB(1, 1), b3 + hstepB, voffB); PG8_STAGE(PG8_SA(1, 0), a3, voffA);
            PG8_WAIT_V(8); PG8_WAIT_L(0); PG8_BAR; PG8_MMA(1, 0, At, B0); PG8_MMA(1, 1, At, B1); PG8_BAR; PG8_SCHED;
        }
        if (wr == 0) PG8_BAR;
        E(acc, cur, wr, wc, fr, fq);
        if (!has_next) break;
#pragma unroll
        for (int a = 0; a < 2; ++a)
#pragma unroll
            for (int b = 0; b < 2; ++b)
#pragma unroll
                for (int m = 0; m < 4; ++m)
#pragma unroll
                    for (int n = 0; n < 2; ++n) acc[a][b][m][n] = (f32x4){0.f, 0.f, 0.f, 0.f};
        cur = nxt; cA = nA; cB = nB; ++ui;
        if (wr == 1) PG8_BAR;
    }
    PG8_WAIT_V(0);
    PG8_BAR;
#undef PG8_SA
#undef PG8_SB
#undef PG8_STAGE
#undef PG8_LDA
#undef PG8_LDB
#undef PG8_MMA
#undef PG8_WAIT_V
#undef PG8_WAIT_L
#undef PG8_BAR
#undef PG8_SCHED
}
}

namespace att {
typedef short v4i16_t __attribute__((ext_vector_type(4)));
__device__ __forceinline__ int crow(int r, int hi) { return (r & 3) + 8 * (r >> 2) + 4 * hi; }
__device__ __forceinline__ int keyrow(int i) { return 32 * ((i >> 2) & 1) + (i & 3) + 4 * (i >> 3); }
__device__ __forceinline__ h4 vtr(const LAS unsigned char* p) { return __builtin_bit_cast(h4, __builtin_amdgcn_ds_read_tr16_b64_v4i16((LAS v4i16_t*)p)); }
__device__ __forceinline__ h8 cat8(h4 a, h4 b) { return (h8){a[0], a[1], a[2], a[3], b[0], b[1], b[2], b[3]}; }
#define MFMA32(a, b, c) __builtin_amdgcn_mfma_f32_32x32x16_f16(a, b, c, 0, 0, 0)
__device__ __forceinline__ h8 pack8(const f32x16& p, int b) {
    u32x4 w; w.x = pkh_rtz(p[b], p[b + 1]); w.y = pkh_rtz(p[b + 2], p[b + 3]); w.z = pkh_rtz(p[b + 4], p[b + 5]); w.w = pkh_rtz(p[b + 6], p[b + 7]);
    return __builtin_bit_cast(h8, w);
}
__device__ __forceinline__ float wave_sum(float v) {
#pragma unroll
    for (int o = 1; o < 64; o <<= 1) v += __shfl_xor(v, o);
    return v;
}
__device__ __forceinline__ float wave_max(float v) {
#pragma unroll
    for (int o = 1; o < 64; o <<= 1) v = fmaxf(v, __shfl_xor(v, o));
    return v;
}

__device__ __forceinline__ void glds16(const void* g, unsigned lds_base) {
    unsigned sv; asm volatile("s_mov_b32 %0, m0\n\ts_mov_b32 m0, %2\n\ts_nop 0\n\tglobal_load_lds_dwordx4 %1, off\n\ts_mov_b32 m0, %0" : "=&s"(sv) : "v"(g), "s"(lds_base) : "memory"); }
#define WAIT_BAR(N) asm volatile("s_waitcnt vmcnt(" #N ") lgkmcnt(0)\n\ts_barrier" ::: "memory")
__device__ __forceinline__ void wait_bar_n(int n) {
    switch (n) { case 0: WAIT_BAR(0); break; case 2: WAIT_BAR(2); break; case 4: WAIT_BAR(4); break; case 6: WAIT_BAR(6); break; case 8: WAIT_BAR(8); break; default: WAIT_BAR(0); break; }
}

constexpr int SB_NS = 6, SB_SLOT = 16384, SB_FLG = 147456 + 2048;
struct SbUnit { int b, h, qb; };
__device__ __forceinline__ bool sb_decode(int u, SbUnit& U) {
    if (u >= 1024) return false;
    const int i = u >> 8, v = u & 255, bh = v >> 1, j = v & 1;
    U.qb = (i == 0) ? j : (i == 1) ? 3 - j : (i == 2) ? 4 + j : 7 - j; U.b = bh >> 3; U.h = bh & 7; return true;
}
__device__ __forceinline__ void sb_phase(LAS unsigned char* lds, const f16* __restrict__ proj, f16* __restrict__ mixed, int vcu, int G, unsigned long long& sw_acc) {
    int tid_ = threadIdx.x; asm volatile("" : "+v"(tid_));
    const int tid = tid_, lane = tid & 63, l31 = lane & 31, hi = lane >> 5; const int w = __builtin_amdgcn_readfirstlane(tid >> 6);
    const unsigned lds0 = (unsigned)(uintptr_t)lds;
    const unsigned kdst = lds0 + w * 1024, vdst = lds0 + 8192 + w * 1024;
    int kfo[4];
    { const int kr = keyrow(l31), fz = (kr >> 1) & 7;
#pragma unroll
      for (int d0 = 0; d0 < 4; ++d0) kfo[d0] = kr * 128 + (((2 * d0 + hi) ^ fz) * 16); }
    int vfo[2];
    { const int q_ = (lane & 15) >> 2, qb1 = (q_ >> 1) & 1;
#pragma unroll
      for (int d0 = 0; d0 < 2; ++d0) vfo[d0] = 8192 + (32 * hi + q_) * 128 + ((d0 ^ qb1) * 64) + ((lane >> 4) & 1) * 32 + (lane & 3) * 8; }
    LAS unsigned* flags = (LAS unsigned*)(lds + SB_FLG);
    const int srow = 8 * w + (lane >> 3);
    const size_t koff = (size_t)srow * PW + C_SBK + (((lane & 7) ^ ((srow >> 1) & 7)) * 8);
    const size_t voff = (size_t)srow * PW + C_SBV + ((((lane & 7) >> 2) ^ ((srow >> 1) & 1)) * 32) + (lane & 3) * 8;
    const size_t qoff = (size_t)(32 * w + l31) * PW;
#define SB_DMA(ks_, vs_, kt_, slot) do { const size_t go_ = (size_t)(kt_) * 64 * PW; glds16((ks_) + go_, (unsigned)__builtin_amdgcn_readfirstlane(kdst + (slot))); glds16((vs_) + go_, (unsigned)__builtin_amdgcn_readfirstlane(vdst + (slot))); } while (0)
#define SB_NEXT_SLOT(s) ((s) == (SB_NS - 1) * SB_SLOT ? 0 : (s) + SB_SLOT)
    SbUnit U, Un; int ui = vcu;
    if (!sb_decode(ui, U)) return;
    int islot = 0, cslot = 0, issued = 0;
    const f16* ksrc = proj + ((size_t)U.b * SEQ) * PW + U.h * 64 + koff; const f16* vsrc = proj + ((size_t)U.b * SEQ) * PW + U.h * 64 + voff;
    h8 qn[4];
    { const f16* Qg = proj + ((size_t)U.b * SEQ + U.qb * 256) * PW + qoff + C_SBQ + U.h * 64 + 8 * hi;
#pragma unroll
      for (int d0 = 0; d0 < 4; ++d0) qn[d0] = *(const h8*)(Qg + 16 * d0); }
    asm volatile("" : "+v"(qn[0]), "+v"(qn[1]), "+v"(qn[2]), "+v"(qn[3]));
    { const int kth = (U.qb * 256 + 255) >> 6, NT0 = kth + 1; for (; issued < 5 && issued < NT0; ++issued) { SB_DMA(ksrc, vsrc, kth - issued, islot); islot = SB_NEXT_SLOT(islot); } }
    for (;;) {
        const size_t rowbase = (size_t)U.b * SEQ;
        const int q0 = U.qb * 256, qw = q0 + 32 * w, t = qw + l31, diag = qw >> 6, kt_hi = (q0 + 255) >> 6, NT = kt_hi + 1;
        h8 qr[4];
#pragma unroll
        for (int d0 = 0; d0 < 4; ++d0) qr[d0] = qn[d0];
        const size_t grow = rowbase + qw + l31;
        u32x2 gv[8];
        { const f16* Gp = proj + grow * PW + C_SBG + U.h * 64 + 4 * hi;
#pragma unroll
          for (int i = 0; i < 8; ++i) gv[i] = *(const u32x2*)(Gp + 8 * i); }
        const bool has_next = sb_decode(ui + G, Un);
        if (has_next) { const f16* Qg = proj + ((size_t)Un.b * SEQ + Un.qb * 256) * PW + qoff + C_SBQ + Un.h * 64 + 8 * hi;
#pragma unroll
            for (int d0 = 0; d0 < 4; ++d0) qn[d0] = *(const h8*)(Qg + 16 * d0); }
        f32x16 o[2]; o[0] = f32x16{}; o[1] = f32x16{};
        float carry = 1.f; int done = 0;
        SW_BEGIN(12);
        for (int j = 0; j < NT; ++j) {
            SW_BEGIN(13);
            wait_bar_n(2 * (issued - (j + 1)));
            SW_END(13);
            if (j > 0) {
                const u32x4 f0 = *(const LAS u32x4*)(flags + ((j - 1) & 1) * 8), f1 = *(const LAS u32x4*)(flags + ((j - 1) & 1) * 8 + 4);
                const unsigned any = (f0.x | f0.y | f0.z | f0.w) | (f1.x | f1.y | f1.z | f1.w);
                if (!__builtin_amdgcn_readfirstlane(any)) break;
            }
            if (issued < NT) { SB_DMA(ksrc, vsrc, kt_hi - issued, islot); ++issued; islot = SB_NEXT_SLOT(islot); }
            const int kt = kt_hi - j;
            if (kt <= diag && !done) {
                const LAS unsigned char* Sb = lds + cslot;
                f32x16 p0 = f32x16{}, p1 = f32x16{};
#pragma unroll
                for (int d0 = 0; d0 < 4; ++d0) { const h8 k0 = *(const LAS h8*)(Sb + kfo[d0]), k1 = *(const LAS h8*)(Sb + kfo[d0] + 2048); p0 = MFMA32(k0, qr[d0], p0); p1 = MFMA32(k1, qr[d0], p1); }
#pragma unroll
                for (int r = 0; r < 16; ++r) { p0[r] = __builtin_amdgcn_rcpf(1.0f + __builtin_amdgcn_exp2f(-p0[r])); p1[r] = __builtin_amdgcn_rcpf(1.0f + __builtin_amdgcn_exp2f(-p1[r])); }
                if (kt == diag) {
                    const int key0 = 64 * kt + 32 * hi;
#pragma unroll
                    for (int r = 0; r < 16; ++r) { if (key0 + r >= t) p0[r] = 0.f; if (key0 + 16 + r >= t) p1[r] = 0.f; }
                }
                float run = 1.f;
#pragma unroll
                for (int r = 15; r >= 0; --r) { const float a = run * p1[r]; run -= a; p1[r] = a; }
#pragma unroll
                for (int r = 15; r >= 0; --r) { const float a = run * p0[r]; run -= a; p0[r] = a; }
                const auto rr = __builtin_amdgcn_permlane32_swap(__float_as_uint(run), __float_as_uint(run), false, false);
                const float T0 = __uint_as_float(rr[0]), T1 = __uint_as_float(rr[1]);
                const float E = carry * (hi ? 1.0f : T1);
                carry = carry * (T0 * T1);
#pragma unroll
                for (int r = 0; r < 16; ++r) { p0[r] *= E; p1[r] *= E; }
                const h8 pa0 = pack8(p0, 0), pa1 = pack8(p0, 8), pa2 = pack8(p1, 0), pa3 = pack8(p1, 8);
#pragma unroll
                for (int d0 = 0; d0 < 2; ++d0) {
                    const LAS unsigned char* Vb = Sb + vfo[d0];
                    const h8 v0 = cat8(vtr(Vb), vtr(Vb + 512));
                    const h8 v1 = cat8(vtr(Vb + 1024), vtr(Vb + 1536));
                    const h8 v2 = cat8(vtr(Vb + 2048), vtr(Vb + 2560));
                    const h8 v3 = cat8(vtr(Vb + 3072), vtr(Vb + 3584));
                    o[d0] = MFMA32(v0, pa0, o[d0]); o[d0] = MFMA32(v1, pa1, o[d0]); o[d0] = MFMA32(v2, pa2, o[d0]); o[d0] = MFMA32(v3, pa3, o[d0]);
                }
#if SB_EARLY_EXIT
                done = __builtin_amdgcn_readfirstlane(__all(carry < 1.0e-37f) ? 1 : 0);
#endif
            }
            if (lane == 0) flags[(j & 1) * 8 + w] = done ? 0u : 1u;
            cslot = SB_NEXT_SLOT(cslot);
        }
        SW_END(12);
        cslot = islot; issued = 0;
        if (has_next) {
            ksrc = proj + ((size_t)Un.b * SEQ) * PW + Un.h * 64 + koff; vsrc = proj + ((size_t)Un.b * SEQ) * PW + Un.h * 64 + voff;
            const int kth = (Un.qb * 256 + 255) >> 6, NTn = kth + 1;
            for (; issued < 5 && issued < NTn; ++issued) { SB_DMA(ksrc, vsrc, kth - issued, islot); islot = SB_NEXT_SLOT(islot); }
        }
        {
            f16* Op = mixed + grow * DM + U.h * 64 + 4 * hi;
#pragma unroll
            for (int d0 = 0; d0 < 2; ++d0)
#pragma unroll
                for (int rg4 = 0; rg4 < 4; ++rg4) {
                    const h4 g = __builtin_bit_cast(h4, gv[d0 * 4 + rg4]);
                    u32x2 wv; wv.x = pkh(o[d0][4 * rg4] * (float)g[0], o[d0][4 * rg4 + 1] * (float)g[1]); wv.y = pkh(o[d0][4 * rg4 + 2] * (float)g[2], o[d0][4 * rg4 + 3] * (float)g[3]);
                    *(u32x2*)(Op + 32 * d0 + 8 * rg4) = wv;
                }
        }
        if (!has_next) break;
        U = Un; ui += G;
        asm volatile("" : "+v"(qn[0]), "+v"(qn[1]), "+v"(qn[2]), "+v"(qn[3]));
    }
#undef SB_DMA
#undef SB_NEXT_SLOT
    WAIT_BAR(0);
}

constexpr int DA_KS = 16384, DA_VRING = 49152, DA_XCH = 114688, DA_SUBG = 147456 + 1024, DA_SSX = 147456 + 3072;
struct DaUnit { int b, h, qt; };
__device__ __forceinline__ bool da_decode(int u, DaUnit& U) {
    if (u >= 1024) return false;
    const int i = u >> 8, v = u & 255, bh = v >> 2, j = v & 3;
    U.qt = (i == 0) ? j : (i == 1) ? 7 - j : (i == 2) ? 8 + j : 15 - j; U.b = bh >> 2; U.h = bh & 3; return true;
}
__device__ __forceinline__ void da_pv(f32x16 (&o)[4], const LAS unsigned char* Vs, const int (&vfo)[4], h8 pa0, h8 pa1, h8 pa2, h8 pa3) {
    h8 f0, f1, f2, f3, g0, g1, g2, g3;
    { const LAS unsigned char* Vb = Vs + vfo[0]; f0 = cat8(vtr(Vb), vtr(Vb + 1024)); f1 = cat8(vtr(Vb + 2048), vtr(Vb + 3072)); f2 = cat8(vtr(Vb + 4096), vtr(Vb + 5120)); f3 = cat8(vtr(Vb + 6144), vtr(Vb + 7168)); }
#pragma unroll
    for (int d0 = 0; d0 < 4; ++d0) {
        if (d0 < 3) { const LAS unsigned char* Vb = Vs + vfo[d0 + 1]; g0 = cat8(vtr(Vb), vtr(Vb + 1024)); g1 = cat8(vtr(Vb + 2048), vtr(Vb + 3072)); g2 = cat8(vtr(Vb + 4096), vtr(Vb + 5120)); g3 = cat8(vtr(Vb + 6144), vtr(Vb + 7168)); }
        o[d0] = MFMA32(f0, pa0, o[d0]); o[d0] = MFMA32(f1, pa1, o[d0]); o[d0] = MFMA32(f2, pa2, o[d0]); o[d0] = MFMA32(f3, pa3, o[d0]);
        if (d0 < 3) { f0 = g0; f1 = g1; f2 = g2; f3 = g3; }
    }
}
__device__ __forceinline__ void da_phase(LAS unsigned char* lds, const f16* __restrict__ proj, f16* __restrict__ mixed, int vcu, int G,
                                         float lam, float mref, const float* __restrict__ subg, float osc, unsigned long long& sw_acc) {
    int tid_ = threadIdx.x; asm volatile("" : "+v"(tid_));
    const int tid = tid_, lane = tid & 63, l31 = lane & 31, hi = lane >> 5; const int w = __builtin_amdgcn_readfirstlane(tid >> 6);
    const int c = w >> 2, rg = w & 3;
    const unsigned lds0 = (unsigned)(uintptr_t)lds;
    const unsigned kdst = lds0 + w * 1024, vdst = lds0 + DA_VRING + w * 1024;
    int kfo[4];
    { const int kr = keyrow(l31);
#pragma unroll
      for (int d0 = 0; d0 < 4; ++d0) kfo[d0] = kr * 256 + (((8 * c + 2 * d0 + hi) ^ (kr & 15)) * 16); }
    int vfo[4];
    { const int q_ = (lane & 15) >> 2;
#pragma unroll
      for (int d0 = 0; d0 < 4; ++d0) vfo[d0] = DA_VRING + (32 * hi + q_) * 256 + ((d0 ^ q_) * 64) + ((lane >> 4) & 1) * 32 + (lane & 3) * 8; }
    const int srow = 4 * w + (lane >> 4);
    const size_t koff = (size_t)srow * PW + C_DAK + (((lane & 15) ^ (srow & 15)) * 8);
    const size_t voff = (size_t)srow * PW + C_DAV + (((((lane & 15) >> 2) ^ (srow & 3)) * 4 + (lane & 3)) * 8);
    const size_t qoff = (size_t)(32 * rg + l31) * PW + C_DAQ + c * 64 + 8 * hi;
    if (tid < 128) ((LAS float*)(lds + DA_SUBG))[tid] = subg[tid];
    LAS unsigned* xch = (LAS unsigned*)(lds + DA_XCH + rg * 8192);
#define DA_DMA(ks_, vs_, kt_, kslot, vslot) do { const size_t go_ = (size_t)(kt_) * 64 * PW; const unsigned kd_ = (unsigned)__builtin_amdgcn_readfirstlane(kdst + (kslot)), vd_ = (unsigned)__builtin_amdgcn_readfirstlane(vdst + (vslot)); \
        glds16((ks_) + go_, kd_); glds16((ks_) + go_ + (size_t)32 * PW, kd_ + 8192); glds16((vs_) + go_, vd_); glds16((vs_) + go_ + (size_t)32 * PW, vd_ + 8192); } while (0)
#define DA_NEXT_K(s) ((s) == 2 * DA_KS ? 0 : (s) + DA_KS)
#define DA_NEXT_V(s) ((s) == 3 * DA_KS ? 0 : (s) + DA_KS)
    DaUnit U, Un; int ui = vcu;
    if (!da_decode(ui, U)) return;
    const f16* ksrc = proj + ((size_t)U.b * SEQ) * PW + U.h * 128 + koff; const f16* vsrc = proj + ((size_t)U.b * SEQ) * PW + U.h * 128 + voff;
    h8 qn[4];
    { const GAS f16* Qg = (const GAS f16*)proj + ((size_t)U.b * SEQ + U.qt * 128) * PW + qoff + U.h * 128;
#pragma unroll
      for (int d0 = 0; d0 < 4; ++d0) qn[d0] = *(const GAS h8*)(Qg + 16 * d0); }
    asm volatile("" : "+v"(qn[0]), "+v"(qn[1]), "+v"(qn[2]), "+v"(qn[3]));
    DA_DMA(ksrc, vsrc, 0, 0, 0); DA_DMA(ksrc, vsrc, 1, DA_KS, DA_KS);
    int ik = 2 * DA_KS, iv = 2 * DA_KS, ck = 0, cv = 0;
    for (;;) {
        const size_t rowbase = (size_t)U.b * SEQ;
        const int qw = U.qt * 128 + 32 * rg, t = qw + l31, lastt = qw >> 6, NT = 2 * U.qt + 2;
        const float cslope = exp2f(-2.0f * (float)(U.h + 1)) * LOG2E;
        h8 qr[4];
#pragma unroll
        for (int d0 = 0; d0 < 4; ++d0) qr[d0] = qn[d0];
        const size_t grow = rowbase + qw + l31;
        const bool has_next = da_decode(ui + G, Un);
        const f16* ksn = ksrc; const f16* vsn = vsrc;
        if (has_next) { ksn = proj + ((size_t)Un.b * SEQ) * PW + Un.h * 128 + koff; vsn = proj + ((size_t)Un.b * SEQ) * PW + Un.h * 128 + voff; }
        f32x16 o[4]; o[0] = f32x16{}; o[1] = f32x16{}; o[2] = f32x16{}; o[3] = f32x16{};
        float lsum = 0.f;
        h8 pq0, pq1, pq2, pq3;
        int pvs = 0;
        SW_BEGIN(2);
        for (int kt = 0; kt < NT; ++kt) {
            SW_BEGIN(3);
            if (kt + 1 < NT || has_next) WAIT_BAR(4); else WAIT_BAR(0);
            SW_END(3);
            if (kt + 2 < NT) { DA_DMA(ksrc, vsrc, kt + 2, ik, iv); ik = DA_NEXT_K(ik); iv = DA_NEXT_V(iv); }
            else if (has_next) { DA_DMA(ksn, vsn, kt + 2 - NT, ik, iv); ik = DA_NEXT_K(ik); iv = DA_NEXT_V(iv); }
            if (c == 1 && kt >= 1 && kt - 1 <= lastt) da_pv(o, lds + pvs, vfo, pq0, pq1, pq2, pq3);
            if (kt <= lastt) {
                const LAS unsigned char* Ks = lds + ck;
                const float d0f = (float)(t - (64 * kt + 32 * hi));
                f32x16 p0, p1;
#pragma unroll
                for (int r = 0; r < 16; ++r) { p0[r] = __builtin_fmaf(-cslope, __builtin_fabsf(d0f - (float)r), -mref); p1[r] = __builtin_fmaf(-cslope, __builtin_fabsf(d0f - (float)(16 + r)), -mref); }
#pragma unroll
                for (int d0 = 0; d0 < 4; ++d0) { const h8 ka = *(const LAS h8*)(Ks + kfo[d0]), kb = *(const LAS h8*)(Ks + kfo[d0] + 4096); p0 = MFMA32(ka, qr[d0], p0); p1 = MFMA32(kb, qr[d0], p1); }
                float s = 0.f;
#pragma unroll
                for (int r = 0; r < 16; ++r) { p0[r] = __builtin_amdgcn_exp2f(p0[r]); p1[r] = __builtin_amdgcn_exp2f(p1[r]); s += p0[r] + p1[r]; }
                lsum += s;
                pq0 = pack8(p0, 0); pq1 = pack8(p0, 8); pq2 = pack8(p1, 0); pq3 = pack8(p1, 8); pvs = cv;
                if (c == 0) da_pv(o, lds + cv, vfo, pq0, pq1, pq2, pq3);
            }
            ck = DA_NEXT_K(ck); cv = DA_NEXT_V(cv);
        }
        if (c == 1 && NT - 1 <= lastt) da_pv(o, lds + pvs, vfo, pq0, pq1, pq2, pq3);
        SW_END(2);
        const int dlo = 2 * c;
        u32x2 gv[8];
        { const GAS f16* Gp = (const GAS f16*)proj + grow * PW + C_DAG + U.h * 128 + 32 * dlo + 4 * hi;
#pragma unroll
          for (int i = 0; i < 8; ++i) gv[i] = *(const GAS u32x2*)(Gp + 8 * i); }
        if (has_next) { const GAS f16* Qg = (const GAS f16*)proj + ((size_t)Un.b * SEQ + Un.qt * 128) * PW + qoff + Un.h * 128;
#pragma unroll
            for (int d0 = 0; d0 < 4; ++d0) qn[d0] = *(const GAS h8*)(Qg + 16 * d0); }
        asm volatile("" ::: "memory");
        { const auto rr = __builtin_amdgcn_permlane32_swap(__float_as_uint(lsum), __float_as_uint(lsum), false, false); lsum = __uint_as_float(rr[0]) + __uint_as_float(rr[1]); }
        const float f = (c == 0 ? 1.0f : lam) / lsum;
        LAS unsigned* xw = xch + (c ^ 1) * 1024;
        LAS unsigned* xr = xch + c * 1024;
        f32x16 ya, yb;
        if (c == 0) {
#pragma unroll
            for (int r2 = 0; r2 < 8; ++r2) { xw[r2 * 64 + lane] = pkh(o[2][2 * r2] * f, o[2][2 * r2 + 1] * f); xw[(8 + r2) * 64 + lane] = pkh(o[3][2 * r2] * f, o[3][2 * r2 + 1] * f); }
            ya = o[0] * f; yb = o[1] * f;
        } else {
#pragma unroll
            for (int r2 = 0; r2 < 8; ++r2) { xw[r2 * 64 + lane] = pkh(o[0][2 * r2] * f, o[0][2 * r2 + 1] * f); xw[(8 + r2) * 64 + lane] = pkh(o[1][2 * r2] * f, o[1][2 * r2 + 1] * f); }
            ya = o[2] * f; yb = o[3] * f;
        }
        asm volatile("s_waitcnt lgkmcnt(0)\n\ts_barrier" ::: "memory");
        const float sgn = (c == 0) ? 1.0f : -1.0f;
        float ss = 0.f;
#pragma unroll
        for (int r2 = 0; r2 < 8; ++r2) {
            const h2 pa = __builtin_bit_cast(h2, xr[r2 * 64 + lane]), pb = __builtin_bit_cast(h2, xr[(8 + r2) * 64 + lane]);
            const float a0 = (ya[2 * r2] - (float)pa[0]) * sgn, a1 = (ya[2 * r2 + 1] - (float)pa[1]) * sgn, b0 = (yb[2 * r2] - (float)pb[0]) * sgn, b1 = (yb[2 * r2 + 1] - (float)pb[1]) * sgn;
            ya[2 * r2] = a0; ya[2 * r2 + 1] = a1; yb[2 * r2] = b0; yb[2 * r2 + 1] = b1; ss += (a0 * a0 + a1 * a1) + (b0 * b0 + b1 * b1);
        }
        { const auto rr = __builtin_amdgcn_permlane32_swap(__float_as_uint(ss), __float_as_uint(ss), false, false); ss = __uint_as_float(rr[0]) + __uint_as_float(rr[1]); }
        LAS float* ssx = (LAS float*)(lds + DA_SSX + rg * 256);
        if (hi == 0) ssx[c * 32 + l31] = ss;
        asm volatile("s_waitcnt lgkmcnt(0)\n\ts_barrier" ::: "memory");
        ss += ssx[(c ^ 1) * 32 + l31];
        const float rn = __builtin_amdgcn_rsqf(ss * (1.0f / 128.0f) + RMS_EPS) * osc;
        {
            const LAS float* sgl = (const LAS float*)(lds + DA_SUBG) + 32 * dlo + 4 * hi;
            GAS f16* Op = (GAS f16*)mixed + grow * DM + 512 + U.h * 128 + 32 * dlo + 4 * hi;
#pragma unroll
            for (int rg4 = 0; rg4 < 4; ++rg4) {
                const h4 g = __builtin_bit_cast(h4, gv[rg4]);
                const f32x4 sg = *(const LAS f32x4*)(sgl + 8 * rg4);
                u32x2 wv;
                wv.x = pkh(ya[4 * rg4] * rn * sg[0] * (float)g[0], ya[4 * rg4 + 1] * rn * sg[1] * (float)g[1]);
                wv.y = pkh(ya[4 * rg4 + 2] * rn * sg[2] * (float)g[2], ya[4 * rg4 + 3] * rn * sg[3] * (float)g[3]);
                *(GAS u32x2*)(Op + 8 * rg4) = wv;
            }
#pragma unroll
            for (int rg4 = 0; rg4 < 4; ++rg4) {
                const h4 g = __builtin_bit_cast(h4, gv[4 + rg4]);
                const f32x4 sg = *(const LAS f32x4*)(sgl + 32 + 8 * rg4);
                u32x2 wv;
                wv.x = pkh(yb[4 * rg4] * rn * sg[0] * (float)g[0], yb[4 * rg4 + 1] * rn * sg[1] * (float)g[1]);
                wv.y = pkh(yb[4 * rg4 + 2] * rn * sg[2] * (float)g[2], yb[4 * rg4 + 3] * rn * sg[3] * (float)g[3]);
                *(GAS u32x2*)(Op + 32 + 8 * rg4) = wv;
            }
        }
        if (!has_next) break;
        U = Un; ui += G; ksrc = ksn; vsrc = vsn;
        asm volatile("" : "+v"(qn[0]), "+v"(qn[1]), "+v"(qn[2]), "+v"(qn[3]));
    }
#undef DA_DMA
#undef DA_NEXT_K
#undef DA_NEXT_V
    WAIT_BAR(0);
}
}

constexpr size_t MiB = 1u << 20;
constexpr size_t WS_CTL = 0, CTL_ZERO_BYTES = 64 * 1024;
constexpr size_t WS_WIN = 2 * MiB;
constexpr size_t WS_WOUT = 18 * MiB;
constexpr size_t WS_PART = 22 * MiB;
constexpr size_t WS_XB = 32 * MiB;
constexpr size_t WS_MIX = 96 * MiB;
constexpr size_t WS_PROJ = 160 * MiB;
constexpr size_t WS_END = 416 * MiB;
constexpr int CW_BAR = 4096;

constexpr int RING_OFF = 0, RING_BYTES = 131072;
constexpr int LDSCTL_OFF = 147456, MISC_OFF = LDSCTL_OFF + 320;
constexpr int LDS_BYTES = 163840;
constexpr int NWAVES = 8;

typedef GAS unsigned gu32;
#define LDS_WAIT() asm volatile("s_waitcnt lgkmcnt(0)" ::: "memory")

#define XB_TMO      128
#define XB_XCNT(j)  (256  + 64 * (j))
#define XB_XSUB(j)  (1280 + 64 * (j))
#define XB_XGEN(j)  (2304 + 64 * (j))
#define XB_TOP      3328
#define XB_TOPGEN   3392
#define XCD_BAR_WORDS 3456
#define XB_SPIN_CAP (1u << 18)
__device__ __forceinline__ unsigned xb_ld(unsigned* p)              { return __hip_atomic_load(p, __ATOMIC_RELAXED, __HIP_MEMORY_SCOPE_AGENT); }
__device__ __forceinline__ unsigned xb_add(unsigned* p, unsigned v) { return __hip_atomic_fetch_add(p, v, __ATOMIC_RELAXED, __HIP_MEMORY_SCOPE_AGENT); }
__device__ __forceinline__ unsigned xb_xcc_id() { return (unsigned)__builtin_amdgcn_s_getreg((3 << 11) | 20) & 0xFu; }
#define XB_SPIN(cond, bar) do { unsigned _sp = 0; while (cond) { __builtin_amdgcn_s_sleep(1); \
    if ((++_sp & 255u) == 0u) { if (xb_ld(&(bar)[XB_TMO])) break; if (_sp > XB_SPIN_CAP) { atomicAdd(&(bar)[XB_TMO], 1u); break; } } } } while (0)
struct XcdBarrier { unsigned* bar; unsigned x; volatile LAS unsigned* st; };
__device__ __forceinline__ XcdBarrier xcd_barrier_post(unsigned* bar, volatile LAS unsigned* st) {
    XcdBarrier b; b.bar = bar; b.x = xb_xcc_id(); b.st = st;
    if (threadIdx.x == 0) (void)xb_add(&bar[XB_XCNT(b.x)], 1u);
    return b;
}
__device__ __forceinline__ void xcd_barrier_complete(unsigned* bar, unsigned x, unsigned& nloc, unsigned& nx) {
    const unsigned G = gridDim.x * gridDim.y * gridDim.z;
    unsigned sum, cnt, mine, sp = 0u;
    for (;;) {
        sum = 0u; cnt = 0u; mine = 0u;
#pragma unroll
        for (unsigned j = 0; j < 16; ++j) { const unsigned c = xb_ld(&bar[XB_XCNT(j)]); sum += c; cnt += (c > 0u) ? 1u : 0u; mine = (j == x) ? c : mine; }
        if (sum == G) break;
        __builtin_amdgcn_s_sleep(1);
        if ((++sp & 255u) == 0u) { if (xb_ld(&bar[XB_TMO])) break; if (sp > XB_SPIN_CAP) { atomicAdd(&bar[XB_TMO], 1u); break; } }
    }
    nloc = mine > 0u ? mine : 1u; nx = cnt > 0u ? cnt : 1u;
}
__device__ __forceinline__ void xcd_barrier(const XcdBarrier& b) {
    asm volatile("s_waitcnt vmcnt(0)" ::: "memory");
    __syncthreads();
    if (threadIdx.x == 0) {
        unsigned* bar = b.bar;
        __builtin_amdgcn_s_waitcnt(0);
        unsigned nloc = b.st[0], nx = b.st[1];
        if (nloc == 0u) { xcd_barrier_complete(bar, b.x, nloc, nx); b.st[0] = nloc; b.st[1] = nx; }
        const unsigned old = xb_add(&bar[XB_XSUB(b.x)], 1u);
        const unsigned gen = old / nloc;
        if (old + 1u == (gen + 1u) * nloc) {
            __builtin_amdgcn_fence(__ATOMIC_RELEASE, "agent");
            asm volatile("s_waitcnt vmcnt(0)" ::: "memory");
            const unsigned og = xb_add(&bar[XB_TOP], 1u);
            const unsigned tg = og / nx;
            if (og + 1u == (tg + 1u) * nx) xb_add(&bar[XB_TOPGEN], 1u);
            else XB_SPIN(xb_ld(&bar[XB_TOPGEN]) == tg, bar);
            __builtin_amdgcn_fence(__ATOMIC_ACQUIRE, "agent");
            xb_add(&bar[XB_XGEN(b.x)], 1u);
            asm volatile("s_waitcnt vmcnt(0)" ::: "memory");
        } else {
            XB_SPIN(xb_ld(&bar[XB_XGEN(b.x)]) == gen, bar);
            __builtin_amdgcn_fence(__ATOMIC_ACQUIRE, "agent");
            asm volatile("s_waitcnt vmcnt(0)" ::: "memory");
        }
    }
    __syncthreads();
}

__device__ __forceinline__ void p0_transpose_item(const float* W, const float* g, int K, int N, f16* WT, LAS float* scr, int item, int lane) {
    const int nblk = N / 32, kb = item / nblk, nb = item % nblk, k0 = 32 * kb, n0 = 32 * nb;
    float v[16];
#pragma unroll
    for (int i = 0; i < 16; ++i) { const int kk = 2 * i + (lane >> 5); v[i] = W[(size_t)(k0 + kk) * N + n0 + (lane & 31)]; }
    if (g) {
#pragma unroll
        for (int i = 0; i < 16; ++i) v[i] *= g[k0 + 2 * i + (lane >> 5)];
    }
#pragma unroll
    for (int i = 0; i < 16; ++i) scr[(2 * i + (lane >> 5)) * 33 + (lane & 31)] = v[i];
    LDS_WAIT(); asm volatile("" ::: "memory");
    const int c = lane & 3;
#pragma unroll
    for (int j = 0; j < 2; ++j) { const int n = (lane >> 2) + 16 * j; const LAS float* sp = scr + (8 * c) * 33 + n;
        u32x4 o; o.x = pkh(sp[0 * 33], sp[1 * 33]); o.y = pkh(sp[2 * 33], sp[3 * 33]); o.z = pkh(sp[4 * 33], sp[5 * 33]); o.w = pkh(sp[6 * 33], sp[7 * 33]);
        *(GAS u32x4*)(WT + (size_t)(n0 + n) * K + k0 + 8 * c) = o; }
    LDS_WAIT(); asm volatile("" ::: "memory");
}
__device__ __forceinline__ void x_rows4(const float* x, f16* xb, float* part, int m0, int stride, int lane) {
    f32x4 v[4][4];
#pragma unroll
    for (int r = 0; r < 4; ++r) { const GAS f32x4* xr = (const GAS f32x4*)(x + (size_t)(m0 + r * stride) * DM) + lane;
#pragma unroll
        for (int j = 0; j < 4; ++j) v[r][j] = xr[64 * j]; }
#pragma unroll
    for (int r = 0; r < 4; ++r) {
        float s = 0.f;
#pragma unroll
        for (int j = 0; j < 4; ++j) s += (v[r][j][0] * v[r][j][0] + v[r][j][1] * v[r][j][1]) + (v[r][j][2] * v[r][j][2] + v[r][j][3] * v[r][j][3]);
        s = att::wave_sum(s);
        const size_t row = (size_t)(m0 + r * stride);
        GAS u32x2* o8 = (GAS u32x2*)(xb + row * DM) + lane;
#pragma unroll
        for (int j = 0; j < 4; ++j) { u32x2 w; w.x = pkh(v[r][j][0], v[r][j][1]); w.y = pkh(v[r][j][2], v[r][j][3]); o8[64 * j] = w; }
        if (lane < 16) part[row * 16 + lane] = (lane == 0) ? s : 0.f;
    }
}

__device__ __forceinline__ void x_row1(const float* x, f16* xb, float* part, int m, int lane) {
    const GAS f32x4* xr = (const GAS f32x4*)(x + (size_t)m * DM) + lane;
    f32x4 v[4]; float s = 0.f;
#pragma unroll
    for (int j = 0; j < 4; ++j) { v[j] = xr[64 * j]; s += (v[j][0] * v[j][0] + v[j][1] * v[j][1]) + (v[j][2] * v[j][2] + v[j][3] * v[j][3]); }
    s = att::wave_sum(s);
    GAS u32x2* o8 = (GAS u32x2*)(xb + (size_t)m * DM) + lane;
#pragma unroll
    for (int j = 0; j < 4; ++j) { u32x2 w; w.x = pkh(v[j][0], v[j][1]); w.y = pkh(v[j][2], v[j][3]); o8[64 * j] = w; }
    if (lane < 16) part[(size_t)m * 16 + lane] = (lane == 0) ? s : 0.f;
}

struct Args { const float* in[11]; float* out; unsigned char* ws; };
__global__ void __launch_bounds__(NWAVES * 64, 2) hybrid_fwd(Args args) {
    extern __shared__ __attribute__((aligned(16))) unsigned char lds_raw[];
    LAS unsigned char* lds = (LAS unsigned char*)lds_raw;
    volatile LAS unsigned* MISC = (volatile LAS unsigned*)(lds + MISC_OFF);
    const int tid = threadIdx.x, lane = tid & 63, wave = __builtin_amdgcn_readfirstlane(tid >> 6);
    const int G = gridDim.x; const int bx = blockIdx.x; const int vcu = (G % 8 == 0) ? (bx % 8) * (G / 8) + bx / 8 : bx;
    unsigned char* ws = args.ws;
    gu32* ctl = (gu32*)(ws + WS_CTL);
    const float* x = args.in[0]; const float* norm_g = args.in[1]; const float* w_in = args.in[2]; const float* w_out = args.in[3];
    const float* q_norm_g = args.in[4]; const float* k_norm_g = args.in[5];
    const float* lq1 = args.in[6]; const float* lk1 = args.in[7]; const float* lq2 = args.in[8]; const float* lk2 = args.in[9]; const float* subln_g = args.in[10];
    float* out = args.out;
    f16* WIN = (f16*)(ws + WS_WIN); f16* WOUT = (f16*)(ws + WS_WOUT); float* PART = (float*)(ws + WS_PART);
    f16* XB = (f16*)(ws + WS_XB); f16* MIX = (f16*)(ws + WS_MIX); f16* PROJ = (f16*)(ws + WS_PROJ);

    unsigned long long sw_acc = 0;
    for (int u = tid; u < (LDS_BYTES - LDSCTL_OFF) / 4; u += NWAVES * 64) ((LAS unsigned*)(lds + LDSCTL_OFF))[u] = 0u;
    __syncthreads();
    XcdBarrier bar = xcd_barrier_post((unsigned*)(ctl + CW_BAR), MISC + 8);

    SW_BEGIN(6);
    for (int rep = 0; rep < REP_PRO; ++rep) {
        LAS float* scr = (LAS float*)(lds + RING_OFF + wave * 16384);
        const int gw = vcu * NWAVES + wave, NGW = G * NWAVES;
        constexpr int I_IN = (DM / 32) * (PW / 32), I_OUT = (DM / 32) * (DM / 32);
        constexpr int NITEMS = DEPTH * (I_IN + I_OUT);
        SW_BEGIN(9);
        for (int it = gw; it < NITEMS; it += NGW) {
            int r = it; const int l = r / (I_IN + I_OUT); r -= l * (I_IN + I_OUT);
            if (r < I_IN) p0_transpose_item(w_in + (size_t)l * DM * PW, norm_g + l * DM, DM, PW, WIN + (size_t)l * PW * DM, scr, r, lane);
            else p0_transpose_item(w_out + (size_t)l * DM * DM, nullptr, DM, DM, WOUT + (size_t)l * DM * DM, scr, r - I_IN, lane);
        }
        SW_END(9);
        SW_BEGIN(10);
        { int m = gw; for (; m + 3 * NGW < MROWS; m += 4 * NGW) x_rows4(x, XB, PART, m, NGW, lane); for (; m < MROWS; m += NGW) x_row1(x, XB, PART, m, lane); }
        SW_END(10);
    }
    SW_END(6);
    { SW_BEGIN(7); xcd_barrier(bar); SW_END(7); }

    for (int l = 0; l < DEPTH; ++l) {
        { unsigned char* wsl = ws; asm volatile("" : "+s"(wsl)); WIN = (f16*)(wsl + WS_WIN); WOUT = (f16*)(wsl + WS_WOUT); PART = (float*)(wsl + WS_PART); XB = (f16*)(wsl + WS_XB); MIX = (f16*)(wsl + WS_MIX); PROJ = (f16*)(wsl + WS_PROJ);
          asm volatile("" : "+s"(out)); asm volatile("" : "+s"(x)); asm volatile("" : "+s"(subln_g)); asm volatile("" : "+s"(q_norm_g)); asm volatile("" : "+s"(k_norm_g)); asm volatile("" : "+s"(bar.bar)); }
        for (int rep = 0; rep < REP_G1; ++rep) {
            pg8::Gemm g{XB, WIN + (size_t)l * PW * DM, MROWS, PW, DM}; pg8::StaticOrder S; S.init(MROWS, PW, G, bx);
            pg8::EpiProj E{PROJ, PART, q_norm_g + l * 64, k_norm_g + l * 64};
            SW_BEGIN(5);
            pg8::gemm_phase<pg8::EpiProj>(lds + RING_OFF, g, S, E);
            SW_END(5);
        }
        { SW_BEGIN(7); xcd_barrier(bar); SW_END(7); }
        {
            const float sa = att::wave_sum(lq1[l * 64 + lane] * lk1[l * 64 + lane]), sb = att::wave_sum(lq2[l * 64 + lane] * lk2[l * 64 + lane]);
            const float lam_init = 0.8f - 0.6f * __expf(-0.3f * (float)l);
            const float lam = __expf(sa) - __expf(sb) + lam_init;
            const float mgq = att::wave_max(fabsf(q_norm_g[l * 64 + lane])), mgk = att::wave_max(fabsf(k_norm_g[l * 64 + lane]));
            const float mref = 8.0f * LOG2E * mgq * mgk * 1.001f - 10.0f;
            __syncthreads();
            for (int rep = 0; rep < REP_DA; ++rep) { SW_BEGIN(1); att::da_phase(lds + RING_OFF, PROJ, MIX, vcu, G, lam, mref, subln_g + l * 128, 1.0f - lam_init, sw_acc); SW_END(1); }
            for (int rep = 0; rep < REP_SB; ++rep) { SW_BEGIN(4); att::sb_phase(lds + RING_OFF, PROJ, MIX, vcu, G, sw_acc); SW_END(4); }
        }
        { SW_BEGIN(7); xcd_barrier(bar); SW_END(7); }
        {
            pg8::Gemm g{MIX, WOUT + (size_t)l * DM * DM, MROWS, DM, DM}; pg8::StaticOrder S; S.init(MROWS, DM, G, bx);
            pg8::EpiOut E{out, XB, PART, (l + 1 < DEPTH) ? 0 : 1};
            SW_BEGIN(8);
            pg8::gemm_phase<pg8::EpiOut>(lds + RING_OFF, g, S, E);
            SW_END(8);
        }
        if (l + 1 < DEPTH) { SW_BEGIN(7); xcd_barrier(bar); SW_END(7); }
    }
#if SW_ID
    if (wave == 0) { const unsigned long long t0 = __builtin_amdgcn_s_memrealtime(), span = (unsigned long long)SW_K * sw_acc; while (__builtin_amdgcn_s_memrealtime() - t0 < span) __builtin_amdgcn_s_sleep(8); }
#endif
}

extern "C" void kernel_launch(void* const* d_in, const int* in_sizes, int n_in, void* d_out, int out_size, void* d_ws, size_t ws_size, hipStream_t stream) {
    static int grid = 0;
    if (grid == 0) {
        if (n_in != 11 || in_sizes[0] != MROWS * DM || out_size != MROWS * DM || ws_size < WS_END) {
            fprintf(stderr, "kernel_launch: unexpected problem shape (n_in %d, in0 %d, out %d, ws %zu); nothing launched\n", n_in, n_in > 0 ? in_sizes[0] : -1, out_size, ws_size); grid = -1; return; }
        int dev = 0, cus = 0, per_cu = 0;
        if (hipGetDevice(&dev) != hipSuccess || hipDeviceGetAttribute(&cus, hipDeviceAttributeMultiprocessorCount, dev) != hipSuccess) { grid = -1; return; }
        if (hipFuncSetAttribute((const void*)hybrid_fwd, hipFuncAttributeMaxDynamicSharedMemorySize, LDS_BYTES) != hipSuccess) { fprintf(stderr, "kernel_launch: hipFuncSetAttribute failed\n"); grid = -1; return; }
        if (hipOccupancyMaxActiveBlocksPerMultiprocessor(&per_cu, (const void*)hybrid_fwd, NWAVES * 64, LDS_BYTES) != hipSuccess || per_cu < 1) {
            fprintf(stderr, "kernel_launch: occupancy query reports %d workgroups per CU; nothing launched\n", per_cu); (void)hipGetLastError(); grid = -1; return; }
        grid = cus;
    }
    if (grid < 0) return;
    if (hipMemsetAsync((char*)d_ws + WS_CTL, 0, CTL_ZERO_BYTES, stream) != hipSuccess) { fprintf(stderr, "kernel_launch: hipMemsetAsync failed\n"); return; }
    Args a{};
    for (int i = 0; i < 11; ++i) a.in[i] = (const float*)d_in[i];
    a.out = (float*)d_out; a.ws = (unsigned char*)d_ws;
    hipLaunchKernelGGL(hybrid_fwd, dim3(grid), dim3(NWAVES * 64), LDS_BYTES, stream, a);
    const hipError_t le = hipPeekAtLastError();
    if (le != hipSuccess) fprintf(stderr, "kernel_launch: launch failed: %s\n", hipGetErrorName(le));
}
```

```cpp
#include <hip/hip_runtime.h>
#include <cstdio>
#include <cstdint>

#ifndef SB_EARLY_EXIT
#define SB_EARLY_EXIT 1
#endif
#define SW_ID 0
#define SW_K 4
#define REP_PRO 1
#define REP_G1 1
#define REP_DA 1
#define REP_SB 1
#define REP_G2 1

#if SW_ID
#define SW_BEGIN(id) unsigned long long sw_t0_##id = 0; if (SW_ID == (id)) sw_t0_##id = __builtin_amdgcn_s_memrealtime()
#define SW_END(id) do { if (SW_ID == (id)) sw_acc += __builtin_amdgcn_s_memrealtime() - sw_t0_##id; } while (0)
#else
#define SW_BEGIN(id) do {} while (0)
#define SW_END(id) do {} while (0)
#endif
#define LAS __attribute__((address_space(3)))
#define GAS __attribute__((address_space(1)))
typedef _Float16 f16;
typedef _Float16 h8 __attribute__((ext_vector_type(8)));
typedef _Float16 h4 __attribute__((ext_vector_type(4)));
typedef _Float16 h2 __attribute__((ext_vector_type(2)));
typedef float f32x4 __attribute__((ext_vector_type(4)));
typedef float f32x16 __attribute__((ext_vector_type(16)));
typedef unsigned u32x4 __attribute__((ext_vector_type(4)));
typedef unsigned u32x2 __attribute__((ext_vector_type(2)));

constexpr int BATCH = 16, SEQ = 2048, DM = 1024, MROWS = BATCH * SEQ, PW = 4096, DEPTH = 2;
constexpr float RMS_EPS = 1e-6f;
constexpr float LOG2E = 1.4426950408889634f;
constexpr float QS = 0.125f * LOG2E;
constexpr int C_SBQ = 0, C_SBK = 512, C_SBV = 1024, C_SBG = 1536, C_DAQ = 2048, C_DAK = 2560, C_DAV = 3072, C_DAG = 3584;

__device__ __forceinline__ unsigned pkh(float lo, float hi) { h2 v = {(f16)lo, (f16)hi}; return __builtin_bit_cast(unsigned, v); }
__device__ __forceinline__ unsigned pkh_rtz(float lo, float hi) { return __builtin_bit_cast(unsigned, __builtin_amdgcn_cvt_pkrtz(lo, hi)); }
__device__ __forceinline__ float silu_f(float v) { return v * __builtin_amdgcn_rcpf(1.0f + __builtin_amdgcn_exp2f(-v * LOG2E)); }

namespace pg8 {
constexpr int BM = 256, BK = 64, HALF = 128, HTB = HALF * BK * 2, STAGE_BYTES = 8 * HTB, NXCD = 8, WGM = 8;
__host__ __device__ __forceinline__ int lds_byte(int r, int c) { const int st = (r >> 4) * 2 + (c >> 5), rr = r & 15, cc = c & 31, ob = rr * 64 + cc * 2; return st * 1024 + (ob ^ (((ob >> 9) & 1) << 5)); }
__host__ __device__ __forceinline__ void stage_rc(int b, int& R, int& C) { const int st = b / 1024, sb = b % 1024, swz = sb ^ (((sb >> 9) & 1) << 5); R = (st >> 1) * 16 + swz / 64; C = (st & 1) * 32 + (swz % 64) / 2; }
__host__ __device__ __forceinline__ int perm32(int rho) { const int n = rho >> 4, i = rho & 15; return 8 * (i >> 2) + 4 * n + (i & 3); }

struct Unit { int pm, pn; };
struct Gemm { const f16* A; const f16* Bt; int M, N, K; };

struct StaticOrder {
    int nM, nN, nwg, G, c;
    __host__ __device__ void init(int M, int N, int G_, int c_) { nM = M / BM; nN = N / BM; nwg = nM * nN; G = G_; c = c_; }
    __host__ __device__ bool next(int i, Unit& u) const {
        const long L = (long)i * G + c; if (L >= nwg) return false;
        int wgid = (int)L; { const int q = nwg / NXCD, r = nwg % NXCD, xcd = wgid % NXCD, off = wgid / NXCD; wgid = (xcd < r ? xcd * (q + 1) : r * (q + 1) + (xcd - r) * q) + off; }
        const int nig = WGM * nN, gid = wgid / nig, fm = gid * WGM, gsz = (nM - fm) < WGM ? (nM - fm) : WGM;
        u.pm = fm + ((wgid % nig) % gsz); u.pn = (wgid % nig) / gsz; return true;
    }
};


struct EpiProj {
    f16* P; const float* part; const float* gq; const float* gk;
    __device__ __forceinline__ void operator()(const f32x4 (&acc)[2][2][4][2], const Unit& u, int wr, int wc, int fr, int fq) const {
        const int sec = u.pn >> 1;
        const int row0 = u.pm * BM + wr * 64 + fr;
        const int colw = u.pn * BM + wc * 64 + 8 * fq;
        f32x4 gain[2][2];
        if (sec == 4 || sec == 5) {
            const float* g = (sec == 4) ? gq : gk;
#pragma unroll
            for (int bj = 0; bj < 2; ++bj)
#pragma unroll
                for (int n = 0; n < 2; ++n) gain[bj][n] = *(const f32x4*)(g + 32 * bj + 8 * fq + 4 * n);
        }
#pragma unroll
        for (int ai = 0; ai < 2; ++ai)
#pragma unroll
            for (int m = 0; m < 4; ++m) {
                const int row = row0 + ai * HALF + m * 16;
                const f32x4 pv = *(const f32x4*)(part + (size_t)row * 16 + fq * 4);
                float s = (pv[0] + pv[1]) + (pv[2] + pv[3]);
                s += __shfl_xor(s, 16); s += __shfl_xor(s, 32);
                const float rs = __builtin_amdgcn_rsqf(s * (1.0f / DM) + RMS_EPS);
                f32x4 v[2][2];
#pragma unroll
                for (int bj = 0; bj < 2; ++bj)
#pragma unroll
                    for (int n = 0; n < 2; ++n) v[bj][n] = acc[ai][bj][m][n] * rs;
                if (sec == 4 || sec == 5) {
                    float ss = 0.f;
#pragma unroll
                    for (int bj = 0; bj < 2; ++bj)
#pragma unroll
                        for (int n = 0; n < 2; ++n) { const f32x4 x = v[bj][n]; ss += (x[0] * x[0] + x[1] * x[1]) + (x[2] * x[2] + x[3] * x[3]); }
                    ss += __shfl_xor(ss, 16); ss += __shfl_xor(ss, 32);
                    float rn = __builtin_amdgcn_rsqf(ss * (1.0f / 64.0f) + RMS_EPS);
                    if (sec == 4) rn *= QS;
#pragma unroll
                    for (int bj = 0; bj < 2; ++bj)
#pragma unroll
                        for (int n = 0; n < 2; ++n) v[bj][n] = v[bj][n] * rn * gain[bj][n];
                } else if (sec == 0) {
#pragma unroll
                    for (int bj = 0; bj < 2; ++bj)
#pragma unroll
                        for (int n = 0; n < 2; ++n) v[bj][n] = v[bj][n] * QS;
                } else if (sec == 3 || sec == 7) {
#pragma unroll
                    for (int bj = 0; bj < 2; ++bj)
#pragma unroll
                        for (int n = 0; n < 2; ++n)
#pragma unroll
                            for (int e = 0; e < 4; ++e) v[bj][n][e] = silu_f(v[bj][n][e]);
                }
                f16* rowp = P + (size_t)row * PW + colw;
#pragma unroll
                for (int bj = 0; bj < 2; ++bj) {
                    u32x4 w; w.x = pkh(v[bj][0][0], v[bj][0][1]); w.y = pkh(v[bj][0][2], v[bj][0][3]); w.z = pkh(v[bj][1][0], v[bj][1][1]); w.w = pkh(v[bj][1][2], v[bj][1][3]);
                    *(u32x4*)(rowp + 32 * bj) = w;
                }
            }
    }
};

struct EpiOut {
    float* out; f16* xb; float* part; int last;
    __device__ __forceinline__ void operator()(const f32x4 (&acc)[2][2][4][2], const Unit& u, int wr, int wc, int fr, int fq) const {
        const int row0 = u.pm * BM + wr * 64 + fr;
        const int colw = u.pn * BM + wc * 64 + 8 * fq;
#pragma unroll
        for (int ai = 0; ai < 2; ++ai) {
            h8 bs[4][2];
#pragma unroll
            for (int m = 0; m < 4; ++m)
#pragma unroll
                for (int bj = 0; bj < 2; ++bj) bs[m][bj] = *(const h8*)(xb + (size_t)(row0 + ai * HALF + m * 16) * DM + colw + 32 * bj);
#pragma unroll
            for (int m = 0; m < 4; ++m) {
                const int row = row0 + ai * HALF + m * 16;
                const size_t off = (size_t)row * DM + colw;
                float ss = 0.f;
#pragma unroll
                for (int bj = 0; bj < 2; ++bj) {
                    const h8 b = bs[m][bj];
                    f32x4 o0 = acc[ai][bj][m][0], o1 = acc[ai][bj][m][1];
                    o0[0] += (float)b[0]; o0[1] += (float)b[1]; o0[2] += (float)b[2]; o0[3] += (float)b[3];
                    o1[0] += (float)b[4]; o1[1] += (float)b[5]; o1[2] += (float)b[6]; o1[3] += (float)b[7];
                    if (last) { *(f32x4*)(out + off + 32 * bj) = o0; *(f32x4*)(out + off + 32 * bj + 4) = o1; }
                    else {
                        ss += (o0[0] * o0[0] + o0[1] * o0[1]) + (o0[2] * o0[2] + o0[3] * o0[3]) + (o1[0] * o1[0] + o1[1] * o1[1]) + (o1[2] * o1[2] + o1[3] * o1[3]);
                        u32x4 w; w.x = pkh(o0[0], o0[1]); w.y = pkh(o0[2], o0[3]); w.z = pkh(o1[0], o1[1]); w.w = pkh(o1[2], o1[3]);
                        *(u32x4*)(xb + off + 32 * bj) = w;
                    }
                }
                if (!last) {
                    ss += __shfl_xor(ss, 16); ss += __shfl_xor(ss, 32);
                    if (fq == 0) part[(size_t)row * 16 + u.pn * 4 + wc] = ss;
                }
            }
        }
    }
};

template <class Epi>
__device__ __forceinline__ void gemm_phase(LAS unsigned char* lds, const Gemm g, const StaticOrder& S, const Epi& E, unsigned long long& sw_acc) {
    int tid_ = threadIdx.x; asm volatile("" : "+v"(tid_));
    const int tid = tid_, wid = __builtin_amdgcn_readfirstlane(tid >> 6), lane = tid & 63, wr = wid >> 2, wc = wid & 3, fr = lane & 15, fq = lane >> 4;
    const int K = g.K, nt = K / BK;
    unsigned voffA[2], voffB[2];
#pragma unroll
    for (int i = 0; i < 2; ++i) { int R, C; stage_rc(tid * 16 + i * 8192, R, C);
        const int Rb = (R >> 5) * 64 + perm32(R & 31);
        voffA[i] = (unsigned)(R * K + C) * 2u; voffB[i] = (unsigned)(Rb * K + C) * 2u; }
    const size_t kstep = (size_t)(BK * 2);
    const size_t hstep = (size_t)HALF * K * 2;
    const size_t hstepB = (size_t)32 * K * 2;
    const size_t tstep = 2 * hstep;
    const unsigned ldsw = (unsigned)wid * 1024u;
    const int aoff = lds_byte(wr * 64 + fr, fq * 8), boff = lds_byte(wc * 32 + fr, fq * 8);
#define PG8_SA(b, h) (((b) * 2 + (h)) * HTB)
#define PG8_SB(b, h) ((4 + (b) * 2 + (h)) * HTB)
#define PG8_STAGE(bufoff, gbase, voff) do { _Pragma("unroll") for (int _i = 0; _i < 2; ++_i) \
        __builtin_amdgcn_global_load_lds((const unsigned*)((const char*)(gbase) + (voff)[_i]), (LAS unsigned*)(lds + (bufoff) + ldsw + _i * 8192), 16, 0, 0); } while (0)
#define PG8_LDA(dst, b, h) do { _Pragma("unroll") for (int m = 0; m < 4; ++m) _Pragma("unroll") for (int k = 0; k < 2; ++k) dst[m][k] = *(const LAS h8*)(lds + PG8_SA(b, h) + aoff + m * 2048 + k * 1024); } while (0)
#define PG8_LDB(dst, b, h) do { _Pragma("unroll") for (int n = 0; n < 2; ++n) _Pragma("unroll") for (int k = 0; k < 2; ++k) dst[n][k] = *(const LAS h8*)(lds + PG8_SB(b, h) + boff + n * 2048 + k * 1024); } while (0)
#define PG8_MMA(ai, bj, At, Bt) do { __builtin_amdgcn_s_setprio(1); _Pragma("unroll") for (int m = 0; m < 4; ++m) _Pragma("unroll") for (int n = 0; n < 2; ++n) _Pragma("unroll") for (int k = 0; k < 2; ++k) \
        acc[ai][bj][m][n] = __builtin_amdgcn_mfma_f32_16x16x32_f16(Bt[n][k], At[m][k], acc[ai][bj][m][n], 0, 0, 0); __builtin_amdgcn_s_setprio(0); } while (0)
#define PG8_WAIT_V(n) asm volatile("s_waitcnt vmcnt(" #n ")" ::: "memory")
#define PG8_WAIT_L(n) asm volatile("s_waitcnt lgkmcnt(" #n ")" ::: "memory")
#define PG8_BAR __builtin_amdgcn_s_barrier()
#define PG8_SCHED __builtin_amdgcn_sched_barrier(0)
    Unit cur, nxt; int ui = 0;
    if (!S.next(0, cur)) return;
    f32x4 acc[2][2][4][2];
#pragma unroll
    for (int a = 0; a < 2; ++a)
#pragma unroll
        for (int b = 0; b < 2; ++b)
#pragma unroll
            for (int m = 0; m < 4; ++m)
#pragma unroll
                for (int n = 0; n < 2; ++n) acc[a][b][m][n] = (f32x4){0.f, 0.f, 0.f, 0.f};
    h8 At[4][2], B0[2][2], B1[2][2];
    const char* cA = (const char*)g.A + (size_t)cur.pm * tstep; const char* cB = (const char*)g.Bt + (size_t)cur.pn * tstep;
    PG8_STAGE(PG8_SB(0, 0), cB, voffB); PG8_STAGE(PG8_SB(0, 1), cB + hstepB, voffB); PG8_STAGE(PG8_SA(0, 0), cA, voffA); PG8_STAGE(PG8_SA(0, 1), cA + hstep, voffA);
    if (wr == 1) PG8_BAR;
    PG8_WAIT_V(2); PG8_BAR;
    PG8_STAGE(PG8_SB(1, 0), cB + kstep, voffB); PG8_STAGE(PG8_SA(1, 0), cA + kstep, voffA); PG8_STAGE(PG8_SB(1, 1), cB + hstepB + kstep, voffB);
    PG8_WAIT_V(6); PG8_BAR;
    for (;;) {
        const bool has_next = S.next(ui + 1, nxt);
        const char* nA = has_next ? (const char*)g.A + (size_t)nxt.pm * tstep : cA; const char* nB = has_next ? (const char*)g.Bt + (size_t)nxt.pn * tstep : cB;
        for (int t = 0; t < nt; t += 2) {
            const bool last = (t == nt - 2);
            const char* a1 = cA + (size_t)(t + 1) * kstep;
            const char* a2 = last ? nA : cA + (size_t)(t + 2) * kstep; const char* b2 = last ? nB : cB + (size_t)(t + 2) * kstep;
            const char* a3 = a2 + kstep; const char* b3 = b2 + kstep;
            PG8_LDB(B0, 0, 0); PG8_LDB(B1, 0, 1); PG8_SCHED; PG8_LDA(At, 0, 0); PG8_STAGE(PG8_SA(1, 1), a1 + hstep, voffA);
            PG8_WAIT_V(8); PG8_WAIT_L(0); PG8_BAR; PG8_MMA(0, 0, At, B0); PG8_MMA(0, 1, At, B1); PG8_BAR; PG8_SCHED;
            PG8_LDA(At, 0, 1); PG8_STAGE(PG8_SB(0, 0), b2, voffB); PG8_STAGE(PG8_SB(0, 1), b2 + hstepB, voffB); PG8_STAGE(PG8_SA(0, 0), a2, voffA);
            PG8_WAIT_V(8); PG8_WAIT_L(0); PG8_BAR; PG8_MMA(1, 0, At, B0); PG8_MMA(1, 1, At, B1); PG8_BAR; PG8_SCHED;
            PG8_LDB(B0, 1, 0); PG8_LDB(B1, 1, 1); PG8_SCHED; PG8_LDA(At, 1, 0); PG8_STAGE(PG8_SA(0, 1), a2 + hstep, voffA);
            PG8_WAIT_V(8); PG8_WAIT_L(0); PG8_BAR; PG8_MMA(0, 0, At, B0); PG8_MMA(0, 1, At, B1); PG8_BAR; PG8_SCHED;
            PG8_LDA(At, 1, 1); PG8_STAGE(PG8_SB(1, 0), b3, voffB); PG8_STAGE(PG8_SB(1, 1), b3 + hstepB, voffB); PG8_STAGE(PG8_SA(1, 0), a3, voffA);
            PG8_WAIT_V(8); PG8_WAIT_L(0); PG8_BAR; PG8_MMA(1, 0, At, B0); PG8_MMA(1, 1, At, B1); PG8_BAR; PG8_SCHED;
        }
        if (wr == 0) PG8_BAR;
        { SW_BEGIN(20); E(acc, cur, wr, wc, fr, fq); SW_END(20); }
        if (!has_next) break;
#pragma unroll
        for (int a = 0; a < 2; ++a)
#pragma unroll
            for (int b = 0; b < 2; ++b)
#pragma unroll
                for (int m = 0; m < 4; ++m)
#pragma unroll
                    for (int n = 0; n < 2; ++n) acc[a][b][m][n] = (f32x4){0.f, 0.f, 0.f, 0.f};
        cur = nxt; cA = nA; cB = nB; ++ui;
        if (wr == 1) PG8_BAR;
    }
    PG8_WAIT_V(0);
    PG8_BAR;
#undef PG8_SA
#undef PG8_SB
#undef PG8_STAGE
#undef PG8_LDA
#undef PG8_LDB
#undef PG8_MMA
#undef PG8_WAIT_V
#undef PG8_WAIT_L
#undef PG8_BAR
#undef PG8_SCHED
}
}

namespace att {
typedef short v4i16_t __attribute__((ext_vector_type(4)));
__device__ __forceinline__ int crow(int r, int hi) { return (r & 3) + 8 * (r >> 2) + 4 * hi; }
__device__ __forceinline__ int keyrow(int i) { return 32 * ((i >> 2) & 1) + (i & 3) + 4 * (i >> 3); }
__device__ __forceinline__ h4 vtr(const LAS unsigned char* p) { return __builtin_bit_cast(h4, __builtin_amdgcn_ds_read_tr16_b64_v4i16((LAS v4i16_t*)p)); }
__device__ __forceinline__ h8 cat8(h4 a, h4 b) { return (h8){a[0], a[1], a[2], a[3], b[0], b[1], b[2], b[3]}; }
#define MFMA32(a, b, c) __builtin_amdgcn_mfma_f32_32x32x16_f16(a, b, c, 0, 0, 0)
__device__ __forceinline__ h8 pack8(const f32x16& p, int b) {
    u32x4 w; w.x = pkh_rtz(p[b], p[b + 1]); w.y = pkh_rtz(p[b + 2], p[b + 3]); w.z = pkh_rtz(p[b + 4], p[b + 5]); w.w = pkh_rtz(p[b + 6], p[b + 7]);
    return __builtin_bit_cast(h8, w);
}
__device__ __forceinline__ float vadd_s(float a, float b) { float r; asm("v_add_f32_e32 %0, %1, %2" : "=v"(r) : "v"(a), "v"(b)); return r; }
template <int KI> __device__ __forceinline__ float fmamk_s(float c, float base) {
    float r; asm volatile("v_fmamk_f32 %0, %1, %2, %3" : "=v"(r) : "v"(c), "i"(__builtin_bit_cast(int, (float)KI)), "v"(base)); return r; }
__device__ __forceinline__ float wave_sum(float v) {
#pragma unroll
    for (int o = 1; o < 64; o <<= 1) v += __shfl_xor(v, o);
    return v;
}
__device__ __forceinline__ float wave_max(float v) {
#pragma unroll
    for (int o = 1; o < 64; o <<= 1) v = fmaxf(v, __shfl_xor(v, o));
    return v;
}

__device__ __forceinline__ void glds16(const void* g, unsigned lds_base) {
    unsigned sv; asm volatile("s_mov_b32 %0, m0\n\ts_mov_b32 m0, %2\n\ts_nop 0\n\tglobal_load_lds_dwordx4 %1, off\n\ts_mov_b32 m0, %0" : "=&s"(sv) : "v"(g), "s"(lds_base) : "memory"); }
#define WAIT_BAR(N) asm volatile("s_waitcnt vmcnt(" #N ") lgkmcnt(0)\n\ts_barrier" ::: "memory")
__device__ __forceinline__ void wait_bar_n(int n) {
    switch (n) { case 0: WAIT_BAR(0); break; case 2: WAIT_BAR(2); break; case 4: WAIT_BAR(4); break; case 6: WAIT_BAR(6); break; case 8: WAIT_BAR(8); break; default: WAIT_BAR(0); break; }
}

constexpr int SB_NS = 6, SB_SLOT = 16384, SB_FLG = 147456 + 2048;
struct SbUnit { int b, h, qb; };
__device__ __forceinline__ bool sb_decode(int u, SbUnit& U) {
    if (u >= 1024) return false;
    const int i = u >> 8, v = u & 255, bh = v >> 1, j = v & 1;
    U.qb = (i == 0) ? j : (i == 1) ? 3 - j : (i == 2) ? 4 + j : 7 - j; U.b = bh >> 3; U.h = bh & 7; return true;
}
__device__ __forceinline__ void sb_phase(LAS unsigned char* lds, const f16* __restrict__ proj, f16* __restrict__ mixed, int vcu, int G, unsigned long long& sw_acc) {
    int tid_ = threadIdx.x; asm volatile("" : "+v"(tid_));
    const int tid = tid_, lane = tid & 63, l31 = lane & 31, hi = lane >> 5; const int w = __builtin_amdgcn_readfirstlane(tid >> 6);
    const unsigned lds0 = (unsigned)(uintptr_t)lds;
    const unsigned kdst = lds0 + w * 1024, vdst = lds0 + 8192 + w * 1024;
    int kfo[4];
    { const int kr = keyrow(l31), fz = (kr >> 1) & 7;
#pragma unroll
      for (int d0 = 0; d0 < 4; ++d0) kfo[d0] = kr * 128 + (((2 * d0 + hi) ^ fz) * 16); }
    int vfo[2];
    { const int q_ = (lane & 15) >> 2, qb1 = (q_ >> 1) & 1;
#pragma unroll
      for (int d0 = 0; d0 < 2; ++d0) vfo[d0] = 8192 + (32 * hi + q_) * 128 + ((d0 ^ qb1) * 64) + ((lane >> 4) & 1) * 32 + (lane & 3) * 8; }
    LAS unsigned* flags = (LAS unsigned*)(lds + SB_FLG);
    const int srow = 8 * w + (lane >> 3);
    const size_t koff = (size_t)srow * PW + C_SBK + (((lane & 7) ^ ((srow >> 1) & 7)) * 8);
    const size_t voff = (size_t)srow * PW + C_SBV + ((((lane & 7) >> 2) ^ ((srow >> 1) & 1)) * 32) + (lane & 3) * 8;
    const size_t qoff = (size_t)(32 * w + l31) * PW;
#define SB_DMA(ks_, vs_, kt_, slot) do { const size_t go_ = (size_t)(kt_) * 64 * PW; glds16((ks_) + go_, (unsigned)__builtin_amdgcn_readfirstlane(kdst + (slot))); glds16((vs_) + go_, (unsigned)__builtin_amdgcn_readfirstlane(vdst + (slot))); } while (0)
#define SB_NEXT_SLOT(s) ((s) == (SB_NS - 1) * SB_SLOT ? 0 : (s) + SB_SLOT)
    SbUnit U, Un; int ui = vcu;
    if (!sb_decode(ui, U)) return;
    int islot = 0, cslot = 0, issued = 0;
    const f16* ksrc = proj + ((size_t)U.b * SEQ) * PW + U.h * 64 + koff; const f16* vsrc = proj + ((size_t)U.b * SEQ) * PW + U.h * 64 + voff;
    h8 qn[4];
    { const f16* Qg = proj + ((size_t)U.b * SEQ + U.qb * 256) * PW + qoff + C_SBQ + U.h * 64 + 8 * hi;
#pragma unroll
      for (int d0 = 0; d0 < 4; ++d0) qn[d0] = *(const h8*)(Qg + 16 * d0); }
    asm volatile("" : "+v"(qn[0]), "+v"(qn[1]), "+v"(qn[2]), "+v"(qn[3]));
    { const int kth = (U.qb * 256 + 255) >> 6, NT0 = kth + 1; for (; issued < 5 && issued < NT0; ++issued) { SB_DMA(ksrc, vsrc, kth - issued, islot); islot = SB_NEXT_SLOT(islot); } }
    for (;;) {
        const size_t rowbase = (size_t)U.b * SEQ;
        const int q0 = U.qb * 256, qw = q0 + 32 * w, t = qw + l31, diag = qw >> 6, kt_hi = (q0 + 255) >> 6, NT = kt_hi + 1;
        h8 qr[4];
#pragma unroll
        for (int d0 = 0; d0 < 4; ++d0) qr[d0] = qn[d0];
        const size_t grow = rowbase + qw + l31;
        u32x2 gv[8];
        { const f16* Gp = proj + grow * PW + C_SBG + U.h * 64 + 4 * hi;
#pragma unroll
          for (int i = 0; i < 8; ++i) gv[i] = *(const u32x2*)(Gp + 8 * i); }
        const bool has_next = sb_decode(ui + G, Un);
        if (has_next) { const f16* Qg = proj + ((size_t)Un.b * SEQ + Un.qb * 256) * PW + qoff + C_SBQ + Un.h * 64 + 8 * hi;
#pragma unroll
            for (int d0 = 0; d0 < 4; ++d0) qn[d0] = *(const h8*)(Qg + 16 * d0); }
        f32x16 o[2]; o[0] = f32x16{}; o[1] = f32x16{};
        float carry = 1.f; int done = 0;
        SW_BEGIN(12);
        for (int j = 0; j < NT; ++j) {
            SW_BEGIN(13);
            wait_bar_n(2 * (issued - (j + 1)));
            SW_END(13);
            if (j > 0) {
                const u32x4 f0 = *(const LAS u32x4*)(flags + ((j - 1) & 1) * 8), f1 = *(const LAS u32x4*)(flags + ((j - 1) & 1) * 8 + 4);
                const unsigned any = (f0.x | f0.y | f0.z | f0.w) | (f1.x | f1.y | f1.z | f1.w);
                if (!__builtin_amdgcn_readfirstlane(any)) break;
            }
#define SB_ISSUE() do { if (issued < NT) { SB_DMA(ksrc, vsrc, kt_hi - issued, islot); ++issued; islot = SB_NEXT_SLOT(islot); } } while (0)
            const int kt = kt_hi - j;
            SB_ISSUE();
            if (kt <= diag && !done) {
                const LAS unsigned char* Sb = lds + cslot;
                f32x16 p0 = f32x16{}, p1 = f32x16{};
#pragma unroll
                for (int d0 = 0; d0 < 4; ++d0) { const h8 k0 = *(const LAS h8*)(Sb + kfo[d0]), k1 = *(const LAS h8*)(Sb + kfo[d0] + 2048); p0 = MFMA32(k0, qr[d0], p0); p1 = MFMA32(k1, qr[d0], p1); }
#pragma unroll
                for (int r = 0; r < 16; ++r) { p0[r] = __builtin_amdgcn_rcpf(1.0f + __builtin_amdgcn_exp2f(-p0[r])); p1[r] = __builtin_amdgcn_rcpf(1.0f + __builtin_amdgcn_exp2f(-p1[r])); }

                if (kt == diag) {
                    const int key0 = 64 * kt + 32 * hi;
#pragma unroll
                    for (int r = 0; r < 16; ++r) { if (key0 + r >= t) p0[r] = 0.f; if (key0 + 16 + r >= t) p1[r] = 0.f; }
                }
                float run = 1.f;
#pragma unroll
                for (int r = 15; r >= 0; --r) { const float a = run * p1[r]; run -= a; p1[r] = a; }
#pragma unroll
                for (int r = 15; r >= 0; --r) { const float a = run * p0[r]; run -= a; p0[r] = a; }
                const auto rr = __builtin_amdgcn_permlane32_swap(__float_as_uint(run), __float_as_uint(run), false, false);
                const float T0 = __uint_as_float(rr[0]), T1 = __uint_as_float(rr[1]);
                const float E = carry * (hi ? 1.0f : T1);
                carry = carry * (T0 * T1);
#pragma unroll
                for (int r = 0; r < 16; ++r) { p0[r] *= E; p1[r] *= E; }
                const h8 pa0 = pack8(p0, 0), pa1 = pack8(p0, 8), pa2 = pack8(p1, 0), pa3 = pack8(p1, 8);
#pragma unroll
                for (int d0 = 0; d0 < 2; ++d0) {
                    const LAS unsigned char* Vb = Sb + vfo[d0];
                    const h8 v0 = cat8(vtr(Vb), vtr(Vb + 512));
                    const h8 v1 = cat8(vtr(Vb + 1024), vtr(Vb + 1536));
                    const h8 v2 = cat8(vtr(Vb + 2048), vtr(Vb + 2560));
                    const h8 v3 = cat8(vtr(Vb + 3072), vtr(Vb + 3584));
                    o[d0] = MFMA32(v0, pa0, o[d0]); o[d0] = MFMA32(v1, pa1, o[d0]); o[d0] = MFMA32(v2, pa2, o[d0]); o[d0] = MFMA32(v3, pa3, o[d0]);
                }
#if SB_EARLY_EXIT
                done = __builtin_amdgcn_readfirstlane(__all(carry < 1.0e-37f) ? 1 : 0);
#endif
            }
            if (lane == 0) flags[(j & 1) * 8 + w] = done ? 0u : 1u;
            cslot = SB_NEXT_SLOT(cslot);
        }
        asm volatile("s_nop 15\n\ts_nop 7" : "+v"(o[0]), "+v"(o[1]));
        SW_END(12);
        cslot = islot; issued = 0;
        if (has_next) {
            ksrc = proj + ((size_t)Un.b * SEQ) * PW + Un.h * 64 + koff; vsrc = proj + ((size_t)Un.b * SEQ) * PW + Un.h * 64 + voff;
            const int kth = (Un.qb * 256 + 255) >> 6, NTn = kth + 1;
            for (; issued < 5 && issued < NTn; ++issued) { SB_DMA(ksrc, vsrc, kth - issued, islot); islot = SB_NEXT_SLOT(islot); }
        }
        {
            f16* Op = mixed + grow * DM + U.h * 64 + 4 * hi;
#pragma unroll
            for (int d0 = 0; d0 < 2; ++d0)
#pragma unroll
                for (int rg4 = 0; rg4 < 4; ++rg4) {
                    const h4 g = __builtin_bit_cast(h4, gv[d0 * 4 + rg4]);
                    u32x2 wv; wv.x = pkh(o[d0][4 * rg4] * (float)g[0], o[d0][4 * rg4 + 1] * (float)g[1]); wv.y = pkh(o[d0][4 * rg4 + 2] * (float)g[2], o[d0][4 * rg4 + 3] * (float)g[3]);
                    *(u32x2*)(Op + 32 * d0 + 8 * rg4) = wv;
                }
        }
        if (!has_next) break;
        U = Un; ui += G;
        asm volatile("" : "+v"(qn[0]), "+v"(qn[1]), "+v"(qn[2]), "+v"(qn[3]));
    }
#undef SB_ISSUE
#undef SB_DMA
#undef SB_NEXT_SLOT
    WAIT_BAR(0);
}

constexpr int DA_KS = 16384, DA_VRING = 49152, DA_XCH = 114688, DA_SUBG = 147456 + 1024, DA_SSX = 147456 + 3072;
struct DaUnit { int b, h, qt; };
__device__ __forceinline__ bool da_decode(int u, DaUnit& U) {
    if (u >= 1024) return false;
    const int i = u >> 8, v = u & 255, bh = v >> 2, j = v & 3;
    U.qt = (i == 0) ? j : (i == 1) ? 7 - j : (i == 2) ? 8 + j : 15 - j; U.b = bh >> 2; U.h = bh & 3; return true;
}
__device__ __forceinline__ void da_pv(f32x16 (&o)[4], const LAS unsigned char* Vs, const int (&vfo)[4], h8 pa0, h8 pa1, h8 pa2, h8 pa3) {
    h8 f0, f1, f2, f3, g0, g1, g2, g3;
    { const LAS unsigned char* Vb = Vs + vfo[0]; f0 = cat8(vtr(Vb), vtr(Vb + 1024)); f1 = cat8(vtr(Vb + 2048), vtr(Vb + 3072)); f2 = cat8(vtr(Vb + 4096), vtr(Vb + 5120)); f3 = cat8(vtr(Vb + 6144), vtr(Vb + 7168)); }
#pragma unroll
    for (int d0 = 0; d0 < 4; ++d0) {
        if (d0 < 3) { const LAS unsigned char* Vb = Vs + vfo[d0 + 1]; g0 = cat8(vtr(Vb), vtr(Vb + 1024)); g1 = cat8(vtr(Vb + 2048), vtr(Vb + 3072)); g2 = cat8(vtr(Vb + 4096), vtr(Vb + 5120)); g3 = cat8(vtr(Vb + 6144), vtr(Vb + 7168)); }
        o[d0] = MFMA32(f0, pa0, o[d0]); o[d0] = MFMA32(f1, pa1, o[d0]); o[d0] = MFMA32(f2, pa2, o[d0]); o[d0] = MFMA32(f3, pa3, o[d0]);
        if (d0 < 3) { f0 = g0; f1 = g1; f2 = g2; f3 = g3; }
    }
}
__device__ __forceinline__ void da_phase(LAS unsigned char* lds, const f16* __restrict__ proj, f16* __restrict__ mixed, int vcu, int G,
                                         float lam, float mref, const float* __restrict__ subg, float osc, unsigned long long& sw_acc) {
    int tid_ = threadIdx.x; asm volatile("" : "+v"(tid_));
    const int tid = tid_, lane = tid & 63, l31 = lane & 31, hi = lane >> 5; const int w = __builtin_amdgcn_readfirstlane(tid >> 6);
    const int c = w >> 2, rg = w & 3;
    const unsigned lds0 = (unsigned)(uintptr_t)lds;
    const unsigned kdst = lds0 + w * 1024, vdst = lds0 + DA_VRING + w * 1024;
    int kfo[4];
    { const int kr = keyrow(l31);
#pragma unroll
      for (int d0 = 0; d0 < 4; ++d0) kfo[d0] = kr * 256 + (((8 * c + 2 * d0 + hi) ^ (kr & 15)) * 16); }
    int vfo[4];
    { const int q_ = (lane & 15) >> 2;
#pragma unroll
      for (int d0 = 0; d0 < 4; ++d0) vfo[d0] = DA_VRING + (32 * hi + q_) * 256 + ((d0 ^ q_) * 64) + ((lane >> 4) & 1) * 32 + (lane & 3) * 8; }
    const int srow = 4 * w + (lane >> 4);
    const size_t koff = (size_t)srow * PW + C_DAK + (((lane & 15) ^ (srow & 15)) * 8);
    const size_t voff = (size_t)srow * PW + C_DAV + (((((lane & 15) >> 2) ^ (srow & 3)) * 4 + (lane & 3)) * 8);
    const size_t qoff = (size_t)(32 * rg + l31) * PW + C_DAQ + c * 64 + 8 * hi;
    if (tid < 128) ((LAS float*)(lds + DA_SUBG))[tid] = subg[tid];
    LAS unsigned* xch = (LAS unsigned*)(lds + DA_XCH + rg * 8192);
#define DA_DMA(ks_, vs_, kt_, kslot, vslot) do { const size_t go_ = (size_t)(kt_) * 64 * PW; const unsigned kd_ = (unsigned)__builtin_amdgcn_readfirstlane(kdst + (kslot)), vd_ = (unsigned)__builtin_amdgcn_readfirstlane(vdst + (vslot)); \
        glds16((ks_) + go_, kd_); glds16((ks_) + go_ + (size_t)32 * PW, kd_ + 8192); glds16((vs_) + go_, vd_); glds16((vs_) + go_ + (size_t)32 * PW, vd_ + 8192); } while (0)
#define DA_NEXT_K(s) ((s) == 2 * DA_KS ? 0 : (s) + DA_KS)
#define DA_NEXT_V(s) ((s) == 3 * DA_KS ? 0 : (s) + DA_KS)
    DaUnit U, Un; int ui = vcu;
    if (!da_decode(ui, U)) return;
    const f16* ksrc = proj + ((size_t)U.b * SEQ) * PW + U.h * 128 + koff; const f16* vsrc = proj + ((size_t)U.b * SEQ) * PW + U.h * 128 + voff;
    h8 qn[4];
    { const GAS f16* Qg = (const GAS f16*)proj + ((size_t)U.b * SEQ + U.qt * 128) * PW + qoff + U.h * 128;
#pragma unroll
      for (int d0 = 0; d0 < 4; ++d0) qn[d0] = *(const GAS h8*)(Qg + 16 * d0); }
    asm volatile("" : "+v"(qn[0]), "+v"(qn[1]), "+v"(qn[2]), "+v"(qn[3]));
    DA_DMA(ksrc, vsrc, 0, 0, 0); DA_DMA(ksrc, vsrc, 1, DA_KS, DA_KS);
    int ik = 2 * DA_KS, iv = 2 * DA_KS, ck = 0, cv = 0;
    for (;;) {
        const size_t rowbase = (size_t)U.b * SEQ;
        const int qw = U.qt * 128 + 32 * rg, t = qw + l31, lastt = qw >> 6, NT = 2 * U.qt + 2;
        const float cslope = exp2f(-2.0f * (float)(U.h + 1)) * LOG2E;
        const float cs64 = 64.0f * cslope, base0 = -cslope * (float)(t - 32 * hi) - mref;
        h8 qr[4];
#pragma unroll
        for (int d0 = 0; d0 < 4; ++d0) qr[d0] = qn[d0];
        const size_t grow = rowbase + qw + l31;
        const bool has_next = da_decode(ui + G, Un);
        const f16* ksn = ksrc; const f16* vsn = vsrc;
        if (has_next) { ksn = proj + ((size_t)Un.b * SEQ) * PW + Un.h * 128 + koff; vsn = proj + ((size_t)Un.b * SEQ) * PW + Un.h * 128 + voff; }
        f32x16 o[4]; o[0] = f32x16{}; o[1] = f32x16{}; o[2] = f32x16{}; o[3] = f32x16{};
        float lsum = 0.f;
        h8 pq0, pq1, pq2, pq3;
        int pvs = 0;
        SW_BEGIN(2);
        for (int kt = 0; kt < NT; ++kt) {
            SW_BEGIN(3);
            if (kt + 1 < NT || has_next) WAIT_BAR(4); else WAIT_BAR(0);
            SW_END(3);
#define DA_ISSUE() do { if (kt + 2 < NT) { DA_DMA(ksrc, vsrc, kt + 2, ik, iv); ik = DA_NEXT_K(ik); iv = DA_NEXT_V(iv); } \
            else if (has_next) { DA_DMA(ksn, vsn, kt + 2 - NT, ik, iv); ik = DA_NEXT_K(ik); iv = DA_NEXT_V(iv); } } while (0)
            DA_ISSUE();
            if (c == 1 && kt >= 1 && kt - 1 <= lastt) da_pv(o, lds + pvs, vfo, pq0, pq1, pq2, pq3);
            if (kt <= lastt) {
                const LAS unsigned char* Ks = lds + ck;
                f32x16 p0, p1;
                const float basek = __builtin_fmaf(cs64, (float)kt, base0);
                __builtin_amdgcn_sched_barrier(0);
                asm volatile("s_nop 7" ::: "memory");
#define DA_INIT(r) p0[r] = fmamk_s<r>(cslope, basek); p1[r] = fmamk_s<16 + r>(cslope, basek);
                DA_INIT(0) DA_INIT(1) DA_INIT(2) DA_INIT(3) DA_INIT(4) DA_INIT(5) DA_INIT(6) DA_INIT(7) DA_INIT(8) DA_INIT(9) DA_INIT(10) DA_INIT(11) DA_INIT(12) DA_INIT(13) DA_INIT(14) DA_INIT(15)
#undef DA_INIT
                asm volatile("s_nop 3" : "+v"(p0), "+v"(p1));
                if (kt == lastt) {
                    const int kd = t - (64 * kt + 32 * hi);
                    const float m2 = -2.0f * mref;
                    asm volatile("" ::: "memory");
#pragma unroll
                    for (int r = 0; r < 16; ++r) { if (r > kd) p0[r] = m2 - p0[r]; if (16 + r > kd) p1[r] = m2 - p1[r]; }
                }
#pragma unroll
                for (int d0 = 0; d0 < 4; ++d0) { const h8 ka = *(const LAS h8*)(Ks + kfo[d0]), kb = *(const LAS h8*)(Ks + kfo[d0] + 4096); p0 = MFMA32(ka, qr[d0], p0); p1 = MFMA32(kb, qr[d0], p1); }
                float s0 = 0.f, s1 = 0.f, s2 = 0.f, s3 = 0.f;
#pragma unroll
                for (int r = 0; r < 16; ++r) { p0[r] = __builtin_amdgcn_exp2f(p0[r]); p1[r] = __builtin_amdgcn_exp2f(p1[r]); }

#pragma unroll
                for (int r = 0; r < 16; r += 2) { s0 += p0[r]; s1 += p0[r + 1]; s2 += p1[r]; s3 += p1[r + 1]; }
                lsum += (s0 + s1) + (s2 + s3);
                pq0 = pack8(p0, 0); pq1 = pack8(p0, 8); pq2 = pack8(p1, 0); pq3 = pack8(p1, 8); pvs = cv;
                if (c == 0) da_pv(o, lds + cv, vfo, pq0, pq1, pq2, pq3);
            }
            ck = DA_NEXT_K(ck); cv = DA_NEXT_V(cv);
        }
        if (c == 1 && NT - 1 <= lastt) da_pv(o, lds + pvs, vfo, pq0, pq1, pq2, pq3);
        asm volatile("s_nop 15\n\ts_nop 7" : "+v"(o[0]), "+v"(o[1]), "+v"(o[2]), "+v"(o[3]));
        SW_END(2);
        const int dlo = 2 * c;
        u32x2 gv[8];
        { const GAS f16* Gp = (const GAS f16*)proj + grow * PW + C_DAG + U.h * 128 + 32 * dlo + 4 * hi;
#pragma unroll
          for (int i = 0; i < 8; ++i) gv[i] = *(const GAS u32x2*)(Gp + 8 * i); }
        if (has_next) { const GAS f16* Qg = (const GAS f16*)proj + ((size_t)Un.b * SEQ + Un.qt * 128) * PW + qoff + Un.h * 128;
#pragma unroll
            for (int d0 = 0; d0 < 4; ++d0) qn[d0] = *(const GAS h8*)(Qg + 16 * d0); }
        asm volatile("" ::: "memory");
        { const auto rr = __builtin_amdgcn_permlane32_swap(__float_as_uint(lsum), __float_as_uint(lsum), false, false); lsum = __uint_as_float(rr[0]) + __uint_as_float(rr[1]); }
        const float f = (c == 0 ? 1.0f : lam) / lsum;
        LAS unsigned* xw = xch + (c ^ 1) * 1024;
        LAS unsigned* xr = xch + c * 1024;
        f32x16 ya, yb;
        if (c == 0) {
#pragma unroll
            for (int r2 = 0; r2 < 8; ++r2) { xw[r2 * 64 + lane] = pkh(o[2][2 * r2] * f, o[2][2 * r2 + 1] * f); xw[(8 + r2) * 64 + lane] = pkh(o[3][2 * r2] * f, o[3][2 * r2 + 1] * f); }
            ya = o[0] * f; yb = o[1] * f;
        } else {
#pragma unroll
            for (int r2 = 0; r2 < 8; ++r2) { xw[r2 * 64 + lane] = pkh(o[0][2 * r2] * f, o[0][2 * r2 + 1] * f); xw[(8 + r2) * 64 + lane] = pkh(o[1][2 * r2] * f, o[1][2 * r2 + 1] * f); }
            ya = o[2] * f; yb = o[3] * f;
        }
        asm volatile("s_waitcnt lgkmcnt(0)\n\ts_barrier" ::: "memory");
        const float sgn = (c == 0) ? 1.0f : -1.0f;
        float ss = 0.f;
#pragma unroll
        for (int r2 = 0; r2 < 8; ++r2) {
            const h2 pa = __builtin_bit_cast(h2, xr[r2 * 64 + lane]), pb = __builtin_bit_cast(h2, xr[(8 + r2) * 64 + lane]);
            const float a0 = (ya[2 * r2] - (float)pa[0]) * sgn, a1 = (ya[2 * r2 + 1] - (float)pa[1]) * sgn, b0 = (yb[2 * r2] - (float)pb[0]) * sgn, b1 = (yb[2 * r2 + 1] - (float)pb[1]) * sgn;
            ya[2 * r2] = a0; ya[2 * r2 + 1] = a1; yb[2 * r2] = b0; yb[2 * r2 + 1] = b1; ss += (a0 * a0 + a1 * a1) + (b0 * b0 + b1 * b1);
        }
        { const auto rr = __builtin_amdgcn_permlane32_swap(__float_as_uint(ss), __float_as_uint(ss), false, false); ss = __uint_as_float(rr[0]) + __uint_as_float(rr[1]); }
        LAS float* ssx = (LAS float*)(lds + DA_SSX + rg * 256);
        if (hi == 0) ssx[c * 32 + l31] = ss;
        asm volatile("s_waitcnt lgkmcnt(0)\n\ts_barrier" ::: "memory");
        ss += ssx[(c ^ 1) * 32 + l31];
        const float rn = __builtin_amdgcn_rsqf(ss * (1.0f / 128.0f) + RMS_EPS) * osc;
        {
            const LAS float* sgl = (const LAS float*)(lds + DA_SUBG) + 32 * dlo + 4 * hi;
            GAS f16* Op = (GAS f16*)mixed + grow * DM + 512 + U.h * 128 + 32 * dlo + 4 * hi;
#pragma unroll
            for (int rg4 = 0; rg4 < 4; ++rg4) {
                const h4 g = __builtin_bit_cast(h4, gv[rg4]);
                const f32x4 sg = *(const LAS f32x4*)(sgl + 8 * rg4);
                u32x2 wv;
                wv.x = pkh(ya[4 * rg4] * rn * sg[0] * (float)g[0], ya[4 * rg4 + 1] * rn * sg[1] * (float)g[1]);
                wv.y = pkh(ya[4 * rg4 + 2] * rn * sg[2] * (float)g[2], ya[4 * rg4 + 3] * rn * sg[3] * (float)g[3]);
                *(GAS u32x2*)(Op + 8 * rg4) = wv;
            }
#pragma unroll
            for (int rg4 = 0; rg4 < 4; ++rg4) {
                const h4 g = __builtin_bit_cast(h4, gv[4 + rg4]);
                const f32x4 sg = *(const LAS f32x4*)(sgl + 32 + 8 * rg4);
                u32x2 wv;
                wv.x = pkh(yb[4 * rg4] * rn * sg[0] * (float)g[0], yb[4 * rg4 + 1] * rn * sg[1] * (float)g[1]);
                wv.y = pkh(yb[4 * rg4 + 2] * rn * sg[2] * (float)g[2], yb[4 * rg4 + 3] * rn * sg[3] * (float)g[3]);
                *(GAS u32x2*)(Op + 32 + 8 * rg4) = wv;
            }
        }
        if (!has_next) break;
        U = Un; ui += G; ksrc = ksn; vsrc = vsn;
        asm volatile("" : "+v"(qn[0]), "+v"(qn[1]), "+v"(qn[2]), "+v"(qn[3]));
    }
#undef DA_DMA
#undef DA_ISSUE
#undef DA_NEXT_K
#undef DA_NEXT_V
    WAIT_BAR(0);
}
}

constexpr size_t MiB = 1u << 20;
constexpr size_t WS_CTL = 0, CTL_ZERO_BYTES = 64 * 1024;
constexpr size_t WS_WIN = 2 * MiB;
constexpr size_t WS_WOUT = 18 * MiB;
constexpr size_t WS_PART = 22 * MiB;
constexpr size_t WS_XB = 32 * MiB;
constexpr size_t WS_MIX = 96 * MiB;
constexpr size_t WS_PROJ = 160 * MiB;
constexpr size_t WS_END = 416 * MiB;
constexpr int CW_BAR = 4096;

constexpr int RING_OFF = 0, RING_BYTES = 131072;
constexpr int LDSCTL_OFF = 147456, MISC_OFF = LDSCTL_OFF + 320;
constexpr int LDS_BYTES = 163840;
constexpr int NWAVES = 8;

typedef GAS unsigned gu32;
#define LDS_WAIT() asm volatile("s_waitcnt lgkmcnt(0)" ::: "memory")

#define XB_TMO      128
#define XB_XCNT(j)  (256  + 64 * (j))
#define XB_XSUB(j)  (1280 + 64 * (j))
#define XB_XGEN(j)  (2304 + 64 * (j))
#define XB_TOP      3328
#define XB_TOPGEN   3392
#define XCD_BAR_WORDS 3456
#define XB_SPIN_CAP (1u << 18)
__device__ __forceinline__ unsigned xb_ld(unsigned* p)              { return __hip_atomic_load(p, __ATOMIC_RELAXED, __HIP_MEMORY_SCOPE_AGENT); }
__device__ __forceinline__ unsigned xb_add(unsigned* p, unsigned v) { return __hip_atomic_fetch_add(p, v, __ATOMIC_RELAXED, __HIP_MEMORY_SCOPE_AGENT); }
__device__ __forceinline__ unsigned xb_xcc_id() { return (unsigned)__builtin_amdgcn_s_getreg((3 << 11) | 20) & 0xFu; }
#define XB_SPIN(cond, bar) do { unsigned _sp = 0; while (cond) { __builtin_amdgcn_s_sleep(1); \
    if ((++_sp & 255u) == 0u) { if (xb_ld(&(bar)[XB_TMO])) break; if (_sp > XB_SPIN_CAP) { atomicAdd(&(bar)[XB_TMO], 1u); break; } } } } while (0)
struct XcdBarrier { unsigned* bar; unsigned x; volatile LAS unsigned* st; };
__device__ __forceinline__ XcdBarrier xcd_barrier_post(unsigned* bar, volatile LAS unsigned* st) {
    XcdBarrier b; b.bar = bar; b.x = xb_xcc_id(); b.st = st;
    if (threadIdx.x == 0) (void)xb_add(&bar[XB_XCNT(b.x)], 1u);
    return b;
}
__device__ __forceinline__ void xcd_barrier_complete(unsigned* bar, unsigned x, unsigned& nloc, unsigned& nx) {
    const unsigned G = gridDim.x * gridDim.y * gridDim.z;
    unsigned sum, cnt, mine, sp = 0u;
    for (;;) {
        sum = 0u; cnt = 0u; mine = 0u;
#pragma unroll
        for (unsigned j = 0; j < 16; ++j) { const unsigned c = xb_ld(&bar[XB_XCNT(j)]); sum += c; cnt += (c > 0u) ? 1u : 0u; mine = (j == x) ? c : mine; }
        if (sum == G) break;
        __builtin_amdgcn_s_sleep(1);
        if ((++sp & 255u) == 0u) { if (xb_ld(&bar[XB_TMO])) break; if (sp > XB_SPIN_CAP) { atomicAdd(&bar[XB_TMO], 1u); break; } }
    }
    nloc = mine > 0u ? mine : 1u; nx = cnt > 0u ? cnt : 1u;
}
__device__ __forceinline__ void xcd_barrier(const XcdBarrier& b) {
    asm volatile("s_waitcnt vmcnt(0)" ::: "memory");
    __syncthreads();
    if (threadIdx.x == 0) {
        unsigned* bar = b.bar;
        __builtin_amdgcn_s_waitcnt(0);
        unsigned nloc = b.st[0], nx = b.st[1];
        if (nloc == 0u) { xcd_barrier_complete(bar, b.x, nloc, nx); b.st[0] = nloc; b.st[1] = nx; }
        const unsigned old = xb_add(&bar[XB_XSUB(b.x)], 1u);
        const unsigned gen = old / nloc;
        if (old + 1u == (gen + 1u) * nloc) {
            __builtin_amdgcn_fence(__ATOMIC_RELEASE, "agent");
            asm volatile("s_waitcnt vmcnt(0)" ::: "memory");
            const unsigned og = xb_add(&bar[XB_TOP], 1u);
            const unsigned tg = og / nx;
            if (og + 1u == (tg + 1u) * nx) xb_add(&bar[XB_TOPGEN], 1u);
            else XB_SPIN(xb_ld(&bar[XB_TOPGEN]) == tg, bar);
            __builtin_amdgcn_fence(__ATOMIC_ACQUIRE, "agent");
            xb_add(&bar[XB_XGEN(b.x)], 1u);
            asm volatile("s_waitcnt vmcnt(0)" ::: "memory");
        } else {
            XB_SPIN(xb_ld(&bar[XB_XGEN(b.x)]) == gen, bar);
            __builtin_amdgcn_fence(__ATOMIC_ACQUIRE, "agent");
            asm volatile("s_waitcnt vmcnt(0)" ::: "memory");
        }
    }
    __syncthreads();
}

__device__ __forceinline__ void p0_transpose_item(const float* W, const float* g, int K, int N, f16* WT, LAS float* scr, int item, int lane) {
    const int nblk = N / 32, kb = item / nblk, nb = item % nblk, k0 = 32 * kb, n0 = 32 * nb;
    float v[16];
#pragma unroll
    for (int i = 0; i < 16; ++i) { const int kk = 2 * i + (lane >> 5); v[i] = W[(size_t)(k0 + kk) * N + n0 + (lane & 31)]; }
    if (g) {
#pragma unroll
        for (int i = 0; i < 16; ++i) v[i] *= g[k0 + 2 * i + (lane >> 5)];
    }
#pragma unroll
    for (int i = 0; i < 16; ++i) scr[(2 * i + (lane >> 5)) * 33 + (lane & 31)] = v[i];
    LDS_WAIT(); asm volatile("" ::: "memory");
    const int c = lane & 3;
#pragma unroll
    for (int j = 0; j < 2; ++j) { const int n = (lane >> 2) + 16 * j; const LAS float* sp = scr + (8 * c) * 33 + n;
        u32x4 o; o.x = pkh(sp[0 * 33], sp[1 * 33]); o.y = pkh(sp[2 * 33], sp[3 * 33]); o.z = pkh(sp[4 * 33], sp[5 * 33]); o.w = pkh(sp[6 * 33], sp[7 * 33]);
        *(GAS u32x4*)(WT + (size_t)(n0 + n) * K + k0 + 8 * c) = o; }
    LDS_WAIT(); asm volatile("" ::: "memory");
}
__device__ __forceinline__ void x_rows4(const float* x, f16* xb, float* part, int m0, int stride, int lane) {
    f32x4 v[4][4];
#pragma unroll
    for (int r = 0; r < 4; ++r) { const GAS f32x4* xr = (const GAS f32x4*)(x + (size_t)(m0 + r * stride) * DM) + lane;
#pragma unroll
        for (int j = 0; j < 4; ++j) v[r][j] = xr[64 * j]; }
#pragma unroll
    for (int r = 0; r < 4; ++r) {
        float s = 0.f;
#pragma unroll
        for (int j = 0; j < 4; ++j) s += (v[r][j][0] * v[r][j][0] + v[r][j][1] * v[r][j][1]) + (v[r][j][2] * v[r][j][2] + v[r][j][3] * v[r][j][3]);
        s = att::wave_sum(s);
        const size_t row = (size_t)(m0 + r * stride);
        GAS u32x2* o8 = (GAS u32x2*)(xb + row * DM) + lane;
#pragma unroll
        for (int j = 0; j < 4; ++j) { u32x2 w; w.x = pkh(v[r][j][0], v[r][j][1]); w.y = pkh(v[r][j][2], v[r][j][3]); o8[64 * j] = w; }
        if (lane < 16) part[row * 16 + lane] = (lane == 0) ? s : 0.f;
    }
}

__device__ __forceinline__ void x_row1(const float* x, f16* xb, float* part, int m, int lane) {
    const GAS f32x4* xr = (const GAS f32x4*)(x + (size_t)m * DM) + lane;
    f32x4 v[4]; float s = 0.f;
#pragma unroll
    for (int j = 0; j < 4; ++j) { v[j] = xr[64 * j]; s += (v[j][0] * v[j][0] + v[j][1] * v[j][1]) + (v[j][2] * v[j][2] + v[j][3] * v[j][3]); }
    s = att::wave_sum(s);
    GAS u32x2* o8 = (GAS u32x2*)(xb + (size_t)m * DM) + lane;
#pragma unroll
    for (int j = 0; j < 4; ++j) { u32x2 w; w.x = pkh(v[j][0], v[j][1]); w.y = pkh(v[j][2], v[j][3]); o8[64 * j] = w; }
    if (lane < 16) part[(size_t)m * 16 + lane] = (lane == 0) ? s : 0.f;
}

struct Args { const float* in[11]; float* out; unsigned char* ws; };
__global__ void __launch_bounds__(NWAVES * 64, 2) hybrid_fwd(Args args) {
    extern __shared__ __attribute__((aligned(16))) unsigned char lds_raw[];
    LAS unsigned char* lds = (LAS unsigned char*)lds_raw;
    volatile LAS unsigned* MISC = (volatile LAS unsigned*)(lds + MISC_OFF);
    const int tid = threadIdx.x, lane = tid & 63, wave = __builtin_amdgcn_readfirstlane(tid >> 6);
    const int G = gridDim.x; const int bx = blockIdx.x; const int vcu = (G % 8 == 0) ? (bx % 8) * (G / 8) + bx / 8 : bx;
    unsigned char* ws = args.ws;
    gu32* ctl = (gu32*)(ws + WS_CTL);
    const float* x = args.in[0]; const float* norm_g = args.in[1]; const float* w_in = args.in[2]; const float* w_out = args.in[3];
    const float* q_norm_g = args.in[4]; const float* k_norm_g = args.in[5];
    const float* lq1 = args.in[6]; const float* lk1 = args.in[7]; const float* lq2 = args.in[8]; const float* lk2 = args.in[9]; const float* subln_g = args.in[10];
    float* out = args.out;
    f16* WIN = (f16*)(ws + WS_WIN); f16* WOUT = (f16*)(ws + WS_WOUT); float* PART = (float*)(ws + WS_PART);
    f16* XB = (f16*)(ws + WS_XB); f16* MIX = (f16*)(ws + WS_MIX); f16* PROJ = (f16*)(ws + WS_PROJ);

    unsigned long long sw_acc = 0;
    for (int u = tid; u < (LDS_BYTES - LDSCTL_OFF) / 4; u += NWAVES * 64) ((LAS unsigned*)(lds + LDSCTL_OFF))[u] = 0u;
    __syncthreads();
    XcdBarrier bar = xcd_barrier_post((unsigned*)(ctl + CW_BAR), MISC + 8);

    SW_BEGIN(6);
    for (int rep = 0; rep < REP_PRO; ++rep) {
        LAS float* scr = (LAS float*)(lds + RING_OFF + wave * 16384);
        const int gw = vcu * NWAVES + wave, NGW = G * NWAVES;
        constexpr int I_IN = (DM / 32) * (PW / 32), I_OUT = (DM / 32) * (DM / 32);
        constexpr int NITEMS = DEPTH * (I_IN + I_OUT);
        SW_BEGIN(9);
        for (int it = gw; it < NITEMS; it += NGW) {
            int r = it; const int l = r / (I_IN + I_OUT); r -= l * (I_IN + I_OUT);
            if (r < I_IN) p0_transpose_item(w_in + (size_t)l * DM * PW, norm_g + l * DM, DM, PW, WIN + (size_t)l * PW * DM, scr, r, lane);
            else p0_transpose_item(w_out + (size_t)l * DM * DM, nullptr, DM, DM, WOUT + (size_t)l * DM * DM, scr, r - I_IN, lane);
        }
        SW_END(9);
        SW_BEGIN(10);
        { int m = gw; for (; m + 3 * NGW < MROWS; m += 4 * NGW) x_rows4(x, XB, PART, m, NGW, lane); for (; m < MROWS; m += NGW) x_row1(x, XB, PART, m, lane); }
        SW_END(10);
    }
    SW_END(6);
    { SW_BEGIN(7); xcd_barrier(bar); SW_END(7); }

    for (int l = 0; l < DEPTH; ++l) {
        { unsigned char* wsl = ws; asm volatile("" : "+s"(wsl)); WIN = (f16*)(wsl + WS_WIN); WOUT = (f16*)(wsl + WS_WOUT); PART = (float*)(wsl + WS_PART); XB = (f16*)(wsl + WS_XB); MIX = (f16*)(wsl + WS_MIX); PROJ = (f16*)(wsl + WS_PROJ);
          asm volatile("" : "+s"(out)); asm volatile("" : "+s"(x)); asm volatile("" : "+s"(subln_g)); asm volatile("" : "+s"(q_norm_g)); asm volatile("" : "+s"(k_norm_g)); asm volatile("" : "+s"(bar.bar)); }
        for (int rep = 0; rep < REP_G1; ++rep) {
            pg8::Gemm g{XB, WIN + (size_t)l * PW * DM, MROWS, PW, DM}; pg8::StaticOrder S; S.init(MROWS, PW, G, bx);
            pg8::EpiProj E{PROJ, PART, q_norm_g + l * 64, k_norm_g + l * 64};
            SW_BEGIN(5);
            pg8::gemm_phase<pg8::EpiProj>(lds + RING_OFF, g, S, E, sw_acc);
            SW_END(5);
        }
        { SW_BEGIN(7); xcd_barrier(bar); SW_END(7); }
        {
            const float sa = att::wave_sum(lq1[l * 64 + lane] * lk1[l * 64 + lane]), sb = att::wave_sum(lq2[l * 64 + lane] * lk2[l * 64 + lane]);
            const float lam_init = 0.8f - 0.6f * __expf(-0.3f * (float)l);
            const float lam = __expf(sa) - __expf(sb) + lam_init;
            const float mgq = att::wave_max(fabsf(q_norm_g[l * 64 + lane])), mgk = att::wave_max(fabsf(k_norm_g[l * 64 + lane]));
            const float mref = 8.0f * LOG2E * mgq * mgk * 1.001f - 10.0f;
            __syncthreads();
            for (int rep = 0; rep < REP_DA; ++rep) { SW_BEGIN(1); att::da_phase(lds + RING_OFF, PROJ, MIX, vcu, G, lam, mref, subln_g + l * 128, 1.0f - lam_init, sw_acc); SW_END(1); }
            for (int rep = 0; rep < REP_SB; ++rep) { SW_BEGIN(4); att::sb_phase(lds + RING_OFF, PROJ, MIX, vcu, G, sw_acc); SW_END(4); }
        }
        { SW_BEGIN(7); xcd_barrier(bar); SW_END(7); }
        {
            pg8::Gemm g{MIX, WOUT + (size_t)l * DM * DM, MROWS, DM, DM}; pg8::StaticOrder S; S.init(MROWS, DM, G, bx);
            pg8::EpiOut E{out, XB, PART, (l + 1 < DEPTH) ? 0 : 1};
            SW_BEGIN(8);
            pg8::gemm_phase<pg8::EpiOut>(lds + RING_OFF, g, S, E, sw_acc);
            SW_END(8);
        }
        if (l + 1 < DEPTH) { SW_BEGIN(7); xcd_barrier(bar); SW_END(7); }
    }
#if SW_ID
    if (wave == 0) { const unsigned long long t0 = __builtin_amdgcn_s_memrealtime(), span = (unsigned long long)SW_K * sw_acc; while (__builtin_amdgcn_s_memrealtime() - t0 < span) __builtin_amdgcn_s_sleep(8); }
#endif
}

extern "C" void kernel_launch(void* const* d_in, const int* in_sizes, int n_in, void* d_out, int out_size, void* d_ws, size_t ws_size, hipStream_t stream) {
    static int grid = 0;
    if (grid == 0) {
        if (n_in != 11 || in_sizes[0] != MROWS * DM || out_size != MROWS * DM || ws_size < WS_END) {
            fprintf(stderr, "kernel_launch: unexpected problem shape (n_in %d, in0 %d, out %d, ws %zu); nothing launched\n", n_in, n_in > 0 ? in_sizes[0] : -1, out_size, ws_size); grid = -1; return; }
        int dev = 0, cus = 0, per_cu = 0;
        if (hipGetDevice(&dev) != hipSuccess || hipDeviceGetAttribute(&cus, hipDeviceAttributeMultiprocessorCount, dev) != hipSuccess) { grid = -1; return; }
        if (hipFuncSetAttribute((const void*)hybrid_fwd, hipFuncAttributeMaxDynamicSharedMemorySize, LDS_BYTES) != hipSuccess) { fprintf(stderr, "kernel_launch: hipFuncSetAttribute failed\n"); grid = -1; return; }
        if (hipOccupancyMaxActiveBlocksPerMultiprocessor(&per_cu, (const void*)hybrid_fwd, NWAVES * 64, LDS_BYTES) != hipSuccess || per_cu < 1) {
            fprintf(stderr, "kernel_launch: occupancy query reports %d workgroups per CU; nothing launched\n", per_cu); (void)hipGetLastError(); grid = -1; return; }
        grid = cus;
    }
    if (grid < 0) return;
    if (hipMemsetAsync((char*)d_ws + WS_CTL, 0, CTL_ZERO_BYTES, stream) != hipSuccess) { fprintf(stderr, "kernel_launch: hipMemsetAsync failed\n"); return; }
    Args a{};
    for (int i = 0; i < 11; ++i) a.in[i] = (const float*)d_in[i];
    a.out = (float*)d_out; a.ws = (unsigned char*)d_ws;
    hipLaunchKernelGGL(hybrid_fwd, dim3(grid), dim3(NWAVES * 64), LDS_BYTES, stream, a);
    const hipError_t le = hipPeekAtLastError();
    if (le != hipSuccess) fprintf(stderr, "kernel_launch: launch failed: %s\n", hipGetErrorName(le));
}
```

```cpp
#include <hip/hip_runtime.h>
#include <cstdio>
#include <cstdint>

#ifndef SB_EARLY_EXIT
#define SB_EARLY_EXIT 1
#endif
#define SW_ID 0
#define SW_K 4
#define REP_PRO 1
#define REP_G1 1
#define REP_DA 1
#define REP_SB 1
#define REP_G2 1

#if SW_ID
#define SW_BEGIN(id) unsigned long long sw_t0_##id = 0; if (SW_ID == (id)) sw_t0_##id = __builtin_amdgcn_s_memrealtime()
#define SW_END(id) do { if (SW_ID == (id)) sw_acc += __builtin_amdgcn_s_memrealtime() - sw_t0_##id; } while (0)
#else
#define SW_BEGIN(id) do {} while (0)
#define SW_END(id) do {} while (0)
#endif
#define LAS __attribute__((address_space(3)))
#define GAS __attribute__((address_space(1)))
typedef _Float16 f16;
typedef _Float16 h8 __attribute__((ext_vector_type(8)));
typedef _Float16 h4 __attribute__((ext_vector_type(4)));
typedef _Float16 h2 __attribute__((ext_vector_type(2)));
typedef float f32x4 __attribute__((ext_vector_type(4)));
typedef float f32x16 __attribute__((ext_vector_type(16)));
typedef unsigned u32x4 __attribute__((ext_vector_type(4)));
typedef unsigned u32x2 __attribute__((ext_vector_type(2)));

constexpr int BATCH = 16, SEQ = 2048, DM = 1024, MROWS = BATCH * SEQ, PW = 4096, DEPTH = 2;
constexpr float RMS_EPS = 1e-6f;
constexpr float LOG2E = 1.4426950408889634f;
constexpr float QS = 0.125f * LOG2E;
constexpr int C_SBQ = 0, C_SBK = 512, C_SBV = 1024, C_SBG = 1536, C_DAQ = 2048, C_DAK = 2560, C_DAV = 3072, C_DAG = 3584;

__device__ __forceinline__ unsigned pkh(float lo, float hi) { h2 v = {(f16)lo, (f16)hi}; return __builtin_bit_cast(unsigned, v); }
__device__ __forceinline__ unsigned pkh_rtz(float lo, float hi) { return __builtin_bit_cast(unsigned, __builtin_amdgcn_cvt_pkrtz(lo, hi)); }
__device__ __forceinline__ float silu_f(float v) { return v * __builtin_amdgcn_rcpf(1.0f + __builtin_amdgcn_exp2f(-v * LOG2E)); }

namespace pg8 {
constexpr int BM = 256, BK = 64, HALF = 128, HTB = HALF * BK * 2, STAGE_BYTES = 8 * HTB, NXCD = 8, WGM = 8;
__host__ __device__ __forceinline__ int lds_byte(int r, int c) { const int st = (r >> 4) * 2 + (c >> 5), rr = r & 15, cc = c & 31, ob = rr * 64 + cc * 2; return st * 1024 + (ob ^ (((ob >> 9) & 1) << 5)); }
__host__ __device__ __forceinline__ void stage_rc(int b, int& R, int& C) { const int st = b / 1024, sb = b % 1024, swz = sb ^ (((sb >> 9) & 1) << 5); R = (st >> 1) * 16 + swz / 64; C = (st & 1) * 32 + (swz % 64) / 2; }
__host__ __device__ __forceinline__ int perm32(int rho) { const int n = rho >> 4, i = rho & 15; return 8 * (i >> 2) + 4 * n + (i & 3); }

struct Unit { int pm, pn; };
struct Gemm { const f16* A; const f16* Bt; int M, N, K; };

struct StaticOrder {
    int nM, nN, nwg, G, c;
    __host__ __device__ void init(int M, int N, int G_, int c_) { nM = M / BM; nN = N / BM; nwg = nM * nN; G = G_; c = c_; }
    __host__ __device__ bool next(int i, Unit& u) const {
        const long L = (long)i * G + c; if (L >= nwg) return false;
        int wgid = (int)L; { const int q = nwg / NXCD, r = nwg % NXCD, xcd = wgid % NXCD, off = wgid / NXCD; wgid = (xcd < r ? xcd * (q + 1) : r * (q + 1) + (xcd - r) * q) + off; }
        const int nig = WGM * nN, gid = wgid / nig, fm = gid * WGM, gsz = (nM - fm) < WGM ? (nM - fm) : WGM;
        u.pm = fm + ((wgid % nig) % gsz); u.pn = (wgid % nig) / gsz; return true;
    }
};


struct EpiProj {
    GAS f16* P; const GAS float* part; const GAS float* gq; const GAS float* gk;
    __device__ __forceinline__ void operator()(const f32x4 (&acc)[2][2][4][2], const Unit& u, int wr, int wc, int fr, int fq) const {
        const int sec = u.pn >> 1;
        const int row0 = u.pm * BM + wr * 64 + fr;
        const int colw = u.pn * BM + wc * 64 + 8 * fq;
        f32x4 gain[2][2];
        if (sec == 4 || sec == 5) {
            const GAS float* g = (sec == 4) ? gq : gk;
#pragma unroll
            for (int bj = 0; bj < 2; ++bj)
#pragma unroll
                for (int n = 0; n < 2; ++n) gain[bj][n] = *(const GAS f32x4*)(g + 32 * bj + 8 * fq + 4 * n);
        }
#pragma unroll
        for (int ai = 0; ai < 2; ++ai)
#pragma unroll
            for (int m = 0; m < 4; ++m) {
                const int row = row0 + ai * HALF + m * 16;
                const f32x4 pv = *(const GAS f32x4*)(part + (size_t)row * 16 + fq * 4);
                float s = (pv[0] + pv[1]) + (pv[2] + pv[3]);
                s += __shfl_xor(s, 16); s += __shfl_xor(s, 32);
                const float rs = __builtin_amdgcn_rsqf(s * (1.0f / DM) + RMS_EPS);
                f32x4 v[2][2];
#pragma unroll
                for (int bj = 0; bj < 2; ++bj)
#pragma unroll
                    for (int n = 0; n < 2; ++n) v[bj][n] = acc[ai][bj][m][n] * rs;
                if (sec == 4 || sec == 5) {
                    float ss = 0.f;
#pragma unroll
                    for (int bj = 0; bj < 2; ++bj)
#pragma unroll
                        for (int n = 0; n < 2; ++n) { const f32x4 x = v[bj][n]; ss += (x[0] * x[0] + x[1] * x[1]) + (x[2] * x[2] + x[3] * x[3]); }
                    ss += __shfl_xor(ss, 16); ss += __shfl_xor(ss, 32);
                    float rn = __builtin_amdgcn_rsqf(ss * (1.0f / 64.0f) + RMS_EPS);
                    if (sec == 4) rn *= QS;
#pragma unroll
                    for (int bj = 0; bj < 2; ++bj)
#pragma unroll
                        for (int n = 0; n < 2; ++n) v[bj][n] = v[bj][n] * rn * gain[bj][n];
                } else if (sec == 0) {
#pragma unroll
                    for (int bj = 0; bj < 2; ++bj)
#pragma unroll
                        for (int n = 0; n < 2; ++n) v[bj][n] = v[bj][n] * QS;
                } else if (sec == 3 || sec == 7) {
#pragma unroll
                    for (int bj = 0; bj < 2; ++bj)
#pragma unroll
                        for (int n = 0; n < 2; ++n)
#pragma unroll
                            for (int e = 0; e < 4; ++e) v[bj][n][e] = silu_f(v[bj][n][e]);
                }
                GAS f16* rowp = P + (size_t)row * PW + colw;
#pragma unroll
                for (int bj = 0; bj < 2; ++bj) {
                    u32x4 w; w.x = pkh(v[bj][0][0], v[bj][0][1]); w.y = pkh(v[bj][0][2], v[bj][0][3]); w.z = pkh(v[bj][1][0], v[bj][1][1]); w.w = pkh(v[bj][1][2], v[bj][1][3]);
                    *(GAS u32x4*)(rowp + 32 * bj) = w;
                }
            }
    }
};

struct EpiOut {
    GAS float* out; GAS f16* xb; GAS float* part; int last;
    __device__ __forceinline__ void operator()(const f32x4 (&acc)[2][2][4][2], const Unit& u, int wr, int wc, int fr, int fq) const {
        const int row0 = u.pm * BM + wr * 64 + fr;
        const int colw = u.pn * BM + wc * 64 + 8 * fq;
#pragma unroll
        for (int ai = 0; ai < 2; ++ai) {
            h8 bs[4][2];
#pragma unroll
            for (int m = 0; m < 4; ++m)
#pragma unroll
                for (int bj = 0; bj < 2; ++bj) bs[m][bj] = *(const GAS h8*)(xb + (size_t)(row0 + ai * HALF + m * 16) * DM + colw + 32 * bj);
#pragma unroll
            for (int m = 0; m < 4; ++m) {
                const int row = row0 + ai * HALF + m * 16;
                const size_t off = (size_t)row * DM + colw;
                float ss = 0.f;
#pragma unroll
                for (int bj = 0; bj < 2; ++bj) {
                    const h8 b = bs[m][bj];
                    f32x4 o0 = acc[ai][bj][m][0], o1 = acc[ai][bj][m][1];
                    o0[0] += (float)b[0]; o0[1] += (float)b[1]; o0[2] += (float)b[2]; o0[3] += (float)b[3];
                    o1[0] += (float)b[4]; o1[1] += (float)b[5]; o1[2] += (float)b[6]; o1[3] += (float)b[7];
                    if (last) { *(GAS f32x4*)(out + off + 32 * bj) = o0; *(GAS f32x4*)(out + off + 32 * bj + 4) = o1; }
                    else {
                        ss += (o0[0] * o0[0] + o0[1] * o0[1]) + (o0[2] * o0[2] + o0[3] * o0[3]) + (o1[0] * o1[0] + o1[1] * o1[1]) + (o1[2] * o1[2] + o1[3] * o1[3]);
                        u32x4 w; w.x = pkh(o0[0], o0[1]); w.y = pkh(o0[2], o0[3]); w.z = pkh(o1[0], o1[1]); w.w = pkh(o1[2], o1[3]);
                        *(GAS u32x4*)(xb + off + 32 * bj) = w;
                    }
                }
                if (!last) {
                    ss += __shfl_xor(ss, 16); ss += __shfl_xor(ss, 32);
                    if (fq == 0) part[(size_t)row * 16 + u.pn * 4 + wc] = ss;
                }
            }
        }
    }
};

template <class Epi>
__device__ __forceinline__ void gemm_phase(LAS unsigned char* lds, const Gemm g, const StaticOrder& S, const Epi& E, unsigned long long& sw_acc) {
    int tid_ = threadIdx.x; asm volatile("" : "+v"(tid_));
    const int tid = tid_, wid = __builtin_amdgcn_readfirstlane(tid >> 6), lane = tid & 63, wr = wid >> 2, wc = wid & 3, fr = lane & 15, fq = lane >> 4;
    const int K = g.K, nt = K / BK;
    unsigned voffA[2], voffB[2];
#pragma unroll
    for (int i = 0; i < 2; ++i) { int R, C; stage_rc(tid * 16 + i * 8192, R, C);
        const int Rb = (R >> 5) * 64 + perm32(R & 31);
        voffA[i] = (unsigned)(R * K + C) * 2u; voffB[i] = (unsigned)(Rb * K + C) * 2u; }
    const size_t kstep = (size_t)(BK * 2);
    const size_t hstep = (size_t)HALF * K * 2;
    const size_t hstepB = (size_t)32 * K * 2;
    const size_t tstep = 2 * hstep;
    const unsigned ldsw = (unsigned)wid * 1024u;
    const int aoff = lds_byte(wr * 64 + fr, fq * 8), boff = lds_byte(wc * 32 + fr, fq * 8);
#define PG8_SA(b, h) (((b) * 2 + (h)) * HTB)
#define PG8_SB(b, h) ((4 + (b) * 2 + (h)) * HTB)
#define PG8_STAGE(bufoff, gbase, voff) do { _Pragma("unroll") for (int _i = 0; _i < 2; ++_i) \
        __builtin_amdgcn_global_load_lds((const unsigned*)((const char*)(gbase) + (voff)[_i]), (LAS unsigned*)(lds + (bufoff) + ldsw + _i * 8192), 16, 0, 0); } while (0)
#define PG8_LDA(dst, b, h) do { _Pragma("unroll") for (int m = 0; m < 4; ++m) _Pragma("unroll") for (int k = 0; k < 2; ++k) dst[m][k] = *(const LAS h8*)(lds + PG8_SA(b, h) + aoff + m * 2048 + k * 1024); } while (0)
#define PG8_LDB(dst, b, h) do { _Pragma("unroll") for (int n = 0; n < 2; ++n) _Pragma("unroll") for (int k = 0; k < 2; ++k) dst[n][k] = *(const LAS h8*)(lds + PG8_SB(b, h) + boff + n * 2048 + k * 1024); } while (0)
#define PG8_MMA(ai, bj, At, Bt) do { __builtin_amdgcn_s_setprio(1); _Pragma("unroll") for (int m = 0; m < 4; ++m) _Pragma("unroll") for (int n = 0; n < 2; ++n) _Pragma("unroll") for (int k = 0; k < 2; ++k) \
        acc[ai][bj][m][n] = __builtin_amdgcn_mfma_f32_16x16x32_f16(Bt[n][k], At[m][k], acc[ai][bj][m][n], 0, 0, 0); __builtin_amdgcn_s_setprio(0); } while (0)
#define PG8_WAIT_V(n) asm volatile("s_waitcnt vmcnt(" #n ")" ::: "memory")
#define PG8_WAIT_L(n) asm volatile("s_waitcnt lgkmcnt(" #n ")" ::: "memory")
#define PG8_BAR __builtin_amdgcn_s_barrier()
#define PG8_SCHED __builtin_amdgcn_sched_barrier(0)
    Unit cur, nxt; int ui = 0;
    if (!S.next(0, cur)) return;
    f32x4 acc[2][2][4][2];
#pragma unroll
    for (int a = 0; a < 2; ++a)
#pragma unroll
        for (int b = 0; b < 2; ++b)
#pragma unroll
            for (int m = 0; m < 4; ++m)
#pragma unroll
                for (int n = 0; n < 2; ++n) acc[a][b][m][n] = (f32x4){0.f, 0.f, 0.f, 0.f};
    h8 At[4][2], B0[2][2], B1[2][2];
    const char* cA = (const char*)g.A + (size_t)cur.pm * tstep; const char* cB = (const char*)g.Bt + (size_t)cur.pn * tstep;
    PG8_STAGE(PG8_SB(0, 0), cB, voffB); PG8_STAGE(PG8_SB(0, 1), cB + hstepB, voffB); PG8_STAGE(PG8_SA(0, 0), cA, voffA); PG8_STAGE(PG8_SA(0, 1), cA + hstep, voffA);
    if (wr == 1) PG8_BAR;
    PG8_WAIT_V(2); PG8_BAR;
    PG8_STAGE(PG8_SB(1, 0), cB + kstep, voffB); PG8_STAGE(PG8_SA(1, 0), cA + kstep, voffA); PG8_STAGE(PG8_SB(1, 1), cB + hstepB + kstep, voffB);
    PG8_WAIT_V(6); PG8_BAR;
    for (;;) {
        const bool has_next = S.next(ui + 1, nxt);
        const char* nA = has_next ? (const char*)g.A + (size_t)nxt.pm * tstep : cA; const char* nB = has_next ? (const char*)g.Bt + (size_t)nxt.pn * tstep : cB;
        for (int t = 0; t < nt; t += 2) {
            const bool last = (t == nt - 2);
            const char* a1 = cA + (size_t)(t + 1) * kstep;
            const char* a2 = last ? nA : cA + (size_t)(t + 2) * kstep; const char* b2 = last ? nB : cB + (size_t)(t + 2) * kstep;
            const char* a3 = a2 + kstep; const char* b3 = b2 + kstep;
            PG8_LDB(B0, 0, 0); PG8_LDB(B1, 0, 1); PG8_SCHED; PG8_LDA(At, 0, 0); PG8_STAGE(PG8_SA(1, 1), a1 + hstep, voffA);
            PG8_WAIT_V(8); PG8_WAIT_L(0); PG8_BAR; PG8_MMA(0, 0, At, B0); PG8_MMA(0, 1, At, B1); PG8_BAR; PG8_SCHED;
            PG8_LDA(At, 0, 1); PG8_STAGE(PG8_SB(0, 0), b2, voffB); PG8_STAGE(PG8_SB(0, 1), b2 + hstepB, voffB); PG8_STAGE(PG8_SA(0, 0), a2, voffA);
            PG8_WAIT_V(8); PG8_WAIT_L(0); PG8_BAR; PG8_MMA(1, 0, At, B0); PG8_MMA(1, 1, At, B1); PG8_BAR; PG8_SCHED;
            PG8_LDB(B0, 1, 0); PG8_LDB(B1, 1, 1); PG8_SCHED; PG8_LDA(At, 1, 0); PG8_STAGE(PG8_SA(0, 1), a2 + hstep, voffA);
            PG8_WAIT_V(8); PG8_WAIT_L(0); PG8_BAR; PG8_MMA(0, 0, At, B0); PG8_MMA(0, 1, At, B1); PG8_BAR; PG8_SCHED;
            PG8_LDA(At, 1, 1); PG8_STAGE(PG8_SB(1, 0), b3, voffB); PG8_STAGE(PG8_SB(1, 1), b3 + hstepB, voffB); PG8_STAGE(PG8_SA(1, 0), a3, voffA);
            PG8_WAIT_V(8); PG8_WAIT_L(0); PG8_BAR; PG8_MMA(1, 0, At, B0); PG8_MMA(1, 1, At, B1); PG8_BAR; PG8_SCHED;
        }
        if (wr == 0) PG8_BAR;
        { SW_BEGIN(20); E(acc, cur, wr, wc, fr, fq); SW_END(20); }
        if (!has_next) break;
#pragma unroll
        for (int a = 0; a < 2; ++a)
#pragma unroll
            for (int b = 0; b < 2; ++b)
#pragma unroll
                for (int m = 0; m < 4; ++m)
#pragma unroll
                    for (int n = 0; n < 2; ++n) acc[a][b][m][n] = (f32x4){0.f, 0.f, 0.f, 0.f};
        cur = nxt; cA = nA; cB = nB; ++ui;
        if (wr == 1) PG8_BAR;
    }
    PG8_WAIT_V(0);
    PG8_BAR;
#undef PG8_SA
#undef PG8_SB
#undef PG8_STAGE
#undef PG8_LDA
#undef PG8_LDB
#undef PG8_MMA
#undef PG8_WAIT_V
#undef PG8_WAIT_L
#undef PG8_BAR
#undef PG8_SCHED
}
}

namespace att {
typedef short v4i16_t __attribute__((ext_vector_type(4)));
__device__ __forceinline__ int crow(int r, int hi) { return (r & 3) + 8 * (r >> 2) + 4 * hi; }
__device__ __forceinline__ int keyrow(int i) { return 32 * ((i >> 2) & 1) + (i & 3) + 4 * (i >> 3); }
__device__ __forceinline__ h4 vtr(const LAS unsigned char* p) { return __builtin_bit_cast(h4, __builtin_amdgcn_ds_read_tr16_b64_v4i16((LAS v4i16_t*)p)); }
__device__ __forceinline__ h8 cat8(h4 a, h4 b) { return (h8){a[0], a[1], a[2], a[3], b[0], b[1], b[2], b[3]}; }
#define MFMA32(a, b, c) __builtin_amdgcn_mfma_f32_32x32x16_f16(a, b, c, 0, 0, 0)
__device__ __forceinline__ h8 pack8(const f32x16& p, int b) {
    u32x4 w; w.x = pkh_rtz(p[b], p[b + 1]); w.y = pkh_rtz(p[b + 2], p[b + 3]); w.z = pkh_rtz(p[b + 4], p[b + 5]); w.w = pkh_rtz(p[b + 6], p[b + 7]);
    return __builtin_bit_cast(h8, w);
}
__device__ __forceinline__ float vadd_s(float a, float b) { float r; asm("v_add_f32_e32 %0, %1, %2" : "=v"(r) : "v"(a), "v"(b)); return r; }
template <int KI> __device__ __forceinline__ float fmamk_s(float c, float base) {
    float r; asm volatile("v_fmamk_f32 %0, %1, %2, %3" : "=v"(r) : "v"(c), "i"(__builtin_bit_cast(int, (float)KI)), "v"(base)); return r; }
__device__ __forceinline__ float wave_sum(float v) {
#pragma unroll
    for (int o = 1; o < 64; o <<= 1) v += __shfl_xor(v, o);
    return v;
}
__device__ __forceinline__ float wave_max(float v) {
#pragma unroll
    for (int o = 1; o < 64; o <<= 1) v = fmaxf(v, __shfl_xor(v, o));
    return v;
}

__device__ __forceinline__ void glds16(const GAS void* g, unsigned lds_base) {
    unsigned sv; asm volatile("s_mov_b32 %0, m0\n\ts_mov_b32 m0, %2\n\ts_nop 0\n\tglobal_load_lds_dwordx4 %1, off\n\ts_mov_b32 m0, %0" : "=&s"(sv) : "v"(g), "s"(lds_base) : "memory"); }
#define WAIT_BAR(N) asm volatile("s_waitcnt vmcnt(" #N ") lgkmcnt(0)\n\ts_barrier" ::: "memory")
__device__ __forceinline__ void wait_bar_n(int n) {
    switch (n) { case 0: WAIT_BAR(0); break; case 2: WAIT_BAR(2); break; case 4: WAIT_BAR(4); break; case 6: WAIT_BAR(6); break; case 8: WAIT_BAR(8); break; case 10: WAIT_BAR(10); break;
                 case 12: WAIT_BAR(12); break; case 14: WAIT_BAR(14); break; case 16: WAIT_BAR(16); break; case 18: WAIT_BAR(18); break; case 20: WAIT_BAR(20); break; default: WAIT_BAR(0); break; }
}

constexpr int SB_NS = 6, SB_SLOT = 16384, SB_FLG = 147456 + 2048;
struct SbUnit { int b, h, qb; };
__device__ __forceinline__ bool sb_decode(int u, SbUnit& U) {
    if (u >= 1024) return false;
    const int i = u >> 8, v = u & 255, bh = v >> 1, j = v & 1;
    U.qb = (i == 0) ? j : (i == 1) ? 3 - j : (i == 2) ? 4 + j : 7 - j; U.b = bh >> 3; U.h = bh & 7; return true;
}
__device__ __forceinline__ void sb_phase(LAS unsigned char* lds, const GAS f16* __restrict__ proj, GAS f16* __restrict__ mixed, int vcu, int G, unsigned long long& sw_acc) {
    int tid_ = threadIdx.x; asm volatile("" : "+v"(tid_));
    const int tid = tid_, lane = tid & 63, l31 = lane & 31, hi = lane >> 5; const int w = __builtin_amdgcn_readfirstlane(tid >> 6);
    const unsigned lds0 = (unsigned)(uintptr_t)lds;
    const unsigned kdst = lds0 + w * 1024, vdst = lds0 + 8192 + w * 1024;
    int kfo[4];
    { const int kr = keyrow(l31), fz = (kr >> 1) & 7;
#pragma unroll
      for (int d0 = 0; d0 < 4; ++d0) kfo[d0] = kr * 128 + (((2 * d0 + hi) ^ fz) * 16); }
    int vfo[2];
    { const int q_ = (lane & 15) >> 2, qb1 = (q_ >> 1) & 1;
#pragma unroll
      for (int d0 = 0; d0 < 2; ++d0) vfo[d0] = 8192 + (32 * hi + q_) * 128 + ((d0 ^ qb1) * 64) + ((lane >> 4) & 1) * 32 + (lane & 3) * 8; }
    LAS unsigned* flags = (LAS unsigned*)(lds + SB_FLG);
    const int srow = 8 * w + (lane >> 3);
    const size_t koff = (size_t)srow * PW + C_SBK + (((lane & 7) ^ ((srow >> 1) & 7)) * 8);
    const size_t voff = (size_t)srow * PW + C_SBV + ((((lane & 7) >> 2) ^ ((srow >> 1) & 1)) * 32) + (lane & 3) * 8;
    const size_t qoff = (size_t)(32 * w + l31) * PW;
#define SB_DMA(ks_, vs_, kt_, slot) do { const size_t go_ = (size_t)(kt_) * 64 * PW; glds16((ks_) + go_, (unsigned)__builtin_amdgcn_readfirstlane(kdst + (slot))); glds16((vs_) + go_, (unsigned)__builtin_amdgcn_readfirstlane(vdst + (slot))); } while (0)
#define SB_NEXT_SLOT(s) ((s) == (SB_NS - 1) * SB_SLOT ? 0 : (s) + SB_SLOT)
    SbUnit U, Un; int ui = vcu;
    if (!sb_decode(ui, U)) return;
    int islot = 0, cslot = 0, issued = 0;
    const GAS f16* ksrc = proj + ((size_t)U.b * SEQ) * PW + U.h * 64 + koff; const GAS f16* vsrc = proj + ((size_t)U.b * SEQ) * PW + U.h * 64 + voff;
    h8 qn[4];
    { const GAS f16* Qg = proj + ((size_t)U.b * SEQ + U.qb * 256) * PW + qoff + C_SBQ + U.h * 64 + 8 * hi;
#pragma unroll
      for (int d0 = 0; d0 < 4; ++d0) qn[d0] = *(const GAS h8*)(Qg + 16 * d0); }
    asm volatile("" : "+v"(qn[0]), "+v"(qn[1]), "+v"(qn[2]), "+v"(qn[3]));
    { const int kth = (U.qb * 256 + 255) >> 6, NT0 = kth + 1; for (; issued < 5 && issued < NT0; ++issued) { SB_DMA(ksrc, vsrc, kth - issued, islot); islot = SB_NEXT_SLOT(islot); } }
    for (;;) {
        const size_t rowbase = (size_t)U.b * SEQ;
        const int q0 = U.qb * 256, qw = q0 + 32 * w, t = qw + l31, diag = qw >> 6, kt_hi = (q0 + 255) >> 6, NT = kt_hi + 1;
        h8 qr[4];
#pragma unroll
        for (int d0 = 0; d0 < 4; ++d0) qr[d0] = qn[d0];
        const size_t grow = rowbase + qw + l31;
        u32x2 gv[8];
        { const GAS f16* Gp = proj + grow * PW + C_SBG + U.h * 64 + 4 * hi;
#pragma unroll
          for (int i = 0; i < 8; ++i) gv[i] = *(const GAS u32x2*)(Gp + 8 * i); }
        const bool has_next = sb_decode(ui + G, Un);
        if (has_next) { const GAS f16* Qg = proj + ((size_t)Un.b * SEQ + Un.qb * 256) * PW + qoff + C_SBQ + Un.h * 64 + 8 * hi;
#pragma unroll
            for (int d0 = 0; d0 < 4; ++d0) qn[d0] = *(const GAS h8*)(Qg + 16 * d0); }
        f32x16 o[2]; o[0] = f32x16{}; o[1] = f32x16{};
        float carry = 1.f; int done = 0;
        SW_BEGIN(12);
        for (int j = 0; j < NT; ++j) {
            SW_BEGIN(13);
            wait_bar_n(2 * (issued - (j + 1)));
            SW_END(13);
            if (j > 0) {
                const u32x4 f0 = *(const LAS u32x4*)(flags + ((j - 1) & 1) * 8), f1 = *(const LAS u32x4*)(flags + ((j - 1) & 1) * 8 + 4);
                const unsigned any = (f0.x | f0.y | f0.z | f0.w) | (f1.x | f1.y | f1.z | f1.w);
                if (!__builtin_amdgcn_readfirstlane(any)) break;
            }
#define SB_ISSUE() do { if (issued < NT) { SB_DMA(ksrc, vsrc, kt_hi - issued, islot); ++issued; islot = SB_NEXT_SLOT(islot); } } while (0)
            const int kt = kt_hi - j;
            SB_ISSUE();
            if (kt <= diag && !done) {
                const LAS unsigned char* Sb = lds + cslot;
                f32x16 p0 = f32x16{}, p1 = f32x16{};
#pragma unroll
                for (int d0 = 0; d0 < 4; ++d0) { const h8 k0 = *(const LAS h8*)(Sb + kfo[d0]), k1 = *(const LAS h8*)(Sb + kfo[d0] + 2048); p0 = MFMA32(k0, qr[d0], p0); p1 = MFMA32(k1, qr[d0], p1); }
#pragma unroll
                for (int r = 0; r < 16; ++r) { p0[r] = __builtin_amdgcn_rcpf(1.0f + __builtin_amdgcn_exp2f(-p0[r])); p1[r] = __builtin_amdgcn_rcpf(1.0f + __builtin_amdgcn_exp2f(-p1[r])); }

                if (kt == diag) {
                    const int key0 = 64 * kt + 32 * hi;
#pragma unroll
                    for (int r = 0; r < 16; ++r) { if (key0 + r >= t) p0[r] = 0.f; if (key0 + 16 + r >= t) p1[r] = 0.f; }
                }
                float run = 1.f;
#pragma unroll
                for (int r = 15; r >= 0; --r) { const float a = run * p1[r]; run -= a; p1[r] = a; }
#pragma unroll
                for (int r = 15; r >= 0; --r) { const float a = run * p0[r]; run -= a; p0[r] = a; }
                const auto rr = __builtin_amdgcn_permlane32_swap(__float_as_uint(run), __float_as_uint(run), false, false);
                const float T0 = __uint_as_float(rr[0]), T1 = __uint_as_float(rr[1]);
                const float E = carry * (hi ? 1.0f : T1);
                carry = carry * (T0 * T1);
#pragma unroll
                for (int r = 0; r < 16; ++r) { p0[r] *= E; p1[r] *= E; }
                const h8 pa0 = pack8(p0, 0), pa1 = pack8(p0, 8), pa2 = pack8(p1, 0), pa3 = pack8(p1, 8);
#pragma unroll
                for (int d0 = 0; d0 < 2; ++d0) {
                    const LAS unsigned char* Vb = Sb + vfo[d0];
                    const h8 v0 = cat8(vtr(Vb), vtr(Vb + 512));
                    const h8 v1 = cat8(vtr(Vb + 1024), vtr(Vb + 1536));
                    const h8 v2 = cat8(vtr(Vb + 2048), vtr(Vb + 2560));
                    const h8 v3 = cat8(vtr(Vb + 3072), vtr(Vb + 3584));
                    o[d0] = MFMA32(v0, pa0, o[d0]); o[d0] = MFMA32(v1, pa1, o[d0]); o[d0] = MFMA32(v2, pa2, o[d0]); o[d0] = MFMA32(v3, pa3, o[d0]);
                }
#if SB_EARLY_EXIT
                done = __builtin_amdgcn_readfirstlane(__all(carry < 1.0e-37f) ? 1 : 0);
#endif
            }
            if (lane == 0) flags[(j & 1) * 8 + w] = done ? 0u : 1u;
            cslot = SB_NEXT_SLOT(cslot);
        }
        asm volatile("s_nop 15\n\ts_nop 7" : "+v"(o[0]), "+v"(o[1]));
        SW_END(12);
        cslot = islot; issued = 0;
        if (has_next) {
            ksrc = proj + ((size_t)Un.b * SEQ) * PW + Un.h * 64 + koff; vsrc = proj + ((size_t)Un.b * SEQ) * PW + Un.h * 64 + voff;
            const int kth = (Un.qb * 256 + 255) >> 6, NTn = kth + 1;
            for (; issued < 5 && issued < NTn; ++issued) { SB_DMA(ksrc, vsrc, kth - issued, islot); islot = SB_NEXT_SLOT(islot); }
        }
        {
            GAS f16* Op = mixed + grow * DM + U.h * 64 + 4 * hi;
#pragma unroll
            for (int d0 = 0; d0 < 2; ++d0)
#pragma unroll
                for (int rg4 = 0; rg4 < 4; ++rg4) {
                    const h4 g = __builtin_bit_cast(h4, gv[d0 * 4 + rg4]);
                    u32x2 wv; wv.x = pkh(o[d0][4 * rg4] * (float)g[0], o[d0][4 * rg4 + 1] * (float)g[1]); wv.y = pkh(o[d0][4 * rg4 + 2] * (float)g[2], o[d0][4 * rg4 + 3] * (float)g[3]);
                    *(GAS u32x2*)(Op + 32 * d0 + 8 * rg4) = wv;
                }
        }
        if (!has_next) break;
        U = Un; ui += G;
    }
#undef SB_ISSUE
#undef SB_DMA
#undef SB_NEXT_SLOT
    WAIT_BAR(0);
}

constexpr int DA_KS = 16384, DA_VRING = 49152, DA_XCH = 114688, DA_SUBG = 147456 + 1024, DA_SSX = 147456 + 3072;
struct DaUnit { int b, h, qt, klo; };
__device__ __forceinline__ int da_qt_of(int r, int i) {
    constexpr unsigned long long Q1 = 0xE92B6AF78C01D543ull, Q2 = 0x6C5B3014A78D29FEull, Q3 = 0x21F0DC6B43E87A59ull;
    return r == 0 ? i : (int)(((r == 1 ? Q1 : r == 2 ? Q2 : Q3) >> (4 * i)) & 15ull);
}
__device__ __forceinline__ int da_klo(int qt, int h) {
    const float cs = exp2f(-2.0f * (float)(h + 1)) * LOG2E;
    const int D = (int)ceilf(160.5f / cs), m = qt * 128 - D - 63;
    return m > 0 ? (m + 63) >> 6 : 0;
}
__device__ __forceinline__ bool da_decode(int u, DaUnit& U) {
    if (u >= 1024) return false;
    const int r = u >> 8, v = u & 255;
    U.b = v >> 4; U.h = r; U.qt = da_qt_of(r, v & 15); U.klo = da_klo(U.qt, U.h); return true;
}
__device__ __forceinline__ void da_pv(f32x16 (&o)[4], const LAS unsigned char* Vs, const int (&vfo)[4], h8 pa0, h8 pa1, h8 pa2, h8 pa3) {
    h8 f0, f1, f2, f3, g0, g1, g2, g3;
    { const LAS unsigned char* Vb = Vs + vfo[0]; f0 = cat8(vtr(Vb), vtr(Vb + 1024)); f1 = cat8(vtr(Vb + 2048), vtr(Vb + 3072)); f2 = cat8(vtr(Vb + 4096), vtr(Vb + 5120)); f3 = cat8(vtr(Vb + 6144), vtr(Vb + 7168)); }
#pragma unroll
    for (int d0 = 0; d0 < 4; ++d0) {
        if (d0 < 3) { const LAS unsigned char* Vb = Vs + vfo[d0 + 1]; g0 = cat8(vtr(Vb), vtr(Vb + 1024)); g1 = cat8(vtr(Vb + 2048), vtr(Vb + 3072)); g2 = cat8(vtr(Vb + 4096), vtr(Vb + 5120)); g3 = cat8(vtr(Vb + 6144), vtr(Vb + 7168)); }
        o[d0] = MFMA32(f0, pa0, o[d0]); o[d0] = MFMA32(f1, pa1, o[d0]); o[d0] = MFMA32(f2, pa2, o[d0]); o[d0] = MFMA32(f3, pa3, o[d0]);
        if (d0 < 3) { f0 = g0; f1 = g1; f2 = g2; f3 = g3; }
    }
}
__device__ __forceinline__ void da_phase(LAS unsigned char* lds, const GAS f16* __restrict__ proj, GAS f16* __restrict__ mixed, int vcu, int G,
                                         float lam, float mref, const GAS float* __restrict__ subg, float osc, unsigned long long& sw_acc) {
    int tid_ = threadIdx.x; asm volatile("" : "+v"(tid_));
    const int tid = tid_, lane = tid & 63, l31 = lane & 31, hi = lane >> 5; const int w = __builtin_amdgcn_readfirstlane(tid >> 6);
    const int c = w >> 2, rg = w & 3;
    const unsigned lds0 = (unsigned)(uintptr_t)lds;
    const unsigned kdst = lds0 + w * 1024, vdst = lds0 + DA_VRING + w * 1024;
    int kfo[4];
    { const int kr = keyrow(l31);
#pragma unroll
      for (int d0 = 0; d0 < 4; ++d0) kfo[d0] = kr * 256 + (((8 * c + 2 * d0 + hi) ^ (kr & 15)) * 16); }
    int vfo[4];
    { const int q_ = (lane & 15) >> 2;
#pragma unroll
      for (int d0 = 0; d0 < 4; ++d0) vfo[d0] = DA_VRING + (32 * hi + q_) * 256 + ((d0 ^ q_) * 64) + ((lane >> 4) & 1) * 32 + (lane & 3) * 8; }
    const int srow = 4 * w + (lane >> 4);
    const size_t koff = (size_t)srow * PW + C_DAK + (((lane & 15) ^ (srow & 15)) * 8);
    const size_t voff = (size_t)srow * PW + C_DAV + (((((lane & 15) >> 2) ^ (srow & 3)) * 4 + (lane & 3)) * 8);
    const size_t qoff = (size_t)(32 * rg + l31) * PW + C_DAQ + c * 64 + 8 * hi;
    if (tid < 128) ((LAS float*)(lds + DA_SUBG))[tid] = subg[tid];
    LAS unsigned* xch = (LAS unsigned*)(lds + DA_XCH + rg * 8192);
#define DA_DMA(ks_, vs_, kt_, kslot, vslot) do { const size_t go_ = (size_t)(kt_) * 64 * PW; const unsigned kd_ = (unsigned)__builtin_amdgcn_readfirstlane(kdst + (kslot)), vd_ = (unsigned)__builtin_amdgcn_readfirstlane(vdst + (vslot)); \
        glds16((ks_) + go_, kd_); glds16((ks_) + go_ + (size_t)32 * PW, kd_ + 8192); glds16((vs_) + go_, vd_); glds16((vs_) + go_ + (size_t)32 * PW, vd_ + 8192); } while (0)
#define DA_NEXT_K(s) ((s) == 2 * DA_KS ? 0 : (s) + DA_KS)
#define DA_NEXT_V(s) ((s) == 3 * DA_KS ? 0 : (s) + DA_KS)
    DaUnit U, Un; int ui = vcu;
    if (!da_decode(ui, U)) return;
    const GAS f16* ksrc = proj + ((size_t)U.b * SEQ) * PW + U.h * 128 + koff; const GAS f16* vsrc = proj + ((size_t)U.b * SEQ) * PW + U.h * 128 + voff;
    h8 qn[4];
    { const GAS f16* Qg = proj + ((size_t)U.b * SEQ + U.qt * 128) * PW + qoff + U.h * 128;
#pragma unroll
      for (int d0 = 0; d0 < 4; ++d0) qn[d0] = *(const GAS h8*)(Qg + 16 * d0); }
    asm volatile("" : "+v"(qn[0]), "+v"(qn[1]), "+v"(qn[2]), "+v"(qn[3]));
    DA_DMA(ksrc, vsrc, U.klo, 0, 0); DA_DMA(ksrc, vsrc, U.klo + 1, DA_KS, DA_KS);
    int ik = 2 * DA_KS, iv = 2 * DA_KS, ck = 0, cv = 0;
    for (;;) {
        const size_t rowbase = (size_t)U.b * SEQ;
        const int qw = U.qt * 128 + 32 * rg, t = qw + l31, lastt = qw >> 6, NT = 2 * U.qt + 2;
        const float cslope = exp2f(-2.0f * (float)(U.h + 1)) * LOG2E;
        const float cs64 = 64.0f * cslope, base0 = -cslope * (float)(t - 32 * hi) - mref;
        h8 qr[4];
#pragma unroll
        for (int d0 = 0; d0 < 4; ++d0) qr[d0] = qn[d0];
        const size_t grow = rowbase + qw + l31;
        const bool has_next = da_decode(ui + G, Un);
        const GAS f16* ksn = ksrc; const GAS f16* vsn = vsrc;
        if (has_next) { ksn = proj + ((size_t)Un.b * SEQ) * PW + Un.h * 128 + koff; vsn = proj + ((size_t)Un.b * SEQ) * PW + Un.h * 128 + voff; }
        f32x16 o[4]; o[0] = f32x16{}; o[1] = f32x16{}; o[2] = f32x16{}; o[3] = f32x16{};
        float lsum = 0.f;
        h8 pq0, pq1, pq2, pq3;
        int pvs = 0;
        SW_BEGIN(2);
        for (int kt = U.klo; kt < NT; ++kt) {
            SW_BEGIN(3);
            if (kt + 1 < NT || has_next) WAIT_BAR(4); else WAIT_BAR(0);
            SW_END(3);
#define DA_ISSUE() do { if (kt + 2 < NT) { DA_DMA(ksrc, vsrc, kt + 2, ik, iv); ik = DA_NEXT_K(ik); iv = DA_NEXT_V(iv); } \
            else if (has_next) { DA_DMA(ksn, vsn, Un.klo + kt + 2 - NT, ik, iv); ik = DA_NEXT_K(ik); iv = DA_NEXT_V(iv); } } while (0)
            DA_ISSUE();
            if (c == 1 && kt > U.klo && kt - 1 <= lastt) da_pv(o, lds + pvs, vfo, pq0, pq1, pq2, pq3);
            if (kt <= lastt) {
                const LAS unsigned char* Ks = lds + ck;
                f32x16 p0, p1;
                const float basek = __builtin_fmaf(cs64, (float)kt, base0);
                __builtin_amdgcn_sched_barrier(0);
                asm volatile("s_nop 7" ::: "memory");
#define DA_INIT(r) p0[r] = fmamk_s<r>(cslope, basek); p1[r] = fmamk_s<16 + r>(cslope, basek);
                DA_INIT(0) DA_INIT(1) DA_INIT(2) DA_INIT(3) DA_INIT(4) DA_INIT(5) DA_INIT(6) DA_INIT(7) DA_INIT(8) DA_INIT(9) DA_INIT(10) DA_INIT(11) DA_INIT(12) DA_INIT(13) DA_INIT(14) DA_INIT(15)
#undef DA_INIT
                asm volatile("s_nop 3" : "+v"(p0), "+v"(p1));
                if (kt == lastt) {
                    const int kd = t - (64 * kt + 32 * hi);
                    const float m2 = -2.0f * mref;
                    asm volatile("" ::: "memory");
#pragma unroll
                    for (int r = 0; r < 16; ++r) { if (r > kd) p0[r] = m2 - p0[r]; if (16 + r > kd) p1[r] = m2 - p1[r]; }
                }
#pragma unroll
                for (int d0 = 0; d0 < 4; ++d0) { const h8 ka = *(const LAS h8*)(Ks + kfo[d0]), kb = *(const LAS h8*)(Ks + kfo[d0] + 4096); p0 = MFMA32(ka, qr[d0], p0); p1 = MFMA32(kb, qr[d0], p1); }
                float s0 = 0.f, s1 = 0.f, s2 = 0.f, s3 = 0.f;
#pragma unroll
                for (int r = 0; r < 16; ++r) { p0[r] = __builtin_amdgcn_exp2f(p0[r]); p1[r] = __builtin_amdgcn_exp2f(p1[r]); }

#pragma unroll
                for (int r = 0; r < 16; r += 2) { s0 += p0[r]; s1 += p0[r + 1]; s2 += p1[r]; s3 += p1[r + 1]; }
                lsum += (s0 + s1) + (s2 + s3);
                pq0 = pack8(p0, 0); pq1 = pack8(p0, 8); pq2 = pack8(p1, 0); pq3 = pack8(p1, 8); pvs = cv;
                if (c == 0) da_pv(o, lds + cv, vfo, pq0, pq1, pq2, pq3);
            }
            ck = DA_NEXT_K(ck); cv = DA_NEXT_V(cv);
        }
        if (c == 1 && NT - 1 <= lastt) da_pv(o, lds + pvs, vfo, pq0, pq1, pq2, pq3);
        asm volatile("s_nop 15\n\ts_nop 7" : "+v"(o[0]), "+v"(o[1]), "+v"(o[2]), "+v"(o[3]));
        SW_END(2);
        const int dlo = 2 * c;
        u32x2 gv[8];
        { const GAS f16* Gp = proj + grow * PW + C_DAG + U.h * 128 + 32 * dlo + 4 * hi;
#pragma unroll
          for (int i = 0; i < 8; ++i) gv[i] = *(const GAS u32x2*)(Gp + 8 * i); }
        if (has_next) { const GAS f16* Qg = proj + ((size_t)Un.b * SEQ + Un.qt * 128) * PW + qoff + Un.h * 128;
#pragma unroll
            for (int d0 = 0; d0 < 4; ++d0) qn[d0] = *(const GAS h8*)(Qg + 16 * d0); }
        asm volatile("" ::: "memory");
        { const auto rr = __builtin_amdgcn_permlane32_swap(__float_as_uint(lsum), __float_as_uint(lsum), false, false); lsum = __uint_as_float(rr[0]) + __uint_as_float(rr[1]); }
        const float f = (c == 0 ? 1.0f : lam) / lsum;
        LAS unsigned* xw = xch + (c ^ 1) * 1024;
        LAS unsigned* xr = xch + c * 1024;
        f32x16 ya, yb;
        if (c == 0) {
#pragma unroll
            for (int r2 = 0; r2 < 8; ++r2) { xw[r2 * 64 + lane] = pkh(o[2][2 * r2] * f, o[2][2 * r2 + 1] * f); xw[(8 + r2) * 64 + lane] = pkh(o[3][2 * r2] * f, o[3][2 * r2 + 1] * f); }
            ya = o[0] * f; yb = o[1] * f;
        } else {
#pragma unroll
            for (int r2 = 0; r2 < 8; ++r2) { xw[r2 * 64 + lane] = pkh(o[0][2 * r2] * f, o[0][2 * r2 + 1] * f); xw[(8 + r2) * 64 + lane] = pkh(o[1][2 * r2] * f, o[1][2 * r2 + 1] * f); }
            ya = o[2] * f; yb = o[3] * f;
        }
        asm volatile("s_waitcnt lgkmcnt(0)\n\ts_barrier" ::: "memory");
        const float sgn = (c == 0) ? 1.0f : -1.0f;
        float ss = 0.f;
#pragma unroll
        for (int r2 = 0; r2 < 8; ++r2) {
            const h2 pa = __builtin_bit_cast(h2, xr[r2 * 64 + lane]), pb = __builtin_bit_cast(h2, xr[(8 + r2) * 64 + lane]);
            const float a0 = (ya[2 * r2] - (float)pa[0]) * sgn, a1 = (ya[2 * r2 + 1] - (float)pa[1]) * sgn, b0 = (yb[2 * r2] - (float)pb[0]) * sgn, b1 = (yb[2 * r2 + 1] - (float)pb[1]) * sgn;
            ya[2 * r2] = a0; ya[2 * r2 + 1] = a1; yb[2 * r2] = b0; yb[2 * r2 + 1] = b1; ss += (a0 * a0 + a1 * a1) + (b0 * b0 + b1 * b1);
        }
        { const auto rr = __builtin_amdgcn_permlane32_swap(__float_as_uint(ss), __float_as_uint(ss), false, false); ss = __uint_as_float(rr[0]) + __uint_as_float(rr[1]); }
        LAS float* ssx = (LAS float*)(lds + DA_SSX + rg * 256);
        if (hi == 0) ssx[c * 32 + l31] = ss;
        asm volatile("s_waitcnt lgkmcnt(0)\n\ts_barrier" ::: "memory");
        ss += ssx[(c ^ 1) * 32 + l31];
        const float rn = __builtin_amdgcn_rsqf(ss * (1.0f / 128.0f) + RMS_EPS) * osc;
        {
            const LAS float* sgl = (const LAS float*)(lds + DA_SUBG) + 32 * dlo + 4 * hi;
            GAS f16* Op = mixed + grow * DM + 512 + U.h * 128 + 32 * dlo + 4 * hi;
#pragma unroll
            for (int rg4 = 0; rg4 < 4; ++rg4) {
                const h4 g = __builtin_bit_cast(h4, gv[rg4]);
                const f32x4 sg = *(const LAS f32x4*)(sgl + 8 * rg4);
                u32x2 wv;
                wv.x = pkh(ya[4 * rg4] * rn * sg[0] * (float)g[0], ya[4 * rg4 + 1] * rn * sg[1] * (float)g[1]);
                wv.y = pkh(ya[4 * rg4 + 2] * rn * sg[2] * (float)g[2], ya[4 * rg4 + 3] * rn * sg[3] * (float)g[3]);
                *(GAS u32x2*)(Op + 8 * rg4) = wv;
            }
#pragma unroll
            for (int rg4 = 0; rg4 < 4; ++rg4) {
                const h4 g = __builtin_bit_cast(h4, gv[4 + rg4]);
                const f32x4 sg = *(const LAS f32x4*)(sgl + 32 + 8 * rg4);
                u32x2 wv;
                wv.x = pkh(yb[4 * rg4] * rn * sg[0] * (float)g[0], yb[4 * rg4 + 1] * rn * sg[1] * (float)g[1]);
                wv.y = pkh(yb[4 * rg4 + 2] * rn * sg[2] * (float)g[2], yb[4 * rg4 + 3] * rn * sg[3] * (float)g[3]);
                *(GAS u32x2*)(Op + 32 + 8 * rg4) = wv;
            }
        }
        if (!has_next) break;
        U = Un; ui += G; ksrc = ksn; vsrc = vsn;
    }
#undef DA_DMA
#undef DA_ISSUE
#undef DA_NEXT_K
#undef DA_NEXT_V
    WAIT_BAR(0);
}
}

constexpr size_t MiB = 1u << 20;
constexpr size_t WS_CTL = 0, CTL_ZERO_BYTES = 64 * 1024;
constexpr size_t WS_WIN = 2 * MiB;
constexpr size_t WS_WOUT = 18 * MiB;
constexpr size_t WS_PART = 22 * MiB;
constexpr size_t WS_XB = 32 * MiB;
constexpr size_t WS_MIX = 96 * MiB;
constexpr size_t WS_PROJ = 160 * MiB;
constexpr size_t WS_END = 416 * MiB;
constexpr int CW_BAR = 4096;

constexpr int RING_OFF = 0, RING_BYTES = 131072;
constexpr int LDSCTL_OFF = 147456, MISC_OFF = LDSCTL_OFF + 320;
constexpr int LDS_BYTES = 163840;
constexpr int NWAVES = 8;

typedef GAS unsigned gu32;
#define LDS_WAIT() asm volatile("s_waitcnt lgkmcnt(0)" ::: "memory")

#define XB_TMO      128
#define XB_XCNT(j)  (256  + 64 * (j))
#define XB_XSUB(j)  (1280 + 64 * (j))
#define XB_XGEN(j)  (2304 + 64 * (j))
#define XB_TOP      3328
#define XB_TOPGEN   3392
#define XCD_BAR_WORDS 3456
#define XB_SPIN_CAP (1u << 18)
__device__ __forceinline__ unsigned xb_ld(unsigned* p)              { return __hip_atomic_load(p, __ATOMIC_RELAXED, __HIP_MEMORY_SCOPE_AGENT); }
__device__ __forceinline__ unsigned xb_add(unsigned* p, unsigned v) { return __hip_atomic_fetch_add(p, v, __ATOMIC_RELAXED, __HIP_MEMORY_SCOPE_AGENT); }
__device__ __forceinline__ unsigned xb_xcc_id() { return (unsigned)__builtin_amdgcn_s_getreg((3 << 11) | 20) & 0xFu; }
#define XB_SPIN(cond, bar) do { unsigned _sp = 0; while (cond) { __builtin_amdgcn_s_sleep(1); \
    if ((++_sp & 255u) == 0u) { if (xb_ld(&(bar)[XB_TMO])) break; if (_sp > XB_SPIN_CAP) { atomicAdd(&(bar)[XB_TMO], 1u); break; } } } } while (0)
struct XcdBarrier { unsigned* bar; unsigned x; volatile LAS unsigned* st; };
__device__ __forceinline__ XcdBarrier xcd_barrier_post(unsigned* bar, volatile LAS unsigned* st) {
    XcdBarrier b; b.bar = bar; b.x = xb_xcc_id(); b.st = st;
    if (threadIdx.x == 0) (void)xb_add(&bar[XB_XCNT(b.x)], 1u);
    return b;
}
__device__ __forceinline__ void xcd_barrier_complete(unsigned* bar, unsigned x, unsigned& nloc, unsigned& nx) {
    const unsigned G = gridDim.x * gridDim.y * gridDim.z;
    unsigned sum, cnt, mine, sp = 0u;
    for (;;) {
        sum = 0u; cnt = 0u; mine = 0u;
#pragma unroll
        for (unsigned j = 0; j < 16; ++j) { const unsigned c = xb_ld(&bar[XB_XCNT(j)]); sum += c; cnt += (c > 0u) ? 1u : 0u; mine = (j == x) ? c : mine; }
        if (sum == G) break;
        __builtin_amdgcn_s_sleep(1);
        if ((++sp & 255u) == 0u) { if (xb_ld(&bar[XB_TMO])) break; if (sp > XB_SPIN_CAP) { atomicAdd(&bar[XB_TMO], 1u); break; } }
    }
    nloc = mine > 0u ? mine : 1u; nx = cnt > 0u ? cnt : 1u;
}
__device__ __forceinline__ void xcd_barrier(const XcdBarrier& b) {
    asm volatile("s_waitcnt vmcnt(0)" ::: "memory");
    __syncthreads();
    if (threadIdx.x == 0) {
        unsigned* bar = b.bar;
        __builtin_amdgcn_s_waitcnt(0);
        unsigned nloc = b.st[0], nx = b.st[1];
        if (nloc == 0u) { xcd_barrier_complete(bar, b.x, nloc, nx); b.st[0] = nloc; b.st[1] = nx; }
        const unsigned old = xb_add(&bar[XB_XSUB(b.x)], 1u);
        const unsigned gen = old / nloc;
        if (old + 1u == (gen + 1u) * nloc) {
            __builtin_amdgcn_fence(__ATOMIC_RELEASE, "agent");
            asm volatile("s_waitcnt vmcnt(0)" ::: "memory");
            const unsigned og = xb_add(&bar[XB_TOP], 1u);
            const unsigned tg = og / nx;
            if (og + 1u == (tg + 1u) * nx) xb_add(&bar[XB_TOPGEN], 1u);
            else XB_SPIN(xb_ld(&bar[XB_TOPGEN]) == tg, bar);
            __builtin_amdgcn_fence(__ATOMIC_ACQUIRE, "agent");
            xb_add(&bar[XB_XGEN(b.x)], 1u);
            asm volatile("s_waitcnt vmcnt(0)" ::: "memory");
        } else {
            XB_SPIN(xb_ld(&bar[XB_XGEN(b.x)]) == gen, bar);
            __builtin_amdgcn_fence(__ATOMIC_ACQUIRE, "agent");
            asm volatile("s_waitcnt vmcnt(0)" ::: "memory");
        }
    }
    __syncthreads();
}

__device__ __forceinline__ void p0_transpose_item(const float* W, const float* g, int K, int N, f16* WT, LAS float* scr, int item, int lane) {
    const int nblk = N / 32, kb = item / nblk, nb = item % nblk, k0 = 32 * kb, n0 = 32 * nb;
    float v[16];
#pragma unroll
    for (int i = 0; i < 16; ++i) { const int kk = 2 * i + (lane >> 5); v[i] = W[(size_t)(k0 + kk) * N + n0 + (lane & 31)]; }
    if (g) {
#pragma unroll
        for (int i = 0; i < 16; ++i) v[i] *= g[k0 + 2 * i + (lane >> 5)];
    }
#pragma unroll
    for (int i = 0; i < 16; ++i) scr[(2 * i + (lane >> 5)) * 33 + (lane & 31)] = v[i];
    LDS_WAIT(); asm volatile("" ::: "memory");
    const int c = lane & 3;
#pragma unroll
    for (int j = 0; j < 2; ++j) { const int n = (lane >> 2) + 16 * j; const LAS float* sp = scr + (8 * c) * 33 + n;
        u32x4 o; o.x = pkh(sp[0 * 33], sp[1 * 33]); o.y = pkh(sp[2 * 33], sp[3 * 33]); o.z = pkh(sp[4 * 33], sp[5 * 33]); o.w = pkh(sp[6 * 33], sp[7 * 33]);
        *(GAS u32x4*)(WT + (size_t)(n0 + n) * K + k0 + 8 * c) = o; }
    LDS_WAIT(); asm volatile("" ::: "memory");
}
__device__ __forceinline__ void x_rows4(const float* x, f16* xb, float* part, int m0, int stride, int lane) {
    f32x4 v[4][4];
#pragma unroll
    for (int r = 0; r < 4; ++r) { const GAS f32x4* xr = (const GAS f32x4*)(x + (size_t)(m0 + r * stride) * DM) + lane;
#pragma unroll
        for (int j = 0; j < 4; ++j) v[r][j] = xr[64 * j]; }
#pragma unroll
    for (int r = 0; r < 4; ++r) {
        float s = 0.f;
#pragma unroll
        for (int j = 0; j < 4; ++j) s += (v[r][j][0] * v[r][j][0] + v[r][j][1] * v[r][j][1]) + (v[r][j][2] * v[r][j][2] + v[r][j][3] * v[r][j][3]);
        s = att::wave_sum(s);
        const size_t row = (size_t)(m0 + r * stride);
        GAS u32x2* o8 = (GAS u32x2*)(xb + row * DM) + lane;
#pragma unroll
        for (int j = 0; j < 4; ++j) { u32x2 w; w.x = pkh(v[r][j][0], v[r][j][1]); w.y = pkh(v[r][j][2], v[r][j][3]); o8[64 * j] = w; }
        if (lane < 16) part[row * 16 + lane] = (lane == 0) ? s : 0.f;
    }
}

__device__ __forceinline__ void x_row1(const float* x, f16* xb, float* part, int m, int lane) {
    const GAS f32x4* xr = (const GAS f32x4*)(x + (size_t)m * DM) + lane;
    f32x4 v[4]; float s = 0.f;
#pragma unroll
    for (int j = 0; j < 4; ++j) { v[j] = xr[64 * j]; s += (v[j][0] * v[j][0] + v[j][1] * v[j][1]) + (v[j][2] * v[j][2] + v[j][3] * v[j][3]); }
    s = att::wave_sum(s);
    GAS u32x2* o8 = (GAS u32x2*)(xb + (size_t)m * DM) + lane;
#pragma unroll
    for (int j = 0; j < 4; ++j) { u32x2 w; w.x = pkh(v[j][0], v[j][1]); w.y = pkh(v[j][2], v[j][3]); o8[64 * j] = w; }
    if (lane < 16) part[(size_t)m * 16 + lane] = (lane == 0) ? s : 0.f;
}

struct Args { const float* in[11]; float* out; unsigned char* ws; };
__global__ void __launch_bounds__(NWAVES * 64, 2) hybrid_fwd(Args args) {
    extern __shared__ __attribute__((aligned(16))) unsigned char lds_raw[];
    LAS unsigned char* lds = (LAS unsigned char*)lds_raw;
    volatile LAS unsigned* MISC = (volatile LAS unsigned*)(lds + MISC_OFF);
    const int tid = threadIdx.x, lane = tid & 63, wave = __builtin_amdgcn_readfirstlane(tid >> 6);
    const int G = gridDim.x; const int bx = blockIdx.x; const int vcu = (G % 8 == 0) ? (bx % 8) * (G / 8) + bx / 8 : bx;
    unsigned char* ws = args.ws;
    gu32* ctl = (gu32*)(ws + WS_CTL);
    const float* x = args.in[0]; const float* norm_g = args.in[1]; const float* w_in = args.in[2]; const float* w_out = args.in[3];
    const float* q_norm_g = args.in[4]; const float* k_norm_g = args.in[5];
    const float* lq1 = args.in[6]; const float* lk1 = args.in[7]; const float* lq2 = args.in[8]; const float* lk2 = args.in[9]; const float* subln_g = args.in[10];
    float* out = args.out;
    GAS unsigned char* wsg = (GAS unsigned char*)ws;
    GAS f16* WIN = (GAS f16*)(wsg + WS_WIN); GAS f16* WOUT = (GAS f16*)(wsg + WS_WOUT); GAS float* PART = (GAS float*)(wsg + WS_PART);
    GAS f16* XB = (GAS f16*)(wsg + WS_XB); GAS f16* MIX = (GAS f16*)(wsg + WS_MIX); GAS f16* PROJ = (GAS f16*)(wsg + WS_PROJ);

    unsigned long long sw_acc = 0;
    for (int u = tid; u < (LDS_BYTES - LDSCTL_OFF) / 4; u += NWAVES * 64) ((LAS unsigned*)(lds + LDSCTL_OFF))[u] = 0u;
    __syncthreads();
    XcdBarrier bar = xcd_barrier_post((unsigned*)(ctl + CW_BAR), MISC + 8);

    SW_BEGIN(6);
    for (int rep = 0; rep < REP_PRO; ++rep) {
        LAS float* scr = (LAS float*)(lds + RING_OFF + wave * 16384);
        const int gw = vcu * NWAVES + wave, NGW = G * NWAVES;
        constexpr int I_IN = (DM / 32) * (PW / 32), I_OUT = (DM / 32) * (DM / 32);
        constexpr int NITEMS = DEPTH * (I_IN + I_OUT);
        SW_BEGIN(9);
        for (int it = gw; it < NITEMS; it += NGW) {
            int r = it; const int l = r / (I_IN + I_OUT); r -= l * (I_IN + I_OUT);
            if (r < I_IN) p0_transpose_item(w_in + (size_t)l * DM * PW, norm_g + l * DM, DM, PW, (f16*)WIN + (size_t)l * PW * DM, scr, r, lane);
            else p0_transpose_item(w_out + (size_t)l * DM * DM, nullptr, DM, DM, (f16*)WOUT + (size_t)l * DM * DM, scr, r - I_IN, lane);
        }
        SW_END(9);
        SW_BEGIN(10);
        { int m = gw; for (; m + 3 * NGW < MROWS; m += 4 * NGW) x_rows4(x, (f16*)XB, (float*)PART, m, NGW, lane); for (; m < MROWS; m += NGW) x_row1(x, (f16*)XB, (float*)PART, m, lane); }
        SW_END(10);
    }
    SW_END(6);
    { SW_BEGIN(7); xcd_barrier(bar); SW_END(7); }

    for (int l = 0; l < DEPTH; ++l) {
        { GAS unsigned char* wsl = wsg; asm volatile("" : "+s"(wsl)); WIN = (GAS f16*)(wsl + WS_WIN); WOUT = (GAS f16*)(wsl + WS_WOUT); PART = (GAS float*)(wsl + WS_PART); XB = (GAS f16*)(wsl + WS_XB); MIX = (GAS f16*)(wsl + WS_MIX); PROJ = (GAS f16*)(wsl + WS_PROJ);
          asm volatile("" : "+s"(out)); asm volatile("" : "+s"(x)); asm volatile("" : "+s"(subln_g)); asm volatile("" : "+s"(q_norm_g)); asm volatile("" : "+s"(k_norm_g)); asm volatile("" : "+s"(bar.bar)); }
        for (int rep = 0; rep < REP_G1; ++rep) {
            pg8::Gemm g{(const f16*)XB, (const f16*)WIN + (size_t)l * PW * DM, MROWS, PW, DM}; pg8::StaticOrder S; S.init(MROWS, PW, G, bx);
            pg8::EpiProj E{PROJ, PART, (const GAS float*)q_norm_g + l * 64, (const GAS float*)k_norm_g + l * 64};
            SW_BEGIN(5);
            pg8::gemm_phase<pg8::EpiProj>(lds + RING_OFF, g, S, E, sw_acc);
            SW_END(5);
        }
        { SW_BEGIN(7); xcd_barrier(bar); SW_END(7); }
        {
            const float sa = att::wave_sum(lq1[l * 64 + lane] * lk1[l * 64 + lane]), sb = att::wave_sum(lq2[l * 64 + lane] * lk2[l * 64 + lane]);
            const float lam_init = 0.8f - 0.6f * __expf(-0.3f * (float)l);
            const float lam = __expf(sa) - __expf(sb) + lam_init;
            const float mgq = att::wave_max(fabsf(q_norm_g[l * 64 + lane])), mgk = att::wave_max(fabsf(k_norm_g[l * 64 + lane]));
            const float mref = 8.0f * LOG2E * mgq * mgk * 1.001f - 10.0f;
            __syncthreads();
            for (int rep = 0; rep < REP_DA; ++rep) { SW_BEGIN(1); att::da_phase(lds + RING_OFF, PROJ, MIX, vcu, G, lam, mref, (const GAS float*)subln_g + l * 128, 1.0f - lam_init, sw_acc); SW_END(1); }
            for (int rep = 0; rep < REP_SB; ++rep) { SW_BEGIN(4); att::sb_phase(lds + RING_OFF, PROJ, MIX, vcu, G, sw_acc); SW_END(4); }
        }
        { SW_BEGIN(7); xcd_barrier(bar); SW_END(7); }
        {
            pg8::Gemm g{(const f16*)MIX, (const f16*)WOUT + (size_t)l * DM * DM, MROWS, DM, DM}; pg8::StaticOrder S; S.init(MROWS, DM, G, bx);
            pg8::EpiOut E{(GAS float*)out, XB, PART, (l + 1 < DEPTH) ? 0 : 1};
            SW_BEGIN(8);
            pg8::gemm_phase<pg8::EpiOut>(lds + RING_OFF, g, S, E, sw_acc);
            SW_END(8);
        }
        if (l + 1 < DEPTH) { SW_BEGIN(7); xcd_barrier(bar); SW_END(7); }
    }
#if SW_ID
    if (wave == 0) { const unsigned long long t0 = __builtin_amdgcn_s_memrealtime(), span = (unsigned long long)SW_K * sw_acc; while (__builtin_amdgcn_s_memrealtime() - t0 < span) __builtin_amdgcn_s_sleep(8); }
#endif
}

extern "C" void kernel_launch(void* const* d_in, const int* in_sizes, int n_in, void* d_out, int out_size, void* d_ws, size_t ws_size, hipStream_t stream) {
    static int grid = 0;
    if (grid == 0) {
        if (n_in != 11 || in_sizes[0] != MROWS * DM || out_size != MROWS * DM || ws_size < WS_END) {
            fprintf(stderr, "kernel_launch: unexpected problem shape (n_in %d, in0 %d, out %d, ws %zu); nothing launched\n", n_in, n_in > 0 ? in_sizes[0] : -1, out_size, ws_size); grid = -1; return; }
        int dev = 0, cus = 0, per_cu = 0;
        if (hipGetDevice(&dev) != hipSuccess || hipDeviceGetAttribute(&cus, hipDeviceAttributeMultiprocessorCount, dev) != hipSuccess) { grid = -1; return; }
        if (hipFuncSetAttribute((const void*)hybrid_fwd, hipFuncAttributeMaxDynamicSharedMemorySize, LDS_BYTES) != hipSuccess) { fprintf(stderr, "kernel_launch: hipFuncSetAttribute failed\n"); grid = -1; return; }
        if (hipOccupancyMaxActiveBlocksPerMultiprocessor(&per_cu, (const void*)hybrid_fwd, NWAVES * 64, LDS_BYTES) != hipSuccess || per_cu < 1) {
            fprintf(stderr, "kernel_launch: occupancy query reports %d workgroups per CU; nothing launched\n", per_cu); (void)hipGetLastError(); grid = -1; return; }
        grid = cus;
    }
    if (grid < 0) return;
    if (hipMemsetAsync((char*)d_ws + WS_CTL, 0, CTL_ZERO_BYTES, stream) != hipSuccess) { fprintf(stderr, "kernel_launch: hipMemsetAsync failed\n"); return; }
    Args a{};
    for (int i = 0; i < 11; ++i) a.in[i] = (const float*)d_in[i];
    a.out = (float*)d_out; a.ws = (unsigned char*)d_ws;
    hipLaunchKernelGGL(hybrid_fwd, dim3(grid), dim3(NWAVES * 64), LDS_BYTES, stream, a);
    const hipError_t le = hipPeekAtLastError();
    if (le != hipSuccess) fprintf(stderr, "kernel_launch: launch failed: %s\n", hipGetErrorName(le));
}
```

```cpp
#include <hip/hip_runtime.h>
#include <cstdio>
#include <cstdint>

#ifndef SB_EARLY_EXIT
#define SB_EARLY_EXIT 1
#endif
#define SW_ID 0
#define SW_K 4
#define REP_PRO 1
#define REP_G1 1
#define REP_DA 1
#define REP_SB 1
#define REP_G2 1

#if SW_ID
#define SW_BEGIN(id) unsigned long long sw_t0_##id = 0; if (SW_ID == (id)) sw_t0_##id = __builtin_amdgcn_s_memrealtime()
#define SW_END(id) do { if (SW_ID == (id)) sw_acc += __builtin_amdgcn_s_memrealtime() - sw_t0_##id; } while (0)
#else
#define SW_BEGIN(id) do {} while (0)
#define SW_END(id) do {} while (0)
#endif
#define LAS __attribute__((address_space(3)))
#define GAS __attribute__((address_space(1)))
typedef _Float16 f16;
typedef _Float16 h8 __attribute__((ext_vector_type(8)));
typedef _Float16 h4 __attribute__((ext_vector_type(4)));
typedef _Float16 h2 __attribute__((ext_vector_type(2)));
typedef float f32x4 __attribute__((ext_vector_type(4)));
typedef float f32x16 __attribute__((ext_vector_type(16)));
typedef unsigned u32x4 __attribute__((ext_vector_type(4)));
typedef unsigned u32x2 __attribute__((ext_vector_type(2)));

constexpr int BATCH = 16, SEQ = 2048, DM = 1024, MROWS = BATCH * SEQ, PW = 4096, DEPTH = 2;
constexpr float RMS_EPS = 1e-6f;
constexpr float LOG2E = 1.4426950408889634f;
constexpr float QS = 0.125f * LOG2E;
constexpr int C_SBQ = 0, C_SBK = 512, C_SBV = 1024, C_SBG = 1536, C_DAQ = 2048, C_DAK = 2560, C_DAV = 3072, C_DAG = 3584;

__device__ __forceinline__ unsigned pkh(float lo, float hi) { h2 v = {(f16)lo, (f16)hi}; return __builtin_bit_cast(unsigned, v); }
__device__ __forceinline__ unsigned pkh_rtz(float lo, float hi) { return __builtin_bit_cast(unsigned, __builtin_amdgcn_cvt_pkrtz(lo, hi)); }
__device__ __forceinline__ float silu_f(float v) { return v * __builtin_amdgcn_rcpf(1.0f + __builtin_amdgcn_exp2f(-v * LOG2E)); }

namespace pg8 {
constexpr int BM = 256, BK = 64, HALF = 128, HTB = HALF * BK * 2, STAGE_BYTES = 8 * HTB, NXCD = 8, WGM = 8;
__host__ __device__ __forceinline__ int lds_byte(int r, int c) { const int st = (r >> 4) * 2 + (c >> 5), rr = r & 15, cc = c & 31, ob = rr * 64 + cc * 2; return st * 1024 + (ob ^ (((ob >> 9) & 1) << 5)); }
__host__ __device__ __forceinline__ void stage_rc(int b, int& R, int& C) { const int st = b / 1024, sb = b % 1024, swz = sb ^ (((sb >> 9) & 1) << 5); R = (st >> 1) * 16 + swz / 64; C = (st & 1) * 32 + (swz % 64) / 2; }
__host__ __device__ __forceinline__ int perm32(int rho) { const int n = rho >> 4, i = rho & 15; return 8 * (i >> 2) + 4 * n + (i & 3); }

struct Unit { int pm, pn; };
struct Gemm { const f16* A; const f16* Bt; int M, N, K; };

struct StaticOrder {
    int nM, nN, nwg, G, c;
    __host__ __device__ void init(int M, int N, int G_, int c_) { nM = M / BM; nN = N / BM; nwg = nM * nN; G = G_; c = c_; }
    __host__ __device__ bool next(int i, Unit& u) const {
        const long L = (long)i * G + c; if (L >= nwg) return false;
        int wgid = (int)L; { const int q = nwg / NXCD, r = nwg % NXCD, xcd = wgid % NXCD, off = wgid / NXCD; wgid = (xcd < r ? xcd * (q + 1) : r * (q + 1) + (xcd - r) * q) + off; }
        const int nig = WGM * nN, gid = wgid / nig, fm = gid * WGM, gsz = (nM - fm) < WGM ? (nM - fm) : WGM;
        u.pm = fm + ((wgid % nig) % gsz); u.pn = (wgid % nig) / gsz; return true;
    }
};


struct EpiProj {
    GAS f16* P; const GAS float* part; const GAS float* gq; const GAS float* gk;
    __device__ __forceinline__ void operator()(const f32x4 (&acc)[2][2][4][2], const Unit& u, int wr, int wc, int fr, int fq) const {
        const int sec = u.pn >> 1;
        const int row0 = u.pm * BM + wr * 64 + fr;
        const int colw = u.pn * BM + wc * 64 + 8 * fq;
        f32x4 gain[2][2];
        if (sec == 4 || sec == 5) {
            const GAS float* g = (sec == 4) ? gq : gk;
#pragma unroll
            for (int bj = 0; bj < 2; ++bj)
#pragma unroll
                for (int n = 0; n < 2; ++n) gain[bj][n] = *(const GAS f32x4*)(g + 32 * bj + 8 * fq + 4 * n);
        }
#pragma unroll
        for (int ai = 0; ai < 2; ++ai)
#pragma unroll
            for (int m = 0; m < 4; ++m) {
                const int row = row0 + ai * HALF + m * 16;
                const f32x4 pv = *(const GAS f32x4*)(part + (size_t)row * 16 + fq * 4);
                float s = (pv[0] + pv[1]) + (pv[2] + pv[3]);
                s += __shfl_xor(s, 16); s += __shfl_xor(s, 32);
                const float rs = __builtin_amdgcn_rsqf(s * (1.0f / DM) + RMS_EPS);
                f32x4 v[2][2];
#pragma unroll
                for (int bj = 0; bj < 2; ++bj)
#pragma unroll
                    for (int n = 0; n < 2; ++n) v[bj][n] = acc[ai][bj][m][n] * rs;
                if (sec == 4 || sec == 5) {
                    float ss = 0.f;
#pragma unroll
                    for (int bj = 0; bj < 2; ++bj)
#pragma unroll
                        for (int n = 0; n < 2; ++n) { const f32x4 x = v[bj][n]; ss += (x[0] * x[0] + x[1] * x[1]) + (x[2] * x[2] + x[3] * x[3]); }
                    ss += __shfl_xor(ss, 16); ss += __shfl_xor(ss, 32);
                    float rn = __builtin_amdgcn_rsqf(ss * (1.0f / 64.0f) + RMS_EPS);
                    if (sec == 4) rn *= QS;
#pragma unroll
                    for (int bj = 0; bj < 2; ++bj)
#pragma unroll
                        for (int n = 0; n < 2; ++n) v[bj][n] = v[bj][n] * rn * gain[bj][n];
                } else if (sec == 0) {
#pragma unroll
                    for (int bj = 0; bj < 2; ++bj)
#pragma unroll
                        for (int n = 0; n < 2; ++n) v[bj][n] = v[bj][n] * QS;
                } else if (sec == 3 || sec == 7) {
#pragma unroll
                    for (int bj = 0; bj < 2; ++bj)
#pragma unroll
                        for (int n = 0; n < 2; ++n)
#pragma unroll
                            for (int e = 0; e < 4; ++e) v[bj][n][e] = silu_f(v[bj][n][e]);
                }
                GAS f16* rowp = P + (size_t)row * PW + colw;
#pragma unroll
                for (int bj = 0; bj < 2; ++bj) {
                    u32x4 w; w.x = pkh(v[bj][0][0], v[bj][0][1]); w.y = pkh(v[bj][0][2], v[bj][0][3]); w.z = pkh(v[bj][1][0], v[bj][1][1]); w.w = pkh(v[bj][1][2], v[bj][1][3]);
                    *(GAS u32x4*)(rowp + 32 * bj) = w;
                }
            }
    }
};

struct EpiOut {
    GAS float* out; GAS f16* xb; GAS float* part; int last;
    __device__ __forceinline__ void operator()(const f32x4 (&acc)[2][2][4][2], const Unit& u, int wr, int wc, int fr, int fq) const {
        const int row0 = u.pm * BM + wr * 64 + fr;
        const int colw = u.pn * BM + wc * 64 + 8 * fq;
#pragma unroll
        for (int ai = 0; ai < 2; ++ai) {
            h8 bs[4][2];
#pragma unroll
            for (int m = 0; m < 4; ++m)
#pragma unroll
                for (int bj = 0; bj < 2; ++bj) bs[m][bj] = *(const GAS h8*)(xb + (size_t)(row0 + ai * HALF + m * 16) * DM + colw + 32 * bj);
#pragma unroll
            for (int m = 0; m < 4; ++m) {
                const int row = row0 + ai * HALF + m * 16;
                const size_t off = (size_t)row * DM + colw;
                float ss = 0.f;
#pragma unroll
                for (int bj = 0; bj < 2; ++bj) {
                    const h8 b = bs[m][bj];
                    f32x4 o0 = acc[ai][bj][m][0], o1 = acc[ai][bj][m][1];
                    o0[0] += (float)b[0]; o0[1] += (float)b[1]; o0[2] += (float)b[2]; o0[3] += (float)b[3];
                    o1[0] += (float)b[4]; o1[1] += (float)b[5]; o1[2] += (float)b[6]; o1[3] += (float)b[7];
                    if (last) { *(GAS f32x4*)(out + off + 32 * bj) = o0; *(GAS f32x4*)(out + off + 32 * bj + 4) = o1; }
                    else {
                        ss += (o0[0] * o0[0] + o0[1] * o0[1]) + (o0[2] * o0[2] + o0[3] * o0[3]) + (o1[0] * o1[0] + o1[1] * o1[1]) + (o1[2] * o1[2] + o1[3] * o1[3]);
                        u32x4 w; w.x = pkh(o0[0], o0[1]); w.y = pkh(o0[2], o0[3]); w.z = pkh(o1[0], o1[1]); w.w = pkh(o1[2], o1[3]);
                        *(GAS u32x4*)(xb + off + 32 * bj) = w;
                    }
                }
                if (!last) {
                    ss += __shfl_xor(ss, 16); ss += __shfl_xor(ss, 32);
                    if (fq == 0) part[(size_t)row * 16 + u.pn * 4 + wc] = ss;
                }
            }
        }
    }
};

template <class Epi>
__device__ __forceinline__ void gemm_phase(LAS unsigned char* lds, const Gemm g, const StaticOrder& S, const Epi& E, unsigned long long& sw_acc) {
    int tid_ = threadIdx.x; asm volatile("" : "+v"(tid_));
    const int tid = tid_, wid = __builtin_amdgcn_readfirstlane(tid >> 6), lane = tid & 63, wr = wid >> 2, wc = wid & 3, fr = lane & 15, fq = lane >> 4;
    const int K = g.K, nt = K / BK;
    unsigned voffA[2], voffB[2];
#pragma unroll
    for (int i = 0; i < 2; ++i) { int R, C; stage_rc(tid * 16 + i * 8192, R, C);
        const int Rb = (R >> 5) * 64 + perm32(R & 31);
        voffA[i] = (unsigned)(R * K + C) * 2u; voffB[i] = (unsigned)(Rb * K + C) * 2u; }
    const size_t kstep = (size_t)(BK * 2);
    const size_t hstep = (size_t)HALF * K * 2;
    const size_t hstepB = (size_t)32 * K * 2;
    const size_t tstep = 2 * hstep;
    const unsigned ldsw = (unsigned)wid * 1024u;
    const int aoff = lds_byte(wr * 64 + fr, fq * 8), boff = lds_byte(wc * 32 + fr, fq * 8);
#define PG8_SA(b, h) (((b) * 2 + (h)) * HTB)
#define PG8_SB(b, h) ((4 + (b) * 2 + (h)) * HTB)
#define PG8_STAGE(bufoff, gbase, voff) do { _Pragma("unroll") for (int _i = 0; _i < 2; ++_i) \
        __builtin_amdgcn_global_load_lds((const unsigned*)((const char*)(gbase) + (voff)[_i]), (LAS unsigned*)(lds + (bufoff) + ldsw + _i * 8192), 16, 0, 0); } while (0)
#define PG8_LDA(dst, b, h) do { _Pragma("unroll") for (int m = 0; m < 4; ++m) _Pragma("unroll") for (int k = 0; k < 2; ++k) dst[m][k] = *(const LAS h8*)(lds + PG8_SA(b, h) + aoff + m * 2048 + k * 1024); } while (0)
#define PG8_LDB(dst, b, h) do { _Pragma("unroll") for (int n = 0; n < 2; ++n) _Pragma("unroll") for (int k = 0; k < 2; ++k) dst[n][k] = *(const LAS h8*)(lds + PG8_SB(b, h) + boff + n * 2048 + k * 1024); } while (0)
#define PG8_MMA(ai, bj, At, Bt) do { __builtin_amdgcn_s_setprio(1); _Pragma("unroll") for (int m = 0; m < 4; ++m) _Pragma("unroll") for (int n = 0; n < 2; ++n) _Pragma("unroll") for (int k = 0; k < 2; ++k) \
        acc[ai][bj][m][n] = __builtin_amdgcn_mfma_f32_16x16x32_f16(Bt[n][k], At[m][k], acc[ai][bj][m][n], 0, 0, 0); __builtin_amdgcn_s_setprio(0); } while (0)
#define PG8_WAIT_V(n) asm volatile("s_waitcnt vmcnt(" #n ")" ::: "memory")
#define PG8_WAIT_L(n) asm volatile("s_waitcnt lgkmcnt(" #n ")" ::: "memory")
#define PG8_BAR __builtin_amdgcn_s_barrier()
#define PG8_SCHED __builtin_amdgcn_sched_barrier(0)
    Unit cur, nxt; int ui = 0;
    if (!S.next(0, cur)) return;
    f32x4 acc[2][2][4][2];
#pragma unroll
    for (int a = 0; a < 2; ++a)
#pragma unroll
        for (int b = 0; b < 2; ++b)
#pragma unroll
            for (int m = 0; m < 4; ++m)
#pragma unroll
                for (int n = 0; n < 2; ++n) acc[a][b][m][n] = (f32x4){0.f, 0.f, 0.f, 0.f};
    h8 At[4][2], B0[2][2], B1[2][2];
    const char* cA = (const char*)g.A + (size_t)cur.pm * tstep; const char* cB = (const char*)g.Bt + (size_t)cur.pn * tstep;
    PG8_STAGE(PG8_SB(0, 0), cB, voffB); PG8_STAGE(PG8_SB(0, 1), cB + hstepB, voffB); PG8_STAGE(PG8_SA(0, 0), cA, voffA); PG8_STAGE(PG8_SA(0, 1), cA + hstep, voffA);
    if (wr == 1) PG8_BAR;
    PG8_WAIT_V(2); PG8_BAR;
    PG8_STAGE(PG8_SB(1, 0), cB + kstep, voffB); PG8_STAGE(PG8_SA(1, 0), cA + kstep, voffA); PG8_STAGE(PG8_SB(1, 1), cB + hstepB + kstep, voffB);
    PG8_WAIT_V(6); PG8_BAR;
    for (;;) {
        const bool has_next = S.next(ui + 1, nxt);
        const char* nA = has_next ? (const char*)g.A + (size_t)nxt.pm * tstep : cA; const char* nB = has_next ? (const char*)g.Bt + (size_t)nxt.pn * tstep : cB;
        for (int t = 0; t < nt; t += 2) {
            const bool last = (t == nt - 2);
            const char* a1 = cA + (size_t)(t + 1) * kstep;
            const char* a2 = last ? nA : cA + (size_t)(t + 2) * kstep; const char* b2 = last ? nB : cB + (size_t)(t + 2) * kstep;
            const char* a3 = a2 + kstep; const char* b3 = b2 + kstep;
            PG8_LDB(B0, 0, 0); PG8_LDB(B1, 0, 1); PG8_SCHED; PG8_LDA(At, 0, 0); PG8_STAGE(PG8_SA(1, 1), a1 + hstep, voffA);
            PG8_WAIT_V(8); PG8_WAIT_L(0); PG8_BAR; PG8_MMA(0, 0, At, B0); PG8_MMA(0, 1, At, B1); PG8_BAR; PG8_SCHED;
            PG8_LDA(At, 0, 1); PG8_STAGE(PG8_SB(0, 0), b2, voffB); PG8_STAGE(PG8_SB(0, 1), b2 + hstepB, voffB); PG8_STAGE(PG8_SA(0, 0), a2, voffA);
            PG8_WAIT_V(8); PG8_WAIT_L(0); PG8_BAR; PG8_MMA(1, 0, At, B0); PG8_MMA(1, 1, At, B1); PG8_BAR; PG8_SCHED;
            PG8_LDB(B0, 1, 0); PG8_LDB(B1, 1, 1); PG8_SCHED; PG8_LDA(At, 1, 0); PG8_STAGE(PG8_SA(0, 1), a2 + hstep, voffA);
            PG8_WAIT_V(8); PG8_WAIT_L(0); PG8_BAR; PG8_MMA(0, 0, At, B0); PG8_MMA(0, 1, At, B1); PG8_BAR; PG8_SCHED;
            PG8_LDA(At, 1, 1); PG8_STAGE(PG8_SB(1, 0), b3, voffB); PG8_STAGE(PG8_SB(1, 1), b3 + hstepB, voffB); PG8_STAGE(PG8_SA(1, 0), a3, voffA);
            PG8_WAIT_V(8); PG8_WAIT_L(0); PG8_BAR; PG8_MMA(1, 0, At, B0); PG8_MMA(1, 1, At, B1); PG8_BAR; PG8_SCHED;
        }
        if (wr == 0) PG8_BAR;
        { SW_BEGIN(20); E(acc, cur, wr, wc, fr, fq); SW_END(20); }
        if (!has_next) break;
#pragma unroll
        for (int a = 0; a < 2; ++a)
#pragma unroll
            for (int b = 0; b < 2; ++b)
#pragma unroll
                for (int m = 0; m < 4; ++m)
#pragma unroll
                    for (int n = 0; n < 2; ++n) acc[a][b][m][n] = (f32x4){0.f, 0.f, 0.f, 0.f};
        cur = nxt; cA = nA; cB = nB; ++ui;
        if (wr == 1) PG8_BAR;
    }
    PG8_WAIT_V(0);
    PG8_BAR;
#undef PG8_SA
#undef PG8_SB
#undef PG8_STAGE
#undef PG8_LDA
#undef PG8_LDB
#undef PG8_MMA
#undef PG8_WAIT_V
#undef PG8_WAIT_L
#undef PG8_BAR
#undef PG8_SCHED
}
}

namespace att {
typedef short v4i16_t __attribute__((ext_vector_type(4)));
__device__ __forceinline__ int crow(int r, int hi) { return (r & 3) + 8 * (r >> 2) + 4 * hi; }
__device__ __forceinline__ int keyrow(int i) { return 32 * ((i >> 2) & 1) + (i & 3) + 4 * (i >> 3); }
__device__ __forceinline__ h4 vtr(const LAS unsigned char* p) { return __builtin_bit_cast(h4, __builtin_amdgcn_ds_read_tr16_b64_v4i16((LAS v4i16_t*)p)); }
__device__ __forceinline__ h8 cat8(h4 a, h4 b) { return (h8){a[0], a[1], a[2], a[3], b[0], b[1], b[2], b[3]}; }
#define MFMA32(a, b, c) __builtin_amdgcn_mfma_f32_32x32x16_f16(a, b, c, 0, 0, 0)
__device__ __forceinline__ h8 pack8(const f32x16& p, int b) {
    u32x4 w; w.x = pkh_rtz(p[b], p[b + 1]); w.y = pkh_rtz(p[b + 2], p[b + 3]); w.z = pkh_rtz(p[b + 4], p[b + 5]); w.w = pkh_rtz(p[b + 6], p[b + 7]);
    return __builtin_bit_cast(h8, w);
}
__device__ __forceinline__ float vadd_s(float a, float b) { float r; asm("v_add_f32_e32 %0, %1, %2" : "=v"(r) : "v"(a), "v"(b)); return r; }
template <int KI> __device__ __forceinline__ float fmamk_s(float c, float base) {
    float r; asm volatile("v_fmamk_f32 %0, %1, %2, %3" : "=v"(r) : "v"(c), "i"(__builtin_bit_cast(int, (float)KI)), "v"(base)); return r; }
__device__ __forceinline__ float wave_sum(float v) {
#pragma unroll
    for (int o = 1; o < 64; o <<= 1) v += __shfl_xor(v, o);
    return v;
}
__device__ __forceinline__ float wave_max(float v) {
#pragma unroll
    for (int o = 1; o < 64; o <<= 1) v = fmaxf(v, __shfl_xor(v, o));
    return v;
}

__device__ __forceinline__ void glds16(const GAS void* g, unsigned lds_base) {
    unsigned sv; asm volatile("s_mov_b32 %0, m0\n\ts_mov_b32 m0, %2\n\ts_nop 0\n\tglobal_load_lds_dwordx4 %1, off\n\ts_mov_b32 m0, %0" : "=&s"(sv) : "v"(g), "s"(lds_base) : "memory"); }
#define WAIT_BAR(N) asm volatile("s_waitcnt vmcnt(" #N ") lgkmcnt(0)\n\ts_barrier" ::: "memory")
__device__ __forceinline__ void wait_bar_n(int n) {
    switch (n) { case 0: WAIT_BAR(0); break; case 2: WAIT_BAR(2); break; case 4: WAIT_BAR(4); break; case 6: WAIT_BAR(6); break; case 8: WAIT_BAR(8); break; case 10: WAIT_BAR(10); break;
                 case 12: WAIT_BAR(12); break; case 14: WAIT_BAR(14); break; case 16: WAIT_BAR(16); break; case 18: WAIT_BAR(18); break; case 20: WAIT_BAR(20); break; default: WAIT_BAR(0); break; }
}

constexpr int SB_SLOT = 65536, SB_FLG = 147456 + 2048;
__device__ __forceinline__ int keyrow16(int i) { return 16 * ((i >> 2) & 1) + (i & 3) + 4 * (i >> 3); }
struct SbUnit { int b, hg, cq; };
__device__ __forceinline__ bool sb_decode(int u, SbUnit& U) {
    if (u >= 1024) return false;
    const int r = u >> 8, v = u & 255, i = v & 15;
    U.b = v >> 4; U.hg = i & 1; U.cq = (i >> 1) + 8 * r; return true;
}
__device__ __forceinline__ void sb_phase(LAS unsigned char* lds, const GAS f16* __restrict__ proj, GAS f16* __restrict__ mixed, int vcu, int G, unsigned long long& sw_acc) {
    int tid_ = threadIdx.x; asm volatile("" : "+v"(tid_));
    const int tid = tid_, lane = tid & 63, l31 = lane & 31, hi = lane >> 5; const int w = __builtin_amdgcn_readfirstlane(tid >> 6);
    const int hh = w & 3, rgp = w >> 2;
    const unsigned lds0 = (unsigned)(uintptr_t)lds;
    const unsigned kdst = lds0 + w * 4096, vdst = lds0 + 32768 + w * 4096;
    int kfo[4];
    { const int kr = keyrow16(l31);
#pragma unroll
      for (int d0 = 0; d0 < 4; ++d0) kfo[d0] = kr * 512 + (((hh * 8 + 2 * d0 + hi) ^ (kr & 15)) * 16); }
    int vfo[2];
    { const int q_ = (lane & 15) >> 2;
#pragma unroll
      for (int d0 = 0; d0 < 2; ++d0) vfo[d0] = 32768 + (16 * hi + q_) * 512 + (((hh * 2 + d0) ^ q_) * 64) + ((lane >> 4) & 1) * 32 + (lane & 3) * 8; }
    LAS unsigned* flags = (LAS unsigned*)(lds + SB_FLG);
    size_t koff[4], voff[4];
#pragma unroll
    for (int i = 0; i < 4; ++i) { const int row = 8 * w + 2 * i + (lane >> 5), p = lane & 31;
        koff[i] = (size_t)row * PW + C_SBK + ((p ^ (row & 15)) * 8);
        voff[i] = (size_t)row * PW + C_SBV + ((((p >> 2) ^ (row & 3)) * 4 + (p & 3)) * 8); }
    const size_t qoff = (size_t)(32 * rgp + l31) * PW;
#define SB_DMA(base_, kt_, slot) do { const GAS f16* b_ = (base_) + (size_t)(kt_) * 64 * PW; const unsigned kd_ = (unsigned)__builtin_amdgcn_readfirstlane(kdst + (slot)), vd_ = (unsigned)__builtin_amdgcn_readfirstlane(vdst + (slot)); \
        _Pragma("unroll") for (int i_ = 0; i_ < 4; ++i_) { glds16(b_ + koff[i_], kd_ + i_ * 1024); glds16(b_ + voff[i_], vd_ + i_ * 1024); } } while (0)
    SbUnit U, Un; int ui = vcu;
    if (!sb_decode(ui, U)) return;
    int islot = 0, cslot = 0;
    const GAS f16* tbase = proj + ((size_t)U.b * SEQ) * PW + U.hg * 256;
    h8 qn[4]; u32x2 gn[8];
    { const size_t grow = (size_t)U.b * SEQ + U.cq * 64 + 32 * rgp + l31; const int h = 4 * U.hg + hh;
      const GAS f16* Qg = proj + grow * PW + C_SBQ + h * 64 + 8 * hi; const GAS f16* Gp = proj + grow * PW + C_SBG + h * 64 + 4 * hi;
#pragma unroll
      for (int d0 = 0; d0 < 4; ++d0) qn[d0] = *(const GAS h8*)(Qg + 16 * d0);
#pragma unroll
      for (int i = 0; i < 8; ++i) gn[i] = *(const GAS u32x2*)(Gp + 8 * i); }
    asm volatile("" : "+v"(qn[0]), "+v"(qn[1]), "+v"(qn[2]), "+v"(qn[3]));
    SB_DMA(tbase, U.cq, islot); islot ^= SB_SLOT;
    for (;;) {
        const size_t rowbase = (size_t)U.b * SEQ;
        const int qw = U.cq * 64 + 32 * rgp, t = qw + l31, NT = U.cq + 1, h = 4 * U.hg + hh;
        const size_t grow = rowbase + qw + l31;
        h8 qr[4]; u32x2 gv[8];
#pragma unroll
        for (int d0 = 0; d0 < 4; ++d0) qr[d0] = qn[d0];
#pragma unroll
        for (int i = 0; i < 8; ++i) gv[i] = gn[i];
        const bool has_next = sb_decode(ui + G, Un);
        f32x16 o[2]; o[0] = f32x16{}; o[1] = f32x16{};
        float carry = 1.f; int done = 0;
        SW_BEGIN(12);
        for (int j = 0; j < NT; ++j) {
            SW_BEGIN(13);
            WAIT_BAR(0);
            SW_END(13);
            if (j > 0) {
                const u32x4 f0 = *(const LAS u32x4*)(flags + ((j - 1) & 1) * 8), f1 = *(const LAS u32x4*)(flags + ((j - 1) & 1) * 8 + 4);
                const unsigned any = (f0.x | f0.y | f0.z | f0.w) | (f1.x | f1.y | f1.z | f1.w);
                if (!__builtin_amdgcn_readfirstlane(any)) break;
            }
            if (j + 1 < NT) { SB_DMA(tbase, U.cq - (j + 1), islot); islot ^= SB_SLOT; }
            const int kt = U.cq - j;
#pragma unroll
            for (int sub = 0; sub < 2; ++sub) {
                const int kb32 = sub == 0 ? 32 : 0;
                const bool diag = (j == 0) && (sub == (rgp == 1 ? 0 : 1));
                const bool skip = (j == 0) && (rgp == 0) && (sub == 0);
                if (!done && !skip) {
                    const LAS unsigned char* Sb = lds + cslot + kb32 * 512;
                    f32x16 p = f32x16{};
#pragma unroll
                    for (int d0 = 0; d0 < 4; ++d0) { const h8 k0 = *(const LAS h8*)(Sb + kfo[d0]); p = MFMA32(k0, qr[d0], p); }
#pragma unroll
                    for (int r = 0; r < 16; ++r) p[r] = __builtin_amdgcn_rcpf(1.0f + __builtin_amdgcn_exp2f(-p[r]));
                    if (diag) {
                        const int key0 = 64 * kt + kb32 + 16 * hi;
#pragma unroll
                        for (int r = 0; r < 16; ++r) if (key0 + r >= t) p[r] = 0.f;
                    }
                    float run = 1.f;
#pragma unroll
                    for (int r = 15; r >= 0; --r) { const float a = run * p[r]; run -= a; p[r] = a; }
                    const auto rr = __builtin_amdgcn_permlane32_swap(__float_as_uint(run), __float_as_uint(run), false, false);
                    const float T0 = __uint_as_float(rr[0]), T1 = __uint_as_float(rr[1]);
                    const float E = carry * (hi ? 1.0f : T1);
                    carry = carry * (T0 * T1);
#pragma unroll
                    for (int r = 0; r < 16; ++r) p[r] *= E;
                    const h8 pa0 = pack8(p, 0), pa1 = pack8(p, 8);
#pragma unroll
                    for (int d0 = 0; d0 < 2; ++d0) {
                        const LAS unsigned char* Vb = Sb + vfo[d0];
                        const h8 v0 = cat8(vtr(Vb), vtr(Vb + 2048));
                        const h8 v1 = cat8(vtr(Vb + 4096), vtr(Vb + 6144));
                        o[d0] = MFMA32(v0, pa0, o[d0]); o[d0] = MFMA32(v1, pa1, o[d0]);
                    }
#if SB_EARLY_EXIT
                    done = __builtin_amdgcn_readfirstlane(__all(carry < 1.0e-37f) ? 1 : 0);
#endif
                }
            }
            if (lane == 0) flags[(j & 1) * 8 + w] = done ? 0u : 1u;
            cslot ^= SB_SLOT;
        }
        asm volatile("s_nop 15\n\ts_nop 7" : "+v"(o[0]), "+v"(o[1]));
        SW_END(12);
        cslot = islot;
        if (has_next) {
            const size_t grown = (size_t)Un.b * SEQ + Un.cq * 64 + 32 * rgp + l31; const int hn = 4 * Un.hg + hh;
            const GAS f16* Qg = proj + grown * PW + C_SBQ + hn * 64 + 8 * hi; const GAS f16* Gp = proj + grown * PW + C_SBG + hn * 64 + 4 * hi;
#pragma unroll
            for (int d0 = 0; d0 < 4; ++d0) qn[d0] = *(const GAS h8*)(Qg + 16 * d0);
#pragma unroll
            for (int i = 0; i < 8; ++i) gn[i] = *(const GAS u32x2*)(Gp + 8 * i);
            asm volatile("" ::: "memory");
            tbase = proj + ((size_t)Un.b * SEQ) * PW + Un.hg * 256;
            SB_DMA(tbase, Un.cq, islot); islot ^= SB_SLOT;
        }
        {
            GAS f16* Op = mixed + grow * DM + h * 64 + 4 * hi;
#pragma unroll
            for (int d0 = 0; d0 < 2; ++d0)
#pragma unroll
                for (int rg4 = 0; rg4 < 4; ++rg4) {
                    const h4 g = __builtin_bit_cast(h4, gv[d0 * 4 + rg4]);
                    u32x2 wv; wv.x = pkh(o[d0][4 * rg4] * (float)g[0], o[d0][4 * rg4 + 1] * (float)g[1]); wv.y = pkh(o[d0][4 * rg4 + 2] * (float)g[2], o[d0][4 * rg4 + 3] * (float)g[3]);
                    *(GAS u32x2*)(Op + 32 * d0 + 8 * rg4) = wv;
                }
        }
        if (!has_next) break;
        U = Un; ui += G;
    }
#undef SB_DMA
    WAIT_BAR(0);
}

constexpr int DA_KS = 16384, DA_VRING = 49152, DA_XCH = 114688, DA_SUBG = 147456 + 1024, DA_SSX = 147456 + 3072;
struct DaUnit { int b, h, qt, klo; };
__device__ __forceinline__ int da_qt_of(int r, int i) {
    constexpr unsigned long long Q1 = 0xE92B6AF78C01D543ull, Q2 = 0x6C5B3014A78D29FEull, Q3 = 0x21F0DC6B43E87A59ull;
    return r == 0 ? i : (int)(((r == 1 ? Q1 : r == 2 ? Q2 : Q3) >> (4 * i)) & 15ull);
}
__device__ __forceinline__ int da_klo(int qt, int h) {
    const float cs = exp2f(-2.0f * (float)(h + 1)) * LOG2E;
    const int D = (int)ceilf(160.5f / cs), m = qt * 128 - D - 63;
    return m > 0 ? (m + 63) >> 6 : 0;
}
__device__ __forceinline__ bool da_decode(int u, DaUnit& U) {
    if (u >= 1024) return false;
    const int r = u >> 8, v = u & 255;
    U.b = v >> 4; U.h = r; U.qt = da_qt_of(r, v & 15); U.klo = da_klo(U.qt, U.h); return true;
}
__device__ __forceinline__ void da_pv(f32x16 (&o)[4], const LAS unsigned char* Vs, const int (&vfo)[4], h8 pa0, h8 pa1, h8 pa2, h8 pa3) {
    h8 f0, f1, f2, f3, g0, g1, g2, g3;
    { const LAS unsigned char* Vb = Vs + vfo[0]; f0 = cat8(vtr(Vb), vtr(Vb + 1024)); f1 = cat8(vtr(Vb + 2048), vtr(Vb + 3072)); f2 = cat8(vtr(Vb + 4096), vtr(Vb + 5120)); f3 = cat8(vtr(Vb + 6144), vtr(Vb + 7168)); }
#pragma unroll
    for (int d0 = 0; d0 < 4; ++d0) {
        if (d0 < 3) { const LAS unsigned char* Vb = Vs + vfo[d0 + 1]; g0 = cat8(vtr(Vb), vtr(Vb + 1024)); g1 = cat8(vtr(Vb + 2048), vtr(Vb + 3072)); g2 = cat8(vtr(Vb + 4096), vtr(Vb + 5120)); g3 = cat8(vtr(Vb + 6144), vtr(Vb + 7168)); }
        o[d0] = MFMA32(f0, pa0, o[d0]); o[d0] = MFMA32(f1, pa1, o[d0]); o[d0] = MFMA32(f2, pa2, o[d0]); o[d0] = MFMA32(f3, pa3, o[d0]);
        if (d0 < 3) { f0 = g0; f1 = g1; f2 = g2; f3 = g3; }
    }
}
__device__ __forceinline__ void da_phase(LAS unsigned char* lds, const GAS f16* __restrict__ proj, GAS f16* __restrict__ mixed, int vcu, int G,
                                         float lam, float mref, const GAS float* __restrict__ subg, float osc, unsigned long long& sw_acc) {
    int tid_ = threadIdx.x; asm volatile("" : "+v"(tid_));
    const int tid = tid_, lane = tid & 63, l31 = lane & 31, hi = lane >> 5; const int w = __builtin_amdgcn_readfirstlane(tid >> 6);
    const int c = w >> 2, rg = w & 3;
    const unsigned lds0 = (unsigned)(uintptr_t)lds;
    const unsigned kdst = lds0 + w * 1024, vdst = lds0 + DA_VRING + w * 1024;
    int kfo[4];
    { const int kr = keyrow(l31);
#pragma unroll
      for (int d0 = 0; d0 < 4; ++d0) kfo[d0] = kr * 256 + (((8 * c + 2 * d0 + hi) ^ (kr & 15)) * 16); }
    int vfo[4];
    { const int q_ = (lane & 15) >> 2;
#pragma unroll
      for (int d0 = 0; d0 < 4; ++d0) vfo[d0] = DA_VRING + (32 * hi + q_) * 256 + ((d0 ^ q_) * 64) + ((lane >> 4) & 1) * 32 + (lane & 3) * 8; }
    const int srow = 4 * w + (lane >> 4);
    const size_t koff = (size_t)srow * PW + C_DAK + (((lane & 15) ^ (srow & 15)) * 8);
    const size_t voff = (size_t)srow * PW + C_DAV + (((((lane & 15) >> 2) ^ (srow & 3)) * 4 + (lane & 3)) * 8);
    const size_t qoff = (size_t)(32 * rg + l31) * PW + C_DAQ + c * 64 + 8 * hi;
    if (tid < 128) ((LAS float*)(lds + DA_SUBG))[tid] = subg[tid];
    LAS unsigned* xch = (LAS unsigned*)(lds + DA_XCH + rg * 8192);
#define DA_DMA(ks_, vs_, kt_, kslot, vslot) do { const size_t go_ = (size_t)(kt_) * 64 * PW; const unsigned kd_ = (unsigned)__builtin_amdgcn_readfirstlane(kdst + (kslot)), vd_ = (unsigned)__builtin_amdgcn_readfirstlane(vdst + (vslot)); \
        glds16((ks_) + go_, kd_); glds16((ks_) + go_ + (size_t)32 * PW, kd_ + 8192); glds16((vs_) + go_, vd_); glds16((vs_) + go_ + (size_t)32 * PW, vd_ + 8192); } while (0)
#define DA_NEXT_K(s) ((s) == 2 * DA_KS ? 0 : (s) + DA_KS)
#define DA_NEXT_V(s) ((s) == 3 * DA_KS ? 0 : (s) + DA_KS)
    DaUnit U, Un; int ui = vcu;
    if (!da_decode(ui, U)) return;
    const GAS f16* ksrc = proj + ((size_t)U.b * SEQ) * PW + U.h * 128 + koff; const GAS f16* vsrc = proj + ((size_t)U.b * SEQ) * PW + U.h * 128 + voff;
    h8 qn[4];
    { const GAS f16* Qg = proj + ((size_t)U.b * SEQ + U.qt * 128) * PW + qoff + U.h * 128;
#pragma unroll
      for (int d0 = 0; d0 < 4; ++d0) qn[d0] = *(const GAS h8*)(Qg + 16 * d0); }
    asm volatile("" : "+v"(qn[0]), "+v"(qn[1]), "+v"(qn[2]), "+v"(qn[3]));
    DA_DMA(ksrc, vsrc, U.klo, 0, 0); DA_DMA(ksrc, vsrc, U.klo + 1, DA_KS, DA_KS);
    int ik = 2 * DA_KS, iv = 2 * DA_KS, ck = 0, cv = 0;
    for (;;) {
        const size_t rowbase = (size_t)U.b * SEQ;
        const int qw = U.qt * 128 + 32 * rg, t = qw + l31, lastt = qw >> 6, NT = 2 * U.qt + 2;
        const float cslope = exp2f(-2.0f * (float)(U.h + 1)) * LOG2E;
        const float cs64 = 64.0f * cslope, base0 = -cslope * (float)(t - 32 * hi) - mref;
        h8 qr[4];
#pragma unroll
        for (int d0 = 0; d0 < 4; ++d0) qr[d0] = qn[d0];
        const size_t grow = rowbase + qw + l31;
        const bool has_next = da_decode(ui + G, Un);
        const GAS f16* ksn = ksrc; const GAS f16* vsn = vsrc;
        if (has_next) { ksn = proj + ((size_t)Un.b * SEQ) * PW + Un.h * 128 + koff; vsn = proj + ((size_t)Un.b * SEQ) * PW + Un.h * 128 + voff; }
        f32x16 o[4]; o[0] = f32x16{}; o[1] = f32x16{}; o[2] = f32x16{}; o[3] = f32x16{};
        float lsum = 0.f;
        h8 pq0, pq1, pq2, pq3;
        int pvs = 0;
        SW_BEGIN(2);
        for (int kt = U.klo; kt < NT; ++kt) {
            SW_BEGIN(3);
            if (kt + 1 < NT || has_next) WAIT_BAR(4); else WAIT_BAR(0);
            SW_END(3);
#define DA_ISSUE() do { if (kt + 2 < NT) { DA_DMA(ksrc, vsrc, kt + 2, ik, iv); ik = DA_NEXT_K(ik); iv = DA_NEXT_V(iv); } \
            else if (has_next) { DA_DMA(ksn, vsn, Un.klo + kt + 2 - NT, ik, iv); ik = DA_NEXT_K(ik); iv = DA_NEXT_V(iv); } } while (0)
            DA_ISSUE();
            if (c == 1 && kt > U.klo && kt - 1 <= lastt) da_pv(o, lds + pvs, vfo, pq0, pq1, pq2, pq3);
            if (kt <= lastt) {
                const LAS unsigned char* Ks = lds + ck;
                f32x16 p0, p1;
                const float basek = __builtin_fmaf(cs64, (float)kt, base0);
                __builtin_amdgcn_sched_barrier(0);
                asm volatile("s_nop 7" ::: "memory");
#define DA_INIT(r) p0[r] = fmamk_s<r>(cslope, basek); p1[r] = fmamk_s<16 + r>(cslope, basek);
                DA_INIT(0) DA_INIT(1) DA_INIT(2) DA_INIT(3) DA_INIT(4) DA_INIT(5) DA_INIT(6) DA_INIT(7) DA_INIT(8) DA_INIT(9) DA_INIT(10) DA_INIT(11) DA_INIT(12) DA_INIT(13) DA_INIT(14) DA_INIT(15)
#undef DA_INIT
                asm volatile("s_nop 3" : "+v"(p0), "+v"(p1));
                if (kt == lastt) {
                    const int kd = t - (64 * kt + 32 * hi);
                    const float m2 = -2.0f * mref;
                    asm volatile("" ::: "memory");
#pragma unroll
                    for (int r = 0; r < 16; ++r) { if (r > kd) p0[r] = m2 - p0[r]; if (16 + r > kd) p1[r] = m2 - p1[r]; }
                }
#pragma unroll
                for (int d0 = 0; d0 < 4; ++d0) { const h8 ka = *(const LAS h8*)(Ks + kfo[d0]), kb = *(const LAS h8*)(Ks + kfo[d0] + 4096); p0 = MFMA32(ka, qr[d0], p0); p1 = MFMA32(kb, qr[d0], p1); }
                float s0 = 0.f, s1 = 0.f, s2 = 0.f, s3 = 0.f;
#pragma unroll
                for (int r = 0; r < 16; ++r) { p0[r] = __builtin_amdgcn_exp2f(p0[r]); p1[r] = __builtin_amdgcn_exp2f(p1[r]); }

#pragma unroll
                for (int r = 0; r < 16; r += 2) { s0 += p0[r]; s1 += p0[r + 1]; s2 += p1[r]; s3 += p1[r + 1]; }
                lsum += (s0 + s1) + (s2 + s3);
                pq0 = pack8(p0, 0); pq1 = pack8(p0, 8); pq2 = pack8(p1, 0); pq3 = pack8(p1, 8); pvs = cv;
                if (c == 0) da_pv(o, lds + cv, vfo, pq0, pq1, pq2, pq3);
            }
            ck = DA_NEXT_K(ck); cv = DA_NEXT_V(cv);
        }
        if (c == 1 && NT - 1 <= lastt) da_pv(o, lds + pvs, vfo, pq0, pq1, pq2, pq3);
        asm volatile("s_nop 15\n\ts_nop 7" : "+v"(o[0]), "+v"(o[1]), "+v"(o[2]), "+v"(o[3]));
        SW_END(2);
        const int dlo = 2 * c;
        u32x2 gv[8];
        { const GAS f16* Gp = proj + grow * PW + C_DAG + U.h * 128 + 32 * dlo + 4 * hi;
#pragma unroll
          for (int i = 0; i < 8; ++i) gv[i] = *(const GAS u32x2*)(Gp + 8 * i); }
        if (has_next) { const GAS f16* Qg = proj + ((size_t)Un.b * SEQ + Un.qt * 128) * PW + qoff + Un.h * 128;
#pragma unroll
            for (int d0 = 0; d0 < 4; ++d0) qn[d0] = *(const GAS h8*)(Qg + 16 * d0); }
        asm volatile("" ::: "memory");
        { const auto rr = __builtin_amdgcn_permlane32_swap(__float_as_uint(lsum), __float_as_uint(lsum), false, false); lsum = __uint_as_float(rr[0]) + __uint_as_float(rr[1]); }
        const float f = (c == 0 ? 1.0f : lam) / lsum;
        LAS unsigned* xw = xch + (c ^ 1) * 1024;
        LAS unsigned* xr = xch + c * 1024;
        f32x16 ya, yb;
        if (c == 0) {
#pragma unroll
            for (int r2 = 0; r2 < 8; ++r2) { xw[r2 * 64 + lane] = pkh(o[2][2 * r2] * f, o[2][2 * r2 + 1] * f); xw[(8 + r2) * 64 + lane] = pkh(o[3][2 * r2] * f, o[3][2 * r2 + 1] * f); }
            ya = o[0] * f; yb = o[1] * f;
        } else {
#pragma unroll
            for (int r2 = 0; r2 < 8; ++r2) { xw[r2 * 64 + lane] = pkh(o[0][2 * r2] * f, o[0][2 * r2 + 1] * f); xw[(8 + r2) * 64 + lane] = pkh(o[1][2 * r2] * f, o[1][2 * r2 + 1] * f); }
            ya = o[2] * f; yb = o[3] * f;
        }
        asm volatile("s_waitcnt lgkmcnt(0)\n\ts_barrier" ::: "memory");
        const float sgn = (c == 0) ? 1.0f : -1.0f;
        float ss = 0.f;
#pragma unroll
        for (int r2 = 0; r2 < 8; ++r2) {
            const h2 pa = __builtin_bit_cast(h2, xr[r2 * 64 + lane]), pb = __builtin_bit_cast(h2, xr[(8 + r2) * 64 + lane]);
            const float a0 = (ya[2 * r2] - (float)pa[0]) * sgn, a1 = (ya[2 * r2 + 1] - (float)pa[1]) * sgn, b0 = (yb[2 * r2] - (float)pb[0]) * sgn, b1 = (yb[2 * r2 + 1] - (float)pb[1]) * sgn;
            ya[2 * r2] = a0; ya[2 * r2 + 1] = a1; yb[2 * r2] = b0; yb[2 * r2 + 1] = b1; ss += (a0 * a0 + a1 * a1) + (b0 * b0 + b1 * b1);
        }
        { const auto rr = __builtin_amdgcn_permlane32_swap(__float_as_uint(ss), __float_as_uint(ss), false, false); ss = __uint_as_float(rr[0]) + __uint_as_float(rr[1]); }
        LAS float* ssx = (LAS float*)(lds + DA_SSX + rg * 256);
        if (hi == 0) ssx[c * 32 + l31] = ss;
        asm volatile("s_waitcnt lgkmcnt(0)\n\ts_barrier" ::: "memory");
        ss += ssx[(c ^ 1) * 32 + l31];
        const float rn = __builtin_amdgcn_rsqf(ss * (1.0f / 128.0f) + RMS_EPS) * osc;
        {
            const LAS float* sgl = (const LAS float*)(lds + DA_SUBG) + 32 * dlo + 4 * hi;
            GAS f16* Op = mixed + grow * DM + 512 + U.h * 128 + 32 * dlo + 4 * hi;
#pragma unroll
            for (int rg4 = 0; rg4 < 4; ++rg4) {
                const h4 g = __builtin_bit_cast(h4, gv[rg4]);
                const f32x4 sg = *(const LAS f32x4*)(sgl + 8 * rg4);
                u32x2 wv;
                wv.x = pkh(ya[4 * rg4] * rn * sg[0] * (float)g[0], ya[4 * rg4 + 1] * rn * sg[1] * (float)g[1]);
                wv.y = pkh(ya[4 * rg4 + 2] * rn * sg[2] * (float)g[2], ya[4 * rg4 + 3] * rn * sg[3] * (float)g[3]);
                *(GAS u32x2*)(Op + 8 * rg4) = wv;
            }
#pragma unroll
            for (int rg4 = 0; rg4 < 4; ++rg4) {
                const h4 g = __builtin_bit_cast(h4, gv[4 + rg4]);
                const f32x4 sg = *(const LAS f32x4*)(sgl + 32 + 8 * rg4);
                u32x2 wv;
                wv.x = pkh(yb[4 * rg4] * rn * sg[0] * (float)g[0], yb[4 * rg4 + 1] * rn * sg[1] * (float)g[1]);
                wv.y = pkh(yb[4 * rg4 + 2] * rn * sg[2] * (float)g[2], yb[4 * rg4 + 3] * rn * sg[3] * (float)g[3]);
                *(GAS u32x2*)(Op + 32 + 8 * rg4) = wv;
            }
        }
        if (!has_next) break;
        U = Un; ui += G; ksrc = ksn; vsrc = vsn;
    }
#undef DA_DMA
#undef DA_ISSUE
#undef DA_NEXT_K
#undef DA_NEXT_V
    WAIT_BAR(0);
}
}

constexpr size_t MiB = 1u << 20;
constexpr size_t WS_CTL = 0, CTL_ZERO_BYTES = 64 * 1024;
constexpr size_t WS_WIN = 2 * MiB;
constexpr size_t WS_WOUT = 18 * MiB;
constexpr size_t WS_PART = 22 * MiB;
constexpr size_t WS_XB = 32 * MiB;
constexpr size_t WS_MIX = 96 * MiB;
constexpr size_t WS_PROJ = 160 * MiB;
constexpr size_t WS_END = 416 * MiB;
constexpr int CW_BAR = 4096;

constexpr int RING_OFF = 0, RING_BYTES = 131072;
constexpr int LDSCTL_OFF = 147456, MISC_OFF = LDSCTL_OFF + 320;
constexpr int LDS_BYTES = 163840;
constexpr int NWAVES = 8;

typedef GAS unsigned gu32;
#define LDS_WAIT() asm volatile("s_waitcnt lgkmcnt(0)" ::: "memory")

#define XB_TMO      128
#define XB_XCNT(j)  (256  + 64 * (j))
#define XB_XSUB(j)  (1280 + 64 * (j))
#define XB_XGEN(j)  (2304 + 64 * (j))
#define XB_TOP      3328
#define XB_TOPGEN   3392
#define XCD_BAR_WORDS 3456
#define XB_SPIN_CAP (1u << 18)
__device__ __forceinline__ unsigned xb_ld(unsigned* p)              { return __hip_atomic_load(p, __ATOMIC_RELAXED, __HIP_MEMORY_SCOPE_AGENT); }
__device__ __forceinline__ unsigned xb_add(unsigned* p, unsigned v) { return __hip_atomic_fetch_add(p, v, __ATOMIC_RELAXED, __HIP_MEMORY_SCOPE_AGENT); }
__device__ __forceinline__ unsigned xb_xcc_id() { return (unsigned)__builtin_amdgcn_s_getreg((3 << 11) | 20) & 0xFu; }
#define XB_SPIN(cond, bar) do { unsigned _sp = 0; while (cond) { __builtin_amdgcn_s_sleep(1); \
    if ((++_sp & 255u) == 0u) { if (xb_ld(&(bar)[XB_TMO])) break; if (_sp > XB_SPIN_CAP) { atomicAdd(&(bar)[XB_TMO], 1u); break; } } } } while (0)
struct XcdBarrier { unsigned* bar; unsigned x; volatile LAS unsigned* st; };
__device__ __forceinline__ XcdBarrier xcd_barrier_post(unsigned* bar, volatile LAS unsigned* st) {
    XcdBarrier b; b.bar = bar; b.x = xb_xcc_id(); b.st = st;
    if (threadIdx.x == 0) (void)xb_add(&bar[XB_XCNT(b.x)], 1u);
    return b;
}
__device__ __forceinline__ void xcd_barrier_complete(unsigned* bar, unsigned x, unsigned& nloc, unsigned& nx) {
    const unsigned G = gridDim.x * gridDim.y * gridDim.z;
    unsigned sum, cnt, mine, sp = 0u;
    for (;;) {
        sum = 0u; cnt = 0u; mine = 0u;
#pragma unroll
        for (unsigned j = 0; j < 16; ++j) { const unsigned c = xb_ld(&bar[XB_XCNT(j)]); sum += c; cnt += (c > 0u) ? 1u : 0u; mine = (j == x) ? c : mine; }
        if (sum == G) break;
        __builtin_amdgcn_s_sleep(1);
        if ((++sp & 255u) == 0u) { if (xb_ld(&bar[XB_TMO])) break; if (sp > XB_SPIN_CAP) { atomicAdd(&bar[XB_TMO], 1u); break; } }
    }
    nloc = mine > 0u ? mine : 1u; nx = cnt > 0u ? cnt : 1u;
}
__device__ __forceinline__ void xcd_barrier(const XcdBarrier& b) {
    asm volatile("s_waitcnt vmcnt(0)" ::: "memory");
    __syncthreads();
    if (threadIdx.x == 0) {
        unsigned* bar = b.bar;
        __builtin_amdgcn_s_waitcnt(0);
        unsigned nloc = b.st[0], nx = b.st[1];
        if (nloc == 0u) { xcd_barrier_complete(bar, b.x, nloc, nx); b.st[0] = nloc; b.st[1] = nx; }
        const unsigned old = xb_add(&bar[XB_XSUB(b.x)], 1u);
        const unsigned gen = old / nloc;
        if (old + 1u == (gen + 1u) * nloc) {
            __builtin_amdgcn_fence(__ATOMIC_RELEASE, "agent");
            asm volatile("s_waitcnt vmcnt(0)" ::: "memory");
            const unsigned og = xb_add(&bar[XB_TOP], 1u);
            const unsigned tg = og / nx;
            if (og + 1u == (tg + 1u) * nx) xb_add(&bar[XB_TOPGEN], 1u);
            else XB_SPIN(xb_ld(&bar[XB_TOPGEN]) == tg, bar);
            __builtin_amdgcn_fence(__ATOMIC_ACQUIRE, "agent");
            xb_add(&bar[XB_XGEN(b.x)], 1u);
            asm volatile("s_waitcnt vmcnt(0)" ::: "memory");
        } else {
            XB_SPIN(xb_ld(&bar[XB_XGEN(b.x)]) == gen, bar);
            __builtin_amdgcn_fence(__ATOMIC_ACQUIRE, "agent");
            asm volatile("s_waitcnt vmcnt(0)" ::: "memory");
        }
    }
    __syncthreads();
}

__device__ __forceinline__ void p0_transpose_item(const float* W, const float* g, int K, int N, f16* WT, LAS float* scr, int item, int lane) {
    const int nblk = N / 32, kb = item / nblk, nb = item % nblk, k0 = 32 * kb, n0 = 32 * nb;
    float v[16];
#pragma unroll
    for (int i = 0; i < 16; ++i) { const int kk = 2 * i + (lane >> 5); v[i] = W[(size_t)(k0 + kk) * N + n0 + (lane & 31)]; }
    if (g) {
#pragma unroll
        for (int i = 0; i < 16; ++i) v[i] *= g[k0 + 2 * i + (lane >> 5)];
    }
#pragma unroll
    for (int i = 0; i < 16; ++i) scr[(2 * i + (lane >> 5)) * 33 + (lane & 31)] = v[i];
    LDS_WAIT(); asm volatile("" ::: "memory");
    const int c = lane & 3;
#pragma unroll
    for (int j = 0; j < 2; ++j) { const int n = (lane >> 2) + 16 * j; const LAS float* sp = scr + (8 * c) * 33 + n;
        u32x4 o; o.x = pkh(sp[0 * 33], sp[1 * 33]); o.y = pkh(sp[2 * 33], sp[3 * 33]); o.z = pkh(sp[4 * 33], sp[5 * 33]); o.w = pkh(sp[6 * 33], sp[7 * 33]);
        *(GAS u32x4*)(WT + (size_t)(n0 + n) * K + k0 + 8 * c) = o; }
    LDS_WAIT(); asm volatile("" ::: "memory");
}
__device__ __forceinline__ void x_rows4(const float* x, f16* xb, float* part, int m0, int stride, int lane) {
    f32x4 v[4][4];
#pragma unroll
    for (int r = 0; r < 4; ++r) { const GAS f32x4* xr = (const GAS f32x4*)(x + (size_t)(m0 + r * stride) * DM) + lane;
#pragma unroll
        for (int j = 0; j < 4; ++j) v[r][j] = xr[64 * j]; }
#pragma unroll
    for (int r = 0; r < 4; ++r) {
        float s = 0.f;
#pragma unroll
        for (int j = 0; j < 4; ++j) s += (v[r][j][0] * v[r][j][0] + v[r][j][1] * v[r][j][1]) + (v[r][j][2] * v[r][j][2] + v[r][j][3] * v[r][j][3]);
        s = att::wave_sum(s);
        const size_t row = (size_t)(m0 + r * stride);
        GAS u32x2* o8 = (GAS u32x2*)(xb + row * DM) + lane;
#pragma unroll
        for (int j = 0; j < 4; ++j) { u32x2 w; w.x = pkh(v[r][j][0], v[r][j][1]); w.y = pkh(v[r][j][2], v[r][j][3]); o8[64 * j] = w; }
        if (lane < 16) part[row * 16 + lane] = (lane == 0) ? s : 0.f;
    }
}

__device__ __forceinline__ void x_row1(const float* x, f16* xb, float* part, int m, int lane) {
    const GAS f32x4* xr = (const GAS f32x4*)(x + (size_t)m * DM) + lane;
    f32x4 v[4]; float s = 0.f;
#pragma unroll
    for (int j = 0; j < 4; ++j) { v[j] = xr[64 * j]; s += (v[j][0] * v[j][0] + v[j][1] * v[j][1]) + (v[j][2] * v[j][2] + v[j][3] * v[j][3]); }
    s = att::wave_sum(s);
    GAS u32x2* o8 = (GAS u32x2*)(xb + (size_t)m * DM) + lane;
#pragma unroll
    for (int j = 0; j < 4; ++j) { u32x2 w; w.x = pkh(v[j][0], v[j][1]); w.y = pkh(v[j][2], v[j][3]); o8[64 * j] = w; }
    if (lane < 16) part[(size_t)m * 16 + lane] = (lane == 0) ? s : 0.f;
}

struct Args { const float* in[11]; float* out; unsigned char* ws; };
__global__ void __launch_bounds__(NWAVES * 64, 2) hybrid_fwd(Args args) {
    extern __shared__ __attribute__((aligned(16))) unsigned char lds_raw[];
    LAS unsigned char* lds = (LAS unsigned char*)lds_raw;
    volatile LAS unsigned* MISC = (volatile LAS unsigned*)(lds + MISC_OFF);
    const int tid = threadIdx.x, lane = tid & 63, wave = __builtin_amdgcn_readfirstlane(tid >> 6);
    const int G = gridDim.x; const int bx = blockIdx.x; const int vcu = (G % 8 == 0) ? (bx % 8) * (G / 8) + bx / 8 : bx;
    unsigned char* ws = args.ws;
    gu32* ctl = (gu32*)(ws + WS_CTL);
    const float* x = args.in[0]; const float* norm_g = args.in[1]; const float* w_in = args.in[2]; const float* w_out = args.in[3];
    const float* q_norm_g = args.in[4]; const float* k_norm_g = args.in[5];
    const float* lq1 = args.in[6]; const float* lk1 = args.in[7]; const float* lq2 = args.in[8]; const float* lk2 = args.in[9]; const float* subln_g = args.in[10];
    float* out = args.out;
    GAS unsigned char* wsg = (GAS unsigned char*)ws;
    GAS f16* WIN = (GAS f16*)(wsg + WS_WIN); GAS f16* WOUT = (GAS f16*)(wsg + WS_WOUT); GAS float* PART = (GAS float*)(wsg + WS_PART);
    GAS f16* XB = (GAS f16*)(wsg + WS_XB); GAS f16* MIX = (GAS f16*)(wsg + WS_MIX); GAS f16* PROJ = (GAS f16*)(wsg + WS_PROJ);

    unsigned long long sw_acc = 0;
    for (int u = tid; u < (LDS_BYTES - LDSCTL_OFF) / 4; u += NWAVES * 64) ((LAS unsigned*)(lds + LDSCTL_OFF))[u] = 0u;
    __syncthreads();
    XcdBarrier bar = xcd_barrier_post((unsigned*)(ctl + CW_BAR), MISC + 8);

    SW_BEGIN(6);
    for (int rep = 0; rep < REP_PRO; ++rep) {
        LAS float* scr = (LAS float*)(lds + RING_OFF + wave * 16384);
        const int gw = vcu * NWAVES + wave, NGW = G * NWAVES;
        constexpr int I_IN = (DM / 32) * (PW / 32), I_OUT = (DM / 32) * (DM / 32);
        constexpr int NITEMS = DEPTH * (I_IN + I_OUT);
        SW_BEGIN(9);
        for (int it = gw; it < NITEMS; it += NGW) {
            int r = it; const int l = r / (I_IN + I_OUT); r -= l * (I_IN + I_OUT);
            if (r < I_IN) p0_transpose_item(w_in + (size_t)l * DM * PW, norm_g + l * DM, DM, PW, (f16*)WIN + (size_t)l * PW * DM, scr, r, lane);
            else p0_transpose_item(w_out + (size_t)l * DM * DM, nullptr, DM, DM, (f16*)WOUT + (size_t)l * DM * DM, scr, r - I_IN, lane);
        }
        SW_END(9);
        SW_BEGIN(10);
        { int m = gw; for (; m + 3 * NGW < MROWS; m += 4 * NGW) x_rows4(x, (f16*)XB, (float*)PART, m, NGW, lane); for (; m < MROWS; m += NGW) x_row1(x, (f16*)XB, (float*)PART, m, lane); }
        SW_END(10);
    }
    SW_END(6);
    { SW_BEGIN(7); xcd_barrier(bar); SW_END(7); }

    for (int l = 0; l < DEPTH; ++l) {
        { GAS unsigned char* wsl = wsg; asm volatile("" : "+s"(wsl)); WIN = (GAS f16*)(wsl + WS_WIN); WOUT = (GAS f16*)(wsl + WS_WOUT); PART = (GAS float*)(wsl + WS_PART); XB = (GAS f16*)(wsl + WS_XB); MIX = (GAS f16*)(wsl + WS_MIX); PROJ = (GAS f16*)(wsl + WS_PROJ);
          asm volatile("" : "+s"(out)); asm volatile("" : "+s"(x)); asm volatile("" : "+s"(subln_g)); asm volatile("" : "+s"(q_norm_g)); asm volatile("" : "+s"(k_norm_g)); asm volatile("" : "+s"(bar.bar)); }
        for (int rep = 0; rep < REP_G1; ++rep) {
            pg8::Gemm g{(const f16*)XB, (const f16*)WIN + (size_t)l * PW * DM, MROWS, PW, DM}; pg8::StaticOrder S; S.init(MROWS, PW, G, bx);
            pg8::EpiProj E{PROJ, PART, (const GAS float*)q_norm_g + l * 64, (const GAS float*)k_norm_g + l * 64};
            SW_BEGIN(5);
            pg8::gemm_phase<pg8::EpiProj>(lds + RING_OFF, g, S, E, sw_acc);
            SW_END(5);
        }
        { SW_BEGIN(7); xcd_barrier(bar); SW_END(7); }
        {
            const float sa = att::wave_sum(lq1[l * 64 + lane] * lk1[l * 64 + lane]), sb = att::wave_sum(lq2[l * 64 + lane] * lk2[l * 64 + lane]);
            const float lam_init = 0.8f - 0.6f * __expf(-0.3f * (float)l);
            const float lam = __expf(sa) - __expf(sb) + lam_init;
            const float mgq = att::wave_max(fabsf(q_norm_g[l * 64 + lane])), mgk = att::wave_max(fabsf(k_norm_g[l * 64 + lane]));
            const float mref = 8.0f * LOG2E * mgq * mgk * 1.001f - 10.0f;
            __syncthreads();
            for (int rep = 0; rep < REP_DA; ++rep) { SW_BEGIN(1); att::da_phase(lds + RING_OFF, PROJ, MIX, vcu, G, lam, mref, (const GAS float*)subln_g + l * 128, 1.0f - lam_init, sw_acc); SW_END(1); }
            for (int rep = 0; rep < REP_SB; ++rep) { SW_BEGIN(4); att::sb_phase(lds + RING_OFF, PROJ, MIX, vcu, G, sw_acc); SW_END(4); }
        }
        { SW_BEGIN(7); xcd_barrier(bar); SW_END(7); }
        {
            pg8::Gemm g{(const f16*)MIX, (const f16*)WOUT + (size_t)l * DM * DM, MROWS, DM, DM}; pg8::StaticOrder S; S.init(MROWS, DM, G, bx);
            pg8::EpiOut E{(GAS float*)out, XB, PART, (l + 1 < DEPTH) ? 0 : 1};
            SW_BEGIN(8);
            pg8::gemm_phase<pg8::EpiOut>(lds + RING_OFF, g, S, E, sw_acc);
            SW_END(8);
        }
        if (l + 1 < DEPTH) { SW_BEGIN(7); xcd_barrier(bar); SW_END(7); }
    }
#if SW_ID
    if (wave == 0) { const unsigned long long t0 = __builtin_amdgcn_s_memrealtime(), span = (unsigned long long)SW_K * sw_acc; while (__builtin_amdgcn_s_memrealtime() - t0 < span) __builtin_amdgcn_s_sleep(8); }
#endif
}

extern "C" void kernel_launch(void* const* d_in, const int* in_sizes, int n_in, void* d_out, int out_size, void* d_ws, size_t ws_size, hipStream_t stream) {
    static int grid = 0;
    if (grid == 0) {
        if (n_in != 11 || in_sizes[0] != MROWS * DM || out_size != MROWS * DM || ws_size < WS_END) {
            fprintf(stderr, "kernel_launch: unexpected problem shape (n_in %d, in0 %d, out %d, ws %zu); nothing launched\n", n_in, n_in > 0 ? in_sizes[0] : -1, out_size, ws_size); grid = -1; return; }
        int dev = 0, cus = 0, per_cu = 0;
        if (hipGetDevice(&dev) != hipSuccess || hipDeviceGetAttribute(&cus, hipDeviceAttributeMultiprocessorCount, dev) != hipSuccess) { grid = -1; return; }
        if (hipFuncSetAttribute((const void*)hybrid_fwd, hipFuncAttributeMaxDynamicSharedMemorySize, LDS_BYTES) != hipSuccess) { fprintf(stderr, "kernel_launch: hipFuncSetAttribute failed\n"); grid = -1; return; }
        if (hipOccupancyMaxActiveBlocksPerMultiprocessor(&per_cu, (const void*)hybrid_fwd, NWAVES * 64, LDS_BYTES) != hipSuccess || per_cu < 1) {
            fprintf(stderr, "kernel_launch: occupancy query reports %d workgroups per CU; nothing launched\n", per_cu); (void)hipGetLastError(); grid = -1; return; }
        grid = cus;
    }
    if (grid < 0) return;
    if (hipMemsetAsync((char*)d_ws + WS_CTL, 0, CTL_ZERO_BYTES, stream) != hipSuccess) { fprintf(stderr, "kernel_launch: hipMemsetAsync failed\n"); return; }
    Args a{};
    for (int i = 0; i < 11; ++i) a.in[i] = (const float*)d_in[i];
    a.out = (float*)d_out; a.ws = (unsigned char*)d_ws;
    hipLaunchKernelGGL(hybrid_fwd, dim3(grid), dim3(NWAVES * 64), LDS_BYTES, stream, a);
    const hipError_t le = hipPeekAtLastError();
    if (le != hipSuccess) fprintf(stderr, "kernel_launch: launch failed: %s\n", hipGetErrorName(le));
}
```

```cpp
#include <hip/hip_runtime.h>
#include <cstdio>
#include <cstdint>

#ifndef SB_EARLY_EXIT
#define SB_EARLY_EXIT 1
#endif
#define SW_ID 0
#define SW_K 4
#define REP_PRO 1
#define REP_G1 1
#define REP_DA 1
#define REP_SB 1
#define REP_G2 1

#if SW_ID
#define SW_BEGIN(id) unsigned long long sw_t0_##id = 0; if (SW_ID == (id)) sw_t0_##id = __builtin_amdgcn_s_memrealtime()
#define SW_END(id) do { if (SW_ID == (id)) sw_acc += __builtin_amdgcn_s_memrealtime() - sw_t0_##id; } while (0)
#else
#define SW_BEGIN(id) do {} while (0)
#define SW_END(id) do {} while (0)
#endif
#define LAS __attribute__((address_space(3)))
#define GAS __attribute__((address_space(1)))
typedef _Float16 f16;
typedef _Float16 h8 __attribute__((ext_vector_type(8)));
typedef _Float16 h4 __attribute__((ext_vector_type(4)));
typedef _Float16 h2 __attribute__((ext_vector_type(2)));
typedef float f32x4 __attribute__((ext_vector_type(4)));
typedef float f32x16 __attribute__((ext_vector_type(16)));
typedef unsigned u32x4 __attribute__((ext_vector_type(4)));
typedef unsigned u32x2 __attribute__((ext_vector_type(2)));

constexpr int BATCH = 16, SEQ = 2048, DM = 1024, MROWS = BATCH * SEQ, PW = 4096, DEPTH = 2;
constexpr float RMS_EPS = 1e-6f;
constexpr float LOG2E = 1.4426950408889634f;
constexpr float QS = 0.125f * LOG2E;
constexpr int C_SBQ = 0, C_SBK = 512, C_SBV = 1024, C_SBG = 1536, C_DAQ = 2048, C_DAK = 2560, C_DAV = 3072, C_DAG = 3584;

__device__ __forceinline__ unsigned pkh(float lo, float hi) { h2 v = {(f16)lo, (f16)hi}; return __builtin_bit_cast(unsigned, v); }
__device__ __forceinline__ unsigned pkh_rtz(float lo, float hi) { return __builtin_bit_cast(unsigned, __builtin_amdgcn_cvt_pkrtz(lo, hi)); }
__device__ __forceinline__ float row4_sum(float s) {
    { const auto r = __builtin_amdgcn_permlane16_swap(__float_as_uint(s), __float_as_uint(s), false, false); s = __uint_as_float(r[0]) + __uint_as_float(r[1]); }
    { const auto r = __builtin_amdgcn_permlane32_swap(__float_as_uint(s), __float_as_uint(s), false, false); s = __uint_as_float(r[0]) + __uint_as_float(r[1]); }
    return s;
}
__device__ __forceinline__ float silu_f(float v) { return v * __builtin_amdgcn_rcpf(1.0f + __builtin_amdgcn_exp2f(-v * LOG2E)); }

namespace pg8 {
constexpr int BM = 256, BK = 64, HALF = 128, HTB = HALF * BK * 2, STAGE_BYTES = 8 * HTB, NXCD = 8, WGM = 8;
__host__ __device__ __forceinline__ int lds_byte(int r, int c) { const int st = (r >> 4) * 2 + (c >> 5), rr = r & 15, cc = c & 31, ob = rr * 64 + cc * 2; return st * 1024 + (ob ^ (((ob >> 9) & 1) << 5)); }
__host__ __device__ __forceinline__ void stage_rc(int b, int& R, int& C) { const int st = b / 1024, sb = b % 1024, swz = sb ^ (((sb >> 9) & 1) << 5); R = (st >> 1) * 16 + swz / 64; C = (st & 1) * 32 + (swz % 64) / 2; }
__host__ __device__ __forceinline__ int perm32(int rho) { const int n = rho >> 4, i = rho & 15; return 8 * (i >> 2) + 4 * n + (i & 3); }

struct Unit { int pm, pn; };
struct Gemm { const f16* A; const f16* Bt; int M, N, K; };

struct StaticOrder {
    int nM, nN, nwg, G, c;
    __host__ __device__ void init(int M, int N, int G_, int c_) { nM = M / BM; nN = N / BM; nwg = nM * nN; G = G_; c = c_; }
    __host__ __device__ bool next(int i, Unit& u) const {
        const long L = (long)i * G + c; if (L >= nwg) return false;
        int wgid = (int)L; { const int q = nwg / NXCD, r = nwg % NXCD, xcd = wgid % NXCD, off = wgid / NXCD; wgid = (xcd < r ? xcd * (q + 1) : r * (q + 1) + (xcd - r) * q) + off; }
        const int nig = WGM * nN, gid = wgid / nig, fm = gid * WGM, gsz = (nM - fm) < WGM ? (nM - fm) : WGM;
        u.pm = fm + ((wgid % nig) % gsz); u.pn = (wgid % nig) / gsz; return true;
    }
};


struct EpiProj {
    GAS f16* P; const GAS float* part; const GAS float* gq; const GAS float* gk;
    __device__ __forceinline__ void operator()(const f32x4 (&acc)[2][2][4][2], const Unit& u, int wr, int wc, int fr, int fq) const {
        const int sec = u.pn >> 1;
        const int row0 = u.pm * BM + wr * 64 + fr;
        const int colw = u.pn * BM + wc * 64 + 8 * fq;
        f32x4 gain[2][2];
        if (sec == 4 || sec == 5) {
            const GAS float* g = (sec == 4) ? gq : gk;
#pragma unroll
            for (int bj = 0; bj < 2; ++bj)
#pragma unroll
                for (int n = 0; n < 2; ++n) gain[bj][n] = *(const GAS f32x4*)(g + 32 * bj + 8 * fq + 4 * n);
        }
#pragma unroll
        for (int ai = 0; ai < 2; ++ai)
#pragma unroll
            for (int m = 0; m < 4; ++m) {
                const int row = row0 + ai * HALF + m * 16;
                const f32x4 pv = *(const GAS f32x4*)(part + (size_t)row * 16 + fq * 4);
                float s = (pv[0] + pv[1]) + (pv[2] + pv[3]);
                s = row4_sum(s);
                const float rs = __builtin_amdgcn_rsqf(s * (1.0f / DM) + RMS_EPS);
                f32x4 v[2][2];
#pragma unroll
                for (int bj = 0; bj < 2; ++bj)
#pragma unroll
                    for (int n = 0; n < 2; ++n) v[bj][n] = acc[ai][bj][m][n] * rs;
                if (sec == 4 || sec == 5) {
                    float ss = 0.f;
#pragma unroll
                    for (int bj = 0; bj < 2; ++bj)
#pragma unroll
                        for (int n = 0; n < 2; ++n) { const f32x4 x = v[bj][n]; ss += (x[0] * x[0] + x[1] * x[1]) + (x[2] * x[2] + x[3] * x[3]); }
                    ss = row4_sum(ss);
                    float rn = __builtin_amdgcn_rsqf(ss * (1.0f / 64.0f) + RMS_EPS);
                    if (sec == 4) rn *= QS;
#pragma unroll
                    for (int bj = 0; bj < 2; ++bj)
#pragma unroll
                        for (int n = 0; n < 2; ++n) v[bj][n] = v[bj][n] * rn * gain[bj][n];
                } else if (sec == 0) {
#pragma unroll
                    for (int bj = 0; bj < 2; ++bj)
#pragma unroll
                        for (int n = 0; n < 2; ++n) v[bj][n] = v[bj][n] * QS;
                } else if (sec == 3 || sec == 7) {
#pragma unroll
                    for (int bj = 0; bj < 2; ++bj)
#pragma unroll
                        for (int n = 0; n < 2; ++n)
#pragma unroll
                            for (int e = 0; e < 4; ++e) v[bj][n][e] = silu_f(v[bj][n][e]);
                }
                GAS f16* rowp = P + (size_t)row * PW + colw;
#pragma unroll
                for (int bj = 0; bj < 2; ++bj) {
                    u32x4 w; w.x = pkh(v[bj][0][0], v[bj][0][1]); w.y = pkh(v[bj][0][2], v[bj][0][3]); w.z = pkh(v[bj][1][0], v[bj][1][1]); w.w = pkh(v[bj][1][2], v[bj][1][3]);
                    *(GAS u32x4*)(rowp + 32 * bj) = w;
                }
            }
    }
};

struct EpiOut {
    GAS float* out; GAS f16* xb; GAS float* part; int last;
    __device__ __forceinline__ void operator()(const f32x4 (&acc)[2][2][4][2], const Unit& u, int wr, int wc, int fr, int fq) const {
        const int row0 = u.pm * BM + wr * 64 + fr;
        const int colw = u.pn * BM + wc * 64 + 8 * fq;
#pragma unroll
        for (int ai = 0; ai < 2; ++ai) {
            h8 bs[4][2];
#pragma unroll
            for (int m = 0; m < 4; ++m)
#pragma unroll
                for (int bj = 0; bj < 2; ++bj) bs[m][bj] = *(const GAS h8*)(xb + (size_t)(row0 + ai * HALF + m * 16) * DM + colw + 32 * bj);
#pragma unroll
            for (int m = 0; m < 4; ++m) {
                const int row = row0 + ai * HALF + m * 16;
                const size_t off = (size_t)row * DM + colw;
                float ss = 0.f;
#pragma unroll
                for (int bj = 0; bj < 2; ++bj) {
                    const h8 b = bs[m][bj];
                    f32x4 o0 = acc[ai][bj][m][0], o1 = acc[ai][bj][m][1];
                    o0[0] += (float)b[0]; o0[1] += (float)b[1]; o0[2] += (float)b[2]; o0[3] += (float)b[3];
                    o1[0] += (float)b[4]; o1[1] += (float)b[5]; o1[2] += (float)b[6]; o1[3] += (float)b[7];
                    if (last) { *(GAS f32x4*)(out + off + 32 * bj) = o0; *(GAS f32x4*)(out + off + 32 * bj + 4) = o1; }
                    else {
                        ss += (o0[0] * o0[0] + o0[1] * o0[1]) + (o0[2] * o0[2] + o0[3] * o0[3]) + (o1[0] * o1[0] + o1[1] * o1[1]) + (o1[2] * o1[2] + o1[3] * o1[3]);
                        u32x4 w; w.x = pkh(o0[0], o0[1]); w.y = pkh(o0[2], o0[3]); w.z = pkh(o1[0], o1[1]); w.w = pkh(o1[2], o1[3]);
                        *(GAS u32x4*)(xb + off + 32 * bj) = w;
                    }
                }
                if (!last) {
                    ss = row4_sum(ss);
                    if (fq == 0) part[(size_t)row * 16 + u.pn * 4 + wc] = ss;
                }
            }
        }
    }
};

template <class Epi>
__device__ __forceinline__ void gemm_phase(LAS unsigned char* lds, const Gemm g, const StaticOrder& S, const Epi& E, unsigned long long& sw_acc) {
    int tid_ = threadIdx.x; asm volatile("" : "+v"(tid_));
    const int tid = tid_, wid = __builtin_amdgcn_readfirstlane(tid >> 6), lane = tid & 63, wr = wid >> 2, wc = wid & 3, fr = lane & 15, fq = lane >> 4;
    const int K = g.K, nt = K / BK;
    unsigned voffA[2], voffB[2];
#pragma unroll
    for (int i = 0; i < 2; ++i) { int R, C; stage_rc(tid * 16 + i * 8192, R, C);
        const int Rb = (R >> 5) * 64 + perm32(R & 31);
        voffA[i] = (unsigned)(R * K + C) * 2u; voffB[i] = (unsigned)(Rb * K + C) * 2u; }
    const size_t kstep = (size_t)(BK * 2);
    const size_t hstep = (size_t)HALF * K * 2;
    const size_t hstepB = (size_t)32 * K * 2;
    const size_t tstep = 2 * hstep;
    const unsigned ldsw = (unsigned)wid * 1024u;
    const int aoff = lds_byte(wr * 64 + fr, fq * 8), boff = lds_byte(wc * 32 + fr, fq * 8);
#define PG8_SA(b, h) (((b) * 2 + (h)) * HTB)
#define PG8_SB(b, h) ((4 + (b) * 2 + (h)) * HTB)
#define PG8_STAGE(bufoff, gbase, voff) do { _Pragma("unroll") for (int _i = 0; _i < 2; ++_i) \
        __builtin_amdgcn_global_load_lds((const unsigned*)((const char*)(gbase) + (voff)[_i]), (LAS unsigned*)(lds + (bufoff) + ldsw + _i * 8192), 16, 0, 0); } while (0)
#define PG8_LDA(dst, b, h) do { _Pragma("unroll") for (int m = 0; m < 4; ++m) _Pragma("unroll") for (int k = 0; k < 2; ++k) dst[m][k] = *(const LAS h8*)(lds + PG8_SA(b, h) + aoff + m * 2048 + k * 1024); } while (0)
#define PG8_LDB(dst, b, h) do { _Pragma("unroll") for (int n = 0; n < 2; ++n) _Pragma("unroll") for (int k = 0; k < 2; ++k) dst[n][k] = *(const LAS h8*)(lds + PG8_SB(b, h) + boff + n * 2048 + k * 1024); } while (0)
#define PG8_MMA(ai, bj, At, Bt) do { __builtin_amdgcn_s_setprio(1); _Pragma("unroll") for (int m = 0; m < 4; ++m) _Pragma("unroll") for (int n = 0; n < 2; ++n) _Pragma("unroll") for (int k = 0; k < 2; ++k) \
        acc[ai][bj][m][n] = __builtin_amdgcn_mfma_f32_16x16x32_f16(Bt[n][k], At[m][k], acc[ai][bj][m][n], 0, 0, 0); __builtin_amdgcn_s_setprio(0); } while (0)
#define PG8_WAIT_V(n) asm volatile("s_waitcnt vmcnt(" #n ")" ::: "memory")
#define PG8_WAIT_L(n) asm volatile("s_waitcnt lgkmcnt(" #n ")" ::: "memory")
#define PG8_BAR __builtin_amdgcn_s_barrier()
#define PG8_SCHED __builtin_amdgcn_sched_barrier(0)
    Unit cur, nxt; int ui = 0;
    if (!S.next(0, cur)) return;
    f32x4 acc[2][2][4][2];
#pragma unroll
    for (int a = 0; a < 2; ++a)
#pragma unroll
        for (int b = 0; b < 2; ++b)
#pragma unroll
            for (int m = 0; m < 4; ++m)
#pragma unroll
                for (int n = 0; n < 2; ++n) acc[a][b][m][n] = (f32x4){0.f, 0.f, 0.f, 0.f};
    h8 At[4][2], B0[2][2], B1[2][2];
    const char* cA = (const char*)g.A + (size_t)cur.pm * tstep; const char* cB = (const char*)g.Bt + (size_t)cur.pn * tstep;
    PG8_STAGE(PG8_SB(0, 0), cB, voffB); PG8_STAGE(PG8_SB(0, 1), cB + hstepB, voffB); PG8_STAGE(PG8_SA(0, 0), cA, voffA); PG8_STAGE(PG8_SA(0, 1), cA + hstep, voffA);
    if (wr == 1) PG8_BAR;
    PG8_WAIT_V(2); PG8_BAR;
    PG8_STAGE(PG8_SB(1, 0), cB + kstep, voffB); PG8_STAGE(PG8_SA(1, 0), cA + kstep, voffA); PG8_STAGE(PG8_SB(1, 1), cB + hstepB + kstep, voffB);
    PG8_WAIT_V(6); PG8_BAR;
    for (;;) {
        const bool has_next = S.next(ui + 1, nxt);
        const char* nA = has_next ? (const char*)g.A + (size_t)nxt.pm * tstep : cA; const char* nB = has_next ? (const char*)g.Bt + (size_t)nxt.pn * tstep : cB;
        for (int t = 0; t < nt; t += 2) {
            const bool last = (t == nt - 2);
            const char* a1 = cA + (size_t)(t + 1) * kstep;
            const char* a2 = last ? nA : cA + (size_t)(t + 2) * kstep; const char* b2 = last ? nB : cB + (size_t)(t + 2) * kstep;
            const char* a3 = a2 + kstep; const char* b3 = b2 + kstep;
            PG8_LDB(B0, 0, 0); PG8_LDB(B1, 0, 1); PG8_SCHED; PG8_LDA(At, 0, 0); PG8_STAGE(PG8_SA(1, 1), a1 + hstep, voffA);
            PG8_WAIT_V(8); PG8_WAIT_L(0); PG8_BAR; PG8_MMA(0, 0, At, B0); PG8_MMA(0, 1, At, B1); PG8_BAR; PG8_SCHED;
            PG8_LDA(At, 0, 1); PG8_STAGE(PG8_SB(0, 0), b2, voffB); PG8_STAGE(PG8_SB(0, 1), b2 + hstepB, voffB); PG8_STAGE(PG8_SA(0, 0), a2, voffA);
            PG8_WAIT_V(8); PG8_WAIT_L(0); PG8_BAR; PG8_MMA(1, 0, At, B0); PG8_MMA(1, 1, At, B1); PG8_BAR; PG8_SCHED;
            PG8_LDB(B0, 1, 0); PG8_LDB(B1, 1, 1); PG8_SCHED; PG8_LDA(At, 1, 0); PG8_STAGE(PG8_SA(0, 1), a2 + hstep, voffA);
            PG8_WAIT_V(8); PG8_WAIT_L(0); PG8_BAR; PG8_MMA(0, 0, At, B0); PG8_MMA(0, 1, At, B1); PG8_BAR; PG8_SCHED;
            PG8_LDA(At, 1, 1); PG8_STAGE(PG8_SB(1, 0), b3, voffB); PG8_STAGE(PG8_SB(1, 1), b3 + hstepB, voffB); PG8_STAGE(PG8_SA(1, 0), a3, voffA);
            PG8_WAIT_V(8); PG8_WAIT_L(0); PG8_BAR; PG8_MMA(1, 0, At, B0); PG8_MMA(1, 1, At, B1); PG8_BAR; PG8_SCHED;
        }
        if (wr == 0) PG8_BAR;
        { SW_BEGIN(20); E(acc, cur, wr, wc, fr, fq); SW_END(20); }
        if (!has_next) break;
#pragma unroll
        for (int a = 0; a < 2; ++a)
#pragma unroll
            for (int b = 0; b < 2; ++b)
#pragma unroll
                for (int m = 0; m < 4; ++m)
#pragma unroll
                    for (int n = 0; n < 2; ++n) acc[a][b][m][n] = (f32x4){0.f, 0.f, 0.f, 0.f};
        cur = nxt; cA = nA; cB = nB; ++ui;
        if (wr == 1) PG8_BAR;
    }
    PG8_WAIT_V(0);
    PG8_BAR;
#undef PG8_SA
#undef PG8_SB
#undef PG8_STAGE
#undef PG8_LDA
#undef PG8_LDB
#undef PG8_MMA
#undef PG8_WAIT_V
#undef PG8_WAIT_L
#undef PG8_BAR
#undef PG8_SCHED
}
}

namespace att {
typedef short v4i16_t __attribute__((ext_vector_type(4)));
__device__ __forceinline__ int crow(int r, int hi) { return (r & 3) + 8 * (r >> 2) + 4 * hi; }
__device__ __forceinline__ int keyrow(int i) { return 32 * ((i >> 2) & 1) + (i & 3) + 4 * (i >> 3); }
__device__ __forceinline__ h4 vtr(const LAS unsigned char* p) { return __builtin_bit_cast(h4, __builtin_amdgcn_ds_read_tr16_b64_v4i16((LAS v4i16_t*)p)); }
__device__ __forceinline__ h8 cat8(h4 a, h4 b) { return (h8){a[0], a[1], a[2], a[3], b[0], b[1], b[2], b[3]}; }
#define MFMA32(a, b, c) __builtin_amdgcn_mfma_f32_32x32x16_f16(a, b, c, 0, 0, 0)
__device__ __forceinline__ h8 pack8(const f32x16& p, int b) {
    u32x4 w; w.x = pkh_rtz(p[b], p[b + 1]); w.y = pkh_rtz(p[b + 2], p[b + 3]); w.z = pkh_rtz(p[b + 4], p[b + 5]); w.w = pkh_rtz(p[b + 6], p[b + 7]);
    return __builtin_bit_cast(h8, w);
}
template <int KI> __device__ __forceinline__ float fmamk_s(float c, float base) {
    float r; asm volatile("v_fmamk_f32 %0, %1, %2, %3" : "=v"(r) : "v"(c), "i"(__builtin_bit_cast(int, (float)KI)), "v"(base)); return r; }
__device__ __forceinline__ float wave_sum(float v) {
#pragma unroll
    for (int o = 1; o < 64; o <<= 1) v += __shfl_xor(v, o);
    return v;
}
__device__ __forceinline__ float wave_max(float v) {
#pragma unroll
    for (int o = 1; o < 64; o <<= 1) v = fmaxf(v, __shfl_xor(v, o));
    return v;
}

__device__ __forceinline__ void glds16(const GAS void* g, unsigned lds_base) {
    unsigned sv; asm volatile("s_mov_b32 %0, m0\n\ts_mov_b32 m0, %2\n\ts_nop 0\n\tglobal_load_lds_dwordx4 %1, off\n\ts_mov_b32 m0, %0" : "=&s"(sv) : "v"(g), "s"(lds_base) : "memory"); }
#define WAIT_BAR(N) asm volatile("s_waitcnt vmcnt(" #N ") lgkmcnt(0)\n\ts_barrier" ::: "memory")
__device__ __forceinline__ void wait_bar_n(int n) {
    switch (n) { case 0: WAIT_BAR(0); break; case 2: WAIT_BAR(2); break; case 4: WAIT_BAR(4); break; case 6: WAIT_BAR(6); break; case 8: WAIT_BAR(8); break; case 10: WAIT_BAR(10); break;
                 case 12: WAIT_BAR(12); break; case 14: WAIT_BAR(14); break; case 16: WAIT_BAR(16); break; case 18: WAIT_BAR(18); break; case 20: WAIT_BAR(20); break; default: WAIT_BAR(0); break; }
}

constexpr int SB_SLOT = 65536, SB_FLG = 147456 + 2048;
__device__ __forceinline__ int keyrow16(int i) { return 16 * ((i >> 2) & 1) + (i & 3) + 4 * (i >> 3); }
struct SbUnit { int b, hg, cq; };
__device__ __forceinline__ bool sb_decode(int u, SbUnit& U) {
    if (u >= 1024) return false;
    const int r = u >> 8, v = u & 255, i = v & 15;
    U.b = v >> 4; U.hg = i & 1; U.cq = (i >> 1) + 8 * r; return true;
}
__device__ __forceinline__ void sb_phase(LAS unsigned char* lds, const GAS f16* __restrict__ proj, GAS f16* __restrict__ mixed, int vcu, int G, unsigned long long& sw_acc) {
    int tid_ = threadIdx.x; asm volatile("" : "+v"(tid_));
    const int tid = tid_, lane = tid & 63, l31 = lane & 31, hi = lane >> 5; const int w = __builtin_amdgcn_readfirstlane(tid >> 6);
    const int hh = w & 3, rgp = w >> 2;
    const unsigned lds0 = (unsigned)(uintptr_t)lds;
    const unsigned kdst = lds0 + w * 4096, vdst = lds0 + 32768 + w * 4096;
    int kfo[4];
    { const int kr = keyrow16(l31);
#pragma unroll
      for (int d0 = 0; d0 < 4; ++d0) kfo[d0] = kr * 512 + (((hh * 8 + 2 * d0 + hi) ^ (kr & 15)) * 16); }
    int vfo[2];
    { const int q_ = (lane & 15) >> 2;
#pragma unroll
      for (int d0 = 0; d0 < 2; ++d0) vfo[d0] = 32768 + (16 * hi + q_) * 512 + (((hh * 2 + d0) ^ q_) * 64) + ((lane >> 4) & 1) * 32 + (lane & 3) * 8; }
    LAS unsigned* flags = (LAS unsigned*)(lds + SB_FLG);
    size_t koff[4], voff[4];
#pragma unroll
    for (int i = 0; i < 4; ++i) { const int row = 8 * w + 2 * i + (lane >> 5), p = lane & 31;
        koff[i] = (size_t)row * PW + C_SBK + ((p ^ (row & 15)) * 8);
        voff[i] = (size_t)row * PW + C_SBV + ((((p >> 2) ^ (row & 3)) * 4 + (p & 3)) * 8); }
    const size_t qoff = (size_t)(32 * rgp + l31) * PW;
#define SB_DMA(base_, kt_, slot) do { const GAS f16* b_ = (base_) + (size_t)(kt_) * 64 * PW; const unsigned kd_ = (unsigned)__builtin_amdgcn_readfirstlane(kdst + (slot)), vd_ = (unsigned)__builtin_amdgcn_readfirstlane(vdst + (slot)); \
        _Pragma("unroll") for (int i_ = 0; i_ < 4; ++i_) { glds16(b_ + koff[i_], kd_ + i_ * 1024); glds16(b_ + voff[i_], vd_ + i_ * 1024); } } while (0)
    SbUnit U, Un; int ui = vcu;
    if (!sb_decode(ui, U)) return;
    int islot = 0, cslot = 0;
    const GAS f16* tbase = proj + ((size_t)U.b * SEQ) * PW + U.hg * 256;
    h8 qn[4]; u32x2 gn[8];
    { const size_t grow = (size_t)U.b * SEQ + U.cq * 64 + 32 * rgp + l31; const int h = 4 * U.hg + hh;
      const GAS f16* Qg = proj + grow * PW + C_SBQ + h * 64 + 8 * hi; const GAS f16* Gp = proj + grow * PW + C_SBG + h * 64 + 4 * hi;
#pragma unroll
      for (int d0 = 0; d0 < 4; ++d0) qn[d0] = *(const GAS h8*)(Qg + 16 * d0);
#pragma unroll
      for (int i = 0; i < 8; ++i) gn[i] = *(const GAS u32x2*)(Gp + 8 * i); }
    asm volatile("" : "+v"(qn[0]), "+v"(qn[1]), "+v"(qn[2]), "+v"(qn[3]));
    SB_DMA(tbase, U.cq, islot); islot ^= SB_SLOT;
    for (;;) {
        const size_t rowbase = (size_t)U.b * SEQ;
        const int qw = U.cq * 64 + 32 * rgp, t = qw + l31, NT = U.cq + 1, h = 4 * U.hg + hh;
        const size_t grow = rowbase + qw + l31;
        h8 qr[4]; u32x2 gv[8];
#pragma unroll
        for (int d0 = 0; d0 < 4; ++d0) qr[d0] = qn[d0];
#pragma unroll
        for (int i = 0; i < 8; ++i) gv[i] = gn[i];
        const bool has_next = sb_decode(ui + G, Un);
        f32x16 o[2]; o[0] = f32x16{}; o[1] = f32x16{};
        float carry = 1.f; int done = 0;
        SW_BEGIN(12);
        for (int j = 0; j < NT; ++j) {
            SW_BEGIN(13);
            WAIT_BAR(0);
            SW_END(13);
            if (j > 0) {
                const u32x4 f0 = *(const LAS u32x4*)(flags + ((j - 1) & 1) * 8), f1 = *(const LAS u32x4*)(flags + ((j - 1) & 1) * 8 + 4);
                const unsigned any = (f0.x | f0.y | f0.z | f0.w) | (f1.x | f1.y | f1.z | f1.w);
                if (!__builtin_amdgcn_readfirstlane(any)) break;
            }
            if (j + 1 < NT) { SB_DMA(tbase, U.cq - (j + 1), islot); islot ^= SB_SLOT; }
            const int kt = U.cq - j;
#pragma unroll
            for (int sub = 0; sub < 2; ++sub) {
                const int kb32 = sub == 0 ? 32 : 0;
                const bool diag = (j == 0) && (sub == (rgp == 1 ? 0 : 1));
                const bool skip = (j == 0) && (rgp == 0) && (sub == 0);
                if (!done && !skip) {
                    const LAS unsigned char* Sb = lds + cslot + kb32 * 512;
                    f32x16 p = f32x16{};
#pragma unroll
                    for (int d0 = 0; d0 < 4; ++d0) { const h8 k0 = *(const LAS h8*)(Sb + kfo[d0]); p = MFMA32(k0, qr[d0], p); }
#pragma unroll
                    for (int r = 0; r < 16; ++r) p[r] = __builtin_amdgcn_rcpf(1.0f + __builtin_amdgcn_exp2f(-p[r]));
                    if (diag) {
                        const int key0 = 64 * kt + kb32 + 16 * hi;
#pragma unroll
                        for (int r = 0; r < 16; ++r) if (key0 + r >= t) p[r] = 0.f;
                    }
                    float run = 1.f;
#pragma unroll
                    for (int r = 15; r >= 0; --r) { const float a = run * p[r]; run -= a; p[r] = a; }
                    const auto rr = __builtin_amdgcn_permlane32_swap(__float_as_uint(run), __float_as_uint(run), false, false);
                    const float T0 = __uint_as_float(rr[0]), T1 = __uint_as_float(rr[1]);
                    const float E = carry * (hi ? 1.0f : T1);
                    carry = carry * (T0 * T1);
#pragma unroll
                    for (int r = 0; r < 16; ++r) p[r] *= E;
                    const h8 pa0 = pack8(p, 0), pa1 = pack8(p, 8);
#pragma unroll
                    for (int d0 = 0; d0 < 2; ++d0) {
                        const LAS unsigned char* Vb = Sb + vfo[d0];
                        const h8 v0 = cat8(vtr(Vb), vtr(Vb + 2048));
                        const h8 v1 = cat8(vtr(Vb + 4096), vtr(Vb + 6144));
                        o[d0] = MFMA32(v0, pa0, o[d0]); o[d0] = MFMA32(v1, pa1, o[d0]);
                    }
#if SB_EARLY_EXIT
                    done = __builtin_amdgcn_readfirstlane(__all(carry < 1.0e-37f) ? 1 : 0);
#endif
                }
            }
            if (lane == 0) flags[(j & 1) * 8 + w] = done ? 0u : 1u;
            cslot ^= SB_SLOT;
        }
        asm volatile("s_nop 15\n\ts_nop 7" : "+v"(o[0]), "+v"(o[1]));
        SW_END(12);
        cslot = islot;
        if (has_next) {
            const size_t grown = (size_t)Un.b * SEQ + Un.cq * 64 + 32 * rgp + l31; const int hn = 4 * Un.hg + hh;
            const GAS f16* Qg = proj + grown * PW + C_SBQ + hn * 64 + 8 * hi; const GAS f16* Gp = proj + grown * PW + C_SBG + hn * 64 + 4 * hi;
#pragma unroll
            for (int d0 = 0; d0 < 4; ++d0) qn[d0] = *(const GAS h8*)(Qg + 16 * d0);
#pragma unroll
            for (int i = 0; i < 8; ++i) gn[i] = *(const GAS u32x2*)(Gp + 8 * i);
            asm volatile("" ::: "memory");
            tbase = proj + ((size_t)Un.b * SEQ) * PW + Un.hg * 256;
            SB_DMA(tbase, Un.cq, islot); islot ^= SB_SLOT;
        }
        {
            GAS f16* Op = mixed + grow * DM + h * 64 + 4 * hi;
#pragma unroll
            for (int d0 = 0; d0 < 2; ++d0)
#pragma unroll
                for (int rg4 = 0; rg4 < 4; ++rg4) {
                    const h4 g = __builtin_bit_cast(h4, gv[d0 * 4 + rg4]);
                    u32x2 wv; wv.x = pkh(o[d0][4 * rg4] * (float)g[0], o[d0][4 * rg4 + 1] * (float)g[1]); wv.y = pkh(o[d0][4 * rg4 + 2] * (float)g[2], o[d0][4 * rg4 + 3] * (float)g[3]);
                    *(GAS u32x2*)(Op + 32 * d0 + 8 * rg4) = wv;
                }
        }
        if (!has_next) break;
        U = Un; ui += G;
    }
#undef SB_DMA
    WAIT_BAR(0);
}

constexpr int DA_KS = 16384, DA_VRING = 49152, DA_XCH = 114688, DA_SUBG = 147456 + 1024, DA_SSX = 147456 + 3072;
struct DaUnit { int b, h, qt, klo; };
__device__ __forceinline__ int da_qt_of(int r, int i) {
    constexpr unsigned long long Q1 = 0xE92B6AF78C01D543ull, Q2 = 0x6C5B3014A78D29FEull, Q3 = 0x21F0DC6B43E87A59ull;
    return r == 0 ? i : (int)(((r == 1 ? Q1 : r == 2 ? Q2 : Q3) >> (4 * i)) & 15ull);
}
__device__ __forceinline__ int da_klo(int qt, int h) {
    const float cs = exp2f(-2.0f * (float)(h + 1)) * LOG2E;
    const int D = (int)ceilf(160.5f / cs), m = qt * 128 - D - 63;
    return m > 0 ? (m + 63) >> 6 : 0;
}
__device__ __forceinline__ bool da_decode(int u, DaUnit& U) {
    if (u >= 1024) return false;
    const int r = u >> 8, v = u & 255;
    U.b = v >> 4; U.h = r; U.qt = da_qt_of(r, v & 15); U.klo = da_klo(U.qt, U.h); return true;
}
__device__ __forceinline__ void da_pv(f32x16 (&o)[4], const LAS unsigned char* Vs, const int (&vfo)[4], h8 pa0, h8 pa1, h8 pa2, h8 pa3) {
    h8 f0, f1, f2, f3, g0, g1, g2, g3;
    { const LAS unsigned char* Vb = Vs + vfo[0]; f0 = cat8(vtr(Vb), vtr(Vb + 1024)); f1 = cat8(vtr(Vb + 2048), vtr(Vb + 3072)); f2 = cat8(vtr(Vb + 4096), vtr(Vb + 5120)); f3 = cat8(vtr(Vb + 6144), vtr(Vb + 7168)); }
#pragma unroll
    for (int d0 = 0; d0 < 4; ++d0) {
        if (d0 < 3) { const LAS unsigned char* Vb = Vs + vfo[d0 + 1]; g0 = cat8(vtr(Vb), vtr(Vb + 1024)); g1 = cat8(vtr(Vb + 2048), vtr(Vb + 3072)); g2 = cat8(vtr(Vb + 4096), vtr(Vb + 5120)); g3 = cat8(vtr(Vb + 6144), vtr(Vb + 7168)); }
        o[d0] = MFMA32(f0, pa0, o[d0]); o[d0] = MFMA32(f1, pa1, o[d0]); o[d0] = MFMA32(f2, pa2, o[d0]); o[d0] = MFMA32(f3, pa3, o[d0]);
        if (d0 < 3) { f0 = g0; f1 = g1; f2 = g2; f3 = g3; }
    }
}
__device__ __forceinline__ void da_phase(LAS unsigned char* lds, const GAS f16* __restrict__ proj, GAS f16* __restrict__ mixed, int vcu, int G,
                                         float lam, float mref, const GAS float* __restrict__ subg, float osc, unsigned long long& sw_acc) {
    int tid_ = threadIdx.x; asm volatile("" : "+v"(tid_));
    const int tid = tid_, lane = tid & 63, l31 = lane & 31, hi = lane >> 5; const int w = __builtin_amdgcn_readfirstlane(tid >> 6);
    const int c = w >> 2, rg = w & 3;
    const unsigned lds0 = (unsigned)(uintptr_t)lds;
    const unsigned kdst = lds0 + w * 1024, vdst = lds0 + DA_VRING + w * 1024;
    int kfo[4];
    { const int kr = keyrow(l31);
#pragma unroll
      for (int d0 = 0; d0 < 4; ++d0) kfo[d0] = kr * 256 + (((8 * c + 2 * d0 + hi) ^ (kr & 15)) * 16); }
    int vfo[4];
    { const int q_ = (lane & 15) >> 2;
#pragma unroll
      for (int d0 = 0; d0 < 4; ++d0) vfo[d0] = DA_VRING + (32 * hi + q_) * 256 + ((d0 ^ q_) * 64) + ((lane >> 4) & 1) * 32 + (lane & 3) * 8; }
    const int srow = 4 * w + (lane >> 4);
    const size_t koff = (size_t)srow * PW + C_DAK + (((lane & 15) ^ (srow & 15)) * 8);
    const size_t voff = (size_t)srow * PW + C_DAV + (((((lane & 15) >> 2) ^ (srow & 3)) * 4 + (lane & 3)) * 8);
    const size_t qoff = (size_t)(32 * rg + l31) * PW + C_DAQ + c * 64 + 8 * hi;
    if (tid < 128) ((LAS float*)(lds + DA_SUBG))[tid] = subg[tid];
    LAS unsigned* xch = (LAS unsigned*)(lds + DA_XCH + rg * 8192);
#define DA_DMA(ks_, vs_, kt_, kslot, vslot) do { const size_t go_ = (size_t)(kt_) * 64 * PW; const unsigned kd_ = (unsigned)__builtin_amdgcn_readfirstlane(kdst + (kslot)), vd_ = (unsigned)__builtin_amdgcn_readfirstlane(vdst + (vslot)); \
        glds16((ks_) + go_, kd_); glds16((ks_) + go_ + (size_t)32 * PW, kd_ + 8192); glds16((vs_) + go_, vd_); glds16((vs_) + go_ + (size_t)32 * PW, vd_ + 8192); } while (0)
#define DA_NEXT_K(s) ((s) == 2 * DA_KS ? 0 : (s) + DA_KS)
#define DA_NEXT_V(s) ((s) == 3 * DA_KS ? 0 : (s) + DA_KS)
    DaUnit U, Un; int ui = vcu;
    if (!da_decode(ui, U)) return;
    const GAS f16* ksrc = proj + ((size_t)U.b * SEQ) * PW + U.h * 128 + koff; const GAS f16* vsrc = proj + ((size_t)U.b * SEQ) * PW + U.h * 128 + voff;
    h8 qn[4];
    { const GAS f16* Qg = proj + ((size_t)U.b * SEQ + U.qt * 128) * PW + qoff + U.h * 128;
#pragma unroll
      for (int d0 = 0; d0 < 4; ++d0) qn[d0] = *(const GAS h8*)(Qg + 16 * d0); }
    asm volatile("" : "+v"(qn[0]), "+v"(qn[1]), "+v"(qn[2]), "+v"(qn[3]));
    DA_DMA(ksrc, vsrc, U.klo, 0, 0); DA_DMA(ksrc, vsrc, U.klo + 1, DA_KS, DA_KS);
    int ik = 2 * DA_KS, iv = 2 * DA_KS, ck = 0, cv = 0;
    for (;;) {
        const size_t rowbase = (size_t)U.b * SEQ;
        const int qw = U.qt * 128 + 32 * rg, t = qw + l31, lastt = qw >> 6, NT = 2 * U.qt + 2;
        const float cslope = exp2f(-2.0f * (float)(U.h + 1)) * LOG2E;
        const float cs64 = 64.0f * cslope, base0 = -cslope * (float)(t - 32 * hi) - mref;
        h8 qr[4];
#pragma unroll
        for (int d0 = 0; d0 < 4; ++d0) qr[d0] = qn[d0];
        const size_t grow = rowbase + qw + l31;
        const bool has_next = da_decode(ui + G, Un);
        const GAS f16* ksn = ksrc; const GAS f16* vsn = vsrc;
        if (has_next) { ksn = proj + ((size_t)Un.b * SEQ) * PW + Un.h * 128 + koff; vsn = proj + ((size_t)Un.b * SEQ) * PW + Un.h * 128 + voff; }
        f32x16 o[4]; o[0] = f32x16{}; o[1] = f32x16{}; o[2] = f32x16{}; o[3] = f32x16{};
        float lsum = 0.f;
        h8 pq0, pq1, pq2, pq3;
        int pvs = 0;
        SW_BEGIN(2);
        for (int kt = U.klo; kt < NT; ++kt) {
            SW_BEGIN(3);
            if (kt + 1 < NT || has_next) WAIT_BAR(4); else WAIT_BAR(0);
            SW_END(3);
#define DA_ISSUE() do { if (kt + 2 < NT) { DA_DMA(ksrc, vsrc, kt + 2, ik, iv); ik = DA_NEXT_K(ik); iv = DA_NEXT_V(iv); } \
            else if (has_next) { DA_DMA(ksn, vsn, Un.klo + kt + 2 - NT, ik, iv); ik = DA_NEXT_K(ik); iv = DA_NEXT_V(iv); } } while (0)
            DA_ISSUE();
            if (c == 1 && kt > U.klo && kt - 1 <= lastt) da_pv(o, lds + pvs, vfo, pq0, pq1, pq2, pq3);
            if (kt <= lastt) {
                const LAS unsigned char* Ks = lds + ck;
                f32x16 p0, p1;
                const float basek = __builtin_fmaf(cs64, (float)kt, base0);
                __builtin_amdgcn_sched_barrier(0);
                asm volatile("s_nop 7" ::: "memory");
#define DA_INIT(r) p0[r] = fmamk_s<r>(cslope, basek); p1[r] = fmamk_s<16 + r>(cslope, basek);
                DA_INIT(0) DA_INIT(1) DA_INIT(2) DA_INIT(3) DA_INIT(4) DA_INIT(5) DA_INIT(6) DA_INIT(7) DA_INIT(8) DA_INIT(9) DA_INIT(10) DA_INIT(11) DA_INIT(12) DA_INIT(13) DA_INIT(14) DA_INIT(15)
#undef DA_INIT
                asm volatile("s_nop 3" : "+v"(p0), "+v"(p1));
                if (kt == lastt) {
                    const int kd = t - (64 * kt + 32 * hi);
                    const float m2 = -2.0f * mref;
                    asm volatile("" ::: "memory");
#pragma unroll
                    for (int r = 0; r < 16; ++r) { if (r > kd) p0[r] = m2 - p0[r]; if (16 + r > kd) p1[r] = m2 - p1[r]; }
                }
#pragma unroll
                for (int d0 = 0; d0 < 4; ++d0) { const h8 ka = *(const LAS h8*)(Ks + kfo[d0]), kb = *(const LAS h8*)(Ks + kfo[d0] + 4096); p0 = MFMA32(ka, qr[d0], p0); p1 = MFMA32(kb, qr[d0], p1); }
                float s0 = 0.f, s1 = 0.f, s2 = 0.f, s3 = 0.f;
#pragma unroll
                for (int r = 0; r < 16; ++r) { p0[r] = __builtin_amdgcn_exp2f(p0[r]); p1[r] = __builtin_amdgcn_exp2f(p1[r]); }

#pragma unroll
                for (int r = 0; r < 16; r += 2) { s0 += p0[r]; s1 += p0[r + 1]; s2 += p1[r]; s3 += p1[r + 1]; }
                lsum += (s0 + s1) + (s2 + s3);
                pq0 = pack8(p0, 0); pq1 = pack8(p0, 8); pq2 = pack8(p1, 0); pq3 = pack8(p1, 8); pvs = cv;
                if (c == 0) da_pv(o, lds + cv, vfo, pq0, pq1, pq2, pq3);
            }
            ck = DA_NEXT_K(ck); cv = DA_NEXT_V(cv);
        }
        if (c == 1 && NT - 1 <= lastt) da_pv(o, lds + pvs, vfo, pq0, pq1, pq2, pq3);
        asm volatile("s_nop 15\n\ts_nop 7" : "+v"(o[0]), "+v"(o[1]), "+v"(o[2]), "+v"(o[3]));
        SW_END(2);
        const int dlo = 2 * c;
        u32x2 gv[8];
        { const GAS f16* Gp = proj + grow * PW + C_DAG + U.h * 128 + 32 * dlo + 4 * hi;
#pragma unroll
          for (int i = 0; i < 8; ++i) gv[i] = *(const GAS u32x2*)(Gp + 8 * i); }
        if (has_next) { const GAS f16* Qg = proj + ((size_t)Un.b * SEQ + Un.qt * 128) * PW + qoff + Un.h * 128;
#pragma unroll
            for (int d0 = 0; d0 < 4; ++d0) qn[d0] = *(const GAS h8*)(Qg + 16 * d0); }
        asm volatile("" ::: "memory");
        { const auto rr = __builtin_amdgcn_permlane32_swap(__float_as_uint(lsum), __float_as_uint(lsum), false, false); lsum = __uint_as_float(rr[0]) + __uint_as_float(rr[1]); }
        const float f = (c == 0 ? 1.0f : lam) / lsum;
        LAS unsigned* xw = xch + (c ^ 1) * 1024;
        LAS unsigned* xr = xch + c * 1024;
        f32x16 ya, yb;
        if (c == 0) {
#pragma unroll
            for (int r2 = 0; r2 < 8; ++r2) { xw[r2 * 64 + lane] = pkh(o[2][2 * r2] * f, o[2][2 * r2 + 1] * f); xw[(8 + r2) * 64 + lane] = pkh(o[3][2 * r2] * f, o[3][2 * r2 + 1] * f); }
            ya = o[0] * f; yb = o[1] * f;
        } else {
#pragma unroll
            for (int r2 = 0; r2 < 8; ++r2) { xw[r2 * 64 + lane] = pkh(o[0][2 * r2] * f, o[0][2 * r2 + 1] * f); xw[(8 + r2) * 64 + lane] = pkh(o[1][2 * r2] * f, o[1][2 * r2 + 1] * f); }
            ya = o[2] * f; yb = o[3] * f;
        }
        asm volatile("s_waitcnt lgkmcnt(0)\n\ts_barrier" ::: "memory");
        const float sgn = (c == 0) ? 1.0f : -1.0f;
        float ss = 0.f;
#pragma unroll
        for (int r2 = 0; r2 < 8; ++r2) {
            const h2 pa = __builtin_bit_cast(h2, xr[r2 * 64 + lane]), pb = __builtin_bit_cast(h2, xr[(8 + r2) * 64 + lane]);
            const float a0 = (ya[2 * r2] - (float)pa[0]) * sgn, a1 = (ya[2 * r2 + 1] - (float)pa[1]) * sgn, b0 = (yb[2 * r2] - (float)pb[0]) * sgn, b1 = (yb[2 * r2 + 1] - (float)pb[1]) * sgn;
            ya[2 * r2] = a0; ya[2 * r2 + 1] = a1; yb[2 * r2] = b0; yb[2 * r2 + 1] = b1; ss += (a0 * a0 + a1 * a1) + (b0 * b0 + b1 * b1);
        }
        { const auto rr = __builtin_amdgcn_permlane32_swap(__float_as_uint(ss), __float_as_uint(ss), false, false); ss = __uint_as_float(rr[0]) + __uint_as_float(rr[1]); }
        LAS float* ssx = (LAS float*)(lds + DA_SSX + rg * 256);
        if (hi == 0) ssx[c * 32 + l31] = ss;
        asm volatile("s_waitcnt lgkmcnt(0)\n\ts_barrier" ::: "memory");
        ss += ssx[(c ^ 1) * 32 + l31];
        const float rn = __builtin_amdgcn_rsqf(ss * (1.0f / 128.0f) + RMS_EPS) * osc;
        {
            const LAS float* sgl = (const LAS float*)(lds + DA_SUBG) + 32 * dlo + 4 * hi;
            GAS f16* Op = mixed + grow * DM + 512 + U.h * 128 + 32 * dlo + 4 * hi;
#pragma unroll
            for (int rg4 = 0; rg4 < 4; ++rg4) {
                const h4 g = __builtin_bit_cast(h4, gv[rg4]);
                const f32x4 sg = *(const LAS f32x4*)(sgl + 8 * rg4);
                u32x2 wv;
                wv.x = pkh(ya[4 * rg4] * rn * sg[0] * (float)g[0], ya[4 * rg4 + 1] * rn * sg[1] * (float)g[1]);
                wv.y = pkh(ya[4 * rg4 + 2] * rn * sg[2] * (float)g[2], ya[4 * rg4 + 3] * rn * sg[3] * (float)g[3]);
                *(GAS u32x2*)(Op + 8 * rg4) = wv;
            }
#pragma unroll
            for (int rg4 = 0; rg4 < 4; ++rg4) {
                const h4 g = __builtin_bit_cast(h4, gv[4 + rg4]);
                const f32x4 sg = *(const LAS f32x4*)(sgl + 32 + 8 * rg4);
                u32x2 wv;
                wv.x = pkh(yb[4 * rg4] * rn * sg[0] * (float)g[0], yb[4 * rg4 + 1] * rn * sg[1] * (float)g[1]);
                wv.y = pkh(yb[4 * rg4 + 2] * rn * sg[2] * (float)g[2], yb[4 * rg4 + 3] * rn * sg[3] * (float)g[3]);
                *(GAS u32x2*)(Op + 32 + 8 * rg4) = wv;
            }
        }
        if (!has_next) break;
        U = Un; ui += G; ksrc = ksn; vsrc = vsn;
    }
#undef DA_DMA
#undef DA_ISSUE
#undef DA_NEXT_K
#undef DA_NEXT_V
    WAIT_BAR(0);
}
}

constexpr size_t MiB = 1u << 20;
constexpr size_t WS_CTL = 0, CTL_ZERO_BYTES = 64 * 1024;
constexpr size_t WS_WIN = 2 * MiB;
constexpr size_t WS_WOUT = 18 * MiB;
constexpr size_t WS_PART = 22 * MiB;
constexpr size_t WS_XB = 32 * MiB;
constexpr size_t WS_MIX = 96 * MiB;
constexpr size_t WS_PROJ = 160 * MiB;
constexpr size_t WS_END = 416 * MiB;
constexpr int CW_BAR = 4096;

constexpr int RING_OFF = 0, RING_BYTES = 131072;
constexpr int LDSCTL_OFF = 147456, MISC_OFF = LDSCTL_OFF + 320;
constexpr int LDS_BYTES = 163840;
constexpr int NWAVES = 8;

typedef GAS unsigned gu32;
#define LDS_WAIT() asm volatile("s_waitcnt lgkmcnt(0)" ::: "memory")

#define XB_TMO      128
#define XB_XCNT(j)  (256  + 64 * (j))
#define XB_XSUB(j)  (1280 + 64 * (j))
#define XB_XGEN(j)  (2304 + 64 * (j))
#define XB_TOP      3328
#define XB_TOPGEN   3392
#define XCD_BAR_WORDS 3456
#define XB_SPIN_CAP (1u << 18)
__device__ __forceinline__ unsigned xb_ld(unsigned* p)              { return __hip_atomic_load(p, __ATOMIC_RELAXED, __HIP_MEMORY_SCOPE_AGENT); }
__device__ __forceinline__ unsigned xb_add(unsigned* p, unsigned v) { return __hip_atomic_fetch_add(p, v, __ATOMIC_RELAXED, __HIP_MEMORY_SCOPE_AGENT); }
__device__ __forceinline__ unsigned xb_xcc_id() { return (unsigned)__builtin_amdgcn_s_getreg((3 << 11) | 20) & 0xFu; }
#define XB_SPIN(cond, bar) do { unsigned _sp = 0; while (cond) { __builtin_amdgcn_s_sleep(1); \
    if ((++_sp & 255u) == 0u) { if (xb_ld(&(bar)[XB_TMO])) break; if (_sp > XB_SPIN_CAP) { atomicAdd(&(bar)[XB_TMO], 1u); break; } } } } while (0)
struct XcdBarrier { unsigned* bar; unsigned x; volatile LAS unsigned* st; };
__device__ __forceinline__ XcdBarrier xcd_barrier_post(unsigned* bar, volatile LAS unsigned* st) {
    XcdBarrier b; b.bar = bar; b.x = xb_xcc_id(); b.st = st;
    if (threadIdx.x == 0) (void)xb_add(&bar[XB_XCNT(b.x)], 1u);
    return b;
}
__device__ __forceinline__ void xcd_barrier_complete(unsigned* bar, unsigned x, unsigned& nloc, unsigned& nx) {
    const unsigned G = gridDim.x * gridDim.y * gridDim.z;
    unsigned sum, cnt, mine, sp = 0u;
    for (;;) {
        sum = 0u; cnt = 0u; mine = 0u;
#pragma unroll
        for (unsigned j = 0; j < 16; ++j) { const unsigned c = xb_ld(&bar[XB_XCNT(j)]); sum += c; cnt += (c > 0u) ? 1u : 0u; mine = (j == x) ? c : mine; }
        if (sum == G) break;
        __builtin_amdgcn_s_sleep(1);
        if ((++sp & 255u) == 0u) { if (xb_ld(&bar[XB_TMO])) break; if (sp > XB_SPIN_CAP) { atomicAdd(&bar[XB_TMO], 1u); break; } }
    }
    nloc = mine > 0u ? mine : 1u; nx = cnt > 0u ? cnt : 1u;
}
__device__ __forceinline__ void xcd_barrier(const XcdBarrier& b) {
    asm volatile("s_waitcnt vmcnt(0)" ::: "memory");
    __syncthreads();
    if (threadIdx.x == 0) {
        unsigned* bar = b.bar;
        __builtin_amdgcn_s_waitcnt(0);
        unsigned nloc = b.st[0], nx = b.st[1];
        if (nloc == 0u) { xcd_barrier_complete(bar, b.x, nloc, nx); b.st[0] = nloc; b.st[1] = nx; }
        const unsigned old = xb_add(&bar[XB_XSUB(b.x)], 1u);
        const unsigned gen = old / nloc;
        if (old + 1u == (gen + 1u) * nloc) {
            __builtin_amdgcn_fence(__ATOMIC_RELEASE, "agent");
            asm volatile("s_waitcnt vmcnt(0)" ::: "memory");
            const unsigned og = xb_add(&bar[XB_TOP], 1u);
            const unsigned tg = og / nx;
            if (og + 1u == (tg + 1u) * nx) xb_add(&bar[XB_TOPGEN], 1u);
            else XB_SPIN(xb_ld(&bar[XB_TOPGEN]) == tg, bar);
            __builtin_amdgcn_fence(__ATOMIC_ACQUIRE, "agent");
            xb_add(&bar[XB_XGEN(b.x)], 1u);
            asm volatile("s_waitcnt vmcnt(0)" ::: "memory");
        } else {
            XB_SPIN(xb_ld(&bar[XB_XGEN(b.x)]) == gen, bar);
            __builtin_amdgcn_fence(__ATOMIC_ACQUIRE, "agent");
            asm volatile("s_waitcnt vmcnt(0)" ::: "memory");
        }
    }
    __syncthreads();
}

__device__ __forceinline__ void p0_transpose_item(const float* W, const float* g, int K, int N, f16* WT, LAS float* scr, int item, int lane) {
    const int nblk = N / 32, kb = item / nblk, nb = item % nblk, k0 = 32 * kb, n0 = 32 * nb;
    float v[16];
#pragma unroll
    for (int i = 0; i < 16; ++i) { const int kk = 2 * i + (lane >> 5); v[i] = W[(size_t)(k0 + kk) * N + n0 + (lane & 31)]; }
    if (g) {
#pragma unroll
        for (int i = 0; i < 16; ++i) v[i] *= g[k0 + 2 * i + (lane >> 5)];
    }
#pragma unroll
    for (int i = 0; i < 16; ++i) scr[(2 * i + (lane >> 5)) * 33 + (lane & 31)] = v[i];
    LDS_WAIT(); asm volatile("" ::: "memory");
    const int c = lane & 3;
#pragma unroll
    for (int j = 0; j < 2; ++j) { const int n = (lane >> 2) + 16 * j; const LAS float* sp = scr + (8 * c) * 33 + n;
        u32x4 o; o.x = pkh(sp[0 * 33], sp[1 * 33]); o.y = pkh(sp[2 * 33], sp[3 * 33]); o.z = pkh(sp[4 * 33], sp[5 * 33]); o.w = pkh(sp[6 * 33], sp[7 * 33]);
        *(GAS u32x4*)(WT + (size_t)(n0 + n) * K + k0 + 8 * c) = o; }
    LDS_WAIT(); asm volatile("" ::: "memory");
}
__device__ __forceinline__ void x_rows4(const float* x, f16* xb, float* part, int m0, int stride, int lane) {
    f32x4 v[4][4];
#pragma unroll
    for (int r = 0; r < 4; ++r) { const GAS f32x4* xr = (const GAS f32x4*)(x + (size_t)(m0 + r * stride) * DM) + lane;
#pragma unroll
        for (int j = 0; j < 4; ++j) v[r][j] = xr[64 * j]; }
#pragma unroll
    for (int r = 0; r < 4; ++r) {
        float s = 0.f;
#pragma unroll
        for (int j = 0; j < 4; ++j) s += (v[r][j][0] * v[r][j][0] + v[r][j][1] * v[r][j][1]) + (v[r][j][2] * v[r][j][2] + v[r][j][3] * v[r][j][3]);
        s = att::wave_sum(s);
        const size_t row = (size_t)(m0 + r * stride);
        GAS u32x2* o8 = (GAS u32x2*)(xb + row * DM) + lane;
#pragma unroll
        for (int j = 0; j < 4; ++j) { u32x2 w; w.x = pkh(v[r][j][0], v[r][j][1]); w.y = pkh(v[r][j][2], v[r][j][3]); o8[64 * j] = w; }
        if (lane < 16) part[row * 16 + lane] = (lane == 0) ? s : 0.f;
    }
}

__device__ __forceinline__ void x_row1(const float* x, f16* xb, float* part, int m, int lane) {
    const GAS f32x4* xr = (const GAS f32x4*)(x + (size_t)m * DM) + lane;
    f32x4 v[4]; float s = 0.f;
#pragma unroll
    for (int j = 0; j < 4; ++j) { v[j] = xr[64 * j]; s += (v[j][0] * v[j][0] + v[j][1] * v[j][1]) + (v[j][2] * v[j][2] + v[j][3] * v[j][3]); }
    s = att::wave_sum(s);
    GAS u32x2* o8 = (GAS u32x2*)(xb + (size_t)m * DM) + lane;
#pragma unroll
    for (int j = 0; j < 4; ++j) { u32x2 w; w.x = pkh(v[j][0], v[j][1]); w.y = pkh(v[j][2], v[j][3]); o8[64 * j] = w; }
    if (lane < 16) part[(size_t)m * 16 + lane] = (lane == 0) ? s : 0.f;
}

struct Args { const float* in[11]; float* out; unsigned char* ws; };
__global__ void __launch_bounds__(NWAVES * 64, 2) hybrid_fwd(Args args) {
    extern __shared__ __attribute__((aligned(16))) unsigned char lds_raw[];
    LAS unsigned char* lds = (LAS unsigned char*)lds_raw;
    volatile LAS unsigned* MISC = (volatile LAS unsigned*)(lds + MISC_OFF);
    const int tid = threadIdx.x, lane = tid & 63, wave = __builtin_amdgcn_readfirstlane(tid >> 6);
    const int G = gridDim.x; const int bx = blockIdx.x; const int vcu = (G % 8 == 0) ? (bx % 8) * (G / 8) + bx / 8 : bx;
    unsigned char* ws = args.ws;
    gu32* ctl = (gu32*)(ws + WS_CTL);
    const float* x = args.in[0]; const float* norm_g = args.in[1]; const float* w_in = args.in[2]; const float* w_out = args.in[3];
    const float* q_norm_g = args.in[4]; const float* k_norm_g = args.in[5];
    const float* lq1 = args.in[6]; const float* lk1 = args.in[7]; const float* lq2 = args.in[8]; const float* lk2 = args.in[9]; const float* subln_g = args.in[10];
    float* out = args.out;
    GAS unsigned char* wsg = (GAS unsigned char*)ws;
    GAS f16* WIN = (GAS f16*)(wsg + WS_WIN); GAS f16* WOUT = (GAS f16*)(wsg + WS_WOUT); GAS float* PART = (GAS float*)(wsg + WS_PART);
    GAS f16* XB = (GAS f16*)(wsg + WS_XB); GAS f16* MIX = (GAS f16*)(wsg + WS_MIX); GAS f16* PROJ = (GAS f16*)(wsg + WS_PROJ);

    unsigned long long sw_acc = 0;
    for (int u = tid; u < (LDS_BYTES - LDSCTL_OFF) / 4; u += NWAVES * 64) ((LAS unsigned*)(lds + LDSCTL_OFF))[u] = 0u;
    __syncthreads();
    XcdBarrier bar = xcd_barrier_post((unsigned*)(ctl + CW_BAR), MISC + 8);

    SW_BEGIN(6);
    for (int rep = 0; rep < REP_PRO; ++rep) {
        LAS float* scr = (LAS float*)(lds + RING_OFF + wave * 16384);
        const int gw = vcu * NWAVES + wave, NGW = G * NWAVES;
        constexpr int I_IN = (DM / 32) * (PW / 32), I_OUT = (DM / 32) * (DM / 32);
        constexpr int NITEMS = DEPTH * (I_IN + I_OUT);
        SW_BEGIN(9);
        for (int it = gw; it < NITEMS; it += NGW) {
            int r = it; const int l = r / (I_IN + I_OUT); r -= l * (I_IN + I_OUT);
            if (r < I_IN) p0_transpose_item(w_in + (size_t)l * DM * PW, norm_g + l * DM, DM, PW, (f16*)WIN + (size_t)l * PW * DM, scr, r, lane);
            else p0_transpose_item(w_out + (size_t)l * DM * DM, nullptr, DM, DM, (f16*)WOUT + (size_t)l * DM * DM, scr, r - I_IN, lane);
        }
        SW_END(9);
        SW_BEGIN(10);
        { int m = gw; for (; m + 3 * NGW < MROWS; m += 4 * NGW) x_rows4(x, (f16*)XB, (float*)PART, m, NGW, lane); for (; m < MROWS; m += NGW) x_row1(x, (f16*)XB, (float*)PART, m, lane); }
        SW_END(10);
    }
    SW_END(6);
    { SW_BEGIN(7); xcd_barrier(bar); SW_END(7); }

    for (int l = 0; l < DEPTH; ++l) {
        { GAS unsigned char* wsl = wsg; asm volatile("" : "+s"(wsl)); WIN = (GAS f16*)(wsl + WS_WIN); WOUT = (GAS f16*)(wsl + WS_WOUT); PART = (GAS float*)(wsl + WS_PART); XB = (GAS f16*)(wsl + WS_XB); MIX = (GAS f16*)(wsl + WS_MIX); PROJ = (GAS f16*)(wsl + WS_PROJ);
          asm volatile("" : "+s"(out)); asm volatile("" : "+s"(x)); asm volatile("" : "+s"(subln_g)); asm volatile("" : "+s"(q_norm_g)); asm volatile("" : "+s"(k_norm_g)); asm volatile("" : "+s"(bar.bar)); }
        for (int rep = 0; rep < REP_G1; ++rep) {
            pg8::Gemm g{(const f16*)XB, (const f16*)WIN + (size_t)l * PW * DM, MROWS, PW, DM}; pg8::StaticOrder S; S.init(MROWS, PW, G, bx);
            pg8::EpiProj E{PROJ, PART, (const GAS float*)q_norm_g + l * 64, (const GAS float*)k_norm_g + l * 64};
            SW_BEGIN(5);
            pg8::gemm_phase<pg8::EpiProj>(lds + RING_OFF, g, S, E, sw_acc);
            SW_END(5);
        }
        { SW_BEGIN(7); xcd_barrier(bar); SW_END(7); }
        {
            const float sa = att::wave_sum(lq1[l * 64 + lane] * lk1[l * 64 + lane]), sb = att::wave_sum(lq2[l * 64 + lane] * lk2[l * 64 + lane]);
            const float lam_init = 0.8f - 0.6f * __expf(-0.3f * (float)l);
            const float lam = __expf(sa) - __expf(sb) + lam_init;
            const float mgq = att::wave_max(fabsf(q_norm_g[l * 64 + lane])), mgk = att::wave_max(fabsf(k_norm_g[l * 64 + lane]));
            const float mref = 8.0f * LOG2E * mgq * mgk * 1.001f - 10.0f;
            __syncthreads();
            for (int rep = 0; rep < REP_DA; ++rep) { SW_BEGIN(1); att::da_phase(lds + RING_OFF, PROJ, MIX, vcu, G, lam, mref, (const GAS float*)subln_g + l * 128, 1.0f - lam_init, sw_acc); SW_END(1); }
            for (int rep = 0; rep < REP_SB; ++rep) { SW_BEGIN(4); att::sb_phase(lds + RING_OFF, PROJ, MIX, vcu, G, sw_acc); SW_END(4); }
        }
        { SW_BEGIN(7); xcd_barrier(bar); SW_END(7); }
        {
            pg8::Gemm g{(const f16*)MIX, (const f16*)WOUT + (size_t)l * DM * DM, MROWS, DM, DM}; pg8::StaticOrder S; S.init(MROWS, DM, G, bx);
            pg8::EpiOut E{(GAS float*)out, XB, PART, (l + 1 < DEPTH) ? 0 : 1};
            SW_BEGIN(8);
            pg8::gemm_phase<pg8::EpiOut>(lds + RING_OFF, g, S, E, sw_acc);
            SW_END(8);
        }
        if (l + 1 < DEPTH) { SW_BEGIN(7); xcd_barrier(bar); SW_END(7); }
    }
#if SW_ID
    if (wave == 0) { const unsigned long long t0 = __builtin_amdgcn_s_memrealtime(), span = (unsigned long long)SW_K * sw_acc; while (__builtin_amdgcn_s_memrealtime() - t0 < span) __builtin_amdgcn_s_sleep(8); }
#endif
}

extern "C" void kernel_launch(void* const* d_in, const int* in_sizes, int n_in, void* d_out, int out_size, void* d_ws, size_t ws_size, hipStream_t stream) {
    static int grid = 0;
    if (grid == 0) {
        if (n_in != 11 || in_sizes[0] != MROWS * DM || out_size != MROWS * DM || ws_size < WS_END) {
            fprintf(stderr, "kernel_launch: unexpected problem shape (n_in %d, in0 %d, out %d, ws %zu); nothing launched\n", n_in, n_in > 0 ? in_sizes[0] : -1, out_size, ws_size); grid = -1; return; }
        int dev = 0, cus = 0, per_cu = 0;
        if (hipGetDevice(&dev) != hipSuccess || hipDeviceGetAttribute(&cus, hipDeviceAttributeMultiprocessorCount, dev) != hipSuccess) { grid = -1; return; }
        if (hipFuncSetAttribute((const void*)hybrid_fwd, hipFuncAttributeMaxDynamicSharedMemorySize, LDS_BYTES) != hipSuccess) { fprintf(stderr, "kernel_launch: hipFuncSetAttribute failed\n"); grid = -1; return; }
        if (hipOccupancyMaxActiveBlocksPerMultiprocessor(&per_cu, (const void*)hybrid_fwd, NWAVES * 64, LDS_BYTES) != hipSuccess || per_cu < 1) {
            fprintf(stderr, "kernel_launch: occupancy query reports %d workgroups per CU; nothing launched\n", per_cu); (void)hipGetLastError(); grid = -1; return; }
        grid = cus;
    }
    if (grid < 0) return;
    if (hipMemsetAsync((char*)d_ws + WS_CTL, 0, CTL_ZERO_BYTES, stream) != hipSuccess) { fprintf(stderr, "kernel_launch: hipMemsetAsync failed\n"); return; }
    Args a{};
    for (int i = 0; i < 11; ++i) a.in[i] = (const float*)d_in[i];
    a.out = (float*)d_out; a.ws = (unsigned char*)d_ws;
    hipLaunchKernelGGL(hybrid_fwd, dim3(grid), dim3(NWAVES * 64), LDS_BYTES, stream, a);
    const hipError_t le = hipPeekAtLastError();
    if (le != hipSuccess) fprintf(stderr, "kernel_launch: launch failed: %s\n", hipGetErrorName(le));
}
```

```cpp
#include <hip/hip_runtime.h>
#include <cstdio>
#include <cstdint>

#ifndef SB_EARLY_EXIT
#define SB_EARLY_EXIT 1
#endif
#define SW_ID 0
#define SW_K 4
#define REP_PRO 1
#define REP_G1 1
#define REP_DA 1
#define REP_SB 1
#define REP_G2 1

#if SW_ID
#define SW_BEGIN(id) unsigned long long sw_t0_##id = 0; if (SW_ID == (id)) sw_t0_##id = __builtin_amdgcn_s_memrealtime()
#define SW_END(id) do { if (SW_ID == (id)) sw_acc += __builtin_amdgcn_s_memrealtime() - sw_t0_##id; } while (0)
#else
#define SW_BEGIN(id) do {} while (0)
#define SW_END(id) do {} while (0)
#endif
#define LAS __attribute__((address_space(3)))
#define GAS __attribute__((address_space(1)))
typedef _Float16 f16;
typedef _Float16 h8 __attribute__((ext_vector_type(8)));
typedef _Float16 h4 __attribute__((ext_vector_type(4)));
typedef _Float16 h2 __attribute__((ext_vector_type(2)));
typedef float f32x4 __attribute__((ext_vector_type(4)));
typedef float f32x16 __attribute__((ext_vector_type(16)));
typedef unsigned u32x4 __attribute__((ext_vector_type(4)));
typedef unsigned u32x2 __attribute__((ext_vector_type(2)));

constexpr int BATCH = 16, SEQ = 2048, DM = 1024, MROWS = BATCH * SEQ, PW = 4096, DEPTH = 2;
constexpr float RMS_EPS = 1e-6f;
constexpr float LOG2E = 1.4426950408889634f;
constexpr float QS = 0.125f * LOG2E;
constexpr int C_SBQ = 0, C_SBK = 512, C_SBV = 1024, C_SBG = 1536, C_DAQ = 2048, C_DAK = 2560, C_DAV = 3072, C_DAG = 3584;

__device__ __forceinline__ unsigned pkh(float lo, float hi) { h2 v = {(f16)lo, (f16)hi}; return __builtin_bit_cast(unsigned, v); }
__device__ __forceinline__ unsigned pkh_rtz(float lo, float hi) { return __builtin_bit_cast(unsigned, __builtin_amdgcn_cvt_pkrtz(lo, hi)); }
__device__ __forceinline__ float row4_sum(float s) {
    { const auto r = __builtin_amdgcn_permlane16_swap(__float_as_uint(s), __float_as_uint(s), false, false); s = __uint_as_float(r[0]) + __uint_as_float(r[1]); }
    { const auto r = __builtin_amdgcn_permlane32_swap(__float_as_uint(s), __float_as_uint(s), false, false); s = __uint_as_float(r[0]) + __uint_as_float(r[1]); }
    return s;
}
__device__ __forceinline__ float silu_f(float v) { return v * __builtin_amdgcn_rcpf(1.0f + __builtin_amdgcn_exp2f(-v * LOG2E)); }

namespace pg8 {
constexpr int BM = 256, BK = 64, HALF = 128, HTB = HALF * BK * 2, STAGE_BYTES = 8 * HTB, NXCD = 8, WGM = 8;
__host__ __device__ __forceinline__ int lds_byte(int r, int c) { const int st = (r >> 4) * 2 + (c >> 5), rr = r & 15, cc = c & 31, ob = rr * 64 + cc * 2; return st * 1024 + (ob ^ (((ob >> 9) & 1) << 5)); }
__host__ __device__ __forceinline__ void stage_rc(int b, int& R, int& C) { const int st = b / 1024, sb = b % 1024, swz = sb ^ (((sb >> 9) & 1) << 5); R = (st >> 1) * 16 + swz / 64; C = (st & 1) * 32 + (swz % 64) / 2; }
__host__ __device__ __forceinline__ int perm32(int rho) { const int n = rho >> 4, i = rho & 15; return 8 * (i >> 2) + 4 * n + (i & 3); }

struct Unit { int pm, pn; };
struct Gemm { const f16* A; const f16* Bt; int M, N, K; };

struct StaticOrder {
    int nM, nN, nwg, G, c;
    __host__ __device__ void init(int M, int N, int G_, int c_) { nM = M / BM; nN = N / BM; nwg = nM * nN; G = G_; c = c_; }
    __host__ __device__ bool next(int i, Unit& u) const {
        const long L = (long)i * G + c; if (L >= nwg) return false;
        int wgid = (int)L; { const int q = nwg / NXCD, r = nwg % NXCD, xcd = wgid % NXCD, off = wgid / NXCD; wgid = (xcd < r ? xcd * (q + 1) : r * (q + 1) + (xcd - r) * q) + off; }
        const int nig = WGM * nN, gid = wgid / nig, fm = gid * WGM, gsz = (nM - fm) < WGM ? (nM - fm) : WGM;
        u.pm = fm + ((wgid % nig) % gsz); u.pn = (wgid % nig) / gsz; return true;
    }
};


struct EpiProj {
    GAS f16* P; const GAS float* part; const GAS float* gq; const GAS float* gk;
    __device__ __forceinline__ void operator()(const f32x4 (&acc)[2][2][4][2], const Unit& u, int wr, int wc, int fr, int fq) const {
        const int sec = u.pn >> 1;
        const int row0 = u.pm * BM + wr * 64 + fr;
        const int colw = u.pn * BM + wc * 64 + 8 * fq;
        f32x4 gain[2][2];
        if (sec == 4 || sec == 5) {
            const GAS float* g = (sec == 4) ? gq : gk;
#pragma unroll
            for (int bj = 0; bj < 2; ++bj)
#pragma unroll
                for (int n = 0; n < 2; ++n) gain[bj][n] = *(const GAS f32x4*)(g + 32 * bj + 8 * fq + 4 * n);
        }
#pragma unroll
        for (int ai = 0; ai < 2; ++ai)
#pragma unroll
            for (int m = 0; m < 4; ++m) {
                const int row = row0 + ai * HALF + m * 16;
                const f32x4 pv = *(const GAS f32x4*)(part + (size_t)row * 16 + fq * 4);
                float s = (pv[0] + pv[1]) + (pv[2] + pv[3]);
                s = row4_sum(s);
                const float rs = __builtin_amdgcn_rsqf(s * (1.0f / DM) + RMS_EPS);
                f32x4 v[2][2];
#pragma unroll
                for (int bj = 0; bj < 2; ++bj)
#pragma unroll
                    for (int n = 0; n < 2; ++n) v[bj][n] = acc[ai][bj][m][n] * rs;
                if (sec == 4 || sec == 5) {
                    float ss = 0.f;
#pragma unroll
                    for (int bj = 0; bj < 2; ++bj)
#pragma unroll
                        for (int n = 0; n < 2; ++n) { const f32x4 x = v[bj][n]; ss += (x[0] * x[0] + x[1] * x[1]) + (x[2] * x[2] + x[3] * x[3]); }
                    ss = row4_sum(ss);
                    float rn = __builtin_amdgcn_rsqf(ss * (1.0f / 64.0f) + RMS_EPS);
                    if (sec == 4) rn *= QS;
#pragma unroll
                    for (int bj = 0; bj < 2; ++bj)
#pragma unroll
                        for (int n = 0; n < 2; ++n) v[bj][n] = v[bj][n] * rn * gain[bj][n];
                } else if (sec == 0) {
#pragma unroll
                    for (int bj = 0; bj < 2; ++bj)
#pragma unroll
                        for (int n = 0; n < 2; ++n) v[bj][n] = v[bj][n] * QS;
                } else if (sec == 3 || sec == 7) {
#pragma unroll
                    for (int bj = 0; bj < 2; ++bj)
#pragma unroll
                        for (int n = 0; n < 2; ++n)
#pragma unroll
                            for (int e = 0; e < 4; ++e) v[bj][n][e] = silu_f(v[bj][n][e]);
                }
                GAS f16* rowp = P + (size_t)row * PW + colw;
#pragma unroll
                for (int bj = 0; bj < 2; ++bj) {
                    u32x4 w; w.x = pkh(v[bj][0][0], v[bj][0][1]); w.y = pkh(v[bj][0][2], v[bj][0][3]); w.z = pkh(v[bj][1][0], v[bj][1][1]); w.w = pkh(v[bj][1][2], v[bj][1][3]);
                    *(GAS u32x4*)(rowp + 32 * bj) = w;
                }
            }
    }
};

struct EpiOut {
    GAS float* out; GAS f16* xb; GAS float* part; int last;
    __device__ __forceinline__ void operator()(const f32x4 (&acc)[2][2][4][2], const Unit& u, int wr, int wc, int fr, int fq) const {
        const int row0 = u.pm * BM + wr * 64 + fr;
        const int colw = u.pn * BM + wc * 64 + 8 * fq;
#pragma unroll
        for (int ai = 0; ai < 2; ++ai) {
            h8 bs[4][2];
#pragma unroll
            for (int m = 0; m < 4; ++m)
#pragma unroll
                for (int bj = 0; bj < 2; ++bj) bs[m][bj] = *(const GAS h8*)(xb + (size_t)(row0 + ai * HALF + m * 16) * DM + colw + 32 * bj);
#pragma unroll
            for (int m = 0; m < 4; ++m) {
                const int row = row0 + ai * HALF + m * 16;
                const size_t off = (size_t)row * DM + colw;
                float ss = 0.f;
#pragma unroll
                for (int bj = 0; bj < 2; ++bj) {
                    const h8 b = bs[m][bj];
                    f32x4 o0 = acc[ai][bj][m][0], o1 = acc[ai][bj][m][1];
                    o0[0] += (float)b[0]; o0[1] += (float)b[1]; o0[2] += (float)b[2]; o0[3] += (float)b[3];
                    o1[0] += (float)b[4]; o1[1] += (float)b[5]; o1[2] += (float)b[6]; o1[3] += (float)b[7];
                    if (last) { *(GAS f32x4*)(out + off + 32 * bj) = o0; *(GAS f32x4*)(out + off + 32 * bj + 4) = o1; }
                    else {
                        ss += (o0[0] * o0[0] + o0[1] * o0[1]) + (o0[2] * o0[2] + o0[3] * o0[3]) + (o1[0] * o1[0] + o1[1] * o1[1]) + (o1[2] * o1[2] + o1[3] * o1[3]);
                        u32x4 w; w.x = pkh(o0[0], o0[1]); w.y = pkh(o0[2], o0[3]); w.z = pkh(o1[0], o1[1]); w.w = pkh(o1[2], o1[3]);
                        *(GAS u32x4*)(xb + off + 32 * bj) = w;
                    }
                }
                if (!last) {
                    ss = row4_sum(ss);
                    if (fq == 0) part[(size_t)row * 16 + u.pn * 4 + wc] = ss;
                }
            }
        }
    }
};

template <class Epi>
__device__ __forceinline__ void gemm_phase(LAS unsigned char* lds, const Gemm g, const StaticOrder& S, const Epi& E, unsigned long long& sw_acc) {
    int tid_ = threadIdx.x; asm volatile("" : "+v"(tid_));
    const int tid = tid_, wid = __builtin_amdgcn_readfirstlane(tid >> 6), lane = tid & 63, wr = wid >> 2, wc = wid & 3, fr = lane & 15, fq = lane >> 4;
    const int K = g.K, nt = K / BK;
    unsigned voffA[2], voffB[2];
#pragma unroll
    for (int i = 0; i < 2; ++i) { int R, C; stage_rc(tid * 16 + i * 8192, R, C);
        const int Rb = (R >> 5) * 64 + perm32(R & 31);
        voffA[i] = (unsigned)(R * K + C) * 2u; voffB[i] = (unsigned)(Rb * K + C) * 2u; }
    const size_t kstep = (size_t)(BK * 2);
    const size_t hstep = (size_t)HALF * K * 2;
    const size_t hstepB = (size_t)32 * K * 2;
    const size_t tstep = 2 * hstep;
    const unsigned ldsw = (unsigned)wid * 1024u;
    const int aoff = lds_byte(wr * 64 + fr, fq * 8), boff = lds_byte(wc * 32 + fr, fq * 8);
#define PG8_SA(b, h) (((b) * 2 + (h)) * HTB)
#define PG8_SB(b, h) ((4 + (b) * 2 + (h)) * HTB)
#define PG8_STAGE(bufoff, gbase, voff) do { _Pragma("unroll") for (int _i = 0; _i < 2; ++_i) \
        __builtin_amdgcn_global_load_lds((const unsigned*)((const char*)(gbase) + (voff)[_i]), (LAS unsigned*)(lds + (bufoff) + ldsw + _i * 8192), 16, 0, 0); } while (0)
#define PG8_LDA(dst, b, h) do { _Pragma("unroll") for (int m = 0; m < 4; ++m) _Pragma("unroll") for (int k = 0; k < 2; ++k) dst[m][k] = *(const LAS h8*)(lds + PG8_SA(b, h) + aoff + m * 2048 + k * 1024); } while (0)
#define PG8_LDB(dst, b, h) do { _Pragma("unroll") for (int n = 0; n < 2; ++n) _Pragma("unroll") for (int k = 0; k < 2; ++k) dst[n][k] = *(const LAS h8*)(lds + PG8_SB(b, h) + boff + n * 2048 + k * 1024); } while (0)
#define PG8_MMA(ai, bj, At, Bt) do { __builtin_amdgcn_s_setprio(1); _Pragma("unroll") for (int m = 0; m < 4; ++m) _Pragma("unroll") for (int n = 0; n < 2; ++n) _Pragma("unroll") for (int k = 0; k < 2; ++k) \
        acc[ai][bj][m][n] = __builtin_amdgcn_mfma_f32_16x16x32_f16(Bt[n][k], At[m][k], acc[ai][bj][m][n], 0, 0, 0); __builtin_amdgcn_s_setprio(0); } while (0)
#define PG8_WAIT_V(n) asm volatile("s_waitcnt vmcnt(" #n ")" ::: "memory")
#define PG8_WAIT_L(n) asm volatile("s_waitcnt lgkmcnt(" #n ")" ::: "memory")
#define PG8_BAR __builtin_amdgcn_s_barrier()
#define PG8_SCHED __builtin_amdgcn_sched_barrier(0)
    Unit cur, nxt; int ui = 0;
    if (!S.next(0, cur)) return;
    f32x4 acc[2][2][4][2];
#pragma unroll
    for (int a = 0; a < 2; ++a)
#pragma unroll
        for (int b = 0; b < 2; ++b)
#pragma unroll
            for (int m = 0; m < 4; ++m)
#pragma unroll
                for (int n = 0; n < 2; ++n) acc[a][b][m][n] = (f32x4){0.f, 0.f, 0.f, 0.f};
    h8 At[4][2], B0[2][2], B1[2][2];
    const char* cA = (const char*)g.A + (size_t)cur.pm * tstep; const char* cB = (const char*)g.Bt + (size_t)cur.pn * tstep;
    PG8_STAGE(PG8_SB(0, 0), cB, voffB); PG8_STAGE(PG8_SB(0, 1), cB + hstepB, voffB); PG8_STAGE(PG8_SA(0, 0), cA, voffA); PG8_STAGE(PG8_SA(0, 1), cA + hstep, voffA);
    if (wr == 1) PG8_BAR;
    PG8_WAIT_V(2); PG8_BAR;
    PG8_STAGE(PG8_SB(1, 0), cB + kstep, voffB); PG8_STAGE(PG8_SA(1, 0), cA + kstep, voffA); PG8_STAGE(PG8_SB(1, 1), cB + hstepB + kstep, voffB);
    PG8_WAIT_V(6); PG8_BAR;
    for (;;) {
        const bool has_next = S.next(ui + 1, nxt);
        const char* nA = has_next ? (const char*)g.A + (size_t)nxt.pm * tstep : cA; const char* nB = has_next ? (const char*)g.Bt + (size_t)nxt.pn * tstep : cB;
        for (int t = 0; t < nt; t += 2) {
            const bool last = (t == nt - 2);
            const char* a1 = cA + (size_t)(t + 1) * kstep;
            const char* a2 = last ? nA : cA + (size_t)(t + 2) * kstep; const char* b2 = last ? nB : cB + (size_t)(t + 2) * kstep;
            const char* a3 = a2 + kstep; const char* b3 = b2 + kstep;
            PG8_LDB(B0, 0, 0); PG8_LDB(B1, 0, 1); PG8_SCHED; PG8_LDA(At, 0, 0); PG8_STAGE(PG8_SA(1, 1), a1 + hstep, voffA);
            PG8_WAIT_V(8); PG8_WAIT_L(0); PG8_BAR; PG8_MMA(0, 0, At, B0); PG8_MMA(0, 1, At, B1); PG8_BAR; PG8_SCHED;
            PG8_LDA(At, 0, 1); PG8_STAGE(PG8_SB(0, 0), b2, voffB); PG8_STAGE(PG8_SB(0, 1), b2 + hstepB, voffB); PG8_STAGE(PG8_SA(0, 0), a2, voffA);
            PG8_WAIT_V(8); PG8_WAIT_L(0); PG8_BAR; PG8_MMA(1, 0, At, B0); PG8_MMA(1, 1, At, B1); PG8_BAR; PG8_SCHED;
            PG8_LDB(B0, 1, 0); PG8_LDB(B1, 1, 1); PG8_SCHED; PG8_LDA(At, 1, 0); PG8_STAGE(PG8_SA(0, 1), a2 + hstep, voffA);
            PG8_WAIT_V(8); PG8_WAIT_L(0); PG8_BAR; PG8_MMA(0, 0, At, B0); PG8_MMA(0, 1, At, B1); PG8_BAR; PG8_SCHED;
            PG8_LDA(At, 1, 1); PG8_STAGE(PG8_SB(1, 0), b3, voffB); PG8_STAGE(PG8_SB(1, 1), b3 + hstepB, voffB); PG8_STAGE(PG8_SA(1, 0), a3, voffA);
            PG8_WAIT_V(8); PG8_WAIT_L(0); PG8_BAR; PG8_MMA(1, 0, At, B0); PG8_MMA(1, 1, At, B1); PG8_BAR; PG8_SCHED;
        }
        if (wr == 0) PG8_BAR;
        { SW_BEGIN(20); E(acc, cur, wr, wc, fr, fq); SW_END(20); }
        if (!has_next) break;
#pragma unroll
        for (int a = 0; a < 2; ++a)
#pragma unroll
            for (int b = 0; b < 2; ++b)
#pragma unroll
                for (int m = 0; m < 4; ++m)
#pragma unroll
                    for (int n = 0; n < 2; ++n) acc[a][b][m][n] = (f32x4){0.f, 0.f, 0.f, 0.f};
        cur = nxt; cA = nA; cB = nB; ++ui;
        if (wr == 1) PG8_BAR;
    }
    PG8_WAIT_V(0);
    PG8_BAR;
#undef PG8_SA
#undef PG8_SB
#undef PG8_STAGE
#undef PG8_LDA
#undef PG8_LDB
#undef PG8_MMA
#undef PG8_WAIT_V
#undef PG8_WAIT_L
#undef PG8_BAR
#undef PG8_SCHED
}
}

namespace att {
typedef short v4i16_t __attribute__((ext_vector_type(4)));
__device__ __forceinline__ int crow(int r, int hi) { return (r & 3) + 8 * (r >> 2) + 4 * hi; }
__device__ __forceinline__ int keyrow(int i) { return 32 * ((i >> 2) & 1) + (i & 3) + 4 * (i >> 3); }
__device__ __forceinline__ h4 vtr(const LAS unsigned char* p) { return __builtin_bit_cast(h4, __builtin_amdgcn_ds_read_tr16_b64_v4i16((LAS v4i16_t*)p)); }
__device__ __forceinline__ h8 cat8(h4 a, h4 b) { return (h8){a[0], a[1], a[2], a[3], b[0], b[1], b[2], b[3]}; }
#define MFMA32(a, b, c) __builtin_amdgcn_mfma_f32_32x32x16_f16(a, b, c, 0, 0, 0)
__device__ __forceinline__ h8 pack8(const f32x16& p, int b) {
    u32x4 w; w.x = pkh_rtz(p[b], p[b + 1]); w.y = pkh_rtz(p[b + 2], p[b + 3]); w.z = pkh_rtz(p[b + 4], p[b + 5]); w.w = pkh_rtz(p[b + 6], p[b + 7]);
    return __builtin_bit_cast(h8, w);
}
template <int KI> __device__ __forceinline__ float fmamk_s(float c, float base) {
    float r; asm volatile("v_fmamk_f32 %0, %1, %2, %3" : "=v"(r) : "v"(c), "i"(__builtin_bit_cast(int, (float)KI)), "v"(base)); return r; }
__device__ __forceinline__ float wave_sum(float v) {
#pragma unroll
    for (int o = 1; o < 64; o <<= 1) v += __shfl_xor(v, o);
    return v;
}
__device__ __forceinline__ float wave_max(float v) {
#pragma unroll
    for (int o = 1; o < 64; o <<= 1) v = fmaxf(v, __shfl_xor(v, o));
    return v;
}

__device__ __forceinline__ void glds16(const GAS void* g, unsigned lds_base) {
    unsigned sv; asm volatile("s_mov_b32 %0, m0\n\ts_mov_b32 m0, %2\n\ts_nop 0\n\tglobal_load_lds_dwordx4 %1, off\n\ts_mov_b32 m0, %0" : "=&s"(sv) : "v"(g), "s"(lds_base) : "memory"); }
#define WAIT_BAR(N) asm volatile("s_waitcnt vmcnt(" #N ") lgkmcnt(0)\n\ts_barrier" ::: "memory")
__device__ __forceinline__ void wait_bar_n(int n) {
    switch (n) { case 0: WAIT_BAR(0); break; case 2: WAIT_BAR(2); break; case 4: WAIT_BAR(4); break; case 6: WAIT_BAR(6); break; case 8: WAIT_BAR(8); break; case 10: WAIT_BAR(10); break;
                 case 12: WAIT_BAR(12); break; case 14: WAIT_BAR(14); break; case 16: WAIT_BAR(16); break; case 18: WAIT_BAR(18); break; case 20: WAIT_BAR(20); break; default: WAIT_BAR(0); break; }
}

constexpr int SB_SLOT = 65536, SB_FLG = 147456 + 2048;
__device__ __forceinline__ int keyrow16(int i) { return 16 * ((i >> 2) & 1) + (i & 3) + 4 * (i >> 3); }
struct SbUnit { int b, hg, cq; };
__device__ __forceinline__ bool sb_decode(int u, SbUnit& U) {
    if (u >= 1024) return false;
    const int r = u >> 8, v = u & 255, i = v & 15;
    U.b = v >> 4; U.hg = i & 1; U.cq = (i >> 1) + 8 * r; return true;
}
__device__ __forceinline__ void sb_phase(LAS unsigned char* lds, const GAS f16* __restrict__ proj, GAS f16* __restrict__ mixed, int vcu, int G, unsigned long long& sw_acc) {
    int tid_ = threadIdx.x; asm volatile("" : "+v"(tid_));
    const int tid = tid_, lane = tid & 63, l31 = lane & 31, hi = lane >> 5; const int w = __builtin_amdgcn_readfirstlane(tid >> 6);
    const int hh = w & 3, rgp = w >> 2;
    const unsigned lds0 = (unsigned)(uintptr_t)lds;
    const unsigned kdst = lds0 + w * 4096, vdst = lds0 + 32768 + w * 4096;
    int kfo[4];
    { const int kr = keyrow16(l31);
#pragma unroll
      for (int d0 = 0; d0 < 4; ++d0) kfo[d0] = kr * 512 + (((hh * 8 + 2 * d0 + hi) ^ (kr & 15)) * 16); }
    int vfo[2];
    { const int q_ = (lane & 15) >> 2;
#pragma unroll
      for (int d0 = 0; d0 < 2; ++d0) vfo[d0] = 32768 + (16 * hi + q_) * 512 + (((hh * 2 + d0) ^ q_) * 64) + ((lane >> 4) & 1) * 32 + (lane & 3) * 8; }
    LAS unsigned* flags = (LAS unsigned*)(lds + SB_FLG);
    size_t koff[4], voff[4];
#pragma unroll
    for (int i = 0; i < 4; ++i) { const int row = 8 * w + 2 * i + (lane >> 5), p = lane & 31;
        koff[i] = (size_t)row * PW + C_SBK + ((p ^ (row & 15)) * 8);
        voff[i] = (size_t)row * PW + C_SBV + ((((p >> 2) ^ (row & 3)) * 4 + (p & 3)) * 8); }
    const size_t qoff = (size_t)(32 * rgp + l31) * PW;
#define SB_DMA(base_, kt_, slot) do { const GAS f16* b_ = (base_) + (size_t)(kt_) * 64 * PW; const unsigned kd_ = (unsigned)__builtin_amdgcn_readfirstlane(kdst + (slot)), vd_ = (unsigned)__builtin_amdgcn_readfirstlane(vdst + (slot)); \
        _Pragma("unroll") for (int i_ = 0; i_ < 4; ++i_) { glds16(b_ + koff[i_], kd_ + i_ * 1024); glds16(b_ + voff[i_], vd_ + i_ * 1024); } } while (0)
    SbUnit U, Un; int ui = vcu;
    if (!sb_decode(ui, U)) return;
    int islot = 0, cslot = 0;
    const GAS f16* tbase = proj + ((size_t)U.b * SEQ) * PW + U.hg * 256;
    h8 qn[4]; u32x2 gn[8];
    { const size_t grow = (size_t)U.b * SEQ + U.cq * 64 + 32 * rgp + l31; const int h = 4 * U.hg + hh;
      const GAS f16* Qg = proj + grow * PW + C_SBQ + h * 64 + 8 * hi; const GAS f16* Gp = proj + grow * PW + C_SBG + h * 64 + 4 * hi;
#pragma unroll
      for (int d0 = 0; d0 < 4; ++d0) qn[d0] = *(const GAS h8*)(Qg + 16 * d0);
#pragma unroll
      for (int i = 0; i < 8; ++i) gn[i] = *(const GAS u32x2*)(Gp + 8 * i); }
    asm volatile("" : "+v"(qn[0]), "+v"(qn[1]), "+v"(qn[2]), "+v"(qn[3]));
    SB_DMA(tbase, U.cq, islot); islot ^= SB_SLOT;
    for (;;) {
        const size_t rowbase = (size_t)U.b * SEQ;
        const int qw = U.cq * 64 + 32 * rgp, t = qw + l31, NT = U.cq + 1, h = 4 * U.hg + hh;
        const size_t grow = rowbase + qw + l31;
        h8 qr[4]; u32x2 gv[8];
#pragma unroll
        for (int d0 = 0; d0 < 4; ++d0) qr[d0] = qn[d0];
#pragma unroll
        for (int i = 0; i < 8; ++i) gv[i] = gn[i];
        const bool has_next = sb_decode(ui + G, Un);
        f32x16 o[2]; o[0] = f32x16{}; o[1] = f32x16{};
        float carry = 1.f; int done = 0;
        SW_BEGIN(12);
        for (int j = 0; j < NT; ++j) {
            SW_BEGIN(13);
            WAIT_BAR(0);
            SW_END(13);
            if (j > 0) {
                const u32x4 f0 = *(const LAS u32x4*)(flags + ((j - 1) & 1) * 8), f1 = *(const LAS u32x4*)(flags + ((j - 1) & 1) * 8 + 4);
                const unsigned any = (f0.x | f0.y | f0.z | f0.w) | (f1.x | f1.y | f1.z | f1.w);
                if (!__builtin_amdgcn_readfirstlane(any)) break;
            }
            if (j + 1 < NT) { SB_DMA(tbase, U.cq - (j + 1), islot); islot ^= SB_SLOT; }
            const int kt = U.cq - j;
#pragma unroll
            for (int sub = 0; sub < 2; ++sub) {
                const int kb32 = sub == 0 ? 32 : 0;
                const bool diag = (j == 0) && (sub == (rgp == 1 ? 0 : 1));
                const bool skip = (j == 0) && (rgp == 0) && (sub == 0);
                if (!done && !skip) {
                    const LAS unsigned char* Sb = lds + cslot + kb32 * 512;
                    f32x16 p = f32x16{};
#pragma unroll
                    for (int d0 = 0; d0 < 4; ++d0) { const h8 k0 = *(const LAS h8*)(Sb + kfo[d0]); p = MFMA32(k0, qr[d0], p); }
#pragma unroll
                    for (int r = 0; r < 16; ++r) p[r] = __builtin_amdgcn_rcpf(1.0f + __builtin_amdgcn_exp2f(-p[r]));
                    if (diag) {
                        const int key0 = 64 * kt + kb32 + 16 * hi;
#pragma unroll
                        for (int r = 0; r < 16; ++r) if (key0 + r >= t) p[r] = 0.f;
                    }
                    float run = 1.f;
#pragma unroll
                    for (int r = 15; r >= 0; --r) { const float a = run * p[r]; run -= a; p[r] = a; }
                    const auto rr = __builtin_amdgcn_permlane32_swap(__float_as_uint(run), __float_as_uint(run), false, false);
                    const float T0 = __uint_as_float(rr[0]), T1 = __uint_as_float(rr[1]);
                    const float E = carry * (hi ? 1.0f : T1);
                    carry = carry * (T0 * T1);
#pragma unroll
                    for (int r = 0; r < 16; ++r) p[r] *= E;
                    const h8 pa0 = pack8(p, 0), pa1 = pack8(p, 8);
#pragma unroll
                    for (int d0 = 0; d0 < 2; ++d0) {
                        const LAS unsigned char* Vb = Sb + vfo[d0];
                        const h8 v0 = cat8(vtr(Vb), vtr(Vb + 2048));
                        const h8 v1 = cat8(vtr(Vb + 4096), vtr(Vb + 6144));
                        o[d0] = MFMA32(v0, pa0, o[d0]); o[d0] = MFMA32(v1, pa1, o[d0]);
                    }
#if SB_EARLY_EXIT
                    done = __builtin_amdgcn_readfirstlane(__all(carry < 1.0e-37f) ? 1 : 0);
#endif
                }
            }
            if (lane == 0) flags[(j & 1) * 8 + w] = done ? 0u : 1u;
            cslot ^= SB_SLOT;
        }
        asm volatile("s_nop 15\n\ts_nop 7" : "+v"(o[0]), "+v"(o[1]));
        SW_END(12);
        cslot = islot;
        if (has_next) {
            const size_t grown = (size_t)Un.b * SEQ + Un.cq * 64 + 32 * rgp + l31; const int hn = 4 * Un.hg + hh;
            const GAS f16* Qg = proj + grown * PW + C_SBQ + hn * 64 + 8 * hi; const GAS f16* Gp = proj + grown * PW + C_SBG + hn * 64 + 4 * hi;
#pragma unroll
            for (int d0 = 0; d0 < 4; ++d0) qn[d0] = *(const GAS h8*)(Qg + 16 * d0);
#pragma unroll
            for (int i = 0; i < 8; ++i) gn[i] = *(const GAS u32x2*)(Gp + 8 * i);
            asm volatile("" ::: "memory");
            tbase = proj + ((size_t)Un.b * SEQ) * PW + Un.hg * 256;
            SB_DMA(tbase, Un.cq, islot); islot ^= SB_SLOT;
        }
        {
            GAS f16* Op = mixed + grow * DM + h * 64 + 4 * hi;
#pragma unroll
            for (int d0 = 0; d0 < 2; ++d0)
#pragma unroll
                for (int rg4 = 0; rg4 < 4; ++rg4) {
                    const h4 g = __builtin_bit_cast(h4, gv[d0 * 4 + rg4]);
                    u32x2 wv; wv.x = pkh(o[d0][4 * rg4] * (float)g[0], o[d0][4 * rg4 + 1] * (float)g[1]); wv.y = pkh(o[d0][4 * rg4 + 2] * (float)g[2], o[d0][4 * rg4 + 3] * (float)g[3]);
                    *(GAS u32x2*)(Op + 32 * d0 + 8 * rg4) = wv;
                }
        }
        if (!has_next) break;
        U = Un; ui += G;
    }
#undef SB_DMA
    WAIT_BAR(0);
}

constexpr int DA_KS = 16384, DA_VRING = 49152, DA_XCH = 114688, DA_SUBG = 147456 + 1024, DA_SSX = 147456 + 3072;
struct DaUnit { int b, h, qt, klo; };
__device__ __forceinline__ int da_qt_of(int r, int i) {
    constexpr unsigned long long Q1 = 0xE92B6AF78C01D543ull, Q2 = 0x6C5B3014A78D29FEull, Q3 = 0x21F0DC6B43E87A59ull;
    return r == 0 ? i : (int)(((r == 1 ? Q1 : r == 2 ? Q2 : Q3) >> (4 * i)) & 15ull);
}
__device__ __forceinline__ int da_klo(int qt, int h) {
    const float cs = exp2f(-2.0f * (float)(h + 1)) * LOG2E;
    const int D = (int)ceilf(160.5f / cs), m = qt * 128 - D - 63;
    return m > 0 ? (m + 63) >> 6 : 0;
}
__device__ __forceinline__ bool da_decode(int u, DaUnit& U) {
    if (u >= 1024) return false;
    const int r = u >> 8, v = u & 255;
    U.b = v >> 4; U.h = r; U.qt = da_qt_of(r, v & 15); U.klo = da_klo(U.qt, U.h); return true;
}
__device__ __forceinline__ void da_pv(f32x16 (&o)[4], const LAS unsigned char* Vs, const int (&vfo)[4], h8 pa0, h8 pa1, h8 pa2, h8 pa3) {
    h8 f0, f1, f2, f3, g0, g1, g2, g3;
    { const LAS unsigned char* Vb = Vs + vfo[0]; f0 = cat8(vtr(Vb), vtr(Vb + 1024)); f1 = cat8(vtr(Vb + 2048), vtr(Vb + 3072)); f2 = cat8(vtr(Vb + 4096), vtr(Vb + 5120)); f3 = cat8(vtr(Vb + 6144), vtr(Vb + 7168)); }
#pragma unroll
    for (int d0 = 0; d0 < 4; ++d0) {
        if (d0 < 3) { const LAS unsigned char* Vb = Vs + vfo[d0 + 1]; g0 = cat8(vtr(Vb), vtr(Vb + 1024)); g1 = cat8(vtr(Vb + 2048), vtr(Vb + 3072)); g2 = cat8(vtr(Vb + 4096), vtr(Vb + 5120)); g3 = cat8(vtr(Vb + 6144), vtr(Vb + 7168)); }
        o[d0] = MFMA32(f0, pa0, o[d0]); o[d0] = MFMA32(f1, pa1, o[d0]); o[d0] = MFMA32(f2, pa2, o[d0]); o[d0] = MFMA32(f3, pa3, o[d0]);
        if (d0 < 3) { f0 = g0; f1 = g1; f2 = g2; f3 = g3; }
    }
}
__device__ __forceinline__ void da_phase(LAS unsigned char* lds, const GAS f16* __restrict__ proj, GAS f16* __restrict__ mixed, int vcu, int G,
                                         float lam, float mref, const GAS float* __restrict__ subg, float osc, unsigned long long& sw_acc) {
    int tid_ = threadIdx.x; asm volatile("" : "+v"(tid_));
    const int tid = tid_, lane = tid & 63, l31 = lane & 31, hi = lane >> 5; const int w = __builtin_amdgcn_readfirstlane(tid >> 6);
    const int c = w >> 2, rg = w & 3;
    const unsigned lds0 = (unsigned)(uintptr_t)lds;
    const unsigned kdst = lds0 + w * 1024, vdst = lds0 + DA_VRING + w * 1024;
    int kfo[4];
    { const int kr = keyrow(l31);
#pragma unroll
      for (int d0 = 0; d0 < 4; ++d0) kfo[d0] = kr * 256 + (((8 * c + 2 * d0 + hi) ^ (kr & 15)) * 16); }
    int vfo[4];
    { const int q_ = (lane & 15) >> 2;
#pragma unroll
      for (int d0 = 0; d0 < 4; ++d0) vfo[d0] = DA_VRING + (32 * hi + q_) * 256 + ((d0 ^ q_) * 64) + ((lane >> 4) & 1) * 32 + (lane & 3) * 8; }
    const int srow = 4 * w + (lane >> 4);
    const size_t koff = (size_t)srow * PW + C_DAK + (((lane & 15) ^ (srow & 15)) * 8);
    const size_t voff = (size_t)srow * PW + C_DAV + (((((lane & 15) >> 2) ^ (srow & 3)) * 4 + (lane & 3)) * 8);
    const size_t qoff = (size_t)(32 * rg + l31) * PW + C_DAQ + c * 64 + 8 * hi;
    if (tid < 128) ((LAS float*)(lds + DA_SUBG))[tid] = subg[tid];
    LAS unsigned* xch = (LAS unsigned*)(lds + DA_XCH + rg * 8192);
#define DA_DMA(ks_, vs_, kt_, kslot, vslot) do { const size_t go_ = (size_t)(kt_) * 64 * PW; const unsigned kd_ = (unsigned)__builtin_amdgcn_readfirstlane(kdst + (kslot)), vd_ = (unsigned)__builtin_amdgcn_readfirstlane(vdst + (vslot)); \
        glds16((ks_) + go_, kd_); glds16((ks_) + go_ + (size_t)32 * PW, kd_ + 8192); glds16((vs_) + go_, vd_); glds16((vs_) + go_ + (size_t)32 * PW, vd_ + 8192); } while (0)
#define DA_NEXT_K(s) ((s) == 2 * DA_KS ? 0 : (s) + DA_KS)
#define DA_NEXT_V(s) ((s) == 3 * DA_KS ? 0 : (s) + DA_KS)
    DaUnit U, Un; int ui = vcu;
    if (!da_decode(ui, U)) return;
    const GAS f16* ksrc = proj + ((size_t)U.b * SEQ) * PW + U.h * 128 + koff; const GAS f16* vsrc = proj + ((size_t)U.b * SEQ) * PW + U.h * 128 + voff;
    h8 qn[4];
    { const GAS f16* Qg = proj + ((size_t)U.b * SEQ + U.qt * 128) * PW + qoff + U.h * 128;
#pragma unroll
      for (int d0 = 0; d0 < 4; ++d0) qn[d0] = *(const GAS h8*)(Qg + 16 * d0); }
    asm volatile("" : "+v"(qn[0]), "+v"(qn[1]), "+v"(qn[2]), "+v"(qn[3]));
    DA_DMA(ksrc, vsrc, U.klo, 0, 0); DA_DMA(ksrc, vsrc, U.klo + 1, DA_KS, DA_KS);
    int ik = 2 * DA_KS, iv = 2 * DA_KS, ck = 0, cv = 0;
    for (;;) {
        const size_t rowbase = (size_t)U.b * SEQ;
        const int qw = U.qt * 128 + 32 * rg, t = qw + l31, lastt = qw >> 6, NT = 2 * U.qt + 2;
        const float cslope = exp2f(-2.0f * (float)(U.h + 1)) * LOG2E;
        const float cs64 = 64.0f * cslope, base0 = -cslope * (float)(t - 32 * hi) - mref;
        h8 qr[4];
#pragma unroll
        for (int d0 = 0; d0 < 4; ++d0) qr[d0] = qn[d0];
        const size_t grow = rowbase + qw + l31;
        const bool has_next = da_decode(ui + G, Un);
        const GAS f16* ksn = ksrc; const GAS f16* vsn = vsrc;
        if (has_next) { ksn = proj + ((size_t)Un.b * SEQ) * PW + Un.h * 128 + koff; vsn = proj + ((size_t)Un.b * SEQ) * PW + Un.h * 128 + voff; }
        f32x16 o[4]; o[0] = f32x16{}; o[1] = f32x16{}; o[2] = f32x16{}; o[3] = f32x16{};
        float lsum = 0.f;
        h8 pq0, pq1, pq2, pq3;
        int pvs = 0;
        SW_BEGIN(2);
        for (int kt = U.klo; kt < NT; ++kt) {
            SW_BEGIN(3);
            if (kt + 1 < NT || has_next) WAIT_BAR(4); else WAIT_BAR(0);
            SW_END(3);
#define DA_ISSUE() do { if (kt + 2 < NT) { DA_DMA(ksrc, vsrc, kt + 2, ik, iv); ik = DA_NEXT_K(ik); iv = DA_NEXT_V(iv); } \
            else if (has_next) { DA_DMA(ksn, vsn, Un.klo + kt + 2 - NT, ik, iv); ik = DA_NEXT_K(ik); iv = DA_NEXT_V(iv); } } while (0)
            DA_ISSUE();
            if (c == 1 && kt > U.klo && kt - 1 <= lastt) da_pv(o, lds + pvs, vfo, pq0, pq1, pq2, pq3);
            if (kt <= lastt) {
                const LAS unsigned char* Ks = lds + ck;
                f32x16 p0, p1;
                const float basek = __builtin_fmaf(cs64, (float)kt, base0);
                __builtin_amdgcn_sched_barrier(0);
                asm volatile("s_nop 7" ::: "memory");
#define DA_INIT(r) p0[r] = fmamk_s<r>(cslope, basek); p1[r] = fmamk_s<16 + r>(cslope, basek);
                DA_INIT(0) DA_INIT(1) DA_INIT(2) DA_INIT(3) DA_INIT(4) DA_INIT(5) DA_INIT(6) DA_INIT(7) DA_INIT(8) DA_INIT(9) DA_INIT(10) DA_INIT(11) DA_INIT(12) DA_INIT(13) DA_INIT(14) DA_INIT(15)
#undef DA_INIT
                asm volatile("s_nop 3" : "+v"(p0), "+v"(p1));
                if (kt == lastt) {
                    const int kd = t - (64 * kt + 32 * hi);
                    const float m2 = -2.0f * mref;
                    asm volatile("" ::: "memory");
#pragma unroll
                    for (int r = 0; r < 16; ++r) { if (r > kd) p0[r] = m2 - p0[r]; if (16 + r > kd) p1[r] = m2 - p1[r]; }
                }
#pragma unroll
                for (int d0 = 0; d0 < 4; ++d0) { const h8 ka = *(const LAS h8*)(Ks + kfo[d0]), kb = *(const LAS h8*)(Ks + kfo[d0] + 4096); p0 = MFMA32(ka, qr[d0], p0); p1 = MFMA32(kb, qr[d0], p1); }
                float s0 = 0.f, s1 = 0.f, s2 = 0.f, s3 = 0.f;
#pragma unroll
                for (int r = 0; r < 16; ++r) { p0[r] = __builtin_amdgcn_exp2f(p0[r]); p1[r] = __builtin_amdgcn_exp2f(p1[r]); }

#pragma unroll
                for (int r = 0; r < 16; r += 2) { s0 += p0[r]; s1 += p0[r + 1]; s2 += p1[r]; s3 += p1[r + 1]; }
                lsum += (s0 + s1) + (s2 + s3);
                pq0 = pack8(p0, 0); pq1 = pack8(p0, 8); pq2 = pack8(p1, 0); pq3 = pack8(p1, 8); pvs = cv;
                if (c == 0) da_pv(o, lds + cv, vfo, pq0, pq1, pq2, pq3);
            }
            ck = DA_NEXT_K(ck); cv = DA_NEXT_V(cv);
        }
        if (c == 1 && NT - 1 <= lastt) da_pv(o, lds + pvs, vfo, pq0, pq1, pq2, pq3);
        asm volatile("s_nop 15\n\ts_nop 7" : "+v"(o[0]), "+v"(o[1]), "+v"(o[2]), "+v"(o[3]));
        SW_END(2);
        const int dlo = 2 * c;
        u32x2 gv[8];
        { const GAS f16* Gp = proj + grow * PW + C_DAG + U.h * 128 + 32 * dlo + 4 * hi;
#pragma unroll
          for (int i = 0; i < 8; ++i) gv[i] = *(const GAS u32x2*)(Gp + 8 * i); }
        if (has_next) { const GAS f16* Qg = proj + ((size_t)Un.b * SEQ + Un.qt * 128) * PW + qoff + Un.h * 128;
#pragma unroll
            for (int d0 = 0; d0 < 4; ++d0) qn[d0] = *(const GAS h8*)(Qg + 16 * d0); }
        asm volatile("" ::: "memory");
        { const auto rr = __builtin_amdgcn_permlane32_swap(__float_as_uint(lsum), __float_as_uint(lsum), false, false); lsum = __uint_as_float(rr[0]) + __uint_as_float(rr[1]); }
        const float f = (c == 0 ? 1.0f : lam) / lsum;
        LAS unsigned* xw = xch + (c ^ 1) * 1024;
        LAS unsigned* xr = xch + c * 1024;
        f32x16 ya, yb;
        if (c == 0) {
#pragma unroll
            for (int r2 = 0; r2 < 8; ++r2) { xw[r2 * 64 + lane] = pkh(o[2][2 * r2] * f, o[2][2 * r2 + 1] * f); xw[(8 + r2) * 64 + lane] = pkh(o[3][2 * r2] * f, o[3][2 * r2 + 1] * f); }
            ya = o[0] * f; yb = o[1] * f;
        } else {
#pragma unroll
            for (int r2 = 0; r2 < 8; ++r2) { xw[r2 * 64 + lane] = pkh(o[0][2 * r2] * f, o[0][2 * r2 + 1] * f); xw[(8 + r2) * 64 + lane] = pkh(o[1][2 * r2] * f, o[1][2 * r2 + 1] * f); }
            ya = o[2] * f; yb = o[3] * f;
        }
        asm volatile("s_waitcnt lgkmcnt(0)\n\ts_barrier" ::: "memory");
        const float sgn = (c == 0) ? 1.0f : -1.0f;
        float ss = 0.f;
#pragma unroll
        for (int r2 = 0; r2 < 8; ++r2) {
            const h2 pa = __builtin_bit_cast(h2, xr[r2 * 64 + lane]), pb = __builtin_bit_cast(h2, xr[(8 + r2) * 64 + lane]);
            const float a0 = (ya[2 * r2] - (float)pa[0]) * sgn, a1 = (ya[2 * r2 + 1] - (float)pa[1]) * sgn, b0 = (yb[2 * r2] - (float)pb[0]) * sgn, b1 = (yb[2 * r2 + 1] - (float)pb[1]) * sgn;
            ya[2 * r2] = a0; ya[2 * r2 + 1] = a1; yb[2 * r2] = b0; yb[2 * r2 + 1] = b1; ss += (a0 * a0 + a1 * a1) + (b0 * b0 + b1 * b1);
        }
        { const auto rr = __builtin_amdgcn_permlane32_swap(__float_as_uint(ss), __float_as_uint(ss), false, false); ss = __uint_as_float(rr[0]) + __uint_as_float(rr[1]); }
        LAS float* ssx = (LAS float*)(lds + DA_SSX + rg * 256);
        if (hi == 0) ssx[c * 32 + l31] = ss;
        asm volatile("s_waitcnt lgkmcnt(0)\n\ts_barrier" ::: "memory");
        ss += ssx[(c ^ 1) * 32 + l31];
        const float rn = __builtin_amdgcn_rsqf(ss * (1.0f / 128.0f) + RMS_EPS) * osc;
        {
            const LAS float* sgl = (const LAS float*)(lds + DA_SUBG) + 32 * dlo + 4 * hi;
            GAS f16* Op = mixed + grow * DM + 512 + U.h * 128 + 32 * dlo + 4 * hi;
#pragma unroll
            for (int rg4 = 0; rg4 < 4; ++rg4) {
                const h4 g = __builtin_bit_cast(h4, gv[rg4]);
                const f32x4 sg = *(const LAS f32x4*)(sgl + 8 * rg4);
                u32x2 wv;
                wv.x = pkh(ya[4 * rg4] * rn * sg[0] * (float)g[0], ya[4 * rg4 + 1] * rn * sg[1] * (float)g[1]);
                wv.y = pkh(ya[4 * rg4 + 2] * rn * sg[2] * (float)g[2], ya[4 * rg4 + 3] * rn * sg[3] * (float)g[3]);
                *(GAS u32x2*)(Op + 8 * rg4) = wv;
            }
#pragma unroll
            for (int rg4 = 0; rg4 < 4; ++rg4) {
                const h4 g = __builtin_bit_cast(h4, gv[4 + rg4]);
                const f32x4 sg = *(const LAS f32x4*)(sgl + 32 + 8 * rg4);
                u32x2 wv;
                wv.x = pkh(yb[4 * rg4] * rn * sg[0] * (float)g[0], yb[4 * rg4 + 1] * rn * sg[1] * (float)g[1]);
                wv.y = pkh(yb[4 * rg4 + 2] * rn * sg[2] * (float)g[2], yb[4 * rg4 + 3] * rn * sg[3] * (float)g[3]);
                *(GAS u32x2*)(Op + 32 + 8 * rg4) = wv;
            }
        }
        if (!has_next) break;
        U = Un; ui += G; ksrc = ksn; vsrc = vsn;
    }
#undef DA_DMA
#undef DA_ISSUE
#undef DA_NEXT_K
#undef DA_NEXT_V
    WAIT_BAR(0);
}
}

constexpr size_t MiB = 1u << 20;
constexpr size_t WS_CTL = 0, CTL_ZERO_BYTES = 64 * 1024;
constexpr size_t WS_WIN = 2 * MiB;
constexpr size_t WS_WOUT = 18 * MiB;
constexpr size_t WS_PART = 22 * MiB;
constexpr size_t WS_XB = 32 * MiB;
constexpr size_t WS_MIX = 96 * MiB;
constexpr size_t WS_PROJ = 160 * MiB;
constexpr size_t WS_END = 416 * MiB;
constexpr int CW_BAR = 4096;

constexpr int RING_OFF = 0, RING_BYTES = 131072;
constexpr int LDSCTL_OFF = 147456, MISC_OFF = LDSCTL_OFF + 320;
constexpr int LDS_BYTES = 163840;
constexpr int NWAVES = 8;

typedef GAS unsigned gu32;
#define LDS_WAIT() asm volatile("s_waitcnt lgkmcnt(0)" ::: "memory")

#define XB_TMO      128
#define XB_XCNT(j)  (256  + 64 * (j))
#define XB_XSUB(j)  (1280 + 64 * (j))
#define XB_XGEN(j)  (2304 + 64 * (j))
#define XB_TOP      3328
#define XB_TOPGEN   3392
#define XCD_BAR_WORDS 3456
#define XB_SPIN_CAP (1u << 18)
__device__ __forceinline__ unsigned xb_ld(unsigned* p)              { return __hip_atomic_load(p, __ATOMIC_RELAXED, __HIP_MEMORY_SCOPE_AGENT); }
__device__ __forceinline__ unsigned xb_add(unsigned* p, unsigned v) { return __hip_atomic_fetch_add(p, v, __ATOMIC_RELAXED, __HIP_MEMORY_SCOPE_AGENT); }
__device__ __forceinline__ unsigned xb_xcc_id() { return (unsigned)__builtin_amdgcn_s_getreg((3 << 11) | 20) & 0xFu; }
#define XB_SPIN(cond, bar) do { unsigned _sp = 0; while (cond) { __builtin_amdgcn_s_sleep(1); \
    if ((++_sp & 255u) == 0u) { if (xb_ld(&(bar)[XB_TMO])) break; if (_sp > XB_SPIN_CAP) { atomicAdd(&(bar)[XB_TMO], 1u); break; } } } } while (0)
struct XcdBarrier { unsigned* bar; unsigned x; volatile LAS unsigned* st; };
__device__ __forceinline__ XcdBarrier xcd_barrier_post(unsigned* bar, volatile LAS unsigned* st) {
    XcdBarrier b; b.bar = bar; b.x = xb_xcc_id(); b.st = st;
    if (threadIdx.x == 0) (void)xb_add(&bar[XB_XCNT(b.x)], 1u);
    return b;
}
__device__ __forceinline__ void xcd_barrier_complete(unsigned* bar, unsigned x, unsigned& nloc, unsigned& nx) {
    const unsigned G = gridDim.x * gridDim.y * gridDim.z;
    unsigned sum, cnt, mine, sp = 0u;
    for (;;) {
        sum = 0u; cnt = 0u; mine = 0u;
#pragma unroll
        for (unsigned j = 0; j < 16; ++j) { const unsigned c = xb_ld(&bar[XB_XCNT(j)]); sum += c; cnt += (c > 0u) ? 1u : 0u; mine = (j == x) ? c : mine; }
        if (sum == G) break;
        __builtin_amdgcn_s_sleep(1);
        if ((++sp & 255u) == 0u) { if (xb_ld(&bar[XB_TMO])) break; if (sp > XB_SPIN_CAP) { atomicAdd(&bar[XB_TMO], 1u); break; } }
    }
    nloc = mine > 0u ? mine : 1u; nx = cnt > 0u ? cnt : 1u;
}
__device__ __forceinline__ void xcd_barrier(const XcdBarrier& b) {
    asm volatile("s_waitcnt vmcnt(0)" ::: "memory");
    __syncthreads();
    if (threadIdx.x == 0) {
        unsigned* bar = b.bar;
        __builtin_amdgcn_s_waitcnt(0);
        unsigned nloc = b.st[0], nx = b.st[1];
        if (nloc == 0u) { xcd_barrier_complete(bar, b.x, nloc, nx); b.st[0] = nloc; b.st[1] = nx; }
        const unsigned old = xb_add(&bar[XB_XSUB(b.x)], 1u);
        const unsigned gen = old / nloc;
        if (old + 1u == (gen + 1u) * nloc) {
            __builtin_amdgcn_fence(__ATOMIC_RELEASE, "agent");
            asm volatile("s_waitcnt vmcnt(0)" ::: "memory");
            const unsigned og = xb_add(&bar[XB_TOP], 1u);
            const unsigned tg = og / nx;
            if (og + 1u == (tg + 1u) * nx) xb_add(&bar[XB_TOPGEN], 1u);
            else XB_SPIN(xb_ld(&bar[XB_TOPGEN]) == tg, bar);
            __builtin_amdgcn_fence(__ATOMIC_ACQUIRE, "agent");
            xb_add(&bar[XB_XGEN(b.x)], 1u);
            asm volatile("s_waitcnt vmcnt(0)" ::: "memory");
        } else {
            XB_SPIN(xb_ld(&bar[XB_XGEN(b.x)]) == gen, bar);
            __builtin_amdgcn_fence(__ATOMIC_ACQUIRE, "agent");
            asm volatile("s_waitcnt vmcnt(0)" ::: "memory");
        }
    }
    __syncthreads();
}

__device__ __forceinline__ void p0_transpose_item(const float* W, const float* g, int K, int N, f16* WT, LAS float* scr, int item, int lane) {
    const int nblk = N / 32, kb = item / nblk, nb = item % nblk, k0 = 32 * kb, n0 = 32 * nb;
    float v[16];
#pragma unroll
    for (int i = 0; i < 16; ++i) { const int kk = 2 * i + (lane >> 5); v[i] = __builtin_nontemporal_load(W + (size_t)(k0 + kk) * N + n0 + (lane & 31)); }
    if (g) {
#pragma unroll
        for (int i = 0; i < 16; ++i) v[i] *= g[k0 + 2 * i + (lane >> 5)];
    }
#pragma unroll
    for (int i = 0; i < 16; ++i) scr[(2 * i + (lane >> 5)) * 33 + (lane & 31)] = v[i];
    LDS_WAIT(); asm volatile("" ::: "memory");
    const int c = lane & 3;
#pragma unroll
    for (int j = 0; j < 2; ++j) { const int n = (lane >> 2) + 16 * j; const LAS float* sp = scr + (8 * c) * 33 + n;
        u32x4 o; o.x = pkh(sp[0 * 33], sp[1 * 33]); o.y = pkh(sp[2 * 33], sp[3 * 33]); o.z = pkh(sp[4 * 33], sp[5 * 33]); o.w = pkh(sp[6 * 33], sp[7 * 33]);
        *(GAS u32x4*)(WT + (size_t)(n0 + n) * K + k0 + 8 * c) = o; }
    LDS_WAIT(); asm volatile("" ::: "memory");
}
__device__ __forceinline__ void x_rows4(const float* x, f16* xb, float* part, int m0, int stride, int lane) {
    f32x4 v[4][4];
#pragma unroll
    for (int r = 0; r < 4; ++r) { const GAS f32x4* xr = (const GAS f32x4*)(x + (size_t)(m0 + r * stride) * DM) + lane;
#pragma unroll
        for (int j = 0; j < 4; ++j) v[r][j] = __builtin_nontemporal_load(xr + 64 * j); }
#pragma unroll
    for (int r = 0; r < 4; ++r) {
        float s = 0.f;
#pragma unroll
        for (int j = 0; j < 4; ++j) s += (v[r][j][0] * v[r][j][0] + v[r][j][1] * v[r][j][1]) + (v[r][j][2] * v[r][j][2] + v[r][j][3] * v[r][j][3]);
        s = att::wave_sum(s);
        const size_t row = (size_t)(m0 + r * stride);
        GAS u32x2* o8 = (GAS u32x2*)(xb + row * DM) + lane;
#pragma unroll
        for (int j = 0; j < 4; ++j) { u32x2 w; w.x = pkh(v[r][j][0], v[r][j][1]); w.y = pkh(v[r][j][2], v[r][j][3]); o8[64 * j] = w; }
        if (lane < 16) part[row * 16 + lane] = (lane == 0) ? s : 0.f;
    }
}

__device__ __forceinline__ void x_row1(const float* x, f16* xb, float* part, int m, int lane) {
    const GAS f32x4* xr = (const GAS f32x4*)(x + (size_t)m * DM) + lane;
    f32x4 v[4]; float s = 0.f;
#pragma unroll
    for (int j = 0; j < 4; ++j) { v[j] = xr[64 * j]; s += (v[j][0] * v[j][0] + v[j][1] * v[j][1]) + (v[j][2] * v[j][2] + v[j][3] * v[j][3]); }
    s = att::wave_sum(s);
    GAS u32x2* o8 = (GAS u32x2*)(xb + (size_t)m * DM) + lane;
#pragma unroll
    for (int j = 0; j < 4; ++j) { u32x2 w; w.x = pkh(v[j][0], v[j][1]); w.y = pkh(v[j][2], v[j][3]); o8[64 * j] = w; }
    if (lane < 16) part[(size_t)m * 16 + lane] = (lane == 0) ? s : 0.f;
}

struct Args { const float* in[11]; float* out; unsigned char* ws; };
__global__ void __launch_bounds__(NWAVES * 64, 2) hybrid_fwd(Args args) {
    extern __shared__ __attribute__((aligned(16))) unsigned char lds_raw[];
    LAS unsigned char* lds = (LAS unsigned char*)lds_raw;
    volatile LAS unsigned* MISC = (volatile LAS unsigned*)(lds + MISC_OFF);
    const int tid = threadIdx.x, lane = tid & 63, wave = __builtin_amdgcn_readfirstlane(tid >> 6);
    const int G = gridDim.x; const int bx = blockIdx.x; const int vcu = (G % 8 == 0) ? (bx % 8) * (G / 8) + bx / 8 : bx;
    unsigned char* ws = args.ws;
    gu32* ctl = (gu32*)(ws + WS_CTL);
    const float* x = args.in[0]; const float* norm_g = args.in[1]; const float* w_in = args.in[2]; const float* w_out = args.in[3];
    const float* q_norm_g = args.in[4]; const float* k_norm_g = args.in[5];
    const float* lq1 = args.in[6]; const float* lk1 = args.in[7]; const float* lq2 = args.in[8]; const float* lk2 = args.in[9]; const float* subln_g = args.in[10];
    float* out = args.out;
    GAS unsigned char* wsg = (GAS unsigned char*)ws;
    GAS f16* WIN = (GAS f16*)(wsg + WS_WIN); GAS f16* WOUT = (GAS f16*)(wsg + WS_WOUT); GAS float* PART = (GAS float*)(wsg + WS_PART);
    GAS f16* XB = (GAS f16*)(wsg + WS_XB); GAS f16* MIX = (GAS f16*)(wsg + WS_MIX); GAS f16* PROJ = (GAS f16*)(wsg + WS_PROJ);

    unsigned long long sw_acc = 0;
    for (int u = tid; u < (LDS_BYTES - LDSCTL_OFF) / 4; u += NWAVES * 64) ((LAS unsigned*)(lds + LDSCTL_OFF))[u] = 0u;
    __syncthreads();
    XcdBarrier bar = xcd_barrier_post((unsigned*)(ctl + CW_BAR), MISC + 8);

    SW_BEGIN(6);
    for (int rep = 0; rep < REP_PRO; ++rep) {
        LAS float* scr = (LAS float*)(lds + RING_OFF + wave * 16384);
        const int gw = vcu * NWAVES + wave, NGW = G * NWAVES;
        constexpr int I_IN = (DM / 32) * (PW / 32), I_OUT = (DM / 32) * (DM / 32);
        constexpr int NITEMS = DEPTH * (I_IN + I_OUT);
        SW_BEGIN(9);
        for (int it = gw; it < NITEMS; it += NGW) {
            int r = it; const int l = r / (I_IN + I_OUT); r -= l * (I_IN + I_OUT);
            if (r < I_IN) p0_transpose_item(w_in + (size_t)l * DM * PW, norm_g + l * DM, DM, PW, (f16*)WIN + (size_t)l * PW * DM, scr, r, lane);
            else p0_transpose_item(w_out + (size_t)l * DM * DM, nullptr, DM, DM, (f16*)WOUT + (size_t)l * DM * DM, scr, r - I_IN, lane);
        }
        SW_END(9);
        SW_BEGIN(10);
        { int m = gw; for (; m + 3 * NGW < MROWS; m += 4 * NGW) x_rows4(x, (f16*)XB, (float*)PART, m, NGW, lane); for (; m < MROWS; m += NGW) x_row1(x, (f16*)XB, (float*)PART, m, lane); }
        SW_END(10);
    }
    SW_END(6);
    { SW_BEGIN(7); xcd_barrier(bar); SW_END(7); }

    for (int l = 0; l < DEPTH; ++l) {
        { GAS unsigned char* wsl = wsg; asm volatile("" : "+s"(wsl)); WIN = (GAS f16*)(wsl + WS_WIN); WOUT = (GAS f16*)(wsl + WS_WOUT); PART = (GAS float*)(wsl + WS_PART); XB = (GAS f16*)(wsl + WS_XB); MIX = (GAS f16*)(wsl + WS_MIX); PROJ = (GAS f16*)(wsl + WS_PROJ);
          asm volatile("" : "+s"(out)); asm volatile("" : "+s"(x)); asm volatile("" : "+s"(subln_g)); asm volatile("" : "+s"(q_norm_g)); asm volatile("" : "+s"(k_norm_g)); asm volatile("" : "+s"(bar.bar)); }
        for (int rep = 0; rep < REP_G1; ++rep) {
            pg8::Gemm g{(const f16*)XB, (const f16*)WIN + (size_t)l * PW * DM, MROWS, PW, DM}; pg8::StaticOrder S; S.init(MROWS, PW, G, bx);
            pg8::EpiProj E{PROJ, PART, (const GAS float*)q_norm_g + l * 64, (const GAS float*)k_norm_g + l * 64};
            SW_BEGIN(5);
            pg8::gemm_phase<pg8::EpiProj>(lds + RING_OFF, g, S, E, sw_acc);
            SW_END(5);
        }
        { SW_BEGIN(7); xcd_barrier(bar); SW_END(7); }
        {
            const float sa = att::wave_sum(lq1[l * 64 + lane] * lk1[l * 64 + lane]), sb = att::wave_sum(lq2[l * 64 + lane] * lk2[l * 64 + lane]);
            const float lam_init = 0.8f - 0.6f * __expf(-0.3f * (float)l);
            const float lam = __expf(sa) - __expf(sb) + lam_init;
            const float mgq = att::wave_max(fabsf(q_norm_g[l * 64 + lane])), mgk = att::wave_max(fabsf(k_norm_g[l * 64 + lane]));
            const float mref = 8.0f * LOG2E * mgq * mgk * 1.001f - 10.0f;
            __syncthreads();
            for (int rep = 0; rep < REP_DA; ++rep) { SW_BEGIN(1); att::da_phase(lds + RING_OFF, PROJ, MIX, vcu, G, lam, mref, (const GAS float*)subln_g + l * 128, 1.0f - lam_init, sw_acc); SW_END(1); }
            for (int rep = 0; rep < REP_SB; ++rep) { SW_BEGIN(4); att::sb_phase(lds + RING_OFF, PROJ, MIX, vcu, G, sw_acc); SW_END(4); }
        }
        { SW_BEGIN(7); xcd_barrier(bar); SW_END(7); }
        {
            pg8::Gemm g{(const f16*)MIX, (const f16*)WOUT + (size_t)l * DM * DM, MROWS, DM, DM}; pg8::StaticOrder S; S.init(MROWS, DM, G, bx);
            pg8::EpiOut E{(GAS float*)out, XB, PART, (l + 1 < DEPTH) ? 0 : 1};
            SW_BEGIN(8);
            pg8::gemm_phase<pg8::EpiOut>(lds + RING_OFF, g, S, E, sw_acc);
            SW_END(8);
        }
        if (l + 1 < DEPTH) { SW_BEGIN(7); xcd_barrier(bar); SW_END(7); }
    }
#if SW_ID
    if (wave == 0) { const unsigned long long t0 = __builtin_amdgcn_s_memrealtime(), span = (unsigned long long)SW_K * sw_acc; while (__builtin_amdgcn_s_memrealtime() - t0 < span) __builtin_amdgcn_s_sleep(8); }
#endif
}

extern "C" void kernel_launch(void* const* d_in, const int* in_sizes, int n_in, void* d_out, int out_size, void* d_ws, size_t ws_size, hipStream_t stream) {
    static int grid = 0;
    if (grid == 0) {
        if (n_in != 11 || in_sizes[0] != MROWS * DM || out_size != MROWS * DM || ws_size < WS_END) {
            fprintf(stderr, "kernel_launch: unexpected problem shape (n_in %d, in0 %d, out %d, ws %zu); nothing launched\n", n_in, n_in > 0 ? in_sizes[0] : -1, out_size, ws_size); grid = -1; return; }
        int dev = 0, cus = 0, per_cu = 0;
        if (hipGetDevice(&dev) != hipSuccess || hipDeviceGetAttribute(&cus, hipDeviceAttributeMultiprocessorCount, dev) != hipSuccess) { grid = -1; return; }
        if (hipFuncSetAttribute((const void*)hybrid_fwd, hipFuncAttributeMaxDynamicSharedMemorySize, LDS_BYTES) != hipSuccess) { fprintf(stderr, "kernel_launch: hipFuncSetAttribute failed\n"); grid = -1; return; }
        if (hipOccupancyMaxActiveBlocksPerMultiprocessor(&per_cu, (const void*)hybrid_fwd, NWAVES * 64, LDS_BYTES) != hipSuccess || per_cu < 1) {
            fprintf(stderr, "kernel_launch: occupancy query reports %d workgroups per CU; nothing launched\n", per_cu); (void)hipGetLastError(); grid = -1; return; }
        grid = cus;
    }
    if (grid < 0) return;
    if (hipMemsetAsync((char*)d_ws + WS_CTL, 0, CTL_ZERO_BYTES, stream) != hipSuccess) { fprintf(stderr, "kernel_launch: hipMemsetAsync failed\n"); return; }
    Args a{};
    for (int i = 0; i < 11; ++i) a.in[i] = (const float*)d_in[i];
    a.out = (float*)d_out; a.ws = (unsigned char*)d_ws;
    hipLaunchKernelGGL(hybrid_fwd, dim3(grid), dim3(NWAVES * 64), LDS_BYTES, stream, a);
    const hipError_t le = hipPeekAtLastError();
    if (le != hipSuccess) fprintf(stderr, "kernel_launch: launch failed: %s\n", hipGetErrorName(le));
}
```

```cpp
#include <hip/hip_runtime.h>
#include <cstdio>
#include <cstdint>

#ifndef SB_EARLY_EXIT
#define SB_EARLY_EXIT 1
#endif
#define SW_ID 0
#define SW_K 4
#define REP_PRO 1
#define REP_G1 1
#define REP_DA 1
#define REP_SB 1
#define REP_G2 1

#if SW_ID
#define SW_BEGIN(id) unsigned long long sw_t0_##id = 0; if (SW_ID == (id)) sw_t0_##id = __builtin_amdgcn_s_memrealtime()
#define SW_END(id) do { if (SW_ID == (id)) sw_acc += __builtin_amdgcn_s_memrealtime() - sw_t0_##id; } while (0)
#else
#define SW_BEGIN(id) do {} while (0)
#define SW_END(id) do {} while (0)
#endif
#define LAS __attribute__((address_space(3)))
#define GAS __attribute__((address_space(1)))
typedef _Float16 f16;
typedef _Float16 h8 __attribute__((ext_vector_type(8)));
typedef _Float16 h4 __attribute__((ext_vector_type(4)));
typedef _Float16 h2 __attribute__((ext_vector_type(2)));
typedef float f32x4 __attribute__((ext_vector_type(4)));
typedef float f32x16 __attribute__((ext_vector_type(16)));
typedef unsigned u32x4 __attribute__((ext_vector_type(4)));
typedef unsigned u32x2 __attribute__((ext_vector_type(2)));

constexpr int BATCH = 16, SEQ = 2048, DM = 1024, MROWS = BATCH * SEQ, PW = 4096, DEPTH = 2;
constexpr float RMS_EPS = 1e-6f;
constexpr float LOG2E = 1.4426950408889634f;
constexpr float QS = 0.125f * LOG2E;
constexpr int C_SBQ = 0, C_SBK = 512, C_SBV = 1024, C_SBG = 1536, C_DAQ = 2048, C_DAK = 2560, C_DAV = 3072, C_DAG = 3584;

__device__ __forceinline__ unsigned pkh(float lo, float hi) { h2 v = {(f16)lo, (f16)hi}; return __builtin_bit_cast(unsigned, v); }
__device__ __forceinline__ unsigned pkh_rtz(float lo, float hi) { return __builtin_bit_cast(unsigned, __builtin_amdgcn_cvt_pkrtz(lo, hi)); }
__device__ __forceinline__ float row4_sum(float s) {
    { const auto r = __builtin_amdgcn_permlane16_swap(__float_as_uint(s), __float_as_uint(s), false, false); s = __uint_as_float(r[0]) + __uint_as_float(r[1]); }
    { const auto r = __builtin_amdgcn_permlane32_swap(__float_as_uint(s), __float_as_uint(s), false, false); s = __uint_as_float(r[0]) + __uint_as_float(r[1]); }
    return s;
}
__device__ __forceinline__ float silu_f(float v) { return v * __builtin_amdgcn_rcpf(1.0f + __builtin_amdgcn_exp2f(-v * LOG2E)); }

namespace pg8 {
constexpr int BM = 256, BK = 64, HALF = 128, HTB = HALF * BK * 2, STAGE_BYTES = 8 * HTB, NXCD = 8, WGM = 8;
__host__ __device__ __forceinline__ int lds_byte(int r, int c) { const int st = (r >> 4) * 2 + (c >> 5), rr = r & 15, cc = c & 31, ob = rr * 64 + cc * 2; return st * 1024 + (ob ^ (((ob >> 9) & 1) << 5)); }
__host__ __device__ __forceinline__ void stage_rc(int b, int& R, int& C) { const int st = b / 1024, sb = b % 1024, swz = sb ^ (((sb >> 9) & 1) << 5); R = (st >> 1) * 16 + swz / 64; C = (st & 1) * 32 + (swz % 64) / 2; }
__host__ __device__ __forceinline__ int perm32(int rho) { const int n = rho >> 4, i = rho & 15; return 8 * (i >> 2) + 4 * n + (i & 3); }

struct Unit { int pm, pn; };
struct Gemm { const f16* A; const f16* Bt; int M, N, K; };

struct StaticOrder {
    int nM, nN, nwg, G, c;
    __host__ __device__ void init(int M, int N, int G_, int c_) { nM = M / BM; nN = N / BM; nwg = nM * nN; G = G_; c = c_; }
    __host__ __device__ bool next(int i, Unit& u) const {
        const long L = (long)i * G + c; if (L >= nwg) return false;
        int wgid = (int)L; { const int q = nwg / NXCD, r = nwg % NXCD, xcd = wgid % NXCD, off = wgid / NXCD; wgid = (xcd < r ? xcd * (q + 1) : r * (q + 1) + (xcd - r) * q) + off; }
        const int nig = WGM * nN, gid = wgid / nig, fm = gid * WGM, gsz = (nM - fm) < WGM ? (nM - fm) : WGM;
        u.pm = fm + ((wgid % nig) % gsz); u.pn = (wgid % nig) / gsz; return true;
    }
};


struct EpiProj {
    GAS f16* P; const GAS float* part; const GAS float* gq; const GAS float* gk; LAS unsigned char* rsc;
    __device__ __forceinline__ void operator()(const f32x4 (&acc)[2][2][4][2], const Unit& u, int wr, int wc, int fr, int fq, bool same_panel) const {
        const int sec = u.pn >> 1;
        const int row0 = u.pm * BM + wr * 64 + fr;
        const int colw = u.pn * BM + wc * 64 + 8 * fq;
        f32x4 gain[2][2];
        if (sec == 4 || sec == 5) {
            const GAS float* g = (sec == 4) ? gq : gk;
#pragma unroll
            for (int bj = 0; bj < 2; ++bj)
#pragma unroll
                for (int n = 0; n < 2; ++n) gain[bj][n] = *(const GAS f32x4*)(g + 32 * bj + 8 * fq + 4 * n);
        }
        f32x4 rsa, rsb;
        LAS f32x4* rcache = (LAS f32x4*)(rsc + ((wr * 4 + wc) * 64 + fq * 16 + fr) * 32);
        if (same_panel) { rsa = rcache[0]; rsb = rcache[1]; }
        else {
            float t8[8];
#pragma unroll
            for (int i = 0; i < 8; ++i) {
                const int row = row0 + (i >> 2) * HALF + (i & 3) * 16;
                const f32x4 pv = *(const GAS f32x4*)(part + (size_t)row * 16 + fq * 4);
                float s = (pv[0] + pv[1]) + (pv[2] + pv[3]);
                s = row4_sum(s);
                t8[i] = __builtin_amdgcn_rsqf(s * (1.0f / DM) + RMS_EPS);
            }
            rsa = (f32x4){t8[0], t8[1], t8[2], t8[3]}; rsb = (f32x4){t8[4], t8[5], t8[6], t8[7]};
            rcache[0] = rsa; rcache[1] = rsb;
        }
#pragma unroll
        for (int ai = 0; ai < 2; ++ai)
#pragma unroll
            for (int m = 0; m < 4; ++m) {
                const int row = row0 + ai * HALF + m * 16;
                const float rs = ai == 0 ? rsa[m] : rsb[m];
                f32x4 v[2][2];
#pragma unroll
                for (int bj = 0; bj < 2; ++bj)
#pragma unroll
                    for (int n = 0; n < 2; ++n) v[bj][n] = acc[ai][bj][m][n] * rs;
                if (sec == 4 || sec == 5) {
                    float ss = 0.f;
#pragma unroll
                    for (int bj = 0; bj < 2; ++bj)
#pragma unroll
                        for (int n = 0; n < 2; ++n) { const f32x4 x = v[bj][n]; ss += (x[0] * x[0] + x[1] * x[1]) + (x[2] * x[2] + x[3] * x[3]); }
                    ss = row4_sum(ss);
                    float rn = __builtin_amdgcn_rsqf(ss * (1.0f / 64.0f) + RMS_EPS);
                    if (sec == 4) rn *= QS;
#pragma unroll
                    for (int bj = 0; bj < 2; ++bj)
#pragma unroll
                        for (int n = 0; n < 2; ++n) v[bj][n] = v[bj][n] * rn * gain[bj][n];
                } else if (sec == 0) {
#pragma unroll
                    for (int bj = 0; bj < 2; ++bj)
#pragma unroll
                        for (int n = 0; n < 2; ++n) v[bj][n] = v[bj][n] * QS;
                } else if (sec == 3 || sec == 7) {
#pragma unroll
                    for (int bj = 0; bj < 2; ++bj)
#pragma unroll
                        for (int n = 0; n < 2; ++n)
#pragma unroll
                            for (int e = 0; e < 4; ++e) v[bj][n][e] = silu_f(v[bj][n][e]);
                }
                GAS f16* rowp = P + (size_t)row * PW + colw;
#pragma unroll
                for (int bj = 0; bj < 2; ++bj) {
                    u32x4 w; w.x = pkh(v[bj][0][0], v[bj][0][1]); w.y = pkh(v[bj][0][2], v[bj][0][3]); w.z = pkh(v[bj][1][0], v[bj][1][1]); w.w = pkh(v[bj][1][2], v[bj][1][3]);
                    *(GAS u32x4*)(rowp + 32 * bj) = w;
                }
            }
    }
};

struct EpiOut {
    GAS float* out; GAS f16* xb; GAS float* part; int last;
    __device__ __forceinline__ void operator()(const f32x4 (&acc)[2][2][4][2], const Unit& u, int wr, int wc, int fr, int fq, bool) const {
        const int row0 = u.pm * BM + wr * 64 + fr;
        const int colw = u.pn * BM + wc * 64 + 8 * fq;
#pragma unroll
        for (int ai = 0; ai < 2; ++ai) {
            h8 bs[4][2];
#pragma unroll
            for (int m = 0; m < 4; ++m)
#pragma unroll
                for (int bj = 0; bj < 2; ++bj) bs[m][bj] = *(const GAS h8*)(xb + (size_t)(row0 + ai * HALF + m * 16) * DM + colw + 32 * bj);
#pragma unroll
            for (int m = 0; m < 4; ++m) {
                const int row = row0 + ai * HALF + m * 16;
                const size_t off = (size_t)row * DM + colw;
                float ss = 0.f;
#pragma unroll
                for (int bj = 0; bj < 2; ++bj) {
                    const h8 b = bs[m][bj];
                    f32x4 o0 = acc[ai][bj][m][0], o1 = acc[ai][bj][m][1];
                    o0[0] += (float)b[0]; o0[1] += (float)b[1]; o0[2] += (float)b[2]; o0[3] += (float)b[3];
                    o1[0] += (float)b[4]; o1[1] += (float)b[5]; o1[2] += (float)b[6]; o1[3] += (float)b[7];
                    if (last) { *(GAS f32x4*)(out + off + 32 * bj) = o0; *(GAS f32x4*)(out + off + 32 * bj + 4) = o1; }
                    else {
                        ss += (o0[0] * o0[0] + o0[1] * o0[1]) + (o0[2] * o0[2] + o0[3] * o0[3]) + (o1[0] * o1[0] + o1[1] * o1[1]) + (o1[2] * o1[2] + o1[3] * o1[3]);
                        u32x4 w; w.x = pkh(o0[0], o0[1]); w.y = pkh(o0[2], o0[3]); w.z = pkh(o1[0], o1[1]); w.w = pkh(o1[2], o1[3]);
                        *(GAS u32x4*)(xb + off + 32 * bj) = w;
                    }
                }
                if (!last) {
                    ss = row4_sum(ss);
                    if (fq == 0) part[(size_t)row * 16 + u.pn * 4 + wc] = ss;
                }
            }
        }
    }
};

template <class Epi>
__device__ __forceinline__ void gemm_phase(LAS unsigned char* lds, const Gemm g, const StaticOrder& S, const Epi& E, unsigned long long& sw_acc) {
    int tid_ = threadIdx.x; asm volatile("" : "+v"(tid_));
    const int tid = tid_, wid = __builtin_amdgcn_readfirstlane(tid >> 6), lane = tid & 63, wr = wid >> 2, wc = wid & 3, fr = lane & 15, fq = lane >> 4;
    const int K = g.K, nt = K / BK;
    unsigned voffA[2], voffB[2];
#pragma unroll
    for (int i = 0; i < 2; ++i) { int R, C; stage_rc(tid * 16 + i * 8192, R, C);
        const int Rb = (R >> 5) * 64 + perm32(R & 31);
        voffA[i] = (unsigned)(R * K + C) * 2u; voffB[i] = (unsigned)(Rb * K + C) * 2u; }
    const size_t kstep = (size_t)(BK * 2);
    const size_t hstep = (size_t)HALF * K * 2;
    const size_t hstepB = (size_t)32 * K * 2;
    const size_t tstep = 2 * hstep;
    const unsigned ldsw = (unsigned)wid * 1024u;
    const int aoff = lds_byte(wr * 64 + fr, fq * 8), boff = lds_byte(wc * 32 + fr, fq * 8);
#define PG8_SA(b, h) (((b) * 2 + (h)) * HTB)
#define PG8_SB(b, h) ((4 + (b) * 2 + (h)) * HTB)
#define PG8_STAGE(bufoff, gbase, voff) do { _Pragma("unroll") for (int _i = 0; _i < 2; ++_i) \
        __builtin_amdgcn_global_load_lds((const unsigned*)((const char*)(gbase) + (voff)[_i]), (LAS unsigned*)(lds + (bufoff) + ldsw + _i * 8192), 16, 0, 0); } while (0)
#define PG8_LDA(dst, b, h) do { _Pragma("unroll") for (int m = 0; m < 4; ++m) _Pragma("unroll") for (int k = 0; k < 2; ++k) dst[m][k] = *(const LAS h8*)(lds + PG8_SA(b, h) + aoff + m * 2048 + k * 1024); } while (0)
#define PG8_LDB(dst, b, h) do { _Pragma("unroll") for (int n = 0; n < 2; ++n) _Pragma("unroll") for (int k = 0; k < 2; ++k) dst[n][k] = *(const LAS h8*)(lds + PG8_SB(b, h) + boff + n * 2048 + k * 1024); } while (0)
#define PG8_MMA(ai, bj, At, Bt) do { __builtin_amdgcn_s_setprio(1); _Pragma("unroll") for (int m = 0; m < 4; ++m) _Pragma("unroll") for (int n = 0; n < 2; ++n) _Pragma("unroll") for (int k = 0; k < 2; ++k) \
        acc[ai][bj][m][n] = __builtin_amdgcn_mfma_f32_16x16x32_f16(Bt[n][k], At[m][k], acc[ai][bj][m][n], 0, 0, 0); __builtin_amdgcn_s_setprio(0); } while (0)
#define PG8_WAIT_V(n) asm volatile("s_waitcnt vmcnt(" #n ")" ::: "memory")
#define PG8_WAIT_L(n) asm volatile("s_waitcnt lgkmcnt(" #n ")" ::: "memory")
#define PG8_BAR __builtin_amdgcn_s_barrier()
#define PG8_SCHED __builtin_amdgcn_sched_barrier(0)
    Unit cur, nxt; int ui = 0, last_pm = -1;
    if (!S.next(0, cur)) return;
    f32x4 acc[2][2][4][2];
#pragma unroll
    for (int a = 0; a < 2; ++a)
#pragma unroll
        for (int b = 0; b < 2; ++b)
#pragma unroll
            for (int m = 0; m < 4; ++m)
#pragma unroll
                for (int n = 0; n < 2; ++n) acc[a][b][m][n] = (f32x4){0.f, 0.f, 0.f, 0.f};
    h8 At[4][2], B0[2][2], B1[2][2];
    const char* cA = (const char*)g.A + (size_t)cur.pm * tstep; const char* cB = (const char*)g.Bt + (size_t)cur.pn * tstep;
    PG8_STAGE(PG8_SB(0, 0), cB, voffB); PG8_STAGE(PG8_SB(0, 1), cB + hstepB, voffB); PG8_STAGE(PG8_SA(0, 0), cA, voffA); PG8_STAGE(PG8_SA(0, 1), cA + hstep, voffA);
    if (wr == 1) PG8_BAR;
    PG8_WAIT_V(2); PG8_BAR;
    PG8_STAGE(PG8_SB(1, 0), cB + kstep, voffB); PG8_STAGE(PG8_SA(1, 0), cA + kstep, voffA); PG8_STAGE(PG8_SB(1, 1), cB + hstepB + kstep, voffB);
    PG8_WAIT_V(6); PG8_BAR;
    for (;;) {
        const bool has_next = S.next(ui + 1, nxt);
        const char* nA = has_next ? (const char*)g.A + (size_t)nxt.pm * tstep : cA; const char* nB = has_next ? (const char*)g.Bt + (size_t)nxt.pn * tstep : cB;
        for (int t = 0; t < nt; t += 2) {
            const bool last = (t == nt - 2);
            const char* a1 = cA + (size_t)(t + 1) * kstep;
            const char* a2 = last ? nA : cA + (size_t)(t + 2) * kstep; const char* b2 = last ? nB : cB + (size_t)(t + 2) * kstep;
            const char* a3 = a2 + kstep; const char* b3 = b2 + kstep;
            PG8_LDB(B0, 0, 0); PG8_LDB(B1, 0, 1); PG8_SCHED; PG8_LDA(At, 0, 0); PG8_STAGE(PG8_SA(1, 1), a1 + hstep, voffA);
            PG8_WAIT_V(8); PG8_WAIT_L(0); PG8_BAR; PG8_MMA(0, 0, At, B0); PG8_MMA(0, 1, At, B1); PG8_BAR; PG8_SCHED;
            PG8_LDA(At, 0, 1); PG8_STAGE(PG8_SB(0, 0), b2, voffB); PG8_STAGE(PG8_SB(0, 1), b2 + hstepB, voffB); PG8_STAGE(PG8_SA(0, 0), a2, voffA);
            PG8_WAIT_V(8); PG8_WAIT_L(0); PG8_BAR; PG8_MMA(1, 0, At, B0); PG8_MMA(1, 1, At, B1); PG8_BAR; PG8_SCHED;
            PG8_LDB(B0, 1, 0); PG8_LDB(B1, 1, 1); PG8_SCHED; PG8_LDA(At, 1, 0); PG8_STAGE(PG8_SA(0, 1), a2 + hstep, voffA);
            PG8_WAIT_V(8); PG8_WAIT_L(0); PG8_BAR; PG8_MMA(0, 0, At, B0); PG8_MMA(0, 1, At, B1); PG8_BAR; PG8_SCHED;
            PG8_LDA(At, 1, 1); PG8_STAGE(PG8_SB(1, 0), b3, voffB); PG8_STAGE(PG8_SB(1, 1), b3 + hstepB, voffB); PG8_STAGE(PG8_SA(1, 0), a3, voffA);
            PG8_WAIT_V(8); PG8_WAIT_L(0); PG8_BAR; PG8_MMA(1, 0, At, B0); PG8_MMA(1, 1, At, B1); PG8_BAR; PG8_SCHED;
        }
        if (wr == 0) PG8_BAR;
        { SW_BEGIN(20); E(acc, cur, wr, wc, fr, fq, cur.pm == last_pm); SW_END(20); last_pm = cur.pm; }
        if (!has_next) break;
#pragma unroll
        for (int a = 0; a < 2; ++a)
#pragma unroll
            for (int b = 0; b < 2; ++b)
#pragma unroll
                for (int m = 0; m < 4; ++m)
#pragma unroll
                    for (int n = 0; n < 2; ++n) acc[a][b][m][n] = (f32x4){0.f, 0.f, 0.f, 0.f};
        cur = nxt; cA = nA; cB = nB; ++ui;
        if (wr == 1) PG8_BAR;
    }
    PG8_WAIT_V(0);
    PG8_BAR;
#undef PG8_SA
#undef PG8_SB
#undef PG8_STAGE
#undef PG8_LDA
#undef PG8_LDB
#undef PG8_MMA
#undef PG8_WAIT_V
#undef PG8_WAIT_L
#undef PG8_BAR
#undef PG8_SCHED
}
}

namespace att {
typedef short v4i16_t __attribute__((ext_vector_type(4)));
__device__ __forceinline__ int crow(int r, int hi) { return (r & 3) + 8 * (r >> 2) + 4 * hi; }
__device__ __forceinline__ int keyrow(int i) { return 32 * ((i >> 2) & 1) + (i & 3) + 4 * (i >> 3); }
__device__ __forceinline__ h4 vtr(const LAS unsigned char* p) { return __builtin_bit_cast(h4, __builtin_amdgcn_ds_read_tr16_b64_v4i16((LAS v4i16_t*)p)); }
__device__ __forceinline__ h8 cat8(h4 a, h4 b) { return (h8){a[0], a[1], a[2], a[3], b[0], b[1], b[2], b[3]}; }
#define MFMA32(a, b, c) __builtin_amdgcn_mfma_f32_32x32x16_f16(a, b, c, 0, 0, 0)
__device__ __forceinline__ h8 pack8(const f32x16& p, int b) {
    u32x4 w; w.x = pkh_rtz(p[b], p[b + 1]); w.y = pkh_rtz(p[b + 2], p[b + 3]); w.z = pkh_rtz(p[b + 4], p[b + 5]); w.w = pkh_rtz(p[b + 6], p[b + 7]);
    return __builtin_bit_cast(h8, w);
}
template <int KI> __device__ __forceinline__ float fmamk_s(float c, float base) {
    float r; asm volatile("v_fmamk_f32 %0, %1, %2, %3" : "=v"(r) : "v"(c), "i"(__builtin_bit_cast(int, (float)KI)), "v"(base)); return r; }
__device__ __forceinline__ float wave_sum(float v) {
#pragma unroll
    for (int o = 1; o < 64; o <<= 1) v += __shfl_xor(v, o);
    return v;
}
__device__ __forceinline__ float wave_max(float v) {
#pragma unroll
    for (int o = 1; o < 64; o <<= 1) v = fmaxf(v, __shfl_xor(v, o));
    return v;
}

__device__ __forceinline__ void glds16(const GAS void* g, unsigned lds_base) {
    unsigned sv; asm volatile("s_mov_b32 %0, m0\n\ts_mov_b32 m0, %2\n\ts_nop 0\n\tglobal_load_lds_dwordx4 %1, off\n\ts_mov_b32 m0, %0" : "=&s"(sv) : "v"(g), "s"(lds_base) : "memory"); }
#define WAIT_BAR(N) asm volatile("s_waitcnt vmcnt(" #N ") lgkmcnt(0)\n\ts_barrier" ::: "memory")
__device__ __forceinline__ void wait_bar_n(int n) {
    switch (n) { case 0: WAIT_BAR(0); break; case 2: WAIT_BAR(2); break; case 4: WAIT_BAR(4); break; case 6: WAIT_BAR(6); break; case 8: WAIT_BAR(8); break; case 10: WAIT_BAR(10); break;
                 case 12: WAIT_BAR(12); break; case 14: WAIT_BAR(14); break; case 16: WAIT_BAR(16); break; case 18: WAIT_BAR(18); break; case 20: WAIT_BAR(20); break; default: WAIT_BAR(0); break; }
}

constexpr int SB_SLOT = 65536, SB_FLG = 147456 + 2048;
__device__ __forceinline__ int keyrow16(int i) { return 16 * ((i >> 2) & 1) + (i & 3) + 4 * (i >> 3); }
struct SbUnit { int b, hg, cq; };
__device__ __forceinline__ bool sb_decode(int u, SbUnit& U) {
    if (u >= 1024) return false;
    const int r = u >> 8, v = u & 255, i = v & 15;
    U.b = v >> 4; U.hg = i & 1; U.cq = (i >> 1) + 8 * r; return true;
}
__device__ __forceinline__ void sb_phase(LAS unsigned char* lds, const GAS f16* __restrict__ proj, GAS f16* __restrict__ mixed, int vcu, int G, unsigned long long& sw_acc) {
    int tid_ = threadIdx.x; asm volatile("" : "+v"(tid_));
    const int tid = tid_, lane = tid & 63, l31 = lane & 31, hi = lane >> 5; const int w = __builtin_amdgcn_readfirstlane(tid >> 6);
    const int hh = w & 3, rgp = w >> 2;
    const unsigned lds0 = (unsigned)(uintptr_t)lds;
    const unsigned kdst = lds0 + w * 4096, vdst = lds0 + 32768 + w * 4096;
    int kfo[4];
    { const int kr = keyrow16(l31);
#pragma unroll
      for (int d0 = 0; d0 < 4; ++d0) kfo[d0] = kr * 512 + (((hh * 8 + 2 * d0 + hi) ^ (kr & 15)) * 16); }
    int vfo[2];
    { const int q_ = (lane & 15) >> 2;
#pragma unroll
      for (int d0 = 0; d0 < 2; ++d0) vfo[d0] = 32768 + (16 * hi + q_) * 512 + (((hh * 2 + d0) ^ q_) * 64) + ((lane >> 4) & 1) * 32 + (lane & 3) * 8; }
    LAS unsigned* flags = (LAS unsigned*)(lds + SB_FLG);
    size_t koff[4], voff[4];
#pragma unroll
    for (int i = 0; i < 4; ++i) { const int row = 8 * w + 2 * i + (lane >> 5), p = lane & 31;
        koff[i] = (size_t)row * PW + C_SBK + ((p ^ (row & 15)) * 8);
        voff[i] = (size_t)row * PW + C_SBV + ((((p >> 2) ^ (row & 3)) * 4 + (p & 3)) * 8); }
    const size_t qoff = (size_t)(32 * rgp + l31) * PW;
#define SB_DMA(base_, kt_, slot) do { const GAS f16* b_ = (base_) + (size_t)(kt_) * 64 * PW; const unsigned kd_ = (unsigned)__builtin_amdgcn_readfirstlane(kdst + (slot)), vd_ = (unsigned)__builtin_amdgcn_readfirstlane(vdst + (slot)); \
        _Pragma("unroll") for (int i_ = 0; i_ < 4; ++i_) { glds16(b_ + koff[i_], kd_ + i_ * 1024); glds16(b_ + voff[i_], vd_ + i_ * 1024); } } while (0)
    SbUnit U, Un; int ui = vcu;
    if (!sb_decode(ui, U)) return;
    int islot = 0, cslot = 0;
    const GAS f16* tbase = proj + ((size_t)U.b * SEQ) * PW + U.hg * 256;
    h8 qn[4]; u32x2 gn[8];
    { const size_t grow = (size_t)U.b * SEQ + U.cq * 64 + 32 * rgp + l31; const int h = 4 * U.hg + hh;
      const GAS f16* Qg = proj + grow * PW + C_SBQ + h * 64 + 8 * hi; const GAS f16* Gp = proj + grow * PW + C_SBG + h * 64 + 4 * hi;
#pragma unroll
      for (int d0 = 0; d0 < 4; ++d0) qn[d0] = *(const GAS h8*)(Qg + 16 * d0);
#pragma unroll
      for (int i = 0; i < 8; ++i) gn[i] = *(const GAS u32x2*)(Gp + 8 * i); }
    asm volatile("" : "+v"(qn[0]), "+v"(qn[1]), "+v"(qn[2]), "+v"(qn[3]));
    SB_DMA(tbase, U.cq, islot); islot ^= SB_SLOT;
    for (;;) {
        const size_t rowbase = (size_t)U.b * SEQ;
        const int qw = U.cq * 64 + 32 * rgp, t = qw + l31, NT = U.cq + 1, h = 4 * U.hg + hh;
        const size_t grow = rowbase + qw + l31;
        h8 qr[4]; u32x2 gv[8];
#pragma unroll
        for (int d0 = 0; d0 < 4; ++d0) qr[d0] = qn[d0];
#pragma unroll
        for (int i = 0; i < 8; ++i) gv[i] = gn[i];
        const bool has_next = sb_decode(ui + G, Un);
        f32x16 o[2]; o[0] = f32x16{}; o[1] = f32x16{};
        float carry = 1.f; int done = 0;
        SW_BEGIN(12);
        for (int j = 0; j < NT; ++j) {
            SW_BEGIN(13);
            WAIT_BAR(0);
            SW_END(13);
            if (j > 0) {
                const u32x4 f0 = *(const LAS u32x4*)(flags + ((j - 1) & 1) * 8), f1 = *(const LAS u32x4*)(flags + ((j - 1) & 1) * 8 + 4);
                const unsigned any = (f0.x | f0.y | f0.z | f0.w) | (f1.x | f1.y | f1.z | f1.w);
                if (!__builtin_amdgcn_readfirstlane(any)) break;
            }
            if (j + 1 < NT) { SB_DMA(tbase, U.cq - (j + 1), islot); islot ^= SB_SLOT; }
            const int kt = U.cq - j;
#pragma unroll
            for (int sub = 0; sub < 2; ++sub) {
                const int kb32 = sub == 0 ? 32 : 0;
                const bool diag = (j == 0) && (sub == (rgp == 1 ? 0 : 1));
                const bool skip = (j == 0) && (rgp == 0) && (sub == 0);
                if (!done && !skip) {
                    const LAS unsigned char* Sb = lds + cslot + kb32 * 512;
                    f32x16 p = f32x16{};
#pragma unroll
                    for (int d0 = 0; d0 < 4; ++d0) { const h8 k0 = *(const LAS h8*)(Sb + kfo[d0]); p = MFMA32(k0, qr[d0], p); }
#pragma unroll
                    for (int r = 0; r < 16; ++r) p[r] = __builtin_amdgcn_rcpf(1.0f + __builtin_amdgcn_exp2f(-p[r]));
                    if (diag) {
                        const int key0 = 64 * kt + kb32 + 16 * hi;
#pragma unroll
                        for (int r = 0; r < 16; ++r) if (key0 + r >= t) p[r] = 0.f;
                    }
                    float run = 1.f;
#pragma unroll
                    for (int r = 15; r >= 0; --r) { const float a = run * p[r]; run -= a; p[r] = a; }
                    const auto rr = __builtin_amdgcn_permlane32_swap(__float_as_uint(run), __float_as_uint(run), false, false);
                    const float T0 = __uint_as_float(rr[0]), T1 = __uint_as_float(rr[1]);
                    const float E = carry * (hi ? 1.0f : T1);
                    carry = carry * (T0 * T1);
#pragma unroll
                    for (int r = 0; r < 16; ++r) p[r] *= E;
                    const h8 pa0 = pack8(p, 0), pa1 = pack8(p, 8);
#pragma unroll
                    for (int d0 = 0; d0 < 2; ++d0) {
                        const LAS unsigned char* Vb = Sb + vfo[d0];
                        const h8 v0 = cat8(vtr(Vb), vtr(Vb + 2048));
                        const h8 v1 = cat8(vtr(Vb + 4096), vtr(Vb + 6144));
                        o[d0] = MFMA32(v0, pa0, o[d0]); o[d0] = MFMA32(v1, pa1, o[d0]);
                    }
#if SB_EARLY_EXIT
                    done = __builtin_amdgcn_readfirstlane(__all(carry < 1.0e-37f) ? 1 : 0);
#endif
                }
            }
            if (lane == 0) flags[(j & 1) * 8 + w] = done ? 0u : 1u;
            cslot ^= SB_SLOT;
        }
        asm volatile("s_nop 15\n\ts_nop 7" : "+v"(o[0]), "+v"(o[1]));
        SW_END(12);
        cslot = islot;
        if (has_next) {
            const size_t grown = (size_t)Un.b * SEQ + Un.cq * 64 + 32 * rgp + l31; const int hn = 4 * Un.hg + hh;
            const GAS f16* Qg = proj + grown * PW + C_SBQ + hn * 64 + 8 * hi; const GAS f16* Gp = proj + grown * PW + C_SBG + hn * 64 + 4 * hi;
#pragma unroll
            for (int d0 = 0; d0 < 4; ++d0) qn[d0] = *(const GAS h8*)(Qg + 16 * d0);
#pragma unroll
            for (int i = 0; i < 8; ++i) gn[i] = *(const GAS u32x2*)(Gp + 8 * i);
            asm volatile("" ::: "memory");
            tbase = proj + ((size_t)Un.b * SEQ) * PW + Un.hg * 256;
            SB_DMA(tbase, Un.cq, islot); islot ^= SB_SLOT;
        }
        {
            GAS f16* Op = mixed + grow * DM + h * 64 + 4 * hi;
#pragma unroll
            for (int d0 = 0; d0 < 2; ++d0)
#pragma unroll
                for (int rg4 = 0; rg4 < 4; ++rg4) {
                    const h4 g = __builtin_bit_cast(h4, gv[d0 * 4 + rg4]);
                    u32x2 wv; wv.x = pkh(o[d0][4 * rg4] * (float)g[0], o[d0][4 * rg4 + 1] * (float)g[1]); wv.y = pkh(o[d0][4 * rg4 + 2] * (float)g[2], o[d0][4 * rg4 + 3] * (float)g[3]);
                    *(GAS u32x2*)(Op + 32 * d0 + 8 * rg4) = wv;
                }
        }
        if (!has_next) break;
        U = Un; ui += G;
    }
#undef SB_DMA
    WAIT_BAR(0);
}

constexpr int DA_KS = 16384, DA_VRING = 49152, DA_XCH = 114688, DA_SUBG = 147456 + 1024, DA_SSX = 147456 + 3072;
struct DaUnit { int b, h, qt, klo; };
__device__ __forceinline__ int da_qt_of(int r, int i) {
    constexpr unsigned long long Q1 = 0xE92B6AF78C01D543ull, Q2 = 0x6C5B3014A78D29FEull, Q3 = 0x21F0DC6B43E87A59ull;
    return r == 0 ? i : (int)(((r == 1 ? Q1 : r == 2 ? Q2 : Q3) >> (4 * i)) & 15ull);
}
__device__ __forceinline__ int da_klo(int qt, int h) {
    const float cs = exp2f(-2.0f * (float)(h + 1)) * LOG2E;
    const int D = (int)ceilf(160.5f / cs), m = qt * 128 - D - 63;
    return m > 0 ? (m + 63) >> 6 : 0;
}
__device__ __forceinline__ bool da_decode(int u, DaUnit& U) {
    if (u >= 1024) return false;
    const int r = u >> 8, v = u & 255;
    U.b = v >> 4; U.h = r; U.qt = da_qt_of(r, v & 15); U.klo = da_klo(U.qt, U.h); return true;
}
__device__ __forceinline__ void da_pv(f32x16 (&o)[4], const LAS unsigned char* Vs, const int (&vfo)[4], h8 pa0, h8 pa1, h8 pa2, h8 pa3) {
    h8 f0, f1, f2, f3, g0, g1, g2, g3;
    { const LAS unsigned char* Vb = Vs + vfo[0]; f0 = cat8(vtr(Vb), vtr(Vb + 1024)); f1 = cat8(vtr(Vb + 2048), vtr(Vb + 3072)); f2 = cat8(vtr(Vb + 4096), vtr(Vb + 5120)); f3 = cat8(vtr(Vb + 6144), vtr(Vb + 7168)); }
#pragma unroll
    for (int d0 = 0; d0 < 4; ++d0) {
        if (d0 < 3) { const LAS unsigned char* Vb = Vs + vfo[d0 + 1]; g0 = cat8(vtr(Vb), vtr(Vb + 1024)); g1 = cat8(vtr(Vb + 2048), vtr(Vb + 3072)); g2 = cat8(vtr(Vb + 4096), vtr(Vb + 5120)); g3 = cat8(vtr(Vb + 6144), vtr(Vb + 7168)); }
        o[d0] = MFMA32(f0, pa0, o[d0]); o[d0] = MFMA32(f1, pa1, o[d0]); o[d0] = MFMA32(f2, pa2, o[d0]); o[d0] = MFMA32(f3, pa3, o[d0]);
        if (d0 < 3) { f0 = g0; f1 = g1; f2 = g2; f3 = g3; }
    }
}
__device__ __forceinline__ void da_phase(LAS unsigned char* lds, const GAS f16* __restrict__ proj, GAS f16* __restrict__ mixed, int vcu, int G,
                                         float lam, float mref, const GAS float* __restrict__ subg, float osc, unsigned long long& sw_acc) {
    int tid_ = threadIdx.x; asm volatile("" : "+v"(tid_));
    const int tid = tid_, lane = tid & 63, l31 = lane & 31, hi = lane >> 5; const int w = __builtin_amdgcn_readfirstlane(tid >> 6);
    const int c = w >> 2, rg = w & 3;
    const unsigned lds0 = (unsigned)(uintptr_t)lds;
    const unsigned kdst = lds0 + w * 1024, vdst = lds0 + DA_VRING + w * 1024;
    int kfo[4];
    { const int kr = keyrow(l31);
#pragma unroll
      for (int d0 = 0; d0 < 4; ++d0) kfo[d0] = kr * 256 + (((8 * c + 2 * d0 + hi) ^ (kr & 15)) * 16); }
    int vfo[4];
    { const int q_ = (lane & 15) >> 2;
#pragma unroll
      for (int d0 = 0; d0 < 4; ++d0) vfo[d0] = DA_VRING + (32 * hi + q_) * 256 + ((d0 ^ q_) * 64) + ((lane >> 4) & 1) * 32 + (lane & 3) * 8; }
    const int srow = 4 * w + (lane >> 4);
    const size_t koff = (size_t)srow * PW + C_DAK + (((lane & 15) ^ (srow & 15)) * 8);
    const size_t voff = (size_t)srow * PW + C_DAV + (((((lane & 15) >> 2) ^ (srow & 3)) * 4 + (lane & 3)) * 8);
    const size_t qoff = (size_t)(32 * rg + l31) * PW + C_DAQ + c * 64 + 8 * hi;
    if (tid < 128) ((LAS float*)(lds + DA_SUBG))[tid] = subg[tid];
    LAS unsigned* xch = (LAS unsigned*)(lds + DA_XCH + rg * 8192);
#define DA_DMA(ks_, vs_, kt_, kslot, vslot) do { const size_t go_ = (size_t)(kt_) * 64 * PW; const unsigned kd_ = (unsigned)__builtin_amdgcn_readfirstlane(kdst + (kslot)), vd_ = (unsigned)__builtin_amdgcn_readfirstlane(vdst + (vslot)); \
        glds16((ks_) + go_, kd_); glds16((ks_) + go_ + (size_t)32 * PW, kd_ + 8192); glds16((vs_) + go_, vd_); glds16((vs_) + go_ + (size_t)32 * PW, vd_ + 8192); } while (0)
#define DA_NEXT_K(s) ((s) == 2 * DA_KS ? 0 : (s) + DA_KS)
#define DA_NEXT_V(s) ((s) == 3 * DA_KS ? 0 : (s) + DA_KS)
    DaUnit U, Un; int ui = vcu;
    if (!da_decode(ui, U)) return;
    const GAS f16* ksrc = proj + ((size_t)U.b * SEQ) * PW + U.h * 128 + koff; const GAS f16* vsrc = proj + ((size_t)U.b * SEQ) * PW + U.h * 128 + voff;
    h8 qn[4];
    { const GAS f16* Qg = proj + ((size_t)U.b * SEQ + U.qt * 128) * PW + qoff + U.h * 128;
#pragma unroll
      for (int d0 = 0; d0 < 4; ++d0) qn[d0] = *(const GAS h8*)(Qg + 16 * d0); }
    asm volatile("" : "+v"(qn[0]), "+v"(qn[1]), "+v"(qn[2]), "+v"(qn[3]));
    DA_DMA(ksrc, vsrc, U.klo, 0, 0); DA_DMA(ksrc, vsrc, U.klo + 1, DA_KS, DA_KS);
    int ik = 2 * DA_KS, iv = 2 * DA_KS, ck = 0, cv = 0;
    for (;;) {
        const size_t rowbase = (size_t)U.b * SEQ;
        const int qw = U.qt * 128 + 32 * rg, t = qw + l31, lastt = qw >> 6, NT = 2 * U.qt + 2;
        const float cslope = exp2f(-2.0f * (float)(U.h + 1)) * LOG2E;
        const float cs64 = 64.0f * cslope, base0 = -cslope * (float)(t - 32 * hi) - mref;
        h8 qr[4];
#pragma unroll
        for (int d0 = 0; d0 < 4; ++d0) qr[d0] = qn[d0];
        const size_t grow = rowbase + qw + l31;
        const bool has_next = da_decode(ui + G, Un);
        const GAS f16* ksn = ksrc; const GAS f16* vsn = vsrc;
        if (has_next) { ksn = proj + ((size_t)Un.b * SEQ) * PW + Un.h * 128 + koff; vsn = proj + ((size_t)Un.b * SEQ) * PW + Un.h * 128 + voff; }
        f32x16 o[4]; o[0] = f32x16{}; o[1] = f32x16{}; o[2] = f32x16{}; o[3] = f32x16{};
        float lsum = 0.f;
        h8 pq0, pq1, pq2, pq3;
        int pvs = 0;
        SW_BEGIN(2);
        for (int kt = U.klo; kt < NT; ++kt) {
            SW_BEGIN(3);
            if (kt + 1 < NT || has_next) WAIT_BAR(4); else WAIT_BAR(0);
            SW_END(3);
#define DA_ISSUE() do { if (kt + 2 < NT) { DA_DMA(ksrc, vsrc, kt + 2, ik, iv); ik = DA_NEXT_K(ik); iv = DA_NEXT_V(iv); } \
            else if (has_next) { DA_DMA(ksn, vsn, Un.klo + kt + 2 - NT, ik, iv); ik = DA_NEXT_K(ik); iv = DA_NEXT_V(iv); } } while (0)
            DA_ISSUE();
            if (c == 1 && kt > U.klo && kt - 1 <= lastt) da_pv(o, lds + pvs, vfo, pq0, pq1, pq2, pq3);
            if (kt <= lastt) {
                const LAS unsigned char* Ks = lds + ck;
                f32x16 p0, p1;
                const float basek = __builtin_fmaf(cs64, (float)kt, base0);
                __builtin_amdgcn_sched_barrier(0);
                asm volatile("s_nop 7" ::: "memory");
#define DA_INIT(r) p0[r] = fmamk_s<r>(cslope, basek); p1[r] = fmamk_s<16 + r>(cslope, basek);
                DA_INIT(0) DA_INIT(1) DA_INIT(2) DA_INIT(3) DA_INIT(4) DA_INIT(5) DA_INIT(6) DA_INIT(7) DA_INIT(8) DA_INIT(9) DA_INIT(10) DA_INIT(11) DA_INIT(12) DA_INIT(13) DA_INIT(14) DA_INIT(15)
#undef DA_INIT
                asm volatile("s_nop 3" : "+v"(p0), "+v"(p1));
                if (kt == lastt) {
                    const int kd = t - (64 * kt + 32 * hi);
                    const float m2 = -2.0f * mref;
                    asm volatile("" ::: "memory");
#pragma unroll
                    for (int r = 0; r < 16; ++r) { if (r > kd) p0[r] = m2 - p0[r]; if (16 + r > kd) p1[r] = m2 - p1[r]; }
                }
#pragma unroll
                for (int d0 = 0; d0 < 4; ++d0) { const h8 ka = *(const LAS h8*)(Ks + kfo[d0]), kb = *(const LAS h8*)(Ks + kfo[d0] + 4096); p0 = MFMA32(ka, qr[d0], p0); p1 = MFMA32(kb, qr[d0], p1); }
                float s0 = 0.f, s1 = 0.f, s2 = 0.f, s3 = 0.f;
#pragma unroll
                for (int r = 0; r < 16; ++r) { p0[r] = __builtin_amdgcn_exp2f(p0[r]); p1[r] = __builtin_amdgcn_exp2f(p1[r]); }

#pragma unroll
                for (int r = 0; r < 16; r += 2) { s0 += p0[r]; s1 += p0[r + 1]; s2 += p1[r]; s3 += p1[r + 1]; }
                lsum += (s0 + s1) + (s2 + s3);
                pq0 = pack8(p0, 0); pq1 = pack8(p0, 8); pq2 = pack8(p1, 0); pq3 = pack8(p1, 8); pvs = cv;
                if (c == 0) da_pv(o, lds + cv, vfo, pq0, pq1, pq2, pq3);
            }
            ck = DA_NEXT_K(ck); cv = DA_NEXT_V(cv);
        }
        if (c == 1 && NT - 1 <= lastt) da_pv(o, lds + pvs, vfo, pq0, pq1, pq2, pq3);
        asm volatile("s_nop 15\n\ts_nop 7" : "+v"(o[0]), "+v"(o[1]), "+v"(o[2]), "+v"(o[3]));
        SW_END(2);
        const int dlo = 2 * c;
        u32x2 gv[8];
        { const GAS f16* Gp = proj + grow * PW + C_DAG + U.h * 128 + 32 * dlo + 4 * hi;
#pragma unroll
          for (int i = 0; i < 8; ++i) gv[i] = *(const GAS u32x2*)(Gp + 8 * i); }
        if (has_next) { const GAS f16* Qg = proj + ((size_t)Un.b * SEQ + Un.qt * 128) * PW + qoff + Un.h * 128;
#pragma unroll
            for (int d0 = 0; d0 < 4; ++d0) qn[d0] = *(const GAS h8*)(Qg + 16 * d0); }
        asm volatile("" ::: "memory");
        { const auto rr = __builtin_amdgcn_permlane32_swap(__float_as_uint(lsum), __float_as_uint(lsum), false, false); lsum = __uint_as_float(rr[0]) + __uint_as_float(rr[1]); }
        const float f = (c == 0 ? 1.0f : lam) / lsum;
        LAS unsigned* xw = xch + (c ^ 1) * 1024;
        LAS unsigned* xr = xch + c * 1024;
        f32x16 ya, yb;
        if (c == 0) {
#pragma unroll
            for (int r2 = 0; r2 < 8; ++r2) { xw[r2 * 64 + lane] = pkh(o[2][2 * r2] * f, o[2][2 * r2 + 1] * f); xw[(8 + r2) * 64 + lane] = pkh(o[3][2 * r2] * f, o[3][2 * r2 + 1] * f); }
            ya = o[0] * f; yb = o[1] * f;
        } else {
#pragma unroll
            for (int r2 = 0; r2 < 8; ++r2) { xw[r2 * 64 + lane] = pkh(o[0][2 * r2] * f, o[0][2 * r2 + 1] * f); xw[(8 + r2) * 64 + lane] = pkh(o[1][2 * r2] * f, o[1][2 * r2 + 1] * f); }
            ya = o[2] * f; yb = o[3] * f;
        }
        asm volatile("s_waitcnt lgkmcnt(0)\n\ts_barrier" ::: "memory");
        const float sgn = (c == 0) ? 1.0f : -1.0f;
        float ss = 0.f;
#pragma unroll
        for (int r2 = 0; r2 < 8; ++r2) {
            const h2 pa = __builtin_bit_cast(h2, xr[r2 * 64 + lane]), pb = __builtin_bit_cast(h2, xr[(8 + r2) * 64 + lane]);
            const float a0 = (ya[2 * r2] - (float)pa[0]) * sgn, a1 = (ya[2 * r2 + 1] - (float)pa[1]) * sgn, b0 = (yb[2 * r2] - (float)pb[0]) * sgn, b1 = (yb[2 * r2 + 1] - (float)pb[1]) * sgn;
            ya[2 * r2] = a0; ya[2 * r2 + 1] = a1; yb[2 * r2] = b0; yb[2 * r2 + 1] = b1; ss += (a0 * a0 + a1 * a1) + (b0 * b0 + b1 * b1);
        }
        { const auto rr = __builtin_amdgcn_permlane32_swap(__float_as_uint(ss), __float_as_uint(ss), false, false); ss = __uint_as_float(rr[0]) + __uint_as_float(rr[1]); }
        LAS float* ssx = (LAS float*)(lds + DA_SSX + rg * 256);
        if (hi == 0) ssx[c * 32 + l31] = ss;
        asm volatile("s_waitcnt lgkmcnt(0)\n\ts_barrier" ::: "memory");
        ss += ssx[(c ^ 1) * 32 + l31];
        const float rn = __builtin_amdgcn_rsqf(ss * (1.0f / 128.0f) + RMS_EPS) * osc;
        {
            const LAS float* sgl = (const LAS float*)(lds + DA_SUBG) + 32 * dlo + 4 * hi;
            GAS f16* Op = mixed + grow * DM + 512 + U.h * 128 + 32 * dlo + 4 * hi;
#pragma unroll
            for (int rg4 = 0; rg4 < 4; ++rg4) {
                const h4 g = __builtin_bit_cast(h4, gv[rg4]);
                const f32x4 sg = *(const LAS f32x4*)(sgl + 8 * rg4);
                u32x2 wv;
                wv.x = pkh(ya[4 * rg4] * rn * sg[0] * (float)g[0], ya[4 * rg4 + 1] * rn * sg[1] * (float)g[1]);
                wv.y = pkh(ya[4 * rg4 + 2] * rn * sg[2] * (float)g[2], ya[4 * rg4 + 3] * rn * sg[3] * (float)g[3]);
                *(GAS u32x2*)(Op + 8 * rg4) = wv;
            }
#pragma unroll
            for (int rg4 = 0; rg4 < 4; ++rg4) {
                const h4 g = __builtin_bit_cast(h4, gv[4 + rg4]);
                const f32x4 sg = *(const LAS f32x4*)(sgl + 32 + 8 * rg4);
                u32x2 wv;
                wv.x = pkh(yb[4 * rg4] * rn * sg[0] * (float)g[0], yb[4 * rg4 + 1] * rn * sg[1] * (float)g[1]);
                wv.y = pkh(yb[4 * rg4 + 2] * rn * sg[2] * (float)g[2], yb[4 * rg4 + 3] * rn * sg[3] * (float)g[3]);
                *(GAS u32x2*)(Op + 32 + 8 * rg4) = wv;
            }
        }
        if (!has_next) break;
        U = Un; ui += G; ksrc = ksn; vsrc = vsn;
    }
#undef DA_DMA
#undef DA_ISSUE
#undef DA_NEXT_K
#undef DA_NEXT_V
    WAIT_BAR(0);
}
}

constexpr size_t MiB = 1u << 20;
constexpr size_t WS_CTL = 0, CTL_ZERO_BYTES = 64 * 1024;
constexpr size_t WS_WIN = 2 * MiB;
constexpr size_t WS_WOUT = 18 * MiB;
constexpr size_t WS_PART = 22 * MiB;
constexpr size_t WS_XB = 32 * MiB;
constexpr size_t WS_MIX = 96 * MiB;
constexpr size_t WS_PROJ = 160 * MiB;
constexpr size_t WS_END = 416 * MiB;
constexpr int CW_BAR = 4096;

constexpr int RING_OFF = 0, RING_BYTES = 131072;
constexpr int LDSCTL_OFF = 147456, MISC_OFF = LDSCTL_OFF + 320;
constexpr int LDS_BYTES = 163840;
constexpr int NWAVES = 8;

typedef GAS unsigned gu32;
#define LDS_WAIT() asm volatile("s_waitcnt lgkmcnt(0)" ::: "memory")

#define XB_TMO      128
#define XB_XCNT(j)  (256  + 64 * (j))
#define XB_XSUB(j)  (1280 + 64 * (j))
#define XB_XGEN(j)  (2304 + 64 * (j))
#define XB_TOP      3328
#define XB_TOPGEN   3392
#define XCD_BAR_WORDS 3456
#define XB_SPIN_CAP (1u << 18)
__device__ __forceinline__ unsigned xb_ld(unsigned* p)              { return __hip_atomic_load(p, __ATOMIC_RELAXED, __HIP_MEMORY_SCOPE_AGENT); }
__device__ __forceinline__ unsigned xb_add(unsigned* p, unsigned v) { return __hip_atomic_fetch_add(p, v, __ATOMIC_RELAXED, __HIP_MEMORY_SCOPE_AGENT); }
__device__ __forceinline__ unsigned xb_xcc_id() { return (unsigned)__builtin_amdgcn_s_getreg((3 << 11) | 20) & 0xFu; }
#define XB_SPIN(cond, bar) do { unsigned _sp = 0; while (cond) { __builtin_amdgcn_s_sleep(1); \
    if ((++_sp & 255u) == 0u) { if (xb_ld(&(bar)[XB_TMO])) break; if (_sp > XB_SPIN_CAP) { atomicAdd(&(bar)[XB_TMO], 1u); break; } } } } while (0)
struct XcdBarrier { unsigned* bar; unsigned x; volatile LAS unsigned* st; };
__device__ __forceinline__ XcdBarrier xcd_barrier_post(unsigned* bar, volatile LAS unsigned* st) {
    XcdBarrier b; b.bar = bar; b.x = xb_xcc_id(); b.st = st;
    if (threadIdx.x == 0) (void)xb_add(&bar[XB_XCNT(b.x)], 1u);
    return b;
}
__device__ __forceinline__ void xcd_barrier_complete(unsigned* bar, unsigned x, unsigned& nloc, unsigned& nx) {
    const unsigned G = gridDim.x * gridDim.y * gridDim.z;
    unsigned sum, cnt, mine, sp = 0u;
    for (;;) {
        sum = 0u; cnt = 0u; mine = 0u;
#pragma unroll
        for (unsigned j = 0; j < 16; ++j) { const unsigned c = xb_ld(&bar[XB_XCNT(j)]); sum += c; cnt += (c > 0u) ? 1u : 0u; mine = (j == x) ? c : mine; }
        if (sum == G) break;
        __builtin_amdgcn_s_sleep(1);
        if ((++sp & 255u) == 0u) { if (xb_ld(&bar[XB_TMO])) break; if (sp > XB_SPIN_CAP) { atomicAdd(&bar[XB_TMO], 1u); break; } }
    }
    nloc = mine > 0u ? mine : 1u; nx = cnt > 0u ? cnt : 1u;
}
__device__ __forceinline__ void xcd_barrier(const XcdBarrier& b) {
    asm volatile("s_waitcnt vmcnt(0)" ::: "memory");
    __syncthreads();
    if (threadIdx.x == 0) {
        unsigned* bar = b.bar;
        __builtin_amdgcn_s_waitcnt(0);
        unsigned nloc = b.st[0], nx = b.st[1];
        if (nloc == 0u) { xcd_barrier_complete(bar, b.x, nloc, nx); b.st[0] = nloc; b.st[1] = nx; }
        const unsigned old = xb_add(&bar[XB_XSUB(b.x)], 1u);
        const unsigned gen = old / nloc;
        if (old + 1u == (gen + 1u) * nloc) {
            __builtin_amdgcn_fence(__ATOMIC_RELEASE, "agent");
            asm volatile("s_waitcnt vmcnt(0)" ::: "memory");
            const unsigned og = xb_add(&bar[XB_TOP], 1u);
            const unsigned tg = og / nx;
            if (og + 1u == (tg + 1u) * nx) xb_add(&bar[XB_TOPGEN], 1u);
            else XB_SPIN(xb_ld(&bar[XB_TOPGEN]) == tg, bar);
            __builtin_amdgcn_fence(__ATOMIC_ACQUIRE, "agent");
            xb_add(&bar[XB_XGEN(b.x)], 1u);
            asm volatile("s_waitcnt vmcnt(0)" ::: "memory");
        } else {
            XB_SPIN(xb_ld(&bar[XB_XGEN(b.x)]) == gen, bar);
            __builtin_amdgcn_fence(__ATOMIC_ACQUIRE, "agent");
            asm volatile("s_waitcnt vmcnt(0)" ::: "memory");
        }
    }
    __syncthreads();
}

__device__ __forceinline__ void p0_transpose_item(const float* W, const float* g, int K, int N, f16* WT, LAS float* scr, int item, int lane) {
    const int nblk = N / 32, kb = item / nblk, nb = item % nblk, k0 = 32 * kb, n0 = 32 * nb;
    float v[16];
#pragma unroll
    for (int i = 0; i < 16; ++i) { const int kk = 2 * i + (lane >> 5); v[i] = __builtin_nontemporal_load(W + (size_t)(k0 + kk) * N + n0 + (lane & 31)); }
    if (g) {
#pragma unroll
        for (int i = 0; i < 16; ++i) v[i] *= g[k0 + 2 * i + (lane >> 5)];
    }
#pragma unroll
    for (int i = 0; i < 16; ++i) scr[(2 * i + (lane >> 5)) * 33 + (lane & 31)] = v[i];
    LDS_WAIT(); asm volatile("" ::: "memory");
    const int c = lane & 3;
#pragma unroll
    for (int j = 0; j < 2; ++j) { const int n = (lane >> 2) + 16 * j; const LAS float* sp = scr + (8 * c) * 33 + n;
        u32x4 o; o.x = pkh(sp[0 * 33], sp[1 * 33]); o.y = pkh(sp[2 * 33], sp[3 * 33]); o.z = pkh(sp[4 * 33], sp[5 * 33]); o.w = pkh(sp[6 * 33], sp[7 * 33]);
        *(GAS u32x4*)(WT + (size_t)(n0 + n) * K + k0 + 8 * c) = o; }
    LDS_WAIT(); asm volatile("" ::: "memory");
}
__device__ __forceinline__ void x_rows4(const float* x, f16* xb, float* part, int m0, int stride, int lane) {
    f32x4 v[4][4];
#pragma unroll
    for (int r = 0; r < 4; ++r) { const GAS f32x4* xr = (const GAS f32x4*)(x + (size_t)(m0 + r * stride) * DM) + lane;
#pragma unroll
        for (int j = 0; j < 4; ++j) v[r][j] = __builtin_nontemporal_load(xr + 64 * j); }
#pragma unroll
    for (int r = 0; r < 4; ++r) {
        float s = 0.f;
#pragma unroll
        for (int j = 0; j < 4; ++j) s += (v[r][j][0] * v[r][j][0] + v[r][j][1] * v[r][j][1]) + (v[r][j][2] * v[r][j][2] + v[r][j][3] * v[r][j][3]);
        s = att::wave_sum(s);
        const size_t row = (size_t)(m0 + r * stride);
        GAS u32x2* o8 = (GAS u32x2*)(xb + row * DM) + lane;
#pragma unroll
        for (int j = 0; j < 4; ++j) { u32x2 w; w.x = pkh(v[r][j][0], v[r][j][1]); w.y = pkh(v[r][j][2], v[r][j][3]); o8[64 * j] = w; }
        if (lane < 16) part[row * 16 + lane] = (lane == 0) ? s : 0.f;
    }
}

__device__ __forceinline__ void x_row1(const float* x, f16* xb, float* part, int m, int lane) {
    const GAS f32x4* xr = (const GAS f32x4*)(x + (size_t)m * DM) + lane;
    f32x4 v[4]; float s = 0.f;
#pragma unroll
    for (int j = 0; j < 4; ++j) { v[j] = xr[64 * j]; s += (v[j][0] * v[j][0] + v[j][1] * v[j][1]) + (v[j][2] * v[j][2] + v[j][3] * v[j][3]); }
    s = att::wave_sum(s);
    GAS u32x2* o8 = (GAS u32x2*)(xb + (size_t)m * DM) + lane;
#pragma unroll
    for (int j = 0; j < 4; ++j) { u32x2 w; w.x = pkh(v[j][0], v[j][1]); w.y = pkh(v[j][2], v[j][3]); o8[64 * j] = w; }
    if (lane < 16) part[(size_t)m * 16 + lane] = (lane == 0) ? s : 0.f;
}

struct Args { const float* in[11]; float* out; unsigned char* ws; };
__global__ void __launch_bounds__(NWAVES * 64, 2) hybrid_fwd(Args args) {
    extern __shared__ __attribute__((aligned(16))) unsigned char lds_raw[];
    LAS unsigned char* lds = (LAS unsigned char*)lds_raw;
    volatile LAS unsigned* MISC = (volatile LAS unsigned*)(lds + MISC_OFF);
    const int tid = threadIdx.x, lane = tid & 63, wave = __builtin_amdgcn_readfirstlane(tid >> 6);
    const int G = gridDim.x; const int bx = blockIdx.x; const int vcu = (G % 8 == 0) ? (bx % 8) * (G / 8) + bx / 8 : bx;
    unsigned char* ws = args.ws;
    gu32* ctl = (gu32*)(ws + WS_CTL);
    const float* x = args.in[0]; const float* norm_g = args.in[1]; const float* w_in = args.in[2]; const float* w_out = args.in[3];
    const float* q_norm_g = args.in[4]; const float* k_norm_g = args.in[5];
    const float* lq1 = args.in[6]; const float* lk1 = args.in[7]; const float* lq2 = args.in[8]; const float* lk2 = args.in[9]; const float* subln_g = args.in[10];
    float* out = args.out;
    GAS unsigned char* wsg = (GAS unsigned char*)ws;
    GAS f16* WIN = (GAS f16*)(wsg + WS_WIN); GAS f16* WOUT = (GAS f16*)(wsg + WS_WOUT); GAS float* PART = (GAS float*)(wsg + WS_PART);
    GAS f16* XB = (GAS f16*)(wsg + WS_XB); GAS f16* MIX = (GAS f16*)(wsg + WS_MIX); GAS f16* PROJ = (GAS f16*)(wsg + WS_PROJ);

    unsigned long long sw_acc = 0;
    for (int u = tid; u < (LDS_BYTES - LDSCTL_OFF) / 4; u += NWAVES * 64) ((LAS unsigned*)(lds + LDSCTL_OFF))[u] = 0u;
    __syncthreads();
    XcdBarrier bar = xcd_barrier_post((unsigned*)(ctl + CW_BAR), MISC + 8);

    SW_BEGIN(6);
    for (int rep = 0; rep < REP_PRO; ++rep) {
        LAS float* scr = (LAS float*)(lds + RING_OFF + wave * 16384);
        const int gw = vcu * NWAVES + wave, NGW = G * NWAVES;
        constexpr int I_IN = (DM / 32) * (PW / 32), I_OUT = (DM / 32) * (DM / 32);
        constexpr int NITEMS = DEPTH * (I_IN + I_OUT);
        SW_BEGIN(9);
        for (int it = gw; it < NITEMS; it += NGW) {
            int r = it; const int l = r / (I_IN + I_OUT); r -= l * (I_IN + I_OUT);
            if (r < I_IN) p0_transpose_item(w_in + (size_t)l * DM * PW, norm_g + l * DM, DM, PW, (f16*)WIN + (size_t)l * PW * DM, scr, r, lane);
            else p0_transpose_item(w_out + (size_t)l * DM * DM, nullptr, DM, DM, (f16*)WOUT + (size_t)l * DM * DM, scr, r - I_IN, lane);
        }
        SW_END(9);
        SW_BEGIN(10);
        { int m = gw; for (; m + 3 * NGW < MROWS; m += 4 * NGW) x_rows4(x, (f16*)XB, (float*)PART, m, NGW, lane); for (; m < MROWS; m += NGW) x_row1(x, (f16*)XB, (float*)PART, m, lane); }
        SW_END(10);
    }
    SW_END(6);
    { SW_BEGIN(7); xcd_barrier(bar); SW_END(7); }

    for (int l = 0; l < DEPTH; ++l) {
        { GAS unsigned char* wsl = wsg; asm volatile("" : "+s"(wsl)); WIN = (GAS f16*)(wsl + WS_WIN); WOUT = (GAS f16*)(wsl + WS_WOUT); PART = (GAS float*)(wsl + WS_PART); XB = (GAS f16*)(wsl + WS_XB); MIX = (GAS f16*)(wsl + WS_MIX); PROJ = (GAS f16*)(wsl + WS_PROJ);
          asm volatile("" : "+s"(out)); asm volatile("" : "+s"(x)); asm volatile("" : "+s"(subln_g)); asm volatile("" : "+s"(q_norm_g)); asm volatile("" : "+s"(k_norm_g)); asm volatile("" : "+s"(bar.bar)); }
        for (int rep = 0; rep < REP_G1; ++rep) {
            pg8::Gemm g{(const f16*)XB, (const f16*)WIN + (size_t)l * PW * DM, MROWS, PW, DM}; pg8::StaticOrder S; S.init(MROWS, PW, G, bx);
            pg8::EpiProj E{PROJ, PART, (const GAS float*)q_norm_g + l * 64, (const GAS float*)k_norm_g + l * 64, lds + RING_BYTES};
            SW_BEGIN(5);
            pg8::gemm_phase<pg8::EpiProj>(lds + RING_OFF, g, S, E, sw_acc);
            SW_END(5);
        }
        { SW_BEGIN(7); xcd_barrier(bar); SW_END(7); }
        {
            const float sa = att::wave_sum(lq1[l * 64 + lane] * lk1[l * 64 + lane]), sb = att::wave_sum(lq2[l * 64 + lane] * lk2[l * 64 + lane]);
            const float lam_init = 0.8f - 0.6f * __expf(-0.3f * (float)l);
            const float lam = __expf(sa) - __expf(sb) + lam_init;
            const float mgq = att::wave_max(fabsf(q_norm_g[l * 64 + lane])), mgk = att::wave_max(fabsf(k_norm_g[l * 64 + lane]));
            const float mref = 8.0f * LOG2E * mgq * mgk * 1.001f - 10.0f;
            __syncthreads();
            for (int rep = 0; rep < REP_DA; ++rep) { SW_BEGIN(1); att::da_phase(lds + RING_OFF, PROJ, MIX, vcu, G, lam, mref, (const GAS float*)subln_g + l * 128, 1.0f - lam_init, sw_acc); SW_END(1); }
            for (int rep = 0; rep < REP_SB; ++rep) { SW_BEGIN(4); att::sb_phase(lds + RING_OFF, PROJ, MIX, vcu, G, sw_acc); SW_END(4); }
        }
        { SW_BEGIN(7); xcd_barrier(bar); SW_END(7); }
        {
            pg8::Gemm g{(const f16*)MIX, (const f16*)WOUT + (size_t)l * DM * DM, MROWS, DM, DM}; pg8::StaticOrder S; S.init(MROWS, DM, G, bx);
            pg8::EpiOut E{(GAS float*)out, XB, PART, (l + 1 < DEPTH) ? 0 : 1};
            SW_BEGIN(8);
            pg8::gemm_phase<pg8::EpiOut>(lds + RING_OFF, g, S, E, sw_acc);
            SW_END(8);
        }
        if (l + 1 < DEPTH) { SW_BEGIN(7); xcd_barrier(bar); SW_END(7); }
    }
#if SW_ID
    if (wave == 0) { const unsigned long long t0 = __builtin_amdgcn_s_memrealtime(), span = (unsigned long long)SW_K * sw_acc; while (__builtin_amdgcn_s_memrealtime() - t0 < span) __builtin_amdgcn_s_sleep(8); }
#endif
}

extern "C" void kernel_launch(void* const* d_in, const int* in_sizes, int n_in, void* d_out, int out_size, void* d_ws, size_t ws_size, hipStream_t stream) {
    static int grid = 0;
    if (grid == 0) {
        if (n_in != 11 || in_sizes[0] != MROWS * DM || out_size != MROWS * DM || ws_size < WS_END) {
            fprintf(stderr, "kernel_launch: unexpected problem shape (n_in %d, in0 %d, out %d, ws %zu); nothing launched\n", n_in, n_in > 0 ? in_sizes[0] : -1, out_size, ws_size); grid = -1; return; }
        int dev = 0, cus = 0, per_cu = 0;
        if (hipGetDevice(&dev) != hipSuccess || hipDeviceGetAttribute(&cus, hipDeviceAttributeMultiprocessorCount, dev) != hipSuccess) { grid = -1; return; }
        if (hipFuncSetAttribute((const void*)hybrid_fwd, hipFuncAttributeMaxDynamicSharedMemorySize, LDS_BYTES) != hipSuccess) { fprintf(stderr, "kernel_launch: hipFuncSetAttribute failed\n"); grid = -1; return; }
        if (hipOccupancyMaxActiveBlocksPerMultiprocessor(&per_cu, (const void*)hybrid_fwd, NWAVES * 64, LDS_BYTES) != hipSuccess || per_cu < 1) {
            fprintf(stderr, "kernel_launch: occupancy query reports %d workgroups per CU; nothing launched\n", per_cu); (void)hipGetLastError(); grid = -1; return; }
        grid = cus;
    }
    if (grid < 0) return;
    if (hipMemsetAsync((char*)d_ws + WS_CTL, 0, CTL_ZERO_BYTES, stream) != hipSuccess) { fprintf(stderr, "kernel_launch: hipMemsetAsync failed\n"); return; }
    Args a{};
    for (int i = 0; i < 11; ++i) a.in[i] = (const float*)d_in[i];
    a.out = (float*)d_out; a.ws = (unsigned char*)d_ws;
    hipLaunchKernelGGL(hybrid_fwd, dim3(grid), dim3(NWAVES * 64), LDS_BYTES, stream, a);
    const hipError_t le = hipPeekAtLastError();
    if (le != hipSuccess) fprintf(stderr, "kernel_launch: launch failed: %s\n", hipGetErrorName(le));
}
```

```cpp
#include <hip/hip_runtime.h>
#include <cstdio>
#include <cstdint>

#ifndef SB_EARLY_EXIT
#define SB_EARLY_EXIT 1
#endif
#define SW_ID 0
#define SW_K 4
#define REP_PRO 1
#define REP_G1 1
#define REP_DA 1
#define REP_SB 1
#define REP_G2 1

#if SW_ID
#define SW_BEGIN(id) unsigned long long sw_t0_##id = 0; if (SW_ID == (id)) sw_t0_##id = __builtin_amdgcn_s_memrealtime()
#define SW_END(id) do { if (SW_ID == (id)) sw_acc += __builtin_amdgcn_s_memrealtime() - sw_t0_##id; } while (0)
#else
#define SW_BEGIN(id) do {} while (0)
#define SW_END(id) do {} while (0)
#endif
#define LAS __attribute__((address_space(3)))
#define GAS __attribute__((address_space(1)))
typedef _Float16 f16;
typedef _Float16 h8 __attribute__((ext_vector_type(8)));
typedef _Float16 h4 __attribute__((ext_vector_type(4)));
typedef _Float16 h2 __attribute__((ext_vector_type(2)));
typedef float f32x4 __attribute__((ext_vector_type(4)));
typedef float f32x16 __attribute__((ext_vector_type(16)));
typedef unsigned u32x4 __attribute__((ext_vector_type(4)));
typedef unsigned u32x2 __attribute__((ext_vector_type(2)));

constexpr int BATCH = 16, SEQ = 2048, DM = 1024, MROWS = BATCH * SEQ, PW = 4096, DEPTH = 2;
constexpr float RMS_EPS = 1e-6f;
constexpr float LOG2E = 1.4426950408889634f;
constexpr float QS = 0.125f * LOG2E;
constexpr int C_SBQ = 0, C_SBK = 512, C_SBV = 1024, C_SBG = 1536, C_DAQ = 2048, C_DAK = 2560, C_DAV = 3072, C_DAG = 3584;

__device__ __forceinline__ unsigned pkh(float lo, float hi) { h2 v = {(f16)lo, (f16)hi}; return __builtin_bit_cast(unsigned, v); }
__device__ __forceinline__ unsigned pkh_rtz(float lo, float hi) { return __builtin_bit_cast(unsigned, __builtin_amdgcn_cvt_pkrtz(lo, hi)); }
__device__ __forceinline__ float row4_sum(float s) {
    { const auto r = __builtin_amdgcn_permlane16_swap(__float_as_uint(s), __float_as_uint(s), false, false); s = __uint_as_float(r[0]) + __uint_as_float(r[1]); }
    { const auto r = __builtin_amdgcn_permlane32_swap(__float_as_uint(s), __float_as_uint(s), false, false); s = __uint_as_float(r[0]) + __uint_as_float(r[1]); }
    return s;
}
__device__ __forceinline__ float silu_f(float v) { return v * __builtin_amdgcn_rcpf(1.0f + __builtin_amdgcn_exp2f(-v * LOG2E)); }

namespace pg8 {
constexpr int BM = 256, BK = 64, HALF = 128, HTB = HALF * BK * 2, STAGE_BYTES = 8 * HTB, NXCD = 8, WGM = 8;
__host__ __device__ __forceinline__ int lds_byte(int r, int c) { const int st = (r >> 4) * 2 + (c >> 5), rr = r & 15, cc = c & 31, ob = rr * 64 + cc * 2; return st * 1024 + (ob ^ (((ob >> 9) & 1) << 5)); }
__host__ __device__ __forceinline__ void stage_rc(int b, int& R, int& C) { const int st = b / 1024, sb = b % 1024, swz = sb ^ (((sb >> 9) & 1) << 5); R = (st >> 1) * 16 + swz / 64; C = (st & 1) * 32 + (swz % 64) / 2; }
__host__ __device__ __forceinline__ int perm32(int rho) { const int n = rho >> 4, i = rho & 15; return 8 * (i >> 2) + 4 * n + (i & 3); }

struct Unit { int pm, pn; };
struct Gemm { const f16* A; const f16* Bt; int M, N, K; };

struct StaticOrder {
    int nM, nN, nwg, G, c;
    __host__ __device__ void init(int M, int N, int G_, int c_) { nM = M / BM; nN = N / BM; nwg = nM * nN; G = G_; c = c_; }
    __host__ __device__ bool next(int i, Unit& u) const {
        const long L = (long)i * G + c; if (L >= nwg) return false;
        int wgid = (int)L; { const int q = nwg / NXCD, r = nwg % NXCD, xcd = wgid % NXCD, off = wgid / NXCD; wgid = (xcd < r ? xcd * (q + 1) : r * (q + 1) + (xcd - r) * q) + off; }
        const int nig = WGM * nN, gid = wgid / nig, fm = gid * WGM, gsz = (nM - fm) < WGM ? (nM - fm) : WGM;
        u.pm = fm + ((wgid % nig) % gsz); u.pn = (wgid % nig) / gsz; return true;
    }
};


struct EpiProj {
    GAS f16* P; const GAS float* part; const GAS float* gq; const GAS float* gk; LAS unsigned char* rsc;
    struct Pre { f32x4 a[2][2]; int pm[2]; };
    __device__ __forceinline__ void pre_load(Pre& R, const StaticOrder& S) const {
        Unit u0, u4; R.pm[0] = S.next(0, u0) ? u0.pm : -1; R.pm[1] = (S.next(4, u4) && u4.pm != R.pm[0]) ? u4.pm : -1;
        const int t = threadIdx.x, row = t >> 1, half = t & 1;
#pragma unroll
        for (int k = 0; k < 2; ++k) { const GAS f32x4* p = (const GAS f32x4*)(part + ((size_t)(R.pm[k] < 0 ? 0 : R.pm[k]) * BM + row) * 16 + half * 8); R.a[k][0] = p[0]; R.a[k][1] = p[1]; }
    }
    __device__ __forceinline__ void pre_finish(const Pre& R) const {
        const int t = threadIdx.x, row = t >> 1, half = t & 1;
#pragma unroll
        for (int k = 0; k < 2; ++k) {
            float sum = ((R.a[k][0][0] + R.a[k][0][1]) + (R.a[k][0][2] + R.a[k][0][3])) + ((R.a[k][1][0] + R.a[k][1][1]) + (R.a[k][1][2] + R.a[k][1][3]));
            sum += __shfl_xor(sum, 1);
            if (half == 0) ((LAS float*)rsc)[k * 256 + row] = __builtin_amdgcn_rsqf(sum * (1.0f / DM) + RMS_EPS);
        }
        if (t == 0) ((LAS int*)(rsc + 2048))[0] = R.pm[0];
        if (t == 1) ((LAS int*)(rsc + 2048))[1] = R.pm[1];
    }
    __device__ __forceinline__ void operator()(const f32x4 (&acc)[2][2][4][2], const Unit& u, int wr, int wc, int fr, int fq) const {
        const int sec = u.pn >> 1;
        const int row0 = u.pm * BM + wr * 64 + fr;
        const int colw = u.pn * BM + wc * 64 + 8 * fq;
        f32x4 gain[2][2];
        if (sec == 4 || sec == 5) {
            const GAS float* g = (sec == 4) ? gq : gk;
#pragma unroll
            for (int bj = 0; bj < 2; ++bj)
#pragma unroll
                for (int n = 0; n < 2; ++n) gain[bj][n] = *(const GAS f32x4*)(g + 32 * bj + 8 * fq + 4 * n);
        }
        const LAS int* tags = (const LAS int*)(rsc + 2048);
        const int slot = (tags[0] == u.pm) ? 0 : (tags[1] == u.pm) ? 1 : -1;
        const LAS float* rtab = (const LAS float*)rsc + (slot > 0 ? 256 : 0) + wr * 64 + fr;
#pragma unroll
        for (int ai = 0; ai < 2; ++ai)
#pragma unroll
            for (int m = 0; m < 4; ++m) {
                const int row = row0 + ai * HALF + m * 16;
                float rs;
                if (slot >= 0) rs = rtab[ai * HALF + m * 16];
                else {
                    const f32x4 pv = *(const GAS f32x4*)(part + (size_t)row * 16 + fq * 4);
                    float s = (pv[0] + pv[1]) + (pv[2] + pv[3]);
                    s = row4_sum(s);
                    rs = __builtin_amdgcn_rsqf(s * (1.0f / DM) + RMS_EPS);
                }
                f32x4 v[2][2];
#pragma unroll
                for (int bj = 0; bj < 2; ++bj)
#pragma unroll
                    for (int n = 0; n < 2; ++n) v[bj][n] = acc[ai][bj][m][n] * rs;
                if (sec == 4 || sec == 5) {
                    float ss = 0.f;
#pragma unroll
                    for (int bj = 0; bj < 2; ++bj)
#pragma unroll
                        for (int n = 0; n < 2; ++n) { const f32x4 x = v[bj][n]; ss += (x[0] * x[0] + x[1] * x[1]) + (x[2] * x[2] + x[3] * x[3]); }
                    ss = row4_sum(ss);
                    float rn = __builtin_amdgcn_rsqf(ss * (1.0f / 64.0f) + RMS_EPS);
                    if (sec == 4) rn *= QS;
#pragma unroll
                    for (int bj = 0; bj < 2; ++bj)
#pragma unroll
                        for (int n = 0; n < 2; ++n) v[bj][n] = v[bj][n] * rn * gain[bj][n];
                } else if (sec == 0) {
#pragma unroll
                    for (int bj = 0; bj < 2; ++bj)
#pragma unroll
                        for (int n = 0; n < 2; ++n) v[bj][n] = v[bj][n] * QS;
                } else if (sec == 3 || sec == 7) {
#pragma unroll
                    for (int bj = 0; bj < 2; ++bj)
#pragma unroll
                        for (int n = 0; n < 2; ++n)
#pragma unroll
                            for (int e = 0; e < 4; ++e) v[bj][n][e] = silu_f(v[bj][n][e]);
                }
                GAS f16* rowp = P + (size_t)row * PW + colw;
#pragma unroll
                for (int bj = 0; bj < 2; ++bj) {
                    u32x4 w; w.x = pkh(v[bj][0][0], v[bj][0][1]); w.y = pkh(v[bj][0][2], v[bj][0][3]); w.z = pkh(v[bj][1][0], v[bj][1][1]); w.w = pkh(v[bj][1][2], v[bj][1][3]);
                    *(GAS u32x4*)(rowp + 32 * bj) = w;
                }
            }
    }
};

struct EpiOut {
    GAS float* out; GAS f16* xb; GAS float* part; int last;
    struct Pre {};
    __device__ __forceinline__ void pre_load(Pre&, const StaticOrder&) const {}
    __device__ __forceinline__ void pre_finish(const Pre&) const {}
    __device__ __forceinline__ void operator()(const f32x4 (&acc)[2][2][4][2], const Unit& u, int wr, int wc, int fr, int fq) const {
        const int row0 = u.pm * BM + wr * 64 + fr;
        const int colw = u.pn * BM + wc * 64 + 8 * fq;
#pragma unroll
        for (int ai = 0; ai < 2; ++ai) {
            h8 bs[4][2];
#pragma unroll
            for (int m = 0; m < 4; ++m)
#pragma unroll
                for (int bj = 0; bj < 2; ++bj) bs[m][bj] = *(const GAS h8*)(xb + (size_t)(row0 + ai * HALF + m * 16) * DM + colw + 32 * bj);
#pragma unroll
            for (int m = 0; m < 4; ++m) {
                const int row = row0 + ai * HALF + m * 16;
                const size_t off = (size_t)row * DM + colw;
                float ss = 0.f;
#pragma unroll
                for (int bj = 0; bj < 2; ++bj) {
                    const h8 b = bs[m][bj];
                    f32x4 o0 = acc[ai][bj][m][0], o1 = acc[ai][bj][m][1];
                    o0[0] += (float)b[0]; o0[1] += (float)b[1]; o0[2] += (float)b[2]; o0[3] += (float)b[3];
                    o1[0] += (float)b[4]; o1[1] += (float)b[5]; o1[2] += (float)b[6]; o1[3] += (float)b[7];
                    if (last) { *(GAS f32x4*)(out + off + 32 * bj) = o0; *(GAS f32x4*)(out + off + 32 * bj + 4) = o1; }
                    else {
                        ss += (o0[0] * o0[0] + o0[1] * o0[1]) + (o0[2] * o0[2] + o0[3] * o0[3]) + (o1[0] * o1[0] + o1[1] * o1[1]) + (o1[2] * o1[2] + o1[3] * o1[3]);
                        u32x4 w; w.x = pkh(o0[0], o0[1]); w.y = pkh(o0[2], o0[3]); w.z = pkh(o1[0], o1[1]); w.w = pkh(o1[2], o1[3]);
                        *(GAS u32x4*)(xb + off + 32 * bj) = w;
                    }
                }
                if (!last) {
                    ss = row4_sum(ss);
                    if (fq == 0) part[(size_t)row * 16 + u.pn * 4 + wc] = ss;
                }
            }
        }
    }
};

template <class Epi>
__device__ __forceinline__ void gemm_phase(LAS unsigned char* lds, const Gemm g, const StaticOrder& S, const Epi& E, unsigned long long& sw_acc) {
    int tid_ = threadIdx.x; asm volatile("" : "+v"(tid_));
    const int tid = tid_, wid = __builtin_amdgcn_readfirstlane(tid >> 6), lane = tid & 63, wr = wid >> 2, wc = wid & 3, fr = lane & 15, fq = lane >> 4;
    const int K = g.K, nt = K / BK;
    unsigned voffA[2], voffB[2];
#pragma unroll
    for (int i = 0; i < 2; ++i) { int R, C; stage_rc(tid * 16 + i * 8192, R, C);
        const int Rb = (R >> 5) * 64 + perm32(R & 31);
        voffA[i] = (unsigned)(R * K + C) * 2u; voffB[i] = (unsigned)(Rb * K + C) * 2u; }
    const size_t kstep = (size_t)(BK * 2);
    const size_t hstep = (size_t)HALF * K * 2;
    const size_t hstepB = (size_t)32 * K * 2;
    const size_t tstep = 2 * hstep;
    const unsigned ldsw = (unsigned)wid * 1024u;
    const int aoff = lds_byte(wr * 64 + fr, fq * 8), boff = lds_byte(wc * 32 + fr, fq * 8);
#define PG8_SA(b, h) (((b) * 2 + (h)) * HTB)
#define PG8_SB(b, h) ((4 + (b) * 2 + (h)) * HTB)
#define PG8_STAGE(bufoff, gbase, voff) do { _Pragma("unroll") for (int _i = 0; _i < 2; ++_i) \
        __builtin_amdgcn_global_load_lds((const unsigned*)((const char*)(gbase) + (voff)[_i]), (LAS unsigned*)(lds + (bufoff) + ldsw + _i * 8192), 16, 0, 0); } while (0)
#define PG8_LDA(dst, b, h) do { _Pragma("unroll") for (int m = 0; m < 4; ++m) _Pragma("unroll") for (int k = 0; k < 2; ++k) dst[m][k] = *(const LAS h8*)(lds + PG8_SA(b, h) + aoff + m * 2048 + k * 1024); } while (0)
#define PG8_LDB(dst, b, h) do { _Pragma("unroll") for (int n = 0; n < 2; ++n) _Pragma("unroll") for (int k = 0; k < 2; ++k) dst[n][k] = *(const LAS h8*)(lds + PG8_SB(b, h) + boff + n * 2048 + k * 1024); } while (0)
#define PG8_MMA(ai, bj, At, Bt) do { __builtin_amdgcn_s_setprio(1); _Pragma("unroll") for (int m = 0; m < 4; ++m) _Pragma("unroll") for (int n = 0; n < 2; ++n) _Pragma("unroll") for (int k = 0; k < 2; ++k) \
        acc[ai][bj][m][n] = __builtin_amdgcn_mfma_f32_16x16x32_f16(Bt[n][k], At[m][k], acc[ai][bj][m][n], 0, 0, 0); __builtin_amdgcn_s_setprio(0); } while (0)
#define PG8_WAIT_V(n) asm volatile("s_waitcnt vmcnt(" #n ")" ::: "memory")
#define PG8_WAIT_L(n) asm volatile("s_waitcnt lgkmcnt(" #n ")" ::: "memory")
#define PG8_BAR __builtin_amdgcn_s_barrier()
#define PG8_SCHED __builtin_amdgcn_sched_barrier(0)
    Unit cur, nxt; int ui = 0;
    if (!S.next(0, cur)) return;
    f32x4 acc[2][2][4][2];
#pragma unroll
    for (int a = 0; a < 2; ++a)
#pragma unroll
        for (int b = 0; b < 2; ++b)
#pragma unroll
            for (int m = 0; m < 4; ++m)
#pragma unroll
                for (int n = 0; n < 2; ++n) acc[a][b][m][n] = (f32x4){0.f, 0.f, 0.f, 0.f};
    h8 At[4][2], B0[2][2], B1[2][2];
    const char* cA = (const char*)g.A + (size_t)cur.pm * tstep; const char* cB = (const char*)g.Bt + (size_t)cur.pn * tstep;
    PG8_STAGE(PG8_SB(0, 0), cB, voffB); PG8_STAGE(PG8_SB(0, 1), cB + hstepB, voffB); PG8_STAGE(PG8_SA(0, 0), cA, voffA); PG8_STAGE(PG8_SA(0, 1), cA + hstep, voffA);
    typename Epi::Pre pre; E.pre_load(pre, S);
    if (wr == 1) PG8_BAR;
    PG8_WAIT_V(2); PG8_BAR;
    E.pre_finish(pre);
    PG8_WAIT_L(0);
    PG8_STAGE(PG8_SB(1, 0), cB + kstep, voffB); PG8_STAGE(PG8_SA(1, 0), cA + kstep, voffA); PG8_STAGE(PG8_SB(1, 1), cB + hstepB + kstep, voffB);
    PG8_WAIT_V(6); PG8_BAR;
    for (;;) {
        const bool has_next = S.next(ui + 1, nxt);
        const char* nA = has_next ? (const char*)g.A + (size_t)nxt.pm * tstep : cA; const char* nB = has_next ? (const char*)g.Bt + (size_t)nxt.pn * tstep : cB;
        for (int t = 0; t < nt; t += 2) {
            const bool last = (t == nt - 2);
            const char* a1 = cA + (size_t)(t + 1) * kstep;
            const char* a2 = last ? nA : cA + (size_t)(t + 2) * kstep; const char* b2 = last ? nB : cB + (size_t)(t + 2) * kstep;
            const char* a3 = a2 + kstep; const char* b3 = b2 + kstep;
            PG8_LDB(B0, 0, 0); PG8_LDB(B1, 0, 1); PG8_SCHED; PG8_LDA(At, 0, 0); PG8_STAGE(PG8_SA(1, 1), a1 + hstep, voffA);
            PG8_WAIT_V(8); PG8_WAIT_L(0); PG8_BAR; PG8_MMA(0, 0, At, B0); PG8_MMA(0, 1, At, B1); PG8_BAR; PG8_SCHED;
            PG8_LDA(At, 0, 1); PG8_STAGE(PG8_SB(0, 0), b2, voffB); PG8_STAGE(PG8_SB(0, 1), b2 + hstepB, voffB); PG8_STAGE(PG8_SA(0, 0), a2, voffA);
            PG8_WAIT_V(8); PG8_WAIT_L(0); PG8_BAR; PG8_MMA(1, 0, At, B0); PG8_MMA(1, 1, At, B1); PG8_BAR; PG8_SCHED;
            PG8_LDB(B0, 1, 0); PG8_LDB(B1, 1, 1); PG8_SCHED; PG8_LDA(At, 1, 0); PG8_STAGE(PG8_SA(0, 1), a2 + hstep, voffA);
            PG8_WAIT_V(8); PG8_WAIT_L(0); PG8_BAR; PG8_MMA(0, 0, At, B0); PG8_MMA(0, 1, At, B1); PG8_BAR; PG8_SCHED;
            PG8_LDA(At, 1, 1); PG8_STAGE(PG8_SB(1, 0), b3, voffB); PG8_STAGE(PG8_SB(1, 1), b3 + hstepB, voffB); PG8_STAGE(PG8_SA(1, 0), a3, voffA);
            PG8_WAIT_V(8); PG8_WAIT_L(0); PG8_BAR; PG8_MMA(1, 0, At, B0); PG8_MMA(1, 1, At, B1); PG8_BAR; PG8_SCHED;
        }
        if (wr == 0) PG8_BAR;
        { SW_BEGIN(20); E(acc, cur, wr, wc, fr, fq); SW_END(20); }
        if (!has_next) break;
#pragma unroll
        for (int a = 0; a < 2; ++a)
#pragma unroll
            for (int b = 0; b < 2; ++b)
#pragma unroll
                for (int m = 0; m < 4; ++m)
#pragma unroll
                    for (int n = 0; n < 2; ++n) acc[a][b][m][n] = (f32x4){0.f, 0.f, 0.f, 0.f};
        cur = nxt; cA = nA; cB = nB; ++ui;
        if (wr == 1) PG8_BAR;
    }
    PG8_WAIT_V(0);
    PG8_BAR;
#undef PG8_SA
#undef PG8_SB
#undef PG8_STAGE
#undef PG8_LDA
#undef PG8_LDB
#undef PG8_MMA
#undef PG8_WAIT_V
#undef PG8_WAIT_L
#undef PG8_BAR
#undef PG8_SCHED
}
}

namespace att {
typedef short v4i16_t __attribute__((ext_vector_type(4)));
__device__ __forceinline__ int crow(int r, int hi) { return (r & 3) + 8 * (r >> 2) + 4 * hi; }
__device__ __forceinline__ int keyrow(int i) { return 32 * ((i >> 2) & 1) + (i & 3) + 4 * (i >> 3); }
__device__ __forceinline__ h4 vtr(const LAS unsigned char* p) { return __builtin_bit_cast(h4, __builtin_amdgcn_ds_read_tr16_b64_v4i16((LAS v4i16_t*)p)); }
__device__ __forceinline__ h8 cat8(h4 a, h4 b) { return (h8){a[0], a[1], a[2], a[3], b[0], b[1], b[2], b[3]}; }
#define MFMA32(a, b, c) __builtin_amdgcn_mfma_f32_32x32x16_f16(a, b, c, 0, 0, 0)
__device__ __forceinline__ h8 pack8(const f32x16& p, int b) {
    u32x4 w; w.x = pkh_rtz(p[b], p[b + 1]); w.y = pkh_rtz(p[b + 2], p[b + 3]); w.z = pkh_rtz(p[b + 4], p[b + 5]); w.w = pkh_rtz(p[b + 6], p[b + 7]);
    return __builtin_bit_cast(h8, w);
}
template <int KI> __device__ __forceinline__ float fmamk_s(float c, float base) {
    float r; asm volatile("v_fmamk_f32 %0, %1, %2, %3" : "=v"(r) : "v"(c), "i"(__builtin_bit_cast(int, (float)KI)), "v"(base)); return r; }
__device__ __forceinline__ float wave_sum(float v) {
#pragma unroll
    for (int o = 1; o < 64; o <<= 1) v += __shfl_xor(v, o);
    return v;
}
__device__ __forceinline__ float wave_max(float v) {
#pragma unroll
    for (int o = 1; o < 64; o <<= 1) v = fmaxf(v, __shfl_xor(v, o));
    return v;
}

__device__ __forceinline__ void glds16(const GAS void* g, unsigned lds_base) {
    unsigned sv; asm volatile("s_mov_b32 %0, m0\n\ts_mov_b32 m0, %2\n\ts_nop 0\n\tglobal_load_lds_dwordx4 %1, off\n\ts_mov_b32 m0, %0" : "=&s"(sv) : "v"(g), "s"(lds_base) : "memory"); }
#define WAIT_BAR(N) asm volatile("s_waitcnt vmcnt(" #N ") lgkmcnt(0)\n\ts_barrier" ::: "memory")
__device__ __forceinline__ void wait_bar_n(int n) {
    switch (n) { case 0: WAIT_BAR(0); break; case 2: WAIT_BAR(2); break; case 4: WAIT_BAR(4); break; case 6: WAIT_BAR(6); break; case 8: WAIT_BAR(8); break; case 10: WAIT_BAR(10); break;
                 case 12: WAIT_BAR(12); break; case 14: WAIT_BAR(14); break; case 16: WAIT_BAR(16); break; case 18: WAIT_BAR(18); break; case 20: WAIT_BAR(20); break; default: WAIT_BAR(0); break; }
}

constexpr int SB_SLOT = 65536, SB_FLG = 147456 + 2048;
__device__ __forceinline__ int keyrow16(int i) { return 16 * ((i >> 2) & 1) + (i & 3) + 4 * (i >> 3); }
struct SbUnit { int b, hg, cq; };
__device__ __forceinline__ bool sb_decode(int u, SbUnit& U) {
    if (u >= 1024) return false;
    const int r = u >> 8, v = u & 255, i = v & 15;
    U.b = v >> 4; U.hg = i & 1; U.cq = (i >> 1) + 8 * r; return true;
}
__device__ __forceinline__ void sb_phase(LAS unsigned char* lds, const GAS f16* __restrict__ proj, GAS f16* __restrict__ mixed, int vcu, int G, unsigned long long& sw_acc) {
    int tid_ = threadIdx.x; asm volatile("" : "+v"(tid_));
    const int tid = tid_, lane = tid & 63, l31 = lane & 31, hi = lane >> 5; const int w = __builtin_amdgcn_readfirstlane(tid >> 6);
    const int hh = w & 3, rgp = w >> 2;
    const unsigned lds0 = (unsigned)(uintptr_t)lds;
    const unsigned kdst = lds0 + w * 4096, vdst = lds0 + 32768 + w * 4096;
    int kfo[4];
    { const int kr = keyrow16(l31);
#pragma unroll
      for (int d0 = 0; d0 < 4; ++d0) kfo[d0] = kr * 512 + (((hh * 8 + 2 * d0 + hi) ^ (kr & 15)) * 16); }
    int vfo[2];
    { const int q_ = (lane & 15) >> 2;
#pragma unroll
      for (int d0 = 0; d0 < 2; ++d0) vfo[d0] = 32768 + (16 * hi + q_) * 512 + (((hh * 2 + d0) ^ q_) * 64) + ((lane >> 4) & 1) * 32 + (lane & 3) * 8; }
    LAS unsigned* flags = (LAS unsigned*)(lds + SB_FLG);
    size_t koff[4], voff[4];
#pragma unroll
    for (int i = 0; i < 4; ++i) { const int row = 8 * w + 2 * i + (lane >> 5), p = lane & 31;
        koff[i] = (size_t)row * PW + C_SBK + ((p ^ (row & 15)) * 8);
        voff[i] = (size_t)row * PW + C_SBV + ((((p >> 2) ^ (row & 3)) * 4 + (p & 3)) * 8); }
    const size_t qoff = (size_t)(32 * rgp + l31) * PW;
#define SB_DMA(base_, kt_, slot) do { const GAS f16* b_ = (base_) + (size_t)(kt_) * 64 * PW; const unsigned kd_ = (unsigned)__builtin_amdgcn_readfirstlane(kdst + (slot)), vd_ = (unsigned)__builtin_amdgcn_readfirstlane(vdst + (slot)); \
        _Pragma("unroll") for (int i_ = 0; i_ < 4; ++i_) { glds16(b_ + koff[i_], kd_ + i_ * 1024); glds16(b_ + voff[i_], vd_ + i_ * 1024); } } while (0)
    SbUnit U, Un; int ui = vcu;
    if (!sb_decode(ui, U)) return;
    int islot = 0, cslot = 0;
    const GAS f16* tbase = proj + ((size_t)U.b * SEQ) * PW + U.hg * 256;
    h8 qn[4]; u32x2 gn[8];
    { const size_t grow = (size_t)U.b * SEQ + U.cq * 64 + 32 * rgp + l31; const int h = 4 * U.hg + hh;
      const GAS f16* Qg = proj + grow * PW + C_SBQ + h * 64 + 8 * hi; const GAS f16* Gp = proj + grow * PW + C_SBG + h * 64 + 4 * hi;
#pragma unroll
      for (int d0 = 0; d0 < 4; ++d0) qn[d0] = *(const GAS h8*)(Qg + 16 * d0);
#pragma unroll
      for (int i = 0; i < 8; ++i) gn[i] = *(const GAS u32x2*)(Gp + 8 * i); }
    asm volatile("" : "+v"(qn[0]), "+v"(qn[1]), "+v"(qn[2]), "+v"(qn[3]));
    SB_DMA(tbase, U.cq, islot); islot ^= SB_SLOT;
    for (;;) {
        const size_t rowbase = (size_t)U.b * SEQ;
        const int qw = U.cq * 64 + 32 * rgp, t = qw + l31, NT = U.cq + 1, h = 4 * U.hg + hh;
        const size_t grow = rowbase + qw + l31;
        h8 qr[4]; u32x2 gv[8];
#pragma unroll
        for (int d0 = 0; d0 < 4; ++d0) qr[d0] = qn[d0];
#pragma unroll
        for (int i = 0; i < 8; ++i) gv[i] = gn[i];
        const bool has_next = sb_decode(ui + G, Un);
        f32x16 o[2]; o[0] = f32x16{}; o[1] = f32x16{};
        float carry = 1.f; int done = 0;
        SW_BEGIN(12);
        for (int j = 0; j < NT; ++j) {
            SW_BEGIN(13);
            WAIT_BAR(0);
            SW_END(13);
            if (j > 0) {
                const u32x4 f0 = *(const LAS u32x4*)(flags + ((j - 1) & 1) * 8), f1 = *(const LAS u32x4*)(flags + ((j - 1) & 1) * 8 + 4);
                const unsigned any = (f0.x | f0.y | f0.z | f0.w) | (f1.x | f1.y | f1.z | f1.w);
                if (!__builtin_amdgcn_readfirstlane(any)) break;
            }
            if (j + 1 < NT) { SB_DMA(tbase, U.cq - (j + 1), islot); islot ^= SB_SLOT; }
            const int kt = U.cq - j;
#pragma unroll
            for (int sub = 0; sub < 2; ++sub) {
                const int kb32 = sub == 0 ? 32 : 0;
                const bool diag = (j == 0) && (sub == (rgp == 1 ? 0 : 1));
                const bool skip = (j == 0) && (rgp == 0) && (sub == 0);
                if (!done && !skip) {
                    const LAS unsigned char* Sb = lds + cslot + kb32 * 512;
                    f32x16 p = f32x16{};
#pragma unroll
                    for (int d0 = 0; d0 < 4; ++d0) { const h8 k0 = *(const LAS h8*)(Sb + kfo[d0]); p = MFMA32(k0, qr[d0], p); }
#pragma unroll
                    for (int r = 0; r < 16; ++r) p[r] = __builtin_amdgcn_rcpf(1.0f + __builtin_amdgcn_exp2f(-p[r]));
                    if (diag) {
                        const int key0 = 64 * kt + kb32 + 16 * hi;
#pragma unroll
                        for (int r = 0; r < 16; ++r) if (key0 + r >= t) p[r] = 0.f;
                    }
                    float run = 1.f;
#pragma unroll
                    for (int r = 15; r >= 0; --r) { const float a = run * p[r]; run -= a; p[r] = a; }
                    const auto rr = __builtin_amdgcn_permlane32_swap(__float_as_uint(run), __float_as_uint(run), false, false);
                    const float T0 = __uint_as_float(rr[0]), T1 = __uint_as_float(rr[1]);
                    const float E = carry * (hi ? 1.0f : T1);
                    carry = carry * (T0 * T1);
#pragma unroll
                    for (int r = 0; r < 16; ++r) p[r] *= E;
                    const h8 pa0 = pack8(p, 0), pa1 = pack8(p, 8);
#pragma unroll
                    for (int d0 = 0; d0 < 2; ++d0) {
                        const LAS unsigned char* Vb = Sb + vfo[d0];
                        const h8 v0 = cat8(vtr(Vb), vtr(Vb + 2048));
                        const h8 v1 = cat8(vtr(Vb + 4096), vtr(Vb + 6144));
                        o[d0] = MFMA32(v0, pa0, o[d0]); o[d0] = MFMA32(v1, pa1, o[d0]);
                    }
#if SB_EARLY_EXIT
                    done = __builtin_amdgcn_readfirstlane(__all(carry < 1.0e-37f) ? 1 : 0);
#endif
                }
            }
            if (lane == 0) flags[(j & 1) * 8 + w] = done ? 0u : 1u;
            cslot ^= SB_SLOT;
        }
        asm volatile("s_nop 15\n\ts_nop 7" : "+v"(o[0]), "+v"(o[1]));
        SW_END(12);
        cslot = islot;
        if (has_next) {
            const size_t grown = (size_t)Un.b * SEQ + Un.cq * 64 + 32 * rgp + l31; const int hn = 4 * Un.hg + hh;
            const GAS f16* Qg = proj + grown * PW + C_SBQ + hn * 64 + 8 * hi; const GAS f16* Gp = proj + grown * PW + C_SBG + hn * 64 + 4 * hi;
#pragma unroll
            for (int d0 = 0; d0 < 4; ++d0) qn[d0] = *(const GAS h8*)(Qg + 16 * d0);
#pragma unroll
            for (int i = 0; i < 8; ++i) gn[i] = *(const GAS u32x2*)(Gp + 8 * i);
            asm volatile("" ::: "memory");
            tbase = proj + ((size_t)Un.b * SEQ) * PW + Un.hg * 256;
            SB_DMA(tbase, Un.cq, islot); islot ^= SB_SLOT;
        }
        {
            GAS f16* Op = mixed + grow * DM + h * 64 + 4 * hi;
#pragma unroll
            for (int d0 = 0; d0 < 2; ++d0)
#pragma unroll
                for (int rg4 = 0; rg4 < 4; ++rg4) {
                    const h4 g = __builtin_bit_cast(h4, gv[d0 * 4 + rg4]);
                    u32x2 wv; wv.x = pkh(o[d0][4 * rg4] * (float)g[0], o[d0][4 * rg4 + 1] * (float)g[1]); wv.y = pkh(o[d0][4 * rg4 + 2] * (float)g[2], o[d0][4 * rg4 + 3] * (float)g[3]);
                    *(GAS u32x2*)(Op + 32 * d0 + 8 * rg4) = wv;
                }
        }
        if (!has_next) break;
        U = Un; ui += G;
    }
#undef SB_DMA
    WAIT_BAR(0);
}

constexpr int DA_KS = 16384, DA_VRING = 49152, DA_XCH = 114688, DA_SUBG = 147456 + 1024, DA_SSX = 147456 + 3072;
struct DaUnit { int b, h, qt, klo; };
__device__ __forceinline__ int da_qt_of(int r, int i) {
    constexpr unsigned long long Q1 = 0xE92B6AF78C01D543ull, Q2 = 0x6C5B3014A78D29FEull, Q3 = 0x21F0DC6B43E87A59ull;
    return r == 0 ? i : (int)(((r == 1 ? Q1 : r == 2 ? Q2 : Q3) >> (4 * i)) & 15ull);
}
__device__ __forceinline__ int da_klo(int qt, int h) {
    const float cs = exp2f(-2.0f * (float)(h + 1)) * LOG2E;
    const int D = (int)ceilf(160.5f / cs), m = qt * 128 - D - 63;
    return m > 0 ? (m + 63) >> 6 : 0;
}
__device__ __forceinline__ bool da_decode(int u, DaUnit& U) {
    if (u >= 1024) return false;
    const int r = u >> 8, v = u & 255;
    U.b = v >> 4; U.h = r; U.qt = da_qt_of(r, v & 15); U.klo = da_klo(U.qt, U.h); return true;
}
__device__ __forceinline__ void da_pv(f32x16 (&o)[4], const LAS unsigned char* Vs, const int (&vfo)[4], h8 pa0, h8 pa1, h8 pa2, h8 pa3) {
    h8 f0, f1, f2, f3, g0, g1, g2, g3;
    { const LAS unsigned char* Vb = Vs + vfo[0]; f0 = cat8(vtr(Vb), vtr(Vb + 1024)); f1 = cat8(vtr(Vb + 2048), vtr(Vb + 3072)); f2 = cat8(vtr(Vb + 4096), vtr(Vb + 5120)); f3 = cat8(vtr(Vb + 6144), vtr(Vb + 7168)); }
#pragma unroll
    for (int d0 = 0; d0 < 4; ++d0) {
        if (d0 < 3) { const LAS unsigned char* Vb = Vs + vfo[d0 + 1]; g0 = cat8(vtr(Vb), vtr(Vb + 1024)); g1 = cat8(vtr(Vb + 2048), vtr(Vb + 3072)); g2 = cat8(vtr(Vb + 4096), vtr(Vb + 5120)); g3 = cat8(vtr(Vb + 6144), vtr(Vb + 7168)); }
        o[d0] = MFMA32(f0, pa0, o[d0]); o[d0] = MFMA32(f1, pa1, o[d0]); o[d0] = MFMA32(f2, pa2, o[d0]); o[d0] = MFMA32(f3, pa3, o[d0]);
        if (d0 < 3) { f0 = g0; f1 = g1; f2 = g2; f3 = g3; }
    }
}
__device__ __forceinline__ void da_phase(LAS unsigned char* lds, const GAS f16* __restrict__ proj, GAS f16* __restrict__ mixed, int vcu, int G,
                                         float lam, float mref, const GAS float* __restrict__ subg, float osc, unsigned long long& sw_acc) {
    int tid_ = threadIdx.x; asm volatile("" : "+v"(tid_));
    const int tid = tid_, lane = tid & 63, l31 = lane & 31, hi = lane >> 5; const int w = __builtin_amdgcn_readfirstlane(tid >> 6);
    const int c = w >> 2, rg = w & 3;
    const unsigned lds0 = (unsigned)(uintptr_t)lds;
    const unsigned kdst = lds0 + w * 1024, vdst = lds0 + DA_VRING + w * 1024;
    int kfo[4];
    { const int kr = keyrow(l31);
#pragma unroll
      for (int d0 = 0; d0 < 4; ++d0) kfo[d0] = kr * 256 + (((8 * c + 2 * d0 + hi) ^ (kr & 15)) * 16); }
    int vfo[4];
    { const int q_ = (lane & 15) >> 2;
#pragma unroll
      for (int d0 = 0; d0 < 4; ++d0) vfo[d0] = DA_VRING + (32 * hi + q_) * 256 + ((d0 ^ q_) * 64) + ((lane >> 4) & 1) * 32 + (lane & 3) * 8; }
    const int srow = 4 * w + (lane >> 4);
    const size_t koff = (size_t)srow * PW + C_DAK + (((lane & 15) ^ (srow & 15)) * 8);
    const size_t voff = (size_t)srow * PW + C_DAV + (((((lane & 15) >> 2) ^ (srow & 3)) * 4 + (lane & 3)) * 8);
    const size_t qoff = (size_t)(32 * rg + l31) * PW + C_DAQ + c * 64 + 8 * hi;
    if (tid < 128) ((LAS float*)(lds + DA_SUBG))[tid] = subg[tid];
    LAS unsigned* xch = (LAS unsigned*)(lds + DA_XCH + rg * 8192);
#define DA_DMA(ks_, vs_, kt_, kslot, vslot) do { const size_t go_ = (size_t)(kt_) * 64 * PW; const unsigned kd_ = (unsigned)__builtin_amdgcn_readfirstlane(kdst + (kslot)), vd_ = (unsigned)__builtin_amdgcn_readfirstlane(vdst + (vslot)); \
        glds16((ks_) + go_, kd_); glds16((ks_) + go_ + (size_t)32 * PW, kd_ + 8192); glds16((vs_) + go_, vd_); glds16((vs_) + go_ + (size_t)32 * PW, vd_ + 8192); } while (0)
#define DA_NEXT_K(s) ((s) == 2 * DA_KS ? 0 : (s) + DA_KS)
#define DA_NEXT_V(s) ((s) == 3 * DA_KS ? 0 : (s) + DA_KS)
    DaUnit U, Un; int ui = vcu;
    if (!da_decode(ui, U)) return;
    const GAS f16* ksrc = proj + ((size_t)U.b * SEQ) * PW + U.h * 128 + koff; const GAS f16* vsrc = proj + ((size_t)U.b * SEQ) * PW + U.h * 128 + voff;
    h8 qn[4];
    { const GAS f16* Qg = proj + ((size_t)U.b * SEQ + U.qt * 128) * PW + qoff + U.h * 128;
#pragma unroll
      for (int d0 = 0; d0 < 4; ++d0) qn[d0] = *(const GAS h8*)(Qg + 16 * d0); }
    asm volatile("" : "+v"(qn[0]), "+v"(qn[1]), "+v"(qn[2]), "+v"(qn[3]));
    DA_DMA(ksrc, vsrc, U.klo, 0, 0); DA_DMA(ksrc, vsrc, U.klo + 1, DA_KS, DA_KS);
    int ik = 2 * DA_KS, iv = 2 * DA_KS, ck = 0, cv = 0;
    for (;;) {
        const size_t rowbase = (size_t)U.b * SEQ;
        const int qw = U.qt * 128 + 32 * rg, t = qw + l31, lastt = qw >> 6, NT = 2 * U.qt + 2;
        const float cslope = exp2f(-2.0f * (float)(U.h + 1)) * LOG2E;
        const float cs64 = 64.0f * cslope, base0 = -cslope * (float)(t - 32 * hi) - mref;
        h8 qr[4];
#pragma unroll
        for (int d0 = 0; d0 < 4; ++d0) qr[d0] = qn[d0];
        const size_t grow = rowbase + qw + l31;
        const bool has_next = da_decode(ui + G, Un);
        const GAS f16* ksn = ksrc; const GAS f16* vsn = vsrc;
        if (has_next) { ksn = proj + ((size_t)Un.b * SEQ) * PW + Un.h * 128 + koff; vsn = proj + ((size_t)Un.b * SEQ) * PW + Un.h * 128 + voff; }
        f32x16 o[4]; o[0] = f32x16{}; o[1] = f32x16{}; o[2] = f32x16{}; o[3] = f32x16{};
        float lsum = 0.f;
        h8 pq0, pq1, pq2, pq3;
        int pvs = 0;
        SW_BEGIN(2);
        for (int kt = U.klo; kt < NT; ++kt) {
            SW_BEGIN(3);
            if (kt + 1 < NT || has_next) WAIT_BAR(4); else WAIT_BAR(0);
            SW_END(3);
#define DA_ISSUE() do { if (kt + 2 < NT) { DA_DMA(ksrc, vsrc, kt + 2, ik, iv); ik = DA_NEXT_K(ik); iv = DA_NEXT_V(iv); } \
            else if (has_next) { DA_DMA(ksn, vsn, Un.klo + kt + 2 - NT, ik, iv); ik = DA_NEXT_K(ik); iv = DA_NEXT_V(iv); } } while (0)
            DA_ISSUE();
            if (c == 1 && kt > U.klo && kt - 1 <= lastt) da_pv(o, lds + pvs, vfo, pq0, pq1, pq2, pq3);
            if (kt <= lastt) {
                const LAS unsigned char* Ks = lds + ck;
                f32x16 p0, p1;
                const float basek = __builtin_fmaf(cs64, (float)kt, base0);
                __builtin_amdgcn_sched_barrier(0);
                asm volatile("s_nop 7" ::: "memory");
#define DA_INIT(r) p0[r] = fmamk_s<r>(cslope, basek); p1[r] = fmamk_s<16 + r>(cslope, basek);
                DA_INIT(0) DA_INIT(1) DA_INIT(2) DA_INIT(3) DA_INIT(4) DA_INIT(5) DA_INIT(6) DA_INIT(7) DA_INIT(8) DA_INIT(9) DA_INIT(10) DA_INIT(11) DA_INIT(12) DA_INIT(13) DA_INIT(14) DA_INIT(15)
#undef DA_INIT
                asm volatile("s_nop 3" : "+v"(p0), "+v"(p1));
                if (kt == lastt) {
                    const int kd = t - (64 * kt + 32 * hi);
                    const float m2 = -2.0f * mref;
                    asm volatile("" ::: "memory");
#pragma unroll
                    for (int r = 0; r < 16; ++r) { if (r > kd) p0[r] = m2 - p0[r]; if (16 + r > kd) p1[r] = m2 - p1[r]; }
                }
#pragma unroll
                for (int d0 = 0; d0 < 4; ++d0) { const h8 ka = *(const LAS h8*)(Ks + kfo[d0]), kb = *(const LAS h8*)(Ks + kfo[d0] + 4096); p0 = MFMA32(ka, qr[d0], p0); p1 = MFMA32(kb, qr[d0], p1); }
                float s0 = 0.f, s1 = 0.f, s2 = 0.f, s3 = 0.f;
#pragma unroll
                for (int r = 0; r < 16; ++r) { p0[r] = __builtin_amdgcn_exp2f(p0[r]); p1[r] = __builtin_amdgcn_exp2f(p1[r]); }

#pragma unroll
                for (int r = 0; r < 16; r += 2) { s0 += p0[r]; s1 += p0[r + 1]; s2 += p1[r]; s3 += p1[r + 1]; }
                lsum += (s0 + s1) + (s2 + s3);
                pq0 = pack8(p0, 0); pq1 = pack8(p0, 8); pq2 = pack8(p1, 0); pq3 = pack8(p1, 8); pvs = cv;
                if (c == 0) da_pv(o, lds + cv, vfo, pq0, pq1, pq2, pq3);
            }
            ck = DA_NEXT_K(ck); cv = DA_NEXT_V(cv);
        }
        if (c == 1 && NT - 1 <= lastt) da_pv(o, lds + pvs, vfo, pq0, pq1, pq2, pq3);
        asm volatile("s_nop 15\n\ts_nop 7" : "+v"(o[0]), "+v"(o[1]), "+v"(o[2]), "+v"(o[3]));
        SW_END(2);
        const int dlo = 2 * c;
        u32x2 gv[8];
        { const GAS f16* Gp = proj + grow * PW + C_DAG + U.h * 128 + 32 * dlo + 4 * hi;
#pragma unroll
          for (int i = 0; i < 8; ++i) gv[i] = *(const GAS u32x2*)(Gp + 8 * i); }
        if (has_next) { const GAS f16* Qg = proj + ((size_t)Un.b * SEQ + Un.qt * 128) * PW + qoff + Un.h * 128;
#pragma unroll
            for (int d0 = 0; d0 < 4; ++d0) qn[d0] = *(const GAS h8*)(Qg + 16 * d0); }
        asm volatile("" ::: "memory");
        { const auto rr = __builtin_amdgcn_permlane32_swap(__float_as_uint(lsum), __float_as_uint(lsum), false, false); lsum = __uint_as_float(rr[0]) + __uint_as_float(rr[1]); }
        const float f = (c == 0 ? 1.0f : lam) / lsum;
        LAS unsigned* xw = xch + (c ^ 1) * 1024;
        LAS unsigned* xr = xch + c * 1024;
        f32x16 ya, yb;
        if (c == 0) {
#pragma unroll
            for (int r2 = 0; r2 < 8; ++r2) { xw[r2 * 64 + lane] = pkh(o[2][2 * r2] * f, o[2][2 * r2 + 1] * f); xw[(8 + r2) * 64 + lane] = pkh(o[3][2 * r2] * f, o[3][2 * r2 + 1] * f); }
            ya = o[0] * f; yb = o[1] * f;
        } else {
#pragma unroll
            for (int r2 = 0; r2 < 8; ++r2) { xw[r2 * 64 + lane] = pkh(o[0][2 * r2] * f, o[0][2 * r2 + 1] * f); xw[(8 + r2) * 64 + lane] = pkh(o[1][2 * r2] * f, o[1][2 * r2 + 1] * f); }
            ya = o[2] * f; yb = o[3] * f;
        }
        asm volatile("s_waitcnt lgkmcnt(0)\n\ts_barrier" ::: "memory");
        const float sgn = (c == 0) ? 1.0f : -1.0f;
        float ss = 0.f;
#pragma unroll
        for (int r2 = 0; r2 < 8; ++r2) {
            const h2 pa = __builtin_bit_cast(h2, xr[r2 * 64 + lane]), pb = __builtin_bit_cast(h2, xr[(8 + r2) * 64 + lane]);
            const float a0 = (ya[2 * r2] - (float)pa[0]) * sgn, a1 = (ya[2 * r2 + 1] - (float)pa[1]) * sgn, b0 = (yb[2 * r2] - (float)pb[0]) * sgn, b1 = (yb[2 * r2 + 1] - (float)pb[1]) * sgn;
            ya[2 * r2] = a0; ya[2 * r2 + 1] = a1; yb[2 * r2] = b0; yb[2 * r2 + 1] = b1; ss += (a0 * a0 + a1 * a1) + (b0 * b0 + b1 * b1);
        }
        { const auto rr = __builtin_amdgcn_permlane32_swap(__float_as_uint(ss), __float_as_uint(ss), false, false); ss = __uint_as_float(rr[0]) + __uint_as_float(rr[1]); }
        LAS float* ssx = (LAS float*)(lds + DA_SSX + rg * 256);
        if (hi == 0) ssx[c * 32 + l31] = ss;
        asm volatile("s_waitcnt lgkmcnt(0)\n\ts_barrier" ::: "memory");
        ss += ssx[(c ^ 1) * 32 + l31];
        const float rn = __builtin_amdgcn_rsqf(ss * (1.0f / 128.0f) + RMS_EPS) * osc;
        {
            const LAS float* sgl = (const LAS float*)(lds + DA_SUBG) + 32 * dlo + 4 * hi;
            GAS f16* Op = mixed + grow * DM + 512 + U.h * 128 + 32 * dlo + 4 * hi;
#pragma unroll
            for (int rg4 = 0; rg4 < 4; ++rg4) {
                const h4 g = __builtin_bit_cast(h4, gv[rg4]);
                const f32x4 sg = *(const LAS f32x4*)(sgl + 8 * rg4);
                u32x2 wv;
                wv.x = pkh(ya[4 * rg4] * rn * sg[0] * (float)g[0], ya[4 * rg4 + 1] * rn * sg[1] * (float)g[1]);
                wv.y = pkh(ya[4 * rg4 + 2] * rn * sg[2] * (float)g[2], ya[4 * rg4 + 3] * rn * sg[3] * (float)g[3]);
                *(GAS u32x2*)(Op + 8 * rg4) = wv;
            }
#pragma unroll
            for (int rg4 = 0; rg4 < 4; ++rg4) {
                const h4 g = __builtin_bit_cast(h4, gv[4 + rg4]);
                const f32x4 sg = *(const LAS f32x4*)(sgl + 32 + 8 * rg4);
                u32x2 wv;
                wv.x = pkh(yb[4 * rg4] * rn * sg[0] * (float)g[0], yb[4 * rg4 + 1] * rn * sg[1] * (float)g[1]);
                wv.y = pkh(yb[4 * rg4 + 2] * rn * sg[2] * (float)g[2], yb[4 * rg4 + 3] * rn * sg[3] * (float)g[3]);
                *(GAS u32x2*)(Op + 32 + 8 * rg4) = wv;
            }
        }
        if (!has_next) break;
        U = Un; ui += G; ksrc = ksn; vsrc = vsn;
    }
#undef DA_DMA
#undef DA_ISSUE
#undef DA_NEXT_K
#undef DA_NEXT_V
    WAIT_BAR(0);
}
}

constexpr size_t MiB = 1u << 20;
constexpr size_t WS_CTL = 0, CTL_ZERO_BYTES = 64 * 1024;
constexpr size_t WS_WIN = 2 * MiB;
constexpr size_t WS_WOUT = 18 * MiB;
constexpr size_t WS_PART = 22 * MiB;
constexpr size_t WS_XB = 32 * MiB;
constexpr size_t WS_MIX = 96 * MiB;
constexpr size_t WS_PROJ = 160 * MiB;
constexpr size_t WS_END = 416 * MiB;
constexpr int CW_BAR = 4096;

constexpr int RING_OFF = 0, RING_BYTES = 131072;
constexpr int LDSCTL_OFF = 147456, MISC_OFF = LDSCTL_OFF + 320;
constexpr int LDS_BYTES = 163840;
constexpr int NWAVES = 8;

typedef GAS unsigned gu32;
#define LDS_WAIT() asm volatile("s_waitcnt lgkmcnt(0)" ::: "memory")

#define XB_TMO      128
#define XB_XCNT(j)  (256  + 64 * (j))
#define XB_XSUB(j)  (1280 + 64 * (j))
#define XB_XGEN(j)  (2304 + 64 * (j))
#define XB_TOP      3328
#define XB_TOPGEN   3392
#define XCD_BAR_WORDS 3456
#define XB_SPIN_CAP (1u << 18)
__device__ __forceinline__ unsigned xb_ld(unsigned* p)              { return __hip_atomic_load(p, __ATOMIC_RELAXED, __HIP_MEMORY_SCOPE_AGENT); }
__device__ __forceinline__ unsigned xb_add(unsigned* p, unsigned v) { return __hip_atomic_fetch_add(p, v, __ATOMIC_RELAXED, __HIP_MEMORY_SCOPE_AGENT); }
__device__ __forceinline__ unsigned xb_xcc_id() { return (unsigned)__builtin_amdgcn_s_getreg((3 << 11) | 20) & 0xFu; }
#define XB_SPIN(cond, bar) do { unsigned _sp = 0; while (cond) { __builtin_amdgcn_s_sleep(1); \
    if ((++_sp & 255u) == 0u) { if (xb_ld(&(bar)[XB_TMO])) break; if (_sp > XB_SPIN_CAP) { atomicAdd(&(bar)[XB_TMO], 1u); break; } } } } while (0)
struct XcdBarrier { unsigned* bar; unsigned x; volatile LAS unsigned* st; };
__device__ __forceinline__ XcdBarrier xcd_barrier_post(unsigned* bar, volatile LAS unsigned* st) {
    XcdBarrier b; b.bar = bar; b.x = xb_xcc_id(); b.st = st;
    if (threadIdx.x == 0) (void)xb_add(&bar[XB_XCNT(b.x)], 1u);
    return b;
}
__device__ __forceinline__ void xcd_barrier_complete(unsigned* bar, unsigned x, unsigned& nloc, unsigned& nx) {
    const unsigned G = gridDim.x * gridDim.y * gridDim.z;
    unsigned sum, cnt, mine, sp = 0u;
    for (;;) {
        sum = 0u; cnt = 0u; mine = 0u;
#pragma unroll
        for (unsigned j = 0; j < 16; ++j) { const unsigned c = xb_ld(&bar[XB_XCNT(j)]); sum += c; cnt += (c > 0u) ? 1u : 0u; mine = (j == x) ? c : mine; }
        if (sum == G) break;
        __builtin_amdgcn_s_sleep(1);
        if ((++sp & 255u) == 0u) { if (xb_ld(&bar[XB_TMO])) break; if (sp > XB_SPIN_CAP) { atomicAdd(&bar[XB_TMO], 1u); break; } }
    }
    nloc = mine > 0u ? mine : 1u; nx = cnt > 0u ? cnt : 1u;
}
__device__ __forceinline__ void xcd_barrier(const XcdBarrier& b) {
    asm volatile("s_waitcnt vmcnt(0)" ::: "memory");
    __syncthreads();
    if (threadIdx.x == 0) {
        unsigned* bar = b.bar;
        __builtin_amdgcn_s_waitcnt(0);
        unsigned nloc = b.st[0], nx = b.st[1];
        if (nloc == 0u) { xcd_barrier_complete(bar, b.x, nloc, nx); b.st[0] = nloc; b.st[1] = nx; }
        const unsigned old = xb_add(&bar[XB_XSUB(b.x)], 1u);
        const unsigned gen = old / nloc;
        if (old + 1u == (gen + 1u) * nloc) {
            __builtin_amdgcn_fence(__ATOMIC_RELEASE, "agent");
            asm volatile("s_waitcnt vmcnt(0)" ::: "memory");
            const unsigned og = xb_add(&bar[XB_TOP], 1u);
            const unsigned tg = og / nx;
            if (og + 1u == (tg + 1u) * nx) xb_add(&bar[XB_TOPGEN], 1u);
            else XB_SPIN(xb_ld(&bar[XB_TOPGEN]) == tg, bar);
            __builtin_amdgcn_fence(__ATOMIC_ACQUIRE, "agent");
            xb_add(&bar[XB_XGEN(b.x)], 1u);
            asm volatile("s_waitcnt vmcnt(0)" ::: "memory");
        } else {
            XB_SPIN(xb_ld(&bar[XB_XGEN(b.x)]) == gen, bar);
            __builtin_amdgcn_fence(__ATOMIC_ACQUIRE, "agent");
            asm volatile("s_waitcnt vmcnt(0)" ::: "memory");
        }
    }
    __syncthreads();
}

__device__ __forceinline__ void p0_transpose_item(const float* W, const float* g, int K, int N, f16* WT, LAS float* scr, int item, int lane) {
    const int nblk = N / 32, kb = item / nblk, nb = item % nblk, k0 = 32 * kb, n0 = 32 * nb;
    float v[16];
#pragma unroll
    for (int i = 0; i < 16; ++i) { const int kk = 2 * i + (lane >> 5); v[i] = __builtin_nontemporal_load(W + (size_t)(k0 + kk) * N + n0 + (lane & 31)); }
    if (g) {
#pragma unroll
        for (int i = 0; i < 16; ++i) v[i] *= g[k0 + 2 * i + (lane >> 5)];
    }
#pragma unroll
    for (int i = 0; i < 16; ++i) scr[(2 * i + (lane >> 5)) * 33 + (lane & 31)] = v[i];
    LDS_WAIT(); asm volatile("" ::: "memory");
    const int c = lane & 3;
#pragma unroll
    for (int j = 0; j < 2; ++j) { const int n = (lane >> 2) + 16 * j; const LAS float* sp = scr + (8 * c) * 33 + n;
        u32x4 o; o.x = pkh(sp[0 * 33], sp[1 * 33]); o.y = pkh(sp[2 * 33], sp[3 * 33]); o.z = pkh(sp[4 * 33], sp[5 * 33]); o.w = pkh(sp[6 * 33], sp[7 * 33]);
        *(GAS u32x4*)(WT + (size_t)(n0 + n) * K + k0 + 8 * c) = o; }
    LDS_WAIT(); asm volatile("" ::: "memory");
}
__device__ __forceinline__ void x_rows4(const float* x, f16* xb, float* part, int m0, int stride, int lane) {
    f32x4 v[4][4];
#pragma unroll
    for (int r = 0; r < 4; ++r) { const GAS f32x4* xr = (const GAS f32x4*)(x + (size_t)(m0 + r * stride) * DM) + lane;
#pragma unroll
        for (int j = 0; j < 4; ++j) v[r][j] = __builtin_nontemporal_load(xr + 64 * j); }
#pragma unroll
    for (int r = 0; r < 4; ++r) {
        float s = 0.f;
#pragma unroll
        for (int j = 0; j < 4; ++j) s += (v[r][j][0] * v[r][j][0] + v[r][j][1] * v[r][j][1]) + (v[r][j][2] * v[r][j][2] + v[r][j][3] * v[r][j][3]);
        s = att::wave_sum(s);
        const size_t row = (size_t)(m0 + r * stride);
        GAS u32x2* o8 = (GAS u32x2*)(xb + row * DM) + lane;
#pragma unroll
        for (int j = 0; j < 4; ++j) { u32x2 w; w.x = pkh(v[r][j][0], v[r][j][1]); w.y = pkh(v[r][j][2], v[r][j][3]); o8[64 * j] = w; }
        if (lane < 16) part[row * 16 + lane] = (lane == 0) ? s : 0.f;
    }
}

__device__ __forceinline__ void x_row1(const float* x, f16* xb, float* part, int m, int lane) {
    const GAS f32x4* xr = (const GAS f32x4*)(x + (size_t)m * DM) + lane;
    f32x4 v[4]; float s = 0.f;
#pragma unroll
    for (int j = 0; j < 4; ++j) { v[j] = xr[64 * j]; s += (v[j][0] * v[j][0] + v[j][1] * v[j][1]) + (v[j][2] * v[j][2] + v[j][3] * v[j][3]); }
    s = att::wave_sum(s);
    GAS u32x2* o8 = (GAS u32x2*)(xb + (size_t)m * DM) + lane;
#pragma unroll
    for (int j = 0; j < 4; ++j) { u32x2 w; w.x = pkh(v[j][0], v[j][1]); w.y = pkh(v[j][2], v[j][3]); o8[64 * j] = w; }
    if (lane < 16) part[(size_t)m * 16 + lane] = (lane == 0) ? s : 0.f;
}

struct Args { const float* in[11]; float* out; unsigned char* ws; };
__global__ void __launch_bounds__(NWAVES * 64, 2) hybrid_fwd(Args args) {
    extern __shared__ __attribute__((aligned(16))) unsigned char lds_raw[];
    LAS unsigned char* lds = (LAS unsigned char*)lds_raw;
    volatile LAS unsigned* MISC = (volatile LAS unsigned*)(lds + MISC_OFF);
    const int tid = threadIdx.x, lane = tid & 63, wave = __builtin_amdgcn_readfirstlane(tid >> 6);
    const int G = gridDim.x; const int bx = blockIdx.x; const int vcu = (G % 8 == 0) ? (bx % 8) * (G / 8) + bx / 8 : bx;
    unsigned char* ws = args.ws;
    gu32* ctl = (gu32*)(ws + WS_CTL);
    const float* x = args.in[0]; const float* norm_g = args.in[1]; const float* w_in = args.in[2]; const float* w_out = args.in[3];
    const float* q_norm_g = args.in[4]; const float* k_norm_g = args.in[5];
    const float* lq1 = args.in[6]; const float* lk1 = args.in[7]; const float* lq2 = args.in[8]; const float* lk2 = args.in[9]; const float* subln_g = args.in[10];
    float* out = args.out;
    GAS unsigned char* wsg = (GAS unsigned char*)ws;
    GAS f16* WIN = (GAS f16*)(wsg + WS_WIN); GAS f16* WOUT = (GAS f16*)(wsg + WS_WOUT); GAS float* PART = (GAS float*)(wsg + WS_PART);
    GAS f16* XB = (GAS f16*)(wsg + WS_XB); GAS f16* MIX = (GAS f16*)(wsg + WS_MIX); GAS f16* PROJ = (GAS f16*)(wsg + WS_PROJ);

    unsigned long long sw_acc = 0;
    for (int u = tid; u < (LDS_BYTES - LDSCTL_OFF) / 4; u += NWAVES * 64) ((LAS unsigned*)(lds + LDSCTL_OFF))[u] = 0u;
    __syncthreads();
    XcdBarrier bar = xcd_barrier_post((unsigned*)(ctl + CW_BAR), MISC + 8);

    SW_BEGIN(6);
    for (int rep = 0; rep < REP_PRO; ++rep) {
        LAS float* scr = (LAS float*)(lds + RING_OFF + wave * 16384);
        const int gw = vcu * NWAVES + wave, NGW = G * NWAVES;
        constexpr int I_IN = (DM / 32) * (PW / 32), I_OUT = (DM / 32) * (DM / 32);
        constexpr int NITEMS = DEPTH * (I_IN + I_OUT);
        SW_BEGIN(9);
        for (int it = gw; it < NITEMS; it += NGW) {
            int r = it; const int l = r / (I_IN + I_OUT); r -= l * (I_IN + I_OUT);
            if (r < I_IN) p0_transpose_item(w_in + (size_t)l * DM * PW, norm_g + l * DM, DM, PW, (f16*)WIN + (size_t)l * PW * DM, scr, r, lane);
            else p0_transpose_item(w_out + (size_t)l * DM * DM, nullptr, DM, DM, (f16*)WOUT + (size_t)l * DM * DM, scr, r - I_IN, lane);
        }
        SW_END(9);
        SW_BEGIN(10);
        { int m = gw; for (; m + 3 * NGW < MROWS; m += 4 * NGW) x_rows4(x, (f16*)XB, (float*)PART, m, NGW, lane); for (; m < MROWS; m += NGW) x_row1(x, (f16*)XB, (float*)PART, m, lane); }
        SW_END(10);
    }
    SW_END(6);
    { SW_BEGIN(7); xcd_barrier(bar); SW_END(7); }

    for (int l = 0; l < DEPTH; ++l) {
        { GAS unsigned char* wsl = wsg; asm volatile("" : "+s"(wsl)); WIN = (GAS f16*)(wsl + WS_WIN); WOUT = (GAS f16*)(wsl + WS_WOUT); PART = (GAS float*)(wsl + WS_PART); XB = (GAS f16*)(wsl + WS_XB); MIX = (GAS f16*)(wsl + WS_MIX); PROJ = (GAS f16*)(wsl + WS_PROJ);
          asm volatile("" : "+s"(out)); asm volatile("" : "+s"(x)); asm volatile("" : "+s"(subln_g)); asm volatile("" : "+s"(q_norm_g)); asm volatile("" : "+s"(k_norm_g)); asm volatile("" : "+s"(bar.bar)); }
        for (int rep = 0; rep < REP_G1; ++rep) {
            pg8::Gemm g{(const f16*)XB, (const f16*)WIN + (size_t)l * PW * DM, MROWS, PW, DM}; pg8::StaticOrder S; S.init(MROWS, PW, G, bx);
            pg8::EpiProj E{PROJ, PART, (const GAS float*)q_norm_g + l * 64, (const GAS float*)k_norm_g + l * 64, lds + RING_BYTES};
            SW_BEGIN(5);
            pg8::gemm_phase<pg8::EpiProj>(lds + RING_OFF, g, S, E, sw_acc);
            SW_END(5);
        }
        { SW_BEGIN(7); xcd_barrier(bar); SW_END(7); }
        {
            const float sa = att::wave_sum(lq1[l * 64 + lane] * lk1[l * 64 + lane]), sb = att::wave_sum(lq2[l * 64 + lane] * lk2[l * 64 + lane]);
            const float lam_init = 0.8f - 0.6f * __expf(-0.3f * (float)l);
            const float lam = __expf(sa) - __expf(sb) + lam_init;
            const float mgq = att::wave_max(fabsf(q_norm_g[l * 64 + lane])), mgk = att::wave_max(fabsf(k_norm_g[l * 64 + lane]));
            const float mref = 8.0f * LOG2E * mgq * mgk * 1.001f - 10.0f;
            __syncthreads();
            for (int rep = 0; rep < REP_DA; ++rep) { SW_BEGIN(1); att::da_phase(lds + RING_OFF, PROJ, MIX, vcu, G, lam, mref, (const GAS float*)subln_g + l * 128, 1.0f - lam_init, sw_acc); SW_END(1); }
            for (int rep = 0; rep < REP_SB; ++rep) { SW_BEGIN(4); att::sb_phase(lds + RING_OFF, PROJ, MIX, vcu, G, sw_acc); SW_END(4); }
        }
        { SW_BEGIN(7); xcd_barrier(bar); SW_END(7); }
        {
            pg8::Gemm g{(const f16*)MIX, (const f16*)WOUT + (size_t)l * DM * DM, MROWS, DM, DM}; pg8::StaticOrder S; S.init(MROWS, DM, G, bx);
            pg8::EpiOut E{(GAS float*)out, XB, PART, (l + 1 < DEPTH) ? 0 : 1};
            SW_BEGIN(8);
            pg8::gemm_phase<pg8::EpiOut>(lds + RING_OFF, g, S, E, sw_acc);
            SW_END(8);
        }
        if (l + 1 < DEPTH) { SW_BEGIN(7); xcd_barrier(bar); SW_END(7); }
    }
#if SW_ID
    if (wave == 0) { const unsigned long long t0 = __builtin_amdgcn_s_memrealtime(), span = (unsigned long long)SW_K * sw_acc; while (__builtin_amdgcn_s_memrealtime() - t0 < span) __builtin_amdgcn_s_sleep(8); }
#endif
}

extern "C" void kernel_launch(void* const* d_in, const int* in_sizes, int n_in, void* d_out, int out_size, void* d_ws, size_t ws_size, hipStream_t stream) {
    static int grid = 0;
    if (grid == 0) {
        if (n_in != 11 || in_sizes[0] != MROWS * DM || out_size != MROWS * DM || ws_size < WS_END) {
            fprintf(stderr, "kernel_launch: unexpected problem shape (n_in %d, in0 %d, out %d, ws %zu); nothing launched\n", n_in, n_in > 0 ? in_sizes[0] : -1, out_size, ws_size); grid = -1; return; }
        int dev = 0, cus = 0, per_cu = 0;
        if (hipGetDevice(&dev) != hipSuccess || hipDeviceGetAttribute(&cus, hipDeviceAttributeMultiprocessorCount, dev) != hipSuccess) { grid = -1; return; }
        if (hipFuncSetAttribute((const void*)hybrid_fwd, hipFuncAttributeMaxDynamicSharedMemorySize, LDS_BYTES) != hipSuccess) { fprintf(stderr, "kernel_launch: hipFuncSetAttribute failed\n"); grid = -1; return; }
        if (hipOccupancyMaxActiveBlocksPerMultiprocessor(&per_cu, (const void*)hybrid_fwd, NWAVES * 64, LDS_BYTES) != hipSuccess || per_cu < 1) {
            fprintf(stderr, "kernel_launch: occupancy query reports %d workgroups per CU; nothing launched\n", per_cu); (void)hipGetLastError(); grid = -1; return; }
        grid = cus;
    }
    if (grid < 0) return;
    if (hipMemsetAsync((char*)d_ws + WS_CTL, 0, CTL_ZERO_BYTES, stream) != hipSuccess) { fprintf(stderr, "kernel_launch: hipMemsetAsync failed\n"); return; }
    Args a{};
    for (int i = 0; i < 11; ++i) a.in[i] = (const float*)d_in[i];
    a.out = (float*)d_out; a.ws = (unsigned char*)d_ws;
    hipLaunchKernelGGL(hybrid_fwd, dim3(grid), dim3(NWAVES * 64), LDS_BYTES, stream, a);
    const hipError_t le = hipPeekAtLastError();
    if (le != hipSuccess) fprintf(stderr, "kernel_launch: launch failed: %s\n", hipGetErrorName(le));
}
```

```cpp
#include <hip/hip_runtime.h>
#include <cstdio>
#include <cstdint>

#ifndef SB_EARLY_EXIT
#define SB_EARLY_EXIT 1
#endif
#define SW_ID 0
#define SW_K 4
#define REP_PRO 1
#define REP_G1 1
#define REP_DA 1
#define REP_SB 1
#define REP_G2 1

#if SW_ID
#define SW_BEGIN(id) unsigned long long sw_t0_##id = 0; if (SW_ID == (id)) sw_t0_##id = __builtin_amdgcn_s_memrealtime()
#define SW_END(id) do { if (SW_ID == (id)) sw_acc += __builtin_amdgcn_s_memrealtime() - sw_t0_##id; } while (0)
#else
#define SW_BEGIN(id) do {} while (0)
#define SW_END(id) do {} while (0)
#endif
#define LAS __attribute__((address_space(3)))
#define GAS __attribute__((address_space(1)))
typedef _Float16 f16;
typedef _Float16 h8 __attribute__((ext_vector_type(8)));
typedef _Float16 h4 __attribute__((ext_vector_type(4)));
typedef _Float16 h2 __attribute__((ext_vector_type(2)));
typedef float f32x4 __attribute__((ext_vector_type(4)));
typedef float f32x16 __attribute__((ext_vector_type(16)));
typedef unsigned u32x4 __attribute__((ext_vector_type(4)));
typedef unsigned u32x2 __attribute__((ext_vector_type(2)));

constexpr int BATCH = 16, SEQ = 2048, DM = 1024, MROWS = BATCH * SEQ, PW = 4096, DEPTH = 2;
constexpr float RMS_EPS = 1e-6f;
constexpr float LOG2E = 1.4426950408889634f;
constexpr float QS = 0.125f * LOG2E;
constexpr int C_SBQ = 0, C_SBK = 512, C_SBV = 1024, C_SBG = 1536, C_DAQ = 2048, C_DAK = 2560, C_DAV = 3072, C_DAG = 3584;

__device__ __forceinline__ unsigned pkh(float lo, float hi) { h2 v = {(f16)lo, (f16)hi}; return __builtin_bit_cast(unsigned, v); }
__device__ __forceinline__ unsigned pkh_rtz(float lo, float hi) { return __builtin_bit_cast(unsigned, __builtin_amdgcn_cvt_pkrtz(lo, hi)); }
__device__ __forceinline__ float row4_sum(float s) {
    { const auto r = __builtin_amdgcn_permlane16_swap(__float_as_uint(s), __float_as_uint(s), false, false); s = __uint_as_float(r[0]) + __uint_as_float(r[1]); }
    { const auto r = __builtin_amdgcn_permlane32_swap(__float_as_uint(s), __float_as_uint(s), false, false); s = __uint_as_float(r[0]) + __uint_as_float(r[1]); }
    return s;
}
__device__ __forceinline__ float silu_f(float v) { return v * __builtin_amdgcn_rcpf(1.0f + __builtin_amdgcn_exp2f(-v * LOG2E)); }

namespace pg8 {
constexpr int BM = 256, BK = 64, HALF = 128, HTB = HALF * BK * 2, STAGE_BYTES = 8 * HTB, NXCD = 8, WGM = 8;
__host__ __device__ __forceinline__ int lds_byte(int r, int c) { const int st = (r >> 4) * 2 + (c >> 5), rr = r & 15, cc = c & 31, ob = rr * 64 + cc * 2; return st * 1024 + (ob ^ (((ob >> 9) & 1) << 5)); }
__host__ __device__ __forceinline__ void stage_rc(int b, int& R, int& C) { const int st = b / 1024, sb = b % 1024, swz = sb ^ (((sb >> 9) & 1) << 5); R = (st >> 1) * 16 + swz / 64; C = (st & 1) * 32 + (swz % 64) / 2; }
__host__ __device__ __forceinline__ int perm32(int rho) { const int n = rho >> 4, i = rho & 15; return 8 * (i >> 2) + 4 * n + (i & 3); }

struct Unit { int pm, pn; };
struct Gemm { const f16* A; const f16* Bt; int M, N, K; };

struct StaticOrder {
    int nM, nN, nwg, G, c;
    __host__ __device__ void init(int M, int N, int G_, int c_) { nM = M / BM; nN = N / BM; nwg = nM * nN; G = G_; c = c_; }
    __host__ __device__ bool next(int i, Unit& u) const {
        const long L = (long)i * G + c; if (L >= nwg) return false;
        int wgid = (int)L; { const int q = nwg / NXCD, r = nwg % NXCD, xcd = wgid % NXCD, off = wgid / NXCD; wgid = (xcd < r ? xcd * (q + 1) : r * (q + 1) + (xcd - r) * q) + off; }
        const int nig = WGM * nN, gid = wgid / nig, fm = gid * WGM, gsz = (nM - fm) < WGM ? (nM - fm) : WGM;
        u.pm = fm + ((wgid % nig) % gsz); u.pn = (wgid % nig) / gsz; return true;
    }
};


struct EpiProj {
    GAS f16* P; const GAS float* part; const GAS float* gq; const GAS float* gk; LAS unsigned char* rsc;
    struct Pre { f32x4 a[2][2]; int pm[2]; };
    __device__ __forceinline__ void pre_load(Pre& R, const StaticOrder& S) const {
        Unit u0, u4; R.pm[0] = S.next(0, u0) ? u0.pm : -1; R.pm[1] = (S.next(4, u4) && u4.pm != R.pm[0]) ? u4.pm : -1;
        const int t = threadIdx.x, row = t >> 1, half = t & 1;
#pragma unroll
        for (int k = 0; k < 2; ++k) { const GAS f32x4* p = (const GAS f32x4*)(part + ((size_t)(R.pm[k] < 0 ? 0 : R.pm[k]) * BM + row) * 16 + half * 8); R.a[k][0] = p[0]; R.a[k][1] = p[1]; }
    }
    __device__ __forceinline__ void pre_finish(const Pre& R) const {
        const int t = threadIdx.x, row = t >> 1, half = t & 1;
#pragma unroll
        for (int k = 0; k < 2; ++k) {
            float sum = ((R.a[k][0][0] + R.a[k][0][1]) + (R.a[k][0][2] + R.a[k][0][3])) + ((R.a[k][1][0] + R.a[k][1][1]) + (R.a[k][1][2] + R.a[k][1][3]));
            sum += __shfl_xor(sum, 1);
            if (half == 0) ((LAS float*)rsc)[k * 256 + row] = __builtin_amdgcn_rsqf(sum * (1.0f / DM) + RMS_EPS);
        }
        if (t == 0) ((LAS int*)(rsc + 2048))[0] = R.pm[0];
        if (t == 1) ((LAS int*)(rsc + 2048))[1] = R.pm[1];
    }
    __device__ __forceinline__ void operator()(const f32x4 (&acc)[2][2][4][2], const Unit& u, int wr, int wc, int fr, int fq) const {
        const int sec = u.pn >> 1;
        const int row0 = u.pm * BM + wr * 64 + fr;
        const int colw = u.pn * BM + wc * 64 + 8 * fq;
        f32x4 gain[2][2];
        if (sec == 4 || sec == 5) {
            const GAS float* g = (sec == 4) ? gq : gk;
#pragma unroll
            for (int bj = 0; bj < 2; ++bj)
#pragma unroll
                for (int n = 0; n < 2; ++n) gain[bj][n] = *(const GAS f32x4*)(g + 32 * bj + 8 * fq + 4 * n);
        }
        const LAS int* tags = (const LAS int*)(rsc + 2048);
        const int slot = (tags[0] == u.pm) ? 0 : (tags[1] == u.pm) ? 1 : -1;
        const LAS float* rtab = (const LAS float*)rsc + (slot > 0 ? 256 : 0) + wr * 64 + fr;
#pragma unroll
        for (int ai = 0; ai < 2; ++ai)
#pragma unroll
            for (int m = 0; m < 4; ++m) {
                const int row = row0 + ai * HALF + m * 16;
                float rs;
                if (slot >= 0) rs = rtab[ai * HALF + m * 16];
                else {
                    const f32x4 pv = *(const GAS f32x4*)(part + (size_t)row * 16 + fq * 4);
                    float s = (pv[0] + pv[1]) + (pv[2] + pv[3]);
                    s = row4_sum(s);
                    rs = __builtin_amdgcn_rsqf(s * (1.0f / DM) + RMS_EPS);
                }
                f32x4 v[2][2];
#pragma unroll
                for (int bj = 0; bj < 2; ++bj)
#pragma unroll
                    for (int n = 0; n < 2; ++n) v[bj][n] = acc[ai][bj][m][n] * rs;
                if (sec == 4 || sec == 5) {
                    float ss = 0.f;
#pragma unroll
                    for (int bj = 0; bj < 2; ++bj)
#pragma unroll
                        for (int n = 0; n < 2; ++n) { const f32x4 x = v[bj][n]; ss += (x[0] * x[0] + x[1] * x[1]) + (x[2] * x[2] + x[3] * x[3]); }
                    ss = row4_sum(ss);
                    float rn = __builtin_amdgcn_rsqf(ss * (1.0f / 64.0f) + RMS_EPS);
                    if (sec == 4) rn *= QS;
#pragma unroll
                    for (int bj = 0; bj < 2; ++bj)
#pragma unroll
                        for (int n = 0; n < 2; ++n) v[bj][n] = v[bj][n] * rn * gain[bj][n];
                } else if (sec == 0) {
#pragma unroll
                    for (int bj = 0; bj < 2; ++bj)
#pragma unroll
                        for (int n = 0; n < 2; ++n) v[bj][n] = v[bj][n] * QS;
                } else if (sec == 3 || sec == 7) {
#pragma unroll
                    for (int bj = 0; bj < 2; ++bj)
#pragma unroll
                        for (int n = 0; n < 2; ++n)
#pragma unroll
                            for (int e = 0; e < 4; ++e) v[bj][n][e] = silu_f(v[bj][n][e]);
                }
                GAS f16* rowp = P + (size_t)row * PW + colw;
#pragma unroll
                for (int bj = 0; bj < 2; ++bj) {
                    u32x4 w; w.x = pkh(v[bj][0][0], v[bj][0][1]); w.y = pkh(v[bj][0][2], v[bj][0][3]); w.z = pkh(v[bj][1][0], v[bj][1][1]); w.w = pkh(v[bj][1][2], v[bj][1][3]);
                    *(GAS u32x4*)(rowp + 32 * bj) = w;
                }
            }
    }
};

struct EpiOut {
    GAS float* out; GAS f16* xb; GAS float* part; int last;
    struct Pre {};
    __device__ __forceinline__ void pre_load(Pre&, const StaticOrder&) const {}
    __device__ __forceinline__ void pre_finish(const Pre&) const {}
    __device__ __forceinline__ void operator()(const f32x4 (&acc)[2][2][4][2], const Unit& u, int wr, int wc, int fr, int fq) const {
        const int row0 = u.pm * BM + wr * 64 + fr;
        const int colw = u.pn * BM + wc * 64 + 8 * fq;
#pragma unroll
        for (int ai = 0; ai < 2; ++ai) {
            h8 bs[4][2];
#pragma unroll
            for (int m = 0; m < 4; ++m)
#pragma unroll
                for (int bj = 0; bj < 2; ++bj) bs[m][bj] = *(const GAS h8*)(xb + (size_t)(row0 + ai * HALF + m * 16) * DM + colw + 32 * bj);
#pragma unroll
            for (int m = 0; m < 4; ++m) {
                const int row = row0 + ai * HALF + m * 16;
                const size_t off = (size_t)row * DM + colw;
                float ss = 0.f;
#pragma unroll
                for (int bj = 0; bj < 2; ++bj) {
                    const h8 b = bs[m][bj];
                    f32x4 o0 = acc[ai][bj][m][0], o1 = acc[ai][bj][m][1];
                    o0[0] += (float)b[0]; o0[1] += (float)b[1]; o0[2] += (float)b[2]; o0[3] += (float)b[3];
                    o1[0] += (float)b[4]; o1[1] += (float)b[5]; o1[2] += (float)b[6]; o1[3] += (float)b[7];
                    if (last) { *(GAS f32x4*)(out + off + 32 * bj) = o0; *(GAS f32x4*)(out + off + 32 * bj + 4) = o1; }
                    else {
                        ss += (o0[0] * o0[0] + o0[1] * o0[1]) + (o0[2] * o0[2] + o0[3] * o0[3]) + (o1[0] * o1[0] + o1[1] * o1[1]) + (o1[2] * o1[2] + o1[3] * o1[3]);
                        u32x4 w; w.x = pkh(o0[0], o0[1]); w.y = pkh(o0[2], o0[3]); w.z = pkh(o1[0], o1[1]); w.w = pkh(o1[2], o1[3]);
                        *(GAS u32x4*)(xb + off + 32 * bj) = w;
                    }
                }
                if (!last) {
                    ss = row4_sum(ss);
                    if (fq == 0) part[(size_t)row * 16 + u.pn * 4 + wc] = ss;
                }
            }
        }
    }
};

template <class Epi>
__device__ __forceinline__ void gemm_phase(LAS unsigned char* lds, const Gemm g, const StaticOrder& S, const Epi& E, unsigned long long& sw_acc) {
    int tid_ = threadIdx.x; asm volatile("" : "+v"(tid_));
    const int tid = tid_, wid = __builtin_amdgcn_readfirstlane(tid >> 6), lane = tid & 63, wr = wid >> 2, wc = wid & 3, fr = lane & 15, fq = lane >> 4;
    const int K = g.K, nt = K / BK;
    unsigned voffA[2], voffB[2];
#pragma unroll
    for (int i = 0; i < 2; ++i) { int R, C; stage_rc(tid * 16 + i * 8192, R, C);
        const int Rb = (R >> 5) * 64 + perm32(R & 31);
        voffA[i] = (unsigned)(R * K + C) * 2u; voffB[i] = (unsigned)(Rb * K + C) * 2u; }
    const size_t kstep = (size_t)(BK * 2);
    const size_t hstep = (size_t)HALF * K * 2;
    const size_t hstepB = (size_t)32 * K * 2;
    const size_t tstep = 2 * hstep;
    const unsigned ldsw = (unsigned)wid * 1024u;
    const int aoff = lds_byte(wr * 64 + fr, fq * 8), boff = lds_byte(wc * 32 + fr, fq * 8);
#define PG8_SA(b, h) (((b) * 2 + (h)) * HTB)
#define PG8_SB(b, h) ((4 + (b) * 2 + (h)) * HTB)
#define PG8_STAGE(bufoff, gbase, voff) do { _Pragma("unroll") for (int _i = 0; _i < 2; ++_i) \
        __builtin_amdgcn_global_load_lds((const unsigned*)((const char*)(gbase) + (voff)[_i]), (LAS unsigned*)(lds + (bufoff) + ldsw + _i * 8192), 16, 0, 0); } while (0)
#define PG8_LDA(dst, b, h) do { _Pragma("unroll") for (int m = 0; m < 4; ++m) _Pragma("unroll") for (int k = 0; k < 2; ++k) dst[m][k] = *(const LAS h8*)(lds + PG8_SA(b, h) + aoff + m * 2048 + k * 1024); } while (0)
#define PG8_LDB(dst, b, h) do { _Pragma("unroll") for (int n = 0; n < 2; ++n) _Pragma("unroll") for (int k = 0; k < 2; ++k) dst[n][k] = *(const LAS h8*)(lds + PG8_SB(b, h) + boff + n * 2048 + k * 1024); } while (0)
#define PG8_MMA(ai, bj, At, Bt) do { __builtin_amdgcn_s_setprio(1); _Pragma("unroll") for (int m = 0; m < 4; ++m) _Pragma("unroll") for (int n = 0; n < 2; ++n) _Pragma("unroll") for (int k = 0; k < 2; ++k) \
        acc[ai][bj][m][n] = __builtin_amdgcn_mfma_f32_16x16x32_f16(Bt[n][k], At[m][k], acc[ai][bj][m][n], 0, 0, 0); __builtin_amdgcn_s_setprio(0); } while (0)
#define PG8_WAIT_V(n) asm volatile("s_waitcnt vmcnt(" #n ")" ::: "memory")
#define PG8_WAIT_L(n) asm volatile("s_waitcnt lgkmcnt(" #n ")" ::: "memory")
#define PG8_BAR __builtin_amdgcn_s_barrier()
#define PG8_SCHED __builtin_amdgcn_sched_barrier(0)
    Unit cur, nxt; int ui = 0;
    if (!S.next(0, cur)) return;
    f32x4 acc[2][2][4][2];
#pragma unroll
    for (int a = 0; a < 2; ++a)
#pragma unroll
        for (int b = 0; b < 2; ++b)
#pragma unroll
            for (int m = 0; m < 4; ++m)
#pragma unroll
                for (int n = 0; n < 2; ++n) acc[a][b][m][n] = (f32x4){0.f, 0.f, 0.f, 0.f};
    h8 At[4][2], B0[2][2], B1[2][2];
    const char* cA = (const char*)g.A + (size_t)cur.pm * tstep; const char* cB = (const char*)g.Bt + (size_t)cur.pn * tstep;
    PG8_STAGE(PG8_SB(0, 0), cB, voffB); PG8_STAGE(PG8_SB(0, 1), cB + hstepB, voffB); PG8_STAGE(PG8_SA(0, 0), cA, voffA); PG8_STAGE(PG8_SA(0, 1), cA + hstep, voffA);
    typename Epi::Pre pre; E.pre_load(pre, S);
    if (wr == 1) PG8_BAR;
    PG8_WAIT_V(2); PG8_BAR;
    E.pre_finish(pre);
    PG8_WAIT_L(0);
    PG8_STAGE(PG8_SB(1, 0), cB + kstep, voffB); PG8_STAGE(PG8_SA(1, 0), cA + kstep, voffA); PG8_STAGE(PG8_SB(1, 1), cB + hstepB + kstep, voffB);
    PG8_WAIT_V(6); PG8_BAR;
    for (;;) {
        const bool has_next = S.next(ui + 1, nxt);
        const char* nA = has_next ? (const char*)g.A + (size_t)nxt.pm * tstep : cA; const char* nB = has_next ? (const char*)g.Bt + (size_t)nxt.pn * tstep : cB;
        for (int t = 0; t < nt; t += 2) {
            const bool last = (t == nt - 2);
            const char* a1 = cA + (size_t)(t + 1) * kstep;
            const char* a2 = last ? nA : cA + (size_t)(t + 2) * kstep; const char* b2 = last ? nB : cB + (size_t)(t + 2) * kstep;
            const char* a3 = a2 + kstep; const char* b3 = b2 + kstep;
            PG8_LDB(B0, 0, 0); PG8_LDB(B1, 0, 1); PG8_SCHED; PG8_LDA(At, 0, 0); PG8_STAGE(PG8_SA(1, 1), a1 + hstep, voffA);
            PG8_WAIT_V(8); PG8_WAIT_L(0); PG8_BAR; PG8_MMA(0, 0, At, B0); PG8_MMA(0, 1, At, B1); PG8_BAR; PG8_SCHED;
            PG8_LDA(At, 0, 1); PG8_STAGE(PG8_SB(0, 0), b2, voffB); PG8_STAGE(PG8_SB(0, 1), b2 + hstepB, voffB); PG8_STAGE(PG8_SA(0, 0), a2, voffA);
            PG8_WAIT_V(8); PG8_WAIT_L(0); PG8_BAR; PG8_MMA(1, 0, At, B0); PG8_MMA(1, 1, At, B1); PG8_BAR; PG8_SCHED;
            PG8_LDB(B0, 1, 0); PG8_LDB(B1, 1, 1); PG8_SCHED; PG8_LDA(At, 1, 0); PG8_STAGE(PG8_SA(0, 1), a2 + hstep, voffA);
            PG8_WAIT_V(8); PG8_WAIT_L(0); PG8_BAR; PG8_MMA(0, 0, At, B0); PG8_MMA(0, 1, At, B1); PG8_BAR; PG8_SCHED;
            PG8_LDA(At, 1, 1); PG8_STAGE(PG8_SB(1, 0), b3, voffB); PG8_STAGE(PG8_SB(1, 1), b3 + hstepB, voffB); PG8_STAGE(PG8_SA(1, 0), a3, voffA);
            PG8_WAIT_V(8); PG8_WAIT_L(0); PG8_BAR; PG8_MMA(1, 0, At, B0); PG8_MMA(1, 1, At, B1); PG8_BAR; PG8_SCHED;
        }
        if (wr == 0) PG8_BAR;
        { SW_BEGIN(20); E(acc, cur, wr, wc, fr, fq); SW_END(20); }
        if (!has_next) break;
#pragma unroll
        for (int a = 0; a < 2; ++a)
#pragma unroll
            for (int b = 0; b < 2; ++b)
#pragma unroll
                for (int m = 0; m < 4; ++m)
#pragma unroll
                    for (int n = 0; n < 2; ++n) acc[a][b][m][n] = (f32x4){0.f, 0.f, 0.f, 0.f};
        cur = nxt; cA = nA; cB = nB; ++ui;
        if (wr == 1) PG8_BAR;
    }
    PG8_WAIT_V(0);
    PG8_BAR;
#undef PG8_SA
#undef PG8_SB
#undef PG8_STAGE
#undef PG8_LDA
#undef PG8_LDB
#undef PG8_MMA
#undef PG8_WAIT_V
#undef PG8_WAIT_L
#undef PG8_BAR
#undef PG8_SCHED
}
}

namespace att {
typedef short v4i16_t __attribute__((ext_vector_type(4)));
__device__ __forceinline__ int crow(int r, int hi) { return (r & 3) + 8 * (r >> 2) + 4 * hi; }
__device__ __forceinline__ int keyrow(int i) { return 32 * ((i >> 2) & 1) + (i & 3) + 4 * (i >> 3); }
__device__ __forceinline__ h4 vtr(const LAS unsigned char* p) { return __builtin_bit_cast(h4, __builtin_amdgcn_ds_read_tr16_b64_v4i16((LAS v4i16_t*)p)); }
__device__ __forceinline__ h8 cat8(h4 a, h4 b) { return (h8){a[0], a[1], a[2], a[3], b[0], b[1], b[2], b[3]}; }
#define MFMA32(a, b, c) __builtin_amdgcn_mfma_f32_32x32x16_f16(a, b, c, 0, 0, 0)
__device__ __forceinline__ h8 pack8(const f32x16& p, int b) {
    u32x4 w; w.x = pkh_rtz(p[b], p[b + 1]); w.y = pkh_rtz(p[b + 2], p[b + 3]); w.z = pkh_rtz(p[b + 4], p[b + 5]); w.w = pkh_rtz(p[b + 6], p[b + 7]);
    return __builtin_bit_cast(h8, w);
}
template <int KI> __device__ __forceinline__ float fmamk_s(float c, float base) {
    float r; asm volatile("v_fmamk_f32 %0, %1, %2, %3" : "=v"(r) : "v"(c), "i"(__builtin_bit_cast(int, (float)KI)), "v"(base)); return r; }
__device__ __forceinline__ float wave_sum(float v) {
#pragma unroll
    for (int o = 1; o < 64; o <<= 1) v += __shfl_xor(v, o);
    return v;
}
__device__ __forceinline__ float wave_max(float v) {
#pragma unroll
    for (int o = 1; o < 64; o <<= 1) v = fmaxf(v, __shfl_xor(v, o));
    return v;
}

__device__ __forceinline__ void glds16(const GAS void* g, unsigned lds_base) {
    unsigned sv; asm volatile("s_mov_b32 %0, m0\n\ts_mov_b32 m0, %2\n\ts_nop 0\n\tglobal_load_lds_dwordx4 %1, off\n\ts_mov_b32 m0, %0" : "=&s"(sv) : "v"(g), "s"(lds_base) : "memory"); }
#define WAIT_BAR(N) asm volatile("s_waitcnt vmcnt(" #N ") lgkmcnt(0)\n\ts_barrier" ::: "memory")
__device__ __forceinline__ void wait_bar_n(int n) {
    switch (n) { case 0: WAIT_BAR(0); break; case 2: WAIT_BAR(2); break; case 4: WAIT_BAR(4); break; case 6: WAIT_BAR(6); break; case 8: WAIT_BAR(8); break; case 10: WAIT_BAR(10); break;
                 case 12: WAIT_BAR(12); break; case 14: WAIT_BAR(14); break; case 16: WAIT_BAR(16); break; case 18: WAIT_BAR(18); break; case 20: WAIT_BAR(20); break; default: WAIT_BAR(0); break; }
}

constexpr int SB_SLOT = 65536, SB_FLG = 147456 + 2048;
__device__ __forceinline__ int keyrow16(int i) { return 16 * ((i >> 2) & 1) + (i & 3) + 4 * (i >> 3); }
struct SbUnit { int b, hg, cq; };
__device__ __forceinline__ bool sb_decode(int u, SbUnit& U) {
    if (u >= 1024) return false;
    const int r = u >> 8, v = u & 255, i = v & 15;
    U.b = v >> 4; U.hg = i & 1; U.cq = (i >> 1) + 8 * r; return true;
}
__device__ __forceinline__ void sb_phase(LAS unsigned char* lds, const GAS f16* __restrict__ proj, GAS f16* __restrict__ mixed, int vcu, int G, unsigned long long& sw_acc) {
    int tid_ = threadIdx.x; asm volatile("" : "+v"(tid_));
    const int tid = tid_, lane = tid & 63, l31 = lane & 31, hi = lane >> 5; const int w = __builtin_amdgcn_readfirstlane(tid >> 6);
    const int hh = w & 3, rgp = w >> 2;
    const unsigned lds0 = (unsigned)(uintptr_t)lds;
    const unsigned kdst = lds0 + w * 4096, vdst = lds0 + 32768 + w * 4096;
    int kfo[4];
    { const int kr = keyrow16(l31);
#pragma unroll
      for (int d0 = 0; d0 < 4; ++d0) kfo[d0] = kr * 512 + (((hh * 8 + 2 * d0 + hi) ^ (kr & 15)) * 16); }
    int vfo[2];
    { const int q_ = (lane & 15) >> 2;
#pragma unroll
      for (int d0 = 0; d0 < 2; ++d0) vfo[d0] = 32768 + (16 * hi + q_) * 512 + (((hh * 2 + d0) ^ q_) * 64) + ((lane >> 4) & 1) * 32 + (lane & 3) * 8; }
    LAS unsigned* flags = (LAS unsigned*)(lds + SB_FLG);
    size_t koff[4], voff[4];
#pragma unroll
    for (int i = 0; i < 4; ++i) { const int row = 8 * w + 2 * i + (lane >> 5), p = lane & 31;
        koff[i] = (size_t)row * PW + C_SBK + ((p ^ (row & 15)) * 8);
        voff[i] = (size_t)row * PW + C_SBV + ((((p >> 2) ^ (row & 3)) * 4 + (p & 3)) * 8); }
    const size_t qoff = (size_t)(32 * rgp + l31) * PW;
#define SB_DMA(base_, kt_, slot) do { const GAS f16* b_ = (base_) + (size_t)(kt_) * 64 * PW; const unsigned kd_ = (unsigned)__builtin_amdgcn_readfirstlane(kdst + (slot)), vd_ = (unsigned)__builtin_amdgcn_readfirstlane(vdst + (slot)); \
        _Pragma("unroll") for (int i_ = 0; i_ < 4; ++i_) { glds16(b_ + koff[i_], kd_ + i_ * 1024); glds16(b_ + voff[i_], vd_ + i_ * 1024); } } while (0)
    SbUnit U, Un; int ui = vcu;
    if (!sb_decode(ui, U)) return;
    int islot = 0, cslot = 0;
    const GAS f16* tbase = proj + ((size_t)U.b * SEQ) * PW + U.hg * 256;
    h8 qn[4]; u32x2 gn[8];
    { const size_t grow = (size_t)U.b * SEQ + U.cq * 64 + 32 * rgp + l31; const int h = 4 * U.hg + hh;
      const GAS f16* Qg = proj + grow * PW + C_SBQ + h * 64 + 8 * hi; const GAS f16* Gp = proj + grow * PW + C_SBG + h * 64 + 4 * hi;
#pragma unroll
      for (int d0 = 0; d0 < 4; ++d0) qn[d0] = *(const GAS h8*)(Qg + 16 * d0);
#pragma unroll
      for (int i = 0; i < 8; ++i) gn[i] = *(const GAS u32x2*)(Gp + 8 * i); }
    asm volatile("" : "+v"(qn[0]), "+v"(qn[1]), "+v"(qn[2]), "+v"(qn[3]));
    SB_DMA(tbase, U.cq, islot); islot ^= SB_SLOT;
    for (;;) {
        const size_t rowbase = (size_t)U.b * SEQ;
        const int qw = U.cq * 64 + 32 * rgp, t = qw + l31, NT = U.cq + 1, h = 4 * U.hg + hh;
        const size_t grow = rowbase + qw + l31;
        h8 qr[4]; u32x2 gv[8];
#pragma unroll
        for (int d0 = 0; d0 < 4; ++d0) qr[d0] = qn[d0];
#pragma unroll
        for (int i = 0; i < 8; ++i) gv[i] = gn[i];
        const bool has_next = sb_decode(ui + G, Un);
        f32x16 o[2]; o[0] = f32x16{}; o[1] = f32x16{};
        float carry = 1.f; int done = 0;
        SW_BEGIN(12);
        for (int j = 0; j < NT; ++j) {
            SW_BEGIN(13);
            WAIT_BAR(0);
            SW_END(13);
            if (j > 0) {
                const u32x4 f0 = *(const LAS u32x4*)(flags + ((j - 1) & 1) * 8), f1 = *(const LAS u32x4*)(flags + ((j - 1) & 1) * 8 + 4);
                const unsigned any = (f0.x | f0.y | f0.z | f0.w) | (f1.x | f1.y | f1.z | f1.w);
                if (!__builtin_amdgcn_readfirstlane(any)) break;
            }
            if (j + 1 < NT) { SB_DMA(tbase, U.cq - (j + 1), islot); islot ^= SB_SLOT; }
            const int kt = U.cq - j;
#pragma unroll
            for (int sub = 0; sub < 2; ++sub) {
                const int kb32 = sub == 0 ? 32 : 0;
                const bool diag = (j == 0) && (sub == (rgp == 1 ? 0 : 1));
                const bool skip = (j == 0) && (rgp == 0) && (sub == 0);
                if (!done && !skip) {
                    const LAS unsigned char* Sb = lds + cslot + kb32 * 512;
                    f32x16 p = f32x16{};
#pragma unroll
                    for (int d0 = 0; d0 < 4; ++d0) { const h8 k0 = *(const LAS h8*)(Sb + kfo[d0]); p = MFMA32(k0, qr[d0], p); }
#pragma unroll
                    for (int r = 0; r < 16; ++r) p[r] = __builtin_amdgcn_rcpf(1.0f + __builtin_amdgcn_exp2f(-p[r]));
                    if (diag) {
                        const int key0 = 64 * kt + kb32 + 16 * hi;
#pragma unroll
                        for (int r = 0; r < 16; ++r) if (key0 + r >= t) p[r] = 0.f;
                    }
                    float run = 1.f;
#pragma unroll
                    for (int r = 15; r >= 0; --r) { const float a = run * p[r]; run -= a; p[r] = a; }
                    const auto rr = __builtin_amdgcn_permlane32_swap(__float_as_uint(run), __float_as_uint(run), false, false);
                    const float T0 = __uint_as_float(rr[0]), T1 = __uint_as_float(rr[1]);
                    const float E = carry * (hi ? 1.0f : T1);
                    carry = carry * (T0 * T1);
#pragma unroll
                    for (int r = 0; r < 16; ++r) p[r] *= E;
                    const h8 pa0 = pack8(p, 0), pa1 = pack8(p, 8);
#pragma unroll
                    for (int d0 = 0; d0 < 2; ++d0) {
                        const LAS unsigned char* Vb = Sb + vfo[d0];
                        const h8 v0 = cat8(vtr(Vb), vtr(Vb + 2048));
                        const h8 v1 = cat8(vtr(Vb + 4096), vtr(Vb + 6144));
                        o[d0] = MFMA32(v0, pa0, o[d0]); o[d0] = MFMA32(v1, pa1, o[d0]);
                    }
#if SB_EARLY_EXIT
                    done = __builtin_amdgcn_readfirstlane(__all(carry < 1.0e-37f) ? 1 : 0);
#endif
                }
            }
            if (lane == 0) flags[(j & 1) * 8 + w] = done ? 0u : 1u;
            cslot ^= SB_SLOT;
        }
        asm volatile("s_nop 15\n\ts_nop 7" : "+v"(o[0]), "+v"(o[1]));
        SW_END(12);
        cslot = islot;
        if (has_next) {
            const size_t grown = (size_t)Un.b * SEQ + Un.cq * 64 + 32 * rgp + l31; const int hn = 4 * Un.hg + hh;
            const GAS f16* Qg = proj + grown * PW + C_SBQ + hn * 64 + 8 * hi; const GAS f16* Gp = proj + grown * PW + C_SBG + hn * 64 + 4 * hi;
#pragma unroll
            for (int d0 = 0; d0 < 4; ++d0) qn[d0] = *(const GAS h8*)(Qg + 16 * d0);
#pragma unroll
            for (int i = 0; i < 8; ++i) gn[i] = *(const GAS u32x2*)(Gp + 8 * i);
            asm volatile("" ::: "memory");
            tbase = proj + ((size_t)Un.b * SEQ) * PW + Un.hg * 256;
            SB_DMA(tbase, Un.cq, islot); islot ^= SB_SLOT;
        }
        {
            GAS f16* Op = mixed + grow * DM + h * 64 + 4 * hi;
#pragma unroll
            for (int d0 = 0; d0 < 2; ++d0)
#pragma unroll
                for (int rg4 = 0; rg4 < 4; ++rg4) {
                    const h4 g = __builtin_bit_cast(h4, gv[d0 * 4 + rg4]);
                    u32x2 wv; wv.x = pkh(o[d0][4 * rg4] * (float)g[0], o[d0][4 * rg4 + 1] * (float)g[1]); wv.y = pkh(o[d0][4 * rg4 + 2] * (float)g[2], o[d0][4 * rg4 + 3] * (float)g[3]);
                    *(GAS u32x2*)(Op + 32 * d0 + 8 * rg4) = wv;
                }
        }
        if (!has_next) break;
        U = Un; ui += G;
    }
#undef SB_DMA
    WAIT_BAR(0);
}

constexpr int DA_KS = 16384, DA_VRING = 49152, DA_XCH = 114688, DA_SUBG = 147456 + 1024, DA_SSX = 147456 + 3072;
struct DaUnit { int b, h, qt, klo; };
__device__ __forceinline__ int da_qt_of(int r, int i) {
    constexpr unsigned long long Q1 = 0xD69701EF58CA42B3ull, Q2 = 0xA185D6F4B972EC30ull, Q3 = 0x3E795A0B468D12CFull;
    return r == 0 ? i : (int)(((r == 1 ? Q1 : r == 2 ? Q2 : Q3) >> (4 * i)) & 15ull);
}
__device__ __forceinline__ int da_klo(int qt, int h) {
    const float cs = exp2f(-2.0f * (float)(h + 1)) * LOG2E;
    const int D = (int)ceilf(35.5f / cs), m = qt * 128 - D - 63;
    return m > 0 ? (m + 63) >> 6 : 0;
}
__device__ __forceinline__ bool da_decode(int u, DaUnit& U) {
    if (u >= 1024) return false;
    const int r = u >> 8, v = u & 255;
    U.b = v >> 4; U.h = r; U.qt = da_qt_of(r, v & 15); U.klo = da_klo(U.qt, U.h); return true;
}
__device__ __forceinline__ void da_pv(f32x16 (&o)[4], const LAS unsigned char* Vs, const int (&vfo)[4], h8 pa0, h8 pa1, h8 pa2, h8 pa3) {
    h8 f0, f1, f2, f3, g0, g1, g2, g3;
    { const LAS unsigned char* Vb = Vs + vfo[0]; f0 = cat8(vtr(Vb), vtr(Vb + 1024)); f1 = cat8(vtr(Vb + 2048), vtr(Vb + 3072)); f2 = cat8(vtr(Vb + 4096), vtr(Vb + 5120)); f3 = cat8(vtr(Vb + 6144), vtr(Vb + 7168)); }
#pragma unroll
    for (int d0 = 0; d0 < 4; ++d0) {
        if (d0 < 3) { const LAS unsigned char* Vb = Vs + vfo[d0 + 1]; g0 = cat8(vtr(Vb), vtr(Vb + 1024)); g1 = cat8(vtr(Vb + 2048), vtr(Vb + 3072)); g2 = cat8(vtr(Vb + 4096), vtr(Vb + 5120)); g3 = cat8(vtr(Vb + 6144), vtr(Vb + 7168)); }
        o[d0] = MFMA32(f0, pa0, o[d0]); o[d0] = MFMA32(f1, pa1, o[d0]); o[d0] = MFMA32(f2, pa2, o[d0]); o[d0] = MFMA32(f3, pa3, o[d0]);
        if (d0 < 3) { f0 = g0; f1 = g1; f2 = g2; f3 = g3; }
    }
}
__device__ __forceinline__ void da_phase(LAS unsigned char* lds, const GAS f16* __restrict__ proj, GAS f16* __restrict__ mixed, int vcu, int G,
                                         float lam, float mref, const GAS float* __restrict__ subg, float osc, unsigned long long& sw_acc) {
    int tid_ = threadIdx.x; asm volatile("" : "+v"(tid_));
    const int tid = tid_, lane = tid & 63, l31 = lane & 31, hi = lane >> 5; const int w = __builtin_amdgcn_readfirstlane(tid >> 6);
    const int c = w >> 2, rg = w & 3;
    const unsigned lds0 = (unsigned)(uintptr_t)lds;
    const unsigned kdst = lds0 + w * 1024, vdst = lds0 + DA_VRING + w * 1024;
    int kfo[4];
    { const int kr = keyrow(l31);
#pragma unroll
      for (int d0 = 0; d0 < 4; ++d0) kfo[d0] = kr * 256 + (((8 * c + 2 * d0 + hi) ^ (kr & 15)) * 16); }
    int vfo[4];
    { const int q_ = (lane & 15) >> 2;
#pragma unroll
      for (int d0 = 0; d0 < 4; ++d0) vfo[d0] = DA_VRING + (32 * hi + q_) * 256 + ((d0 ^ q_) * 64) + ((lane >> 4) & 1) * 32 + (lane & 3) * 8; }
    const int srow = 4 * w + (lane >> 4);
    const size_t koff = (size_t)srow * PW + C_DAK + (((lane & 15) ^ (srow & 15)) * 8);
    const size_t voff = (size_t)srow * PW + C_DAV + (((((lane & 15) >> 2) ^ (srow & 3)) * 4 + (lane & 3)) * 8);
    const size_t qoff = (size_t)(32 * rg + l31) * PW + C_DAQ + c * 64 + 8 * hi;
    h8 ones; { const f16 one = (l31 == 0) ? (f16)1.0f : (f16)0.0f; ones = (h8){one, one, one, one, one, one, one, one}; }
    if (tid < 128) ((LAS float*)(lds + DA_SUBG))[tid] = subg[tid];
    LAS unsigned* xch = (LAS unsigned*)(lds + DA_XCH + rg * 8192);
#define DA_DMA(ks_, vs_, kt_, kslot, vslot) do { const size_t go_ = (size_t)(kt_) * 64 * PW; const unsigned kd_ = (unsigned)__builtin_amdgcn_readfirstlane(kdst + (kslot)), vd_ = (unsigned)__builtin_amdgcn_readfirstlane(vdst + (vslot)); \
        glds16((ks_) + go_, kd_); glds16((ks_) + go_ + (size_t)32 * PW, kd_ + 8192); glds16((vs_) + go_, vd_); glds16((vs_) + go_ + (size_t)32 * PW, vd_ + 8192); } while (0)
#define DA_NEXT_K(s) ((s) == 2 * DA_KS ? 0 : (s) + DA_KS)
#define DA_NEXT_V(s) ((s) == 3 * DA_KS ? 0 : (s) + DA_KS)
    DaUnit U, Un; int ui = vcu;
    if (!da_decode(ui, U)) return;
    const GAS f16* ksrc = proj + ((size_t)U.b * SEQ) * PW + U.h * 128 + koff; const GAS f16* vsrc = proj + ((size_t)U.b * SEQ) * PW + U.h * 128 + voff;
    h8 qn[4];
    { const GAS f16* Qg = proj + ((size_t)U.b * SEQ + U.qt * 128) * PW + qoff + U.h * 128;
#pragma unroll
      for (int d0 = 0; d0 < 4; ++d0) qn[d0] = *(const GAS h8*)(Qg + 16 * d0); }
    asm volatile("" : "+v"(qn[0]), "+v"(qn[1]), "+v"(qn[2]), "+v"(qn[3]));
    DA_DMA(ksrc, vsrc, U.klo, 0, 0); DA_DMA(ksrc, vsrc, U.klo + 1, DA_KS, DA_KS);
    int ik = 2 * DA_KS, iv = 2 * DA_KS, ck = 0, cv = 0;
    for (;;) {
        const size_t rowbase = (size_t)U.b * SEQ;
        const int qw = U.qt * 128 + 32 * rg, t = qw + l31, lastt = qw >> 6, NT = 2 * U.qt + 2;
        const float cslope = exp2f(-2.0f * (float)(U.h + 1)) * LOG2E;
        const float cs64 = 64.0f * cslope, base0 = -cslope * (float)(t - 32 * hi) - mref;
        h8 qr[4];
#pragma unroll
        for (int d0 = 0; d0 < 4; ++d0) qr[d0] = qn[d0];
        const size_t grow = rowbase + qw + l31;
        const bool has_next = da_decode(ui + G, Un);
        const GAS f16* ksn = ksrc; const GAS f16* vsn = vsrc;
        if (has_next) { ksn = proj + ((size_t)Un.b * SEQ) * PW + Un.h * 128 + koff; vsn = proj + ((size_t)Un.b * SEQ) * PW + Un.h * 128 + voff; }
        f32x16 o[4]; o[0] = f32x16{}; o[1] = f32x16{}; o[2] = f32x16{}; o[3] = f32x16{};
        f32x16 osum = f32x16{};
        SW_BEGIN(2);
        for (int kt = U.klo; kt < NT; ++kt) {
            SW_BEGIN(3);
            if (kt + 1 < NT || has_next) WAIT_BAR(4); else WAIT_BAR(0);
            SW_END(3);
#define DA_ISSUE() do { if (kt + 2 < NT) { DA_DMA(ksrc, vsrc, kt + 2, ik, iv); ik = DA_NEXT_K(ik); iv = DA_NEXT_V(iv); } \
            else if (has_next) { DA_DMA(ksn, vsn, Un.klo + kt + 2 - NT, ik, iv); ik = DA_NEXT_K(ik); iv = DA_NEXT_V(iv); } } while (0)
            DA_ISSUE();
            if (kt <= lastt) {
                const LAS unsigned char* Ks = lds + ck;
                f32x16 p0, p1;
                const float basek = __builtin_fmaf(cs64, (float)kt, base0);
                __builtin_amdgcn_sched_barrier(0);
                asm volatile("s_nop 7" ::: "memory");
#define DA_INIT(r) p0[r] = fmamk_s<r>(cslope, basek); p1[r] = fmamk_s<16 + r>(cslope, basek);
                DA_INIT(0) DA_INIT(1) DA_INIT(2) DA_INIT(3) DA_INIT(4) DA_INIT(5) DA_INIT(6) DA_INIT(7) DA_INIT(8) DA_INIT(9) DA_INIT(10) DA_INIT(11) DA_INIT(12) DA_INIT(13) DA_INIT(14) DA_INIT(15)
#undef DA_INIT
                asm volatile("s_nop 3" : "+v"(p0), "+v"(p1));
                if (kt == lastt) {
                    const int kd = t - (64 * kt + 32 * hi);
                    const float m2 = -2.0f * mref;
                    asm volatile("" ::: "memory");
#pragma unroll
                    for (int r = 0; r < 16; ++r) { if (r > kd) p0[r] = m2 - p0[r]; if (16 + r > kd) p1[r] = m2 - p1[r]; }
                }
#pragma unroll
                for (int d0 = 0; d0 < 4; ++d0) { const h8 ka = *(const LAS h8*)(Ks + kfo[d0]), kb = *(const LAS h8*)(Ks + kfo[d0] + 4096); p0 = MFMA32(ka, qr[d0], p0); p1 = MFMA32(kb, qr[d0], p1); }
#pragma unroll
                for (int r = 0; r < 16; ++r) { p0[r] = __builtin_amdgcn_exp2f(p0[r]); p1[r] = __builtin_amdgcn_exp2f(p1[r]); }
                const h8 pq0 = pack8(p0, 0), pq1 = pack8(p0, 8), pq2 = pack8(p1, 0), pq3 = pack8(p1, 8);
                osum = MFMA32(ones, pq0, osum); osum = MFMA32(ones, pq1, osum); osum = MFMA32(ones, pq2, osum); osum = MFMA32(ones, pq3, osum);
                da_pv(o, lds + cv, vfo, pq0, pq1, pq2, pq3);
            }
            ck = DA_NEXT_K(ck); cv = DA_NEXT_V(cv);
        }
        asm volatile("s_nop 15\n\ts_nop 7" : "+v"(o[0]), "+v"(o[1]), "+v"(o[2]), "+v"(o[3]), "+v"(osum));
        SW_END(2);
        const int dlo = 2 * c;
        u32x2 gv[8];
        { const GAS f16* Gp = proj + grow * PW + C_DAG + U.h * 128 + 32 * dlo + 4 * hi;
#pragma unroll
          for (int i = 0; i < 8; ++i) gv[i] = *(const GAS u32x2*)(Gp + 8 * i); }
        if (has_next) { const GAS f16* Qg = proj + ((size_t)Un.b * SEQ + Un.qt * 128) * PW + qoff + Un.h * 128;
#pragma unroll
            for (int d0 = 0; d0 < 4; ++d0) qn[d0] = *(const GAS h8*)(Qg + 16 * d0); }
        asm volatile("" ::: "memory");
        float lsum = osum[0];
        { const auto rr = __builtin_amdgcn_permlane32_swap(__float_as_uint(lsum), __float_as_uint(lsum), false, false); lsum = __uint_as_float(rr[0]) + __uint_as_float(rr[1]); }
        const float f = (c == 0 ? 1.0f : lam) / lsum;
        LAS unsigned* xw = xch + (c ^ 1) * 1024;
        LAS unsigned* xr = xch + c * 1024;
        f32x16 ya, yb;
        if (c == 0) {
#pragma unroll
            for (int r2 = 0; r2 < 8; ++r2) { xw[r2 * 64 + lane] = pkh(o[2][2 * r2] * f, o[2][2 * r2 + 1] * f); xw[(8 + r2) * 64 + lane] = pkh(o[3][2 * r2] * f, o[3][2 * r2 + 1] * f); }
            ya = o[0] * f; yb = o[1] * f;
        } else {
#pragma unroll
            for (int r2 = 0; r2 < 8; ++r2) { xw[r2 * 64 + lane] = pkh(o[0][2 * r2] * f, o[0][2 * r2 + 1] * f); xw[(8 + r2) * 64 + lane] = pkh(o[1][2 * r2] * f, o[1][2 * r2 + 1] * f); }
            ya = o[2] * f; yb = o[3] * f;
        }
        asm volatile("s_waitcnt lgkmcnt(0)\n\ts_barrier" ::: "memory");
        const float sgn = (c == 0) ? 1.0f : -1.0f;
        float ss = 0.f;
#pragma unroll
        for (int r2 = 0; r2 < 8; ++r2) {
            const h2 pa = __builtin_bit_cast(h2, xr[r2 * 64 + lane]), pb = __builtin_bit_cast(h2, xr[(8 + r2) * 64 + lane]);
            const float a0 = (ya[2 * r2] - (float)pa[0]) * sgn, a1 = (ya[2 * r2 + 1] - (float)pa[1]) * sgn, b0 = (yb[2 * r2] - (float)pb[0]) * sgn, b1 = (yb[2 * r2 + 1] - (float)pb[1]) * sgn;
            ya[2 * r2] = a0; ya[2 * r2 + 1] = a1; yb[2 * r2] = b0; yb[2 * r2 + 1] = b1; ss += (a0 * a0 + a1 * a1) + (b0 * b0 + b1 * b1);
        }
        { const auto rr = __builtin_amdgcn_permlane32_swap(__float_as_uint(ss), __float_as_uint(ss), false, false); ss = __uint_as_float(rr[0]) + __uint_as_float(rr[1]); }
        LAS float* ssx = (LAS float*)(lds + DA_SSX + rg * 256);
        if (hi == 0) ssx[c * 32 + l31] = ss;
        asm volatile("s_waitcnt lgkmcnt(0)\n\ts_barrier" ::: "memory");
        ss += ssx[(c ^ 1) * 32 + l31];
        const float rn = __builtin_amdgcn_rsqf(ss * (1.0f / 128.0f) + RMS_EPS) * osc;
        {
            const LAS float* sgl = (const LAS float*)(lds + DA_SUBG) + 32 * dlo + 4 * hi;
            GAS f16* Op = mixed + grow * DM + 512 + U.h * 128 + 32 * dlo + 4 * hi;
#pragma unroll
            for (int rg4 = 0; rg4 < 4; ++rg4) {
                const h4 g = __builtin_bit_cast(h4, gv[rg4]);
                const f32x4 sg = *(const LAS f32x4*)(sgl + 8 * rg4);
                u32x2 wv;
                wv.x = pkh(ya[4 * rg4] * rn * sg[0] * (float)g[0], ya[4 * rg4 + 1] * rn * sg[1] * (float)g[1]);
                wv.y = pkh(ya[4 * rg4 + 2] * rn * sg[2] * (float)g[2], ya[4 * rg4 + 3] * rn * sg[3] * (float)g[3]);
                *(GAS u32x2*)(Op + 8 * rg4) = wv;
            }
#pragma unroll
            for (int rg4 = 0; rg4 < 4; ++rg4) {
                const h4 g = __builtin_bit_cast(h4, gv[4 + rg4]);
                const f32x4 sg = *(const LAS f32x4*)(sgl + 32 + 8 * rg4);
                u32x2 wv;
                wv.x = pkh(yb[4 * rg4] * rn * sg[0] * (float)g[0], yb[4 * rg4 + 1] * rn * sg[1] * (float)g[1]);
                wv.y = pkh(yb[4 * rg4 + 2] * rn * sg[2] * (float)g[2], yb[4 * rg4 + 3] * rn * sg[3] * (float)g[3]);
                *(GAS u32x2*)(Op + 32 + 8 * rg4) = wv;
            }
        }
        if (!has_next) break;
        U = Un; ui += G; ksrc = ksn; vsrc = vsn;
    }
#undef DA_DMA
#undef DA_ISSUE
#undef DA_NEXT_K
#undef DA_NEXT_V
    WAIT_BAR(0);
}
}

constexpr size_t MiB = 1u << 20;
constexpr size_t WS_CTL = 0, CTL_ZERO_BYTES = 64 * 1024;
constexpr size_t WS_WIN = 2 * MiB;
constexpr size_t WS_WOUT = 18 * MiB;
constexpr size_t WS_PART = 22 * MiB;
constexpr size_t WS_XB = 32 * MiB;
constexpr size_t WS_MIX = 96 * MiB;
constexpr size_t WS_PROJ = 160 * MiB;
constexpr size_t WS_END = 416 * MiB;
constexpr int CW_BAR = 4096;

constexpr int RING_OFF = 0, RING_BYTES = 131072;
constexpr int LDSCTL_OFF = 147456, MISC_OFF = LDSCTL_OFF + 320;
constexpr int LDS_BYTES = 163840;
constexpr int NWAVES = 8;

typedef GAS unsigned gu32;
#define LDS_WAIT() asm volatile("s_waitcnt lgkmcnt(0)" ::: "memory")

#define XB_TMO      128
#define XB_XCNT(j)  (256  + 64 * (j))
#define XB_XSUB(j)  (1280 + 64 * (j))
#define XB_XGEN(j)  (2304 + 64 * (j))
#define XB_TOP      3328
#define XB_TOPGEN   3392
#define XCD_BAR_WORDS 3456
#define XB_SPIN_CAP (1u << 18)
__device__ __forceinline__ unsigned xb_ld(unsigned* p)              { return __hip_atomic_load(p, __ATOMIC_RELAXED, __HIP_MEMORY_SCOPE_AGENT); }
__device__ __forceinline__ unsigned xb_add(unsigned* p, unsigned v) { return __hip_atomic_fetch_add(p, v, __ATOMIC_RELAXED, __HIP_MEMORY_SCOPE_AGENT); }
__device__ __forceinline__ unsigned xb_xcc_id() { return (unsigned)__builtin_amdgcn_s_getreg((3 << 11) | 20) & 0xFu; }
#define XB_SPIN(cond, bar) do { unsigned _sp = 0; while (cond) { __builtin_amdgcn_s_sleep(1); \
    if ((++_sp & 255u) == 0u) { if (xb_ld(&(bar)[XB_TMO])) break; if (_sp > XB_SPIN_CAP) { atomicAdd(&(bar)[XB_TMO], 1u); break; } } } } while (0)
struct XcdBarrier { unsigned* bar; unsigned x; volatile LAS unsigned* st; };
__device__ __forceinline__ XcdBarrier xcd_barrier_post(unsigned* bar, volatile LAS unsigned* st) {
    XcdBarrier b; b.bar = bar; b.x = xb_xcc_id(); b.st = st;
    if (threadIdx.x == 0) (void)xb_add(&bar[XB_XCNT(b.x)], 1u);
    return b;
}
__device__ __forceinline__ void xcd_barrier_complete(unsigned* bar, unsigned x, unsigned& nloc, unsigned& nx) {
    const unsigned G = gridDim.x * gridDim.y * gridDim.z;
    unsigned sum, cnt, mine, sp = 0u;
    for (;;) {
        sum = 0u; cnt = 0u; mine = 0u;
#pragma unroll
        for (unsigned j = 0; j < 16; ++j) { const unsigned c = xb_ld(&bar[XB_XCNT(j)]); sum += c; cnt += (c > 0u) ? 1u : 0u; mine = (j == x) ? c : mine; }
        if (sum == G) break;
        __builtin_amdgcn_s_sleep(1);
        if ((++sp & 255u) == 0u) { if (xb_ld(&bar[XB_TMO])) break; if (sp > XB_SPIN_CAP) { atomicAdd(&bar[XB_TMO], 1u); break; } }
    }
    nloc = mine > 0u ? mine : 1u; nx = cnt > 0u ? cnt : 1u;
}
__device__ __forceinline__ void xcd_barrier(const XcdBarrier& b) {
    asm volatile("s_waitcnt vmcnt(0)" ::: "memory");
    __syncthreads();
    if (threadIdx.x == 0) {
        unsigned* bar = b.bar;
        __builtin_amdgcn_s_waitcnt(0);
        unsigned nloc = b.st[0], nx = b.st[1];
        if (nloc == 0u) { xcd_barrier_complete(bar, b.x, nloc, nx); b.st[0] = nloc; b.st[1] = nx; }
        const unsigned old = xb_add(&bar[XB_XSUB(b.x)], 1u);
        const unsigned gen = old / nloc;
        if (old + 1u == (gen + 1u) * nloc) {
            __builtin_amdgcn_fence(__ATOMIC_RELEASE, "agent");
            asm volatile("s_waitcnt vmcnt(0)" ::: "memory");
            const unsigned og = xb_add(&bar[XB_TOP], 1u);
            const unsigned tg = og / nx;
            if (og + 1u == (tg + 1u) * nx) xb_add(&bar[XB_TOPGEN], 1u);
            else XB_SPIN(xb_ld(&bar[XB_TOPGEN]) == tg, bar);
            __builtin_amdgcn_fence(__ATOMIC_ACQUIRE, "agent");
            xb_add(&bar[XB_XGEN(b.x)], 1u);
            asm volatile("s_waitcnt vmcnt(0)" ::: "memory");
        } else {
            XB_SPIN(xb_ld(&bar[XB_XGEN(b.x)]) == gen, bar);
            __builtin_amdgcn_fence(__ATOMIC_ACQUIRE, "agent");
            asm volatile("s_waitcnt vmcnt(0)" ::: "memory");
        }
    }
    __syncthreads();
}

__device__ __forceinline__ void p0_transpose_item(const float* W, const float* g, int K, int N, f16* WT, LAS float* scr, int item, int lane) {
    const int nblk = N / 32, kb = item / nblk, nb = item % nblk, k0 = 32 * kb, n0 = 32 * nb;
    float v[16];
#pragma unroll
    for (int i = 0; i < 16; ++i) { const int kk = 2 * i + (lane >> 5); v[i] = __builtin_nontemporal_load(W + (size_t)(k0 + kk) * N + n0 + (lane & 31)); }
    if (g) {
#pragma unroll
        for (int i = 0; i < 16; ++i) v[i] *= g[k0 + 2 * i + (lane >> 5)];
    }
#pragma unroll
    for (int i = 0; i < 16; ++i) scr[(2 * i + (lane >> 5)) * 33 + (lane & 31)] = v[i];
    LDS_WAIT(); asm volatile("" ::: "memory");
    const int c = lane & 3;
#pragma unroll
    for (int j = 0; j < 2; ++j) { const int n = (lane >> 2) + 16 * j; const LAS float* sp = scr + (8 * c) * 33 + n;
        u32x4 o; o.x = pkh(sp[0 * 33], sp[1 * 33]); o.y = pkh(sp[2 * 33], sp[3 * 33]); o.z = pkh(sp[4 * 33], sp[5 * 33]); o.w = pkh(sp[6 * 33], sp[7 * 33]);
        *(GAS u32x4*)(WT + (size_t)(n0 + n) * K + k0 + 8 * c) = o; }
    LDS_WAIT(); asm volatile("" ::: "memory");
}
__device__ __forceinline__ void x_rows4(const float* x, f16* xb, float* part, int m0, int stride, int lane) {
    f32x4 v[4][4];
#pragma unroll
    for (int r = 0; r < 4; ++r) { const GAS f32x4* xr = (const GAS f32x4*)(x + (size_t)(m0 + r * stride) * DM) + lane;
#pragma unroll
        for (int j = 0; j < 4; ++j) v[r][j] = __builtin_nontemporal_load(xr + 64 * j); }
#pragma unroll
    for (int r = 0; r < 4; ++r) {
        float s = 0.f;
#pragma unroll
        for (int j = 0; j < 4; ++j) s += (v[r][j][0] * v[r][j][0] + v[r][j][1] * v[r][j][1]) + (v[r][j][2] * v[r][j][2] + v[r][j][3] * v[r][j][3]);
        s = att::wave_sum(s);
        const size_t row = (size_t)(m0 + r * stride);
        GAS u32x2* o8 = (GAS u32x2*)(xb + row * DM) + lane;
#pragma unroll
        for (int j = 0; j < 4; ++j) { u32x2 w; w.x = pkh(v[r][j][0], v[r][j][1]); w.y = pkh(v[r][j][2], v[r][j][3]); o8[64 * j] = w; }
        if (lane < 16) part[row * 16 + lane] = (lane == 0) ? s : 0.f;
    }
}

__device__ __forceinline__ void x_row1(const float* x, f16* xb, float* part, int m, int lane) {
    const GAS f32x4* xr = (const GAS f32x4*)(x + (size_t)m * DM) + lane;
    f32x4 v[4]; float s = 0.f;
#pragma unroll
    for (int j = 0; j < 4; ++j) { v[j] = xr[64 * j]; s += (v[j][0] * v[j][0] + v[j][1] * v[j][1]) + (v[j][2] * v[j][2] + v[j][3] * v[j][3]); }
    s = att::wave_sum(s);
    GAS u32x2* o8 = (GAS u32x2*)(xb + (size_t)m * DM) + lane;
#pragma unroll
    for (int j = 0; j < 4; ++j) { u32x2 w; w.x = pkh(v[j][0], v[j][1]); w.y = pkh(v[j][2], v[j][3]); o8[64 * j] = w; }
    if (lane < 16) part[(size_t)m * 16 + lane] = (lane == 0) ? s : 0.f;
}

struct Args { const float* in[11]; float* out; unsigned char* ws; };
__global__ void __launch_bounds__(NWAVES * 64, 2) hybrid_fwd(Args args) {
    extern __shared__ __attribute__((aligned(16))) unsigned char lds_raw[];
    LAS unsigned char* lds = (LAS unsigned char*)lds_raw;
    volatile LAS unsigned* MISC = (volatile LAS unsigned*)(lds + MISC_OFF);
    const int tid = threadIdx.x, lane = tid & 63, wave = __builtin_amdgcn_readfirstlane(tid >> 6);
    const int G = gridDim.x; const int bx = blockIdx.x; const int vcu = (G % 8 == 0) ? (bx % 8) * (G / 8) + bx / 8 : bx;
    unsigned char* ws = args.ws;
    gu32* ctl = (gu32*)(ws + WS_CTL);
    const float* x = args.in[0]; const float* norm_g = args.in[1]; const float* w_in = args.in[2]; const float* w_out = args.in[3];
    const float* q_norm_g = args.in[4]; const float* k_norm_g = args.in[5];
    const float* lq1 = args.in[6]; const float* lk1 = args.in[7]; const float* lq2 = args.in[8]; const float* lk2 = args.in[9]; const float* subln_g = args.in[10];
    float* out = args.out;
    GAS unsigned char* wsg = (GAS unsigned char*)ws;
    GAS f16* WIN = (GAS f16*)(wsg + WS_WIN); GAS f16* WOUT = (GAS f16*)(wsg + WS_WOUT); GAS float* PART = (GAS float*)(wsg + WS_PART);
    GAS f16* XB = (GAS f16*)(wsg + WS_XB); GAS f16* MIX = (GAS f16*)(wsg + WS_MIX); GAS f16* PROJ = (GAS f16*)(wsg + WS_PROJ);

    unsigned long long sw_acc = 0;
    for (int u = tid; u < (LDS_BYTES - LDSCTL_OFF) / 4; u += NWAVES * 64) ((LAS unsigned*)(lds + LDSCTL_OFF))[u] = 0u;
    __syncthreads();
    XcdBarrier bar = xcd_barrier_post((unsigned*)(ctl + CW_BAR), MISC + 8);

    SW_BEGIN(6);
    for (int rep = 0; rep < REP_PRO; ++rep) {
        LAS float* scr = (LAS float*)(lds + RING_OFF + wave * 16384);
        const int gw = vcu * NWAVES + wave, NGW = G * NWAVES;
        constexpr int I_IN = (DM / 32) * (PW / 32), I_OUT = (DM / 32) * (DM / 32);
        constexpr int NITEMS = DEPTH * (I_IN + I_OUT);
        SW_BEGIN(9);
        for (int it = gw; it < NITEMS; it += NGW) {
            int r = it; const int l = r / (I_IN + I_OUT); r -= l * (I_IN + I_OUT);
            if (r < I_IN) p0_transpose_item(w_in + (size_t)l * DM * PW, norm_g + l * DM, DM, PW, (f16*)WIN + (size_t)l * PW * DM, scr, r, lane);
            else p0_transpose_item(w_out + (size_t)l * DM * DM, nullptr, DM, DM, (f16*)WOUT + (size_t)l * DM * DM, scr, r - I_IN, lane);
        }
        SW_END(9);
        SW_BEGIN(10);
        { int m = gw; for (; m + 3 * NGW < MROWS; m += 4 * NGW) x_rows4(x, (f16*)XB, (float*)PART, m, NGW, lane); for (; m < MROWS; m += NGW) x_row1(x, (f16*)XB, (float*)PART, m, lane); }
        SW_END(10);
    }
    SW_END(6);
    { SW_BEGIN(7); xcd_barrier(bar); SW_END(7); }

    for (int l = 0; l < DEPTH; ++l) {
        { GAS unsigned char* wsl = wsg; asm volatile("" : "+s"(wsl)); WIN = (GAS f16*)(wsl + WS_WIN); WOUT = (GAS f16*)(wsl + WS_WOUT); PART = (GAS float*)(wsl + WS_PART); XB = (GAS f16*)(wsl + WS_XB); MIX = (GAS f16*)(wsl + WS_MIX); PROJ = (GAS f16*)(wsl + WS_PROJ);
          asm volatile("" : "+s"(out)); asm volatile("" : "+s"(x)); asm volatile("" : "+s"(subln_g)); asm volatile("" : "+s"(q_norm_g)); asm volatile("" : "+s"(k_norm_g)); asm volatile("" : "+s"(bar.bar)); }
        for (int rep = 0; rep < REP_G1; ++rep) {
            pg8::Gemm g{(const f16*)XB, (const f16*)WIN + (size_t)l * PW * DM, MROWS, PW, DM}; pg8::StaticOrder S; S.init(MROWS, PW, G, bx);
            pg8::EpiProj E{PROJ, PART, (const GAS float*)q_norm_g + l * 64, (const GAS float*)k_norm_g + l * 64, lds + RING_BYTES};
            SW_BEGIN(5);
            pg8::gemm_phase<pg8::EpiProj>(lds + RING_OFF, g, S, E, sw_acc);
            SW_END(5);
        }
        { SW_BEGIN(7); xcd_barrier(bar); SW_END(7); }
        {
            const float sa = att::wave_sum(lq1[l * 64 + lane] * lk1[l * 64 + lane]), sb = att::wave_sum(lq2[l * 64 + lane] * lk2[l * 64 + lane]);
            const float lam_init = 0.8f - 0.6f * __expf(-0.3f * (float)l);
            const float lam = __expf(sa) - __expf(sb) + lam_init;
            const float mgq = att::wave_max(fabsf(q_norm_g[l * 64 + lane])), mgk = att::wave_max(fabsf(k_norm_g[l * 64 + lane]));
            const float mref = 8.0f * LOG2E * mgq * mgk * 1.001f - 10.0f;
            __syncthreads();
            for (int rep = 0; rep < REP_DA; ++rep) { SW_BEGIN(1); att::da_phase(lds + RING_OFF, PROJ, MIX, vcu, G, lam, mref, (const GAS float*)subln_g + l * 128, 1.0f - lam_init, sw_acc); SW_END(1); }
            for (int rep = 0; rep < REP_SB; ++rep) { SW_BEGIN(4); att::sb_phase(lds + RING_OFF, PROJ, MIX, vcu, G, sw_acc); SW_END(4); }
        }
        { SW_BEGIN(7); xcd_barrier(bar); SW_END(7); }
        {
            pg8::Gemm g{(const f16*)MIX, (const f16*)WOUT + (size_t)l * DM * DM, MROWS, DM, DM}; pg8::StaticOrder S; S.init(MROWS, DM, G, bx);
            pg8::EpiOut E{(GAS float*)out, XB, PART, (l + 1 < DEPTH) ? 0 : 1};
            SW_BEGIN(8);
            pg8::gemm_phase<pg8::EpiOut>(lds + RING_OFF, g, S, E, sw_acc);
            SW_END(8);
        }
        if (l + 1 < DEPTH) { SW_BEGIN(7); xcd_barrier(bar); SW_END(7); }
    }
#if SW_ID
    if (wave == 0) { const unsigned long long t0 = __builtin_amdgcn_s_memrealtime(), span = (unsigned long long)SW_K * sw_acc; while (__builtin_amdgcn_s_memrealtime() - t0 < span) __builtin_amdgcn_s_sleep(8); }
#endif
}

extern "C" void kernel_launch(void* const* d_in, const int* in_sizes, int n_in, void* d_out, int out_size, void* d_ws, size_t ws_size, hipStream_t stream) {
    static int grid = 0;
    if (grid == 0) {
        if (n_in != 11 || in_sizes[0] != MROWS * DM || out_size != MROWS * DM || ws_size < WS_END) {
            fprintf(stderr, "kernel_launch: unexpected problem shape (n_in %d, in0 %d, out %d, ws %zu); nothing launched\n", n_in, n_in > 0 ? in_sizes[0] : -1, out_size, ws_size); grid = -1; return; }
        int dev = 0, cus = 0, per_cu = 0;
        if (hipGetDevice(&dev) != hipSuccess || hipDeviceGetAttribute(&cus, hipDeviceAttributeMultiprocessorCount, dev) != hipSuccess) { grid = -1; return; }
        if (hipFuncSetAttribute((const void*)hybrid_fwd, hipFuncAttributeMaxDynamicSharedMemorySize, LDS_BYTES) != hipSuccess) { fprintf(stderr, "kernel_launch: hipFuncSetAttribute failed\n"); grid = -1; return; }
        if (hipOccupancyMaxActiveBlocksPerMultiprocessor(&per_cu, (const void*)hybrid_fwd, NWAVES * 64, LDS_BYTES) != hipSuccess || per_cu < 1) {
            fprintf(stderr, "kernel_launch: occupancy query reports %d workgroups per CU; nothing launched\n", per_cu); (void)hipGetLastError(); grid = -1; return; }
        grid = cus;
    }
    if (grid < 0) return;
    if (hipMemsetAsync((char*)d_ws + WS_CTL, 0, CTL_ZERO_BYTES, stream) != hipSuccess) { fprintf(stderr, "kernel_launch: hipMemsetAsync failed\n"); return; }
    Args a{};
    for (int i = 0; i < 11; ++i) a.in[i] = (const float*)d_in[i];
    a.out = (float*)d_out; a.ws = (unsigned char*)d_ws;
    hipLaunchKernelGGL(hybrid_fwd, dim3(grid), dim3(NWAVES * 64), LDS_BYTES, stream, a);
    const hipError_t le = hipPeekAtLastError();
    if (le != hipSuccess) fprintf(stderr, "kernel_launch: launch failed: %s\n", hipGetErrorName(le));
}
```

```cpp
#include <hip/hip_runtime.h>
#include <cstdio>
#include <cstdint>

#ifndef SB_EARLY_EXIT
#define SB_EARLY_EXIT 1
#endif
#define SW_ID 0
#define SW_K 4
#define REP_PRO 1
#define REP_G1 1
#define REP_DA 1
#define REP_SB 1
#define REP_G2 1

#if SW_ID
#define SW_BEGIN(id) unsigned long long sw_t0_##id = 0; if (SW_ID == (id)) sw_t0_##id = __builtin_amdgcn_s_memrealtime()
#define SW_END(id) do { if (SW_ID == (id)) sw_acc += __builtin_amdgcn_s_memrealtime() - sw_t0_##id; } while (0)
#else
#define SW_BEGIN(id) do {} while (0)
#define SW_END(id) do {} while (0)
#endif
#define LAS __attribute__((address_space(3)))
#define GAS __attribute__((address_space(1)))
typedef _Float16 f16;
typedef _Float16 h8 __attribute__((ext_vector_type(8)));
typedef _Float16 h4 __attribute__((ext_vector_type(4)));
typedef _Float16 h2 __attribute__((ext_vector_type(2)));
typedef float f32x4 __attribute__((ext_vector_type(4)));
typedef float f32x16 __attribute__((ext_vector_type(16)));
typedef unsigned u32x4 __attribute__((ext_vector_type(4)));
typedef unsigned u32x2 __attribute__((ext_vector_type(2)));

constexpr int BATCH = 16, SEQ = 2048, DM = 1024, MROWS = BATCH * SEQ, PW = 4096, DEPTH = 2;
constexpr float RMS_EPS = 1e-6f;
constexpr float LOG2E = 1.4426950408889634f;
constexpr float QS = 0.125f * LOG2E;
constexpr int C_SBQ = 0, C_SBK = 512, C_SBV = 1024, C_SBG = 1536, C_DAQ = 2048, C_DAK = 2560, C_DAV = 3072, C_DAG = 3584;

__device__ __forceinline__ unsigned pkh(float lo, float hi) { h2 v = {(f16)lo, (f16)hi}; return __builtin_bit_cast(unsigned, v); }
__device__ __forceinline__ unsigned pkh_rtz(float lo, float hi) { return __builtin_bit_cast(unsigned, __builtin_amdgcn_cvt_pkrtz(lo, hi)); }
__device__ __forceinline__ float row4_sum(float s) {
    { const auto r = __builtin_amdgcn_permlane16_swap(__float_as_uint(s), __float_as_uint(s), false, false); s = __uint_as_float(r[0]) + __uint_as_float(r[1]); }
    { const auto r = __builtin_amdgcn_permlane32_swap(__float_as_uint(s), __float_as_uint(s), false, false); s = __uint_as_float(r[0]) + __uint_as_float(r[1]); }
    return s;
}
__device__ __forceinline__ float silu_f(float v) { return v * __builtin_amdgcn_rcpf(1.0f + __builtin_amdgcn_exp2f(-v * LOG2E)); }

namespace pg8 {
constexpr int BM = 256, BK = 64, HALF = 128, HTB = HALF * BK * 2, STAGE_BYTES = 8 * HTB, NXCD = 8, WGM = 8;
__host__ __device__ __forceinline__ int lds_byte(int r, int c) { const int st = (r >> 4) * 2 + (c >> 5), rr = r & 15, cc = c & 31, ob = rr * 64 + cc * 2; return st * 1024 + (ob ^ (((ob >> 9) & 1) << 5)); }
__host__ __device__ __forceinline__ void stage_rc(int b, int& R, int& C) { const int st = b / 1024, sb = b % 1024, swz = sb ^ (((sb >> 9) & 1) << 5); R = (st >> 1) * 16 + swz / 64; C = (st & 1) * 32 + (swz % 64) / 2; }
__host__ __device__ __forceinline__ int perm32(int rho) { const int n = rho >> 4, i = rho & 15; return 8 * (i >> 2) + 4 * n + (i & 3); }

struct Unit { int pm, pn; };
struct Gemm { const f16* A; const f16* Bt; int M, N, K; };

struct StaticOrder {
    int nM, nN, nwg, G, c;
    __host__ __device__ void init(int M, int N, int G_, int c_) { nM = M / BM; nN = N / BM; nwg = nM * nN; G = G_; c = c_; }
    __host__ __device__ bool next(int i, Unit& u) const {
        const long L = (long)i * G + c; if (L >= nwg) return false;
        int wgid = (int)L; { const int q = nwg / NXCD, r = nwg % NXCD, xcd = wgid % NXCD, off = wgid / NXCD; wgid = (xcd < r ? xcd * (q + 1) : r * (q + 1) + (xcd - r) * q) + off; }
        const int nig = WGM * nN, gid = wgid / nig, fm = gid * WGM, gsz = (nM - fm) < WGM ? (nM - fm) : WGM;
        u.pm = fm + ((wgid % nig) % gsz); u.pn = (wgid % nig) / gsz; return true;
    }
};


struct EpiProj {
    GAS f16* P; const GAS float* part; const GAS float* gq; const GAS float* gk; LAS unsigned char* rsc;
    struct Pre { f32x4 a[2][2]; int pm[2]; };
    __device__ __forceinline__ void pre_load(Pre& R, const StaticOrder& S) const {
        Unit u0, u4; R.pm[0] = S.next(0, u0) ? u0.pm : -1; R.pm[1] = (S.next(4, u4) && u4.pm != R.pm[0]) ? u4.pm : -1;
        const int t = threadIdx.x, row = t >> 1, half = t & 1;
#pragma unroll
        for (int k = 0; k < 2; ++k) { const GAS f32x4* p = (const GAS f32x4*)(part + ((size_t)(R.pm[k] < 0 ? 0 : R.pm[k]) * BM + row) * 16 + half * 8); R.a[k][0] = p[0]; R.a[k][1] = p[1]; }
    }
    __device__ __forceinline__ void pre_finish(const Pre& R) const {
        const int t = threadIdx.x, row = t >> 1, half = t & 1;
#pragma unroll
        for (int k = 0; k < 2; ++k) {
            float sum = ((R.a[k][0][0] + R.a[k][0][1]) + (R.a[k][0][2] + R.a[k][0][3])) + ((R.a[k][1][0] + R.a[k][1][1]) + (R.a[k][1][2] + R.a[k][1][3]));
            sum += __shfl_xor(sum, 1);
            if (half == 0) ((LAS float*)rsc)[k * 256 + row] = __builtin_amdgcn_rsqf(sum * (1.0f / DM) + RMS_EPS);
        }
        if (t == 0) ((LAS int*)(rsc + 2048))[0] = R.pm[0];
        if (t == 1) ((LAS int*)(rsc + 2048))[1] = R.pm[1];
    }
    __device__ __forceinline__ void operator()(const f32x4 (&acc)[2][2][4][2], const Unit& u, int wr, int wc, int fr, int fq) const {
        const int sec = u.pn >> 1;
        const int row0 = u.pm * BM + wr * 64 + fr;
        const int colw = u.pn * BM + wc * 64 + 8 * fq;
        f32x4 gain[2][2];
        if (sec == 4 || sec == 5) {
            const GAS float* g = (sec == 4) ? gq : gk;
#pragma unroll
            for (int bj = 0; bj < 2; ++bj)
#pragma unroll
                for (int n = 0; n < 2; ++n) gain[bj][n] = *(const GAS f32x4*)(g + 32 * bj + 8 * fq + 4 * n);
        }
        const LAS int* tags = (const LAS int*)(rsc + 2048);
        const int slot = (tags[0] == u.pm) ? 0 : (tags[1] == u.pm) ? 1 : -1;
        const LAS float* rtab = (const LAS float*)rsc + (slot > 0 ? 256 : 0) + wr * 64 + fr;
#pragma unroll
        for (int ai = 0; ai < 2; ++ai)
#pragma unroll
            for (int m = 0; m < 4; ++m) {
                const int row = row0 + ai * HALF + m * 16;
                float rs;
                if (slot >= 0) rs = rtab[ai * HALF + m * 16];
                else {
                    const f32x4 pv = *(const GAS f32x4*)(part + (size_t)row * 16 + fq * 4);
                    float s = (pv[0] + pv[1]) + (pv[2] + pv[3]);
                    s = row4_sum(s);
                    rs = __builtin_amdgcn_rsqf(s * (1.0f / DM) + RMS_EPS);
                }
                f32x4 v[2][2];
#pragma unroll
                for (int bj = 0; bj < 2; ++bj)
#pragma unroll
                    for (int n = 0; n < 2; ++n) v[bj][n] = acc[ai][bj][m][n] * rs;
                if (sec == 4 || sec == 5) {
                    float ss = 0.f;
#pragma unroll
                    for (int bj = 0; bj < 2; ++bj)
#pragma unroll
                        for (int n = 0; n < 2; ++n) { const f32x4 x = v[bj][n]; ss += (x[0] * x[0] + x[1] * x[1]) + (x[2] * x[2] + x[3] * x[3]); }
                    ss = row4_sum(ss);
                    float rn = __builtin_amdgcn_rsqf(ss * (1.0f / 64.0f) + RMS_EPS);
                    if (sec == 4) rn *= QS;
#pragma unroll
                    for (int bj = 0; bj < 2; ++bj)
#pragma unroll
                        for (int n = 0; n < 2; ++n) v[bj][n] = v[bj][n] * rn * gain[bj][n];
                } else if (sec == 0) {
#pragma unroll
                    for (int bj = 0; bj < 2; ++bj)
#pragma unroll
                        for (int n = 0; n < 2; ++n) v[bj][n] = v[bj][n] * QS;
                } else if (sec == 3 || sec == 7) {
#pragma unroll
                    for (int bj = 0; bj < 2; ++bj)
#pragma unroll
                        for (int n = 0; n < 2; ++n)
#pragma unroll
                            for (int e = 0; e < 4; ++e) v[bj][n][e] = silu_f(v[bj][n][e]);
                }
                GAS f16* rowp = P + (size_t)row * PW + colw;
#pragma unroll
                for (int bj = 0; bj < 2; ++bj) {
                    u32x4 w; w.x = pkh(v[bj][0][0], v[bj][0][1]); w.y = pkh(v[bj][0][2], v[bj][0][3]); w.z = pkh(v[bj][1][0], v[bj][1][1]); w.w = pkh(v[bj][1][2], v[bj][1][3]);
                    *(GAS u32x4*)(rowp + 32 * bj) = w;
                }
            }
    }
};

struct EpiOut {
    GAS float* out; GAS f16* xb; GAS float* part; int last;
    struct Pre {};
    __device__ __forceinline__ void pre_load(Pre&, const StaticOrder&) const {}
    __device__ __forceinline__ void pre_finish(const Pre&) const {}
    __device__ __forceinline__ void operator()(const f32x4 (&acc)[2][2][4][2], const Unit& u, int wr, int wc, int fr, int fq) const {
        const int row0 = u.pm * BM + wr * 64 + fr;
        const int colw = u.pn * BM + wc * 64 + 8 * fq;
#pragma unroll
        for (int ai = 0; ai < 2; ++ai) {
            h8 bs[4][2];
#pragma unroll
            for (int m = 0; m < 4; ++m)
#pragma unroll
                for (int bj = 0; bj < 2; ++bj) bs[m][bj] = *(const GAS h8*)(xb + (size_t)(row0 + ai * HALF + m * 16) * DM + colw + 32 * bj);
#pragma unroll
            for (int m = 0; m < 4; ++m) {
                const int row = row0 + ai * HALF + m * 16;
                const size_t off = (size_t)row * DM + colw;
                float ss = 0.f;
#pragma unroll
                for (int bj = 0; bj < 2; ++bj) {
                    const h8 b = bs[m][bj];
                    f32x4 o0 = acc[ai][bj][m][0], o1 = acc[ai][bj][m][1];
                    o0[0] += (float)b[0]; o0[1] += (float)b[1]; o0[2] += (float)b[2]; o0[3] += (float)b[3];
                    o1[0] += (float)b[4]; o1[1] += (float)b[5]; o1[2] += (float)b[6]; o1[3] += (float)b[7];
                    if (last) { *(GAS f32x4*)(out + off + 32 * bj) = o0; *(GAS f32x4*)(out + off + 32 * bj + 4) = o1; }
                    else {
                        ss += (o0[0] * o0[0] + o0[1] * o0[1]) + (o0[2] * o0[2] + o0[3] * o0[3]) + (o1[0] * o1[0] + o1[1] * o1[1]) + (o1[2] * o1[2] + o1[3] * o1[3]);
                        u32x4 w; w.x = pkh(o0[0], o0[1]); w.y = pkh(o0[2], o0[3]); w.z = pkh(o1[0], o1[1]); w.w = pkh(o1[2], o1[3]);
                        *(GAS u32x4*)(xb + off + 32 * bj) = w;
                    }
                }
                if (!last) {
                    ss = row4_sum(ss);
                    if (fq == 0) part[(size_t)row * 16 + u.pn * 4 + wc] = ss;
                }
            }
        }
    }
};

template <class Epi>
__device__ __forceinline__ void gemm_phase(LAS unsigned char* lds, const Gemm g, const StaticOrder& S, const Epi& E, unsigned long long& sw_acc) {
    int tid_ = threadIdx.x; asm volatile("" : "+v"(tid_));
    const int tid = tid_, wid = __builtin_amdgcn_readfirstlane(tid >> 6), lane = tid & 63, wr = wid >> 2, wc = wid & 3, fr = lane & 15, fq = lane >> 4;
    const int K = g.K, nt = K / BK;
    unsigned voffA[2], voffB[2];
#pragma unroll
    for (int i = 0; i < 2; ++i) { int R, C; stage_rc(tid * 16 + i * 8192, R, C);
        const int Rb = (R >> 5) * 64 + perm32(R & 31);
        voffA[i] = (unsigned)(R * K + C) * 2u; voffB[i] = (unsigned)(Rb * K + C) * 2u; }
    const size_t kstep = (size_t)(BK * 2);
    const size_t hstep = (size_t)HALF * K * 2;
    const size_t hstepB = (size_t)32 * K * 2;
    const size_t tstep = 2 * hstep;
    const unsigned ldsw = (unsigned)wid * 1024u;
    const int aoff = lds_byte(wr * 64 + fr, fq * 8), boff = lds_byte(wc * 32 + fr, fq * 8);
#define PG8_SA(b, h) (((b) * 2 + (h)) * HTB)
#define PG8_SB(b, h) ((4 + (b) * 2 + (h)) * HTB)
#define PG8_STAGE(bufoff, gbase, voff) do { _Pragma("unroll") for (int _i = 0; _i < 2; ++_i) \
        __builtin_amdgcn_global_load_lds((const unsigned*)((const char*)(gbase) + (voff)[_i]), (LAS unsigned*)(lds + (bufoff) + ldsw + _i * 8192), 16, 0, 0); } while (0)
#define PG8_LDA(dst, b, h) do { _Pragma("unroll") for (int m = 0; m < 4; ++m) _Pragma("unroll") for (int k = 0; k < 2; ++k) dst[m][k] = *(const LAS h8*)(lds + PG8_SA(b, h) + aoff + m * 2048 + k * 1024); } while (0)
#define PG8_LDB(dst, b, h) do { _Pragma("unroll") for (int n = 0; n < 2; ++n) _Pragma("unroll") for (int k = 0; k < 2; ++k) dst[n][k] = *(const LAS h8*)(lds + PG8_SB(b, h) + boff + n * 2048 + k * 1024); } while (0)
#define PG8_MMA(ai, bj, At, Bt) do { __builtin_amdgcn_s_setprio(1); _Pragma("unroll") for (int m = 0; m < 4; ++m) _Pragma("unroll") for (int n = 0; n < 2; ++n) _Pragma("unroll") for (int k = 0; k < 2; ++k) \
        acc[ai][bj][m][n] = __builtin_amdgcn_mfma_f32_16x16x32_f16(Bt[n][k], At[m][k], acc[ai][bj][m][n], 0, 0, 0); __builtin_amdgcn_s_setprio(0); } while (0)
#define PG8_WAIT_V(n) asm volatile("s_waitcnt vmcnt(" #n ")" ::: "memory")
#define PG8_WAIT_L(n) asm volatile("s_waitcnt lgkmcnt(" #n ")" ::: "memory")
#define PG8_BAR __builtin_amdgcn_s_barrier()
#define PG8_SCHED __builtin_amdgcn_sched_barrier(0)
    Unit cur, nxt; int ui = 0;
    if (!S.next(0, cur)) return;
    f32x4 acc[2][2][4][2];
#pragma unroll
    for (int a = 0; a < 2; ++a)
#pragma unroll
        for (int b = 0; b < 2; ++b)
#pragma unroll
            for (int m = 0; m < 4; ++m)
#pragma unroll
                for (int n = 0; n < 2; ++n) acc[a][b][m][n] = (f32x4){0.f, 0.f, 0.f, 0.f};
    h8 At[4][2], B0[2][2], B1[2][2];
    const char* cA = (const char*)g.A + (size_t)cur.pm * tstep; const char* cB = (const char*)g.Bt + (size_t)cur.pn * tstep;
    PG8_STAGE(PG8_SB(0, 0), cB, voffB); PG8_STAGE(PG8_SB(0, 1), cB + hstepB, voffB); PG8_STAGE(PG8_SA(0, 0), cA, voffA); PG8_STAGE(PG8_SA(0, 1), cA + hstep, voffA);
    typename Epi::Pre pre; E.pre_load(pre, S);
    if (wr == 1) PG8_BAR;
    PG8_WAIT_V(2); PG8_BAR;
    E.pre_finish(pre);
    PG8_WAIT_L(0);
    PG8_STAGE(PG8_SB(1, 0), cB + kstep, voffB); PG8_STAGE(PG8_SA(1, 0), cA + kstep, voffA); PG8_STAGE(PG8_SB(1, 1), cB + hstepB + kstep, voffB);
    PG8_WAIT_V(6); PG8_BAR;
    for (;;) {
        const bool has_next = S.next(ui + 1, nxt);
        const char* nA = has_next ? (const char*)g.A + (size_t)nxt.pm * tstep : cA; const char* nB = has_next ? (const char*)g.Bt + (size_t)nxt.pn * tstep : cB;
        for (int t = 0; t < nt; t += 2) {
            const bool last = (t == nt - 2);
            const char* a1 = cA + (size_t)(t + 1) * kstep;
            const char* a2 = last ? nA : cA + (size_t)(t + 2) * kstep; const char* b2 = last ? nB : cB + (size_t)(t + 2) * kstep;
            const char* a3 = a2 + kstep; const char* b3 = b2 + kstep;
            PG8_LDB(B0, 0, 0); PG8_LDB(B1, 0, 1); PG8_SCHED; PG8_LDA(At, 0, 0); PG8_STAGE(PG8_SA(1, 1), a1 + hstep, voffA);
            PG8_WAIT_V(8); PG8_WAIT_L(0); PG8_BAR; PG8_MMA(0, 0, At, B0); PG8_MMA(0, 1, At, B1); PG8_BAR; PG8_SCHED;
            PG8_LDA(At, 0, 1); PG8_STAGE(PG8_SB(0, 0), b2, voffB); PG8_STAGE(PG8_SB(0, 1), b2 + hstepB, voffB); PG8_STAGE(PG8_SA(0, 0), a2, voffA);
            PG8_WAIT_V(8); PG8_WAIT_L(0); PG8_BAR; PG8_MMA(1, 0, At, B0); PG8_MMA(1, 1, At, B1); PG8_BAR; PG8_SCHED;
            PG8_LDB(B0, 1, 0); PG8_LDB(B1, 1, 1); PG8_SCHED; PG8_LDA(At, 1, 0); PG8_STAGE(PG8_SA(0, 1), a2 + hstep, voffA);
            PG8_WAIT_V(8); PG8_WAIT_L(0); PG8_BAR; PG8_MMA(0, 0, At, B0); PG8_MMA(0, 1, At, B1); PG8_BAR; PG8_SCHED;
            PG8_LDA(At, 1, 1); PG8_STAGE(PG8_SB(1, 0), b3, voffB); PG8_STAGE(PG8_SB(1, 1), b3 + hstepB, voffB); PG8_STAGE(PG8_SA(1, 0), a3, voffA);
            PG8_WAIT_V(8); PG8_WAIT_L(0); PG8_BAR; PG8_MMA(1, 0, At, B0); PG8_MMA(1, 1, At, B1); PG8_BAR; PG8_SCHED;
        }
        if (wr == 0) PG8_BAR;
        { SW_BEGIN(20); E(acc, cur, wr, wc, fr, fq); SW_END(20); }
        if (!has_next) break;
#pragma unroll
        for (int a = 0; a < 2; ++a)
#pragma unroll
            for (int b = 0; b < 2; ++b)
#pragma unroll
                for (int m = 0; m < 4; ++m)
#pragma unroll
                    for (int n = 0; n < 2; ++n) acc[a][b][m][n] = (f32x4){0.f, 0.f, 0.f, 0.f};
        cur = nxt; cA = nA; cB = nB; ++ui;
        if (wr == 1) PG8_BAR;
    }
    PG8_WAIT_V(0);
    PG8_BAR;
#undef PG8_SA
#undef PG8_SB
#undef PG8_STAGE
#undef PG8_LDA
#undef PG8_LDB
#undef PG8_MMA
#undef PG8_WAIT_V
#undef PG8_WAIT_L
#undef PG8_BAR
#undef PG8_SCHED
}
}

namespace att {
typedef short v4i16_t __attribute__((ext_vector_type(4)));
__device__ __forceinline__ int crow(int r, int hi) { return (r & 3) + 8 * (r >> 2) + 4 * hi; }
__device__ __forceinline__ int keyrow(int i) { return 32 * ((i >> 2) & 1) + (i & 3) + 4 * (i >> 3); }
__device__ __forceinline__ h4 vtr(const LAS unsigned char* p) { return __builtin_bit_cast(h4, __builtin_amdgcn_ds_read_tr16_b64_v4i16((LAS v4i16_t*)p)); }
__device__ __forceinline__ h8 cat8(h4 a, h4 b) { return (h8){a[0], a[1], a[2], a[3], b[0], b[1], b[2], b[3]}; }
#define MFMA32(a, b, c) __builtin_amdgcn_mfma_f32_32x32x16_f16(a, b, c, 0, 0, 0)
__device__ __forceinline__ h8 pack8(const f32x16& p, int b) {
    u32x4 w; w.x = pkh_rtz(p[b], p[b + 1]); w.y = pkh_rtz(p[b + 2], p[b + 3]); w.z = pkh_rtz(p[b + 4], p[b + 5]); w.w = pkh_rtz(p[b + 6], p[b + 7]);
    return __builtin_bit_cast(h8, w);
}
template <int KI> __device__ __forceinline__ float fmamk_s(float c, float base) {
    float r; asm volatile("v_fmamk_f32 %0, %1, %2, %3" : "=v"(r) : "v"(c), "i"(__builtin_bit_cast(int, (float)KI)), "v"(base)); return r; }
__device__ __forceinline__ void ld_groups_raw(const GAS f16* rowp  , int hi, u32x4 (&L)[4]) {
#pragma unroll
    for (int k = 0; k < 4; ++k) L[k] = *(const GAS u32x4*)(rowp + 16 * k + 8 * hi);
}
__device__ __forceinline__ void unpack_groups(const u32x4 (&L)[4], u32x2 (&g)[8]) {
#pragma unroll
    for (int k = 0; k < 4; ++k) {
        const auto rx = __builtin_amdgcn_permlane32_swap(L[k].x, L[k].z, false, false), ry = __builtin_amdgcn_permlane32_swap(L[k].y, L[k].w, false, false);
        g[2 * k].x = rx[0]; g[2 * k].y = ry[0]; g[2 * k + 1].x = rx[1]; g[2 * k + 1].y = ry[1];
    }
}
__device__ __forceinline__ void st_groups2(GAS f16* rowp, int hi, int k, u32x2 a  , u32x2 b  ) {
    const auto rx = __builtin_amdgcn_permlane32_swap(a.x, b.x, false, false), ry = __builtin_amdgcn_permlane32_swap(a.y, b.y, false, false);
    u32x4 w; w.x = rx[0]; w.y = ry[0]; w.z = rx[1]; w.w = ry[1];
    *(GAS u32x4*)(rowp + 16 * k + 8 * hi) = w;
}
__device__ __forceinline__ float wave_sum(float v) {
#pragma unroll
    for (int o = 1; o < 64; o <<= 1) v += __shfl_xor(v, o);
    return v;
}
__device__ __forceinline__ float wave_max(float v) {
#pragma unroll
    for (int o = 1; o < 64; o <<= 1) v = fmaxf(v, __shfl_xor(v, o));
    return v;
}

__device__ __forceinline__ void glds16(const GAS void* g, unsigned lds_base) {
    unsigned sv; asm volatile("s_mov_b32 %0, m0\n\ts_mov_b32 m0, %2\n\ts_nop 0\n\tglobal_load_lds_dwordx4 %1, off\n\ts_mov_b32 m0, %0" : "=&s"(sv) : "v"(g), "s"(lds_base) : "memory"); }
#define WAIT_BAR(N) asm volatile("s_waitcnt vmcnt(" #N ") lgkmcnt(0)\n\ts_barrier" ::: "memory")
__device__ __forceinline__ void wait_bar_n(int n) {
    switch (n) { case 0: WAIT_BAR(0); break; case 2: WAIT_BAR(2); break; case 4: WAIT_BAR(4); break; case 6: WAIT_BAR(6); break; case 8: WAIT_BAR(8); break; case 10: WAIT_BAR(10); break;
                 case 12: WAIT_BAR(12); break; case 14: WAIT_BAR(14); break; case 16: WAIT_BAR(16); break; case 18: WAIT_BAR(18); break; case 20: WAIT_BAR(20); break; default: WAIT_BAR(0); break; }
}

constexpr int SB_SLOT = 65536, SB_FLG = 147456 + 2048;
__device__ __forceinline__ int keyrow16(int i) { return 16 * ((i >> 2) & 1) + (i & 3) + 4 * (i >> 3); }
struct SbUnit { int b, hg, cq; };
__device__ __forceinline__ bool sb_decode(int u, SbUnit& U) {
    if (u >= 1024) return false;
    const int r = u >> 8, v = u & 255, i = v & 15;
    U.b = v >> 4; U.hg = i & 1; U.cq = (i >> 1) + 8 * r; return true;
}
__device__ __forceinline__ void sb_phase(LAS unsigned char* lds, const GAS f16* __restrict__ proj, GAS f16* __restrict__ mixed, int vcu, int G, unsigned long long& sw_acc) {
    int tid_ = threadIdx.x; asm volatile("" : "+v"(tid_));
    const int tid = tid_, lane = tid & 63, l31 = lane & 31, hi = lane >> 5; const int w = __builtin_amdgcn_readfirstlane(tid >> 6);
    const int hh = w & 3, rgp = w >> 2;
    const unsigned lds0 = (unsigned)(uintptr_t)lds;
    const unsigned kdst = lds0 + w * 4096, vdst = lds0 + 32768 + w * 4096;
    int kfo[4];
    { const int kr = keyrow16(l31);
#pragma unroll
      for (int d0 = 0; d0 < 4; ++d0) kfo[d0] = kr * 512 + (((hh * 8 + 2 * d0 + hi) ^ (kr & 15)) * 16); }
    int vfo[2];
    { const int q_ = (lane & 15) >> 2;
#pragma unroll
      for (int d0 = 0; d0 < 2; ++d0) vfo[d0] = 32768 + (16 * hi + q_) * 512 + (((hh * 2 + d0) ^ q_) * 64) + ((lane >> 4) & 1) * 32 + (lane & 3) * 8; }
    LAS unsigned* flags = (LAS unsigned*)(lds + SB_FLG);
    size_t koff[4], voff[4];
#pragma unroll
    for (int i = 0; i < 4; ++i) { const int row = 8 * w + 2 * i + (lane >> 5), p = lane & 31;
        koff[i] = (size_t)row * PW + C_SBK + ((p ^ (row & 15)) * 8);
        voff[i] = (size_t)row * PW + C_SBV + ((((p >> 2) ^ (row & 3)) * 4 + (p & 3)) * 8); }
    const size_t qoff = (size_t)(32 * rgp + l31) * PW;
#define SB_DMA(base_, kt_, slot) do { const GAS f16* b_ = (base_) + (size_t)(kt_) * 64 * PW; const unsigned kd_ = (unsigned)__builtin_amdgcn_readfirstlane(kdst + (slot)), vd_ = (unsigned)__builtin_amdgcn_readfirstlane(vdst + (slot)); \
        _Pragma("unroll") for (int i_ = 0; i_ < 4; ++i_) { glds16(b_ + koff[i_], kd_ + i_ * 1024); glds16(b_ + voff[i_], vd_ + i_ * 1024); } } while (0)
    SbUnit U, Un; int ui = vcu;
    if (!sb_decode(ui, U)) return;
    int islot = 0, cslot = 0;
    const GAS f16* tbase = proj + ((size_t)U.b * SEQ) * PW + U.hg * 256;
    h8 qn[4]; u32x4 gn[4];
    { const size_t grow = (size_t)U.b * SEQ + U.cq * 64 + 32 * rgp + l31; const int h = 4 * U.hg + hh;
      const GAS f16* Qg = proj + grow * PW + C_SBQ + h * 64 + 8 * hi; const GAS f16* Gp = proj + grow * PW + C_SBG + h * 64;
#pragma unroll
      for (int d0 = 0; d0 < 4; ++d0) qn[d0] = *(const GAS h8*)(Qg + 16 * d0);
      ld_groups_raw(Gp, hi, gn); }
    asm volatile("" : "+v"(qn[0]), "+v"(qn[1]), "+v"(qn[2]), "+v"(qn[3]));
    SB_DMA(tbase, U.cq, islot); islot ^= SB_SLOT;
    for (;;) {
        const size_t rowbase = (size_t)U.b * SEQ;
        const int qw = U.cq * 64 + 32 * rgp, t = qw + l31, NT = U.cq + 1, h = 4 * U.hg + hh;
        const size_t grow = rowbase + qw + l31;
        h8 qr[4]; u32x4 gr[4];
#pragma unroll
        for (int d0 = 0; d0 < 4; ++d0) qr[d0] = qn[d0];
#pragma unroll
        for (int i = 0; i < 4; ++i) gr[i] = gn[i];
        const bool has_next = sb_decode(ui + G, Un);
        f32x16 o[2]; o[0] = f32x16{}; o[1] = f32x16{};
        float carry = 1.f; int done = 0;
        SW_BEGIN(12);
        for (int j = 0; j < NT; ++j) {
            SW_BEGIN(13);
            WAIT_BAR(0);
            SW_END(13);
            if (j > 0) {
                const u32x4 f0 = *(const LAS u32x4*)(flags + ((j - 1) & 1) * 8), f1 = *(const LAS u32x4*)(flags + ((j - 1) & 1) * 8 + 4);
                const unsigned any = (f0.x | f0.y | f0.z | f0.w) | (f1.x | f1.y | f1.z | f1.w);
                if (!__builtin_amdgcn_readfirstlane(any)) break;
            }
            if (j + 1 < NT) { SB_DMA(tbase, U.cq - (j + 1), islot); islot ^= SB_SLOT; }
            const int kt = U.cq - j;
#pragma unroll
            for (int sub = 0; sub < 2; ++sub) {
                const int kb32 = sub == 0 ? 32 : 0;
                const bool diag = (j == 0) && (sub == (rgp == 1 ? 0 : 1));
                const bool skip = (j == 0) && (rgp == 0) && (sub == 0);
                if (!done && !skip) {
                    const LAS unsigned char* Sb = lds + cslot + kb32 * 512;
                    f32x16 p = f32x16{};
#pragma unroll
                    for (int d0 = 0; d0 < 4; ++d0) { const h8 k0 = *(const LAS h8*)(Sb + kfo[d0]); p = MFMA32(k0, qr[d0], p); }
#pragma unroll
                    for (int r = 0; r < 16; ++r) p[r] = __builtin_amdgcn_rcpf(1.0f + __builtin_amdgcn_exp2f(-p[r]));
                    if (diag) {
                        const int key0 = 64 * kt + kb32 + 16 * hi;
#pragma unroll
                        for (int r = 0; r < 16; ++r) if (key0 + r >= t) p[r] = 0.f;
                    }
                    float run = 1.f;
#pragma unroll
                    for (int r = 15; r >= 0; --r) { const float a = run * p[r]; run -= a; p[r] = a; }
                    const auto rr = __builtin_amdgcn_permlane32_swap(__float_as_uint(run), __float_as_uint(run), false, false);
                    const float T0 = __uint_as_float(rr[0]), T1 = __uint_as_float(rr[1]);
                    const float E = carry * (hi ? 1.0f : T1);
                    carry = carry * (T0 * T1);
#pragma unroll
                    for (int r = 0; r < 16; ++r) p[r] *= E;
                    const h8 pa0 = pack8(p, 0), pa1 = pack8(p, 8);
#pragma unroll
                    for (int d0 = 0; d0 < 2; ++d0) {
                        const LAS unsigned char* Vb = Sb + vfo[d0];
                        const h8 v0 = cat8(vtr(Vb), vtr(Vb + 2048));
                        const h8 v1 = cat8(vtr(Vb + 4096), vtr(Vb + 6144));
                        o[d0] = MFMA32(v0, pa0, o[d0]); o[d0] = MFMA32(v1, pa1, o[d0]);
                    }
#if SB_EARLY_EXIT
                    done = __builtin_amdgcn_readfirstlane(__all(carry < 1.0e-37f) ? 1 : 0);
#endif
                }
            }
            if (lane == 0) flags[(j & 1) * 8 + w] = done ? 0u : 1u;
            cslot ^= SB_SLOT;
        }
        asm volatile("s_nop 15\n\ts_nop 7" : "+v"(o[0]), "+v"(o[1]));
        SW_END(12);
        cslot = islot;
        if (has_next) {
            const size_t grown = (size_t)Un.b * SEQ + Un.cq * 64 + 32 * rgp + l31; const int hn = 4 * Un.hg + hh;
            const GAS f16* Qg = proj + grown * PW + C_SBQ + hn * 64 + 8 * hi; const GAS f16* Gp = proj + grown * PW + C_SBG + hn * 64;
#pragma unroll
            for (int d0 = 0; d0 < 4; ++d0) qn[d0] = *(const GAS h8*)(Qg + 16 * d0);
            ld_groups_raw(Gp, hi, gn);
            asm volatile("" ::: "memory");
            tbase = proj + ((size_t)Un.b * SEQ) * PW + Un.hg * 256;
            SB_DMA(tbase, Un.cq, islot); islot ^= SB_SLOT;
        }
        {
            GAS f16* Op = mixed + grow * DM + h * 64;
            u32x2 gv[8]; unpack_groups(gr, gv);
#pragma unroll
            for (int d0 = 0; d0 < 2; ++d0)
#pragma unroll
                for (int pr = 0; pr < 2; ++pr) {
                    u32x2 wv[2];
#pragma unroll
                    for (int e = 0; e < 2; ++e) { const int rg4 = 2 * pr + e; const h4 g = __builtin_bit_cast(h4, gv[d0 * 4 + rg4]);
                        wv[e].x = pkh(o[d0][4 * rg4] * (float)g[0], o[d0][4 * rg4 + 1] * (float)g[1]); wv[e].y = pkh(o[d0][4 * rg4 + 2] * (float)g[2], o[d0][4 * rg4 + 3] * (float)g[3]); }
                    st_groups2(Op, hi, 2 * d0 + pr, wv[0], wv[1]);
                }
        }
        if (!has_next) break;
        U = Un; ui += G;
    }
#undef SB_DMA
    WAIT_BAR(0);
}

constexpr int DA_KS = 16384, DA_VRING = 49152, DA_XCH = 114688, DA_SUBG = 147456 + 1024, DA_SSX = 147456 + 3072;
struct DaUnit { int b, h, qt, klo; };
__device__ __forceinline__ int da_qt_of(int r, int i) {
    constexpr unsigned long long Q1 = 0xD69701EF58CA42B3ull, Q2 = 0xA185D6F4B972EC30ull, Q3 = 0x3E795A0B468D12CFull;
    return r == 0 ? i : (int)(((r == 1 ? Q1 : r == 2 ? Q2 : Q3) >> (4 * i)) & 15ull);
}
__device__ __forceinline__ int da_klo(int qt, int h) {
    const float cs = exp2f(-2.0f * (float)(h + 1)) * LOG2E;
    const int D = (int)ceilf(35.5f / cs), m = qt * 128 - D - 63;
    return m > 0 ? (m + 63) >> 6 : 0;
}
__device__ __forceinline__ bool da_decode(int u, DaUnit& U) {
    if (u >= 1024) return false;
    const int r = u >> 8, v = u & 255;
    U.b = v >> 4; U.h = r; U.qt = da_qt_of(r, v & 15); U.klo = da_klo(U.qt, U.h); return true;
}
__device__ __forceinline__ void da_pv(f32x16 (&o)[4], const LAS unsigned char* Vs, const int (&vfo)[4], h8 pa0, h8 pa1, h8 pa2, h8 pa3) {
    h8 f0, f1, f2, f3, g0, g1, g2, g3;
    { const LAS unsigned char* Vb = Vs + vfo[0]; f0 = cat8(vtr(Vb), vtr(Vb + 1024)); f1 = cat8(vtr(Vb + 2048), vtr(Vb + 3072)); f2 = cat8(vtr(Vb + 4096), vtr(Vb + 5120)); f3 = cat8(vtr(Vb + 6144), vtr(Vb + 7168)); }
#pragma unroll
    for (int d0 = 0; d0 < 4; ++d0) {
        if (d0 < 3) { const LAS unsigned char* Vb = Vs + vfo[d0 + 1]; g0 = cat8(vtr(Vb), vtr(Vb + 1024)); g1 = cat8(vtr(Vb + 2048), vtr(Vb + 3072)); g2 = cat8(vtr(Vb + 4096), vtr(Vb + 5120)); g3 = cat8(vtr(Vb + 6144), vtr(Vb + 7168)); }
        o[d0] = MFMA32(f0, pa0, o[d0]); o[d0] = MFMA32(f1, pa1, o[d0]); o[d0] = MFMA32(f2, pa2, o[d0]); o[d0] = MFMA32(f3, pa3, o[d0]);
        if (d0 < 3) { f0 = g0; f1 = g1; f2 = g2; f3 = g3; }
    }
}
__device__ __forceinline__ void da_phase(LAS unsigned char* lds, const GAS f16* __restrict__ proj, GAS f16* __restrict__ mixed, int vcu, int G,
                                         float lam, float mref, const GAS float* __restrict__ subg, float osc, unsigned long long& sw_acc) {
    int tid_ = threadIdx.x; asm volatile("" : "+v"(tid_));
    const int tid = tid_, lane = tid & 63, l31 = lane & 31, hi = lane >> 5; const int w = __builtin_amdgcn_readfirstlane(tid >> 6);
    const int c = w >> 2, rg = w & 3;
    const unsigned lds0 = (unsigned)(uintptr_t)lds;
    const unsigned kdst = lds0 + w * 1024, vdst = lds0 + DA_VRING + w * 1024;
    int kfo[4];
    { const int kr = keyrow(l31);
#pragma unroll
      for (int d0 = 0; d0 < 4; ++d0) kfo[d0] = kr * 256 + (((8 * c + 2 * d0 + hi) ^ (kr & 15)) * 16); }
    int vfo[4];
    { const int q_ = (lane & 15) >> 2;
#pragma unroll
      for (int d0 = 0; d0 < 4; ++d0) vfo[d0] = DA_VRING + (32 * hi + q_) * 256 + ((d0 ^ q_) * 64) + ((lane >> 4) & 1) * 32 + (lane & 3) * 8; }
    const int srow = 4 * w + (lane >> 4);
    const size_t koff = (size_t)srow * PW + C_DAK + (((lane & 15) ^ (srow & 15)) * 8);
    const size_t voff = (size_t)srow * PW + C_DAV + (((((lane & 15) >> 2) ^ (srow & 3)) * 4 + (lane & 3)) * 8);
    const size_t qoff = (size_t)(32 * rg + l31) * PW + C_DAQ + c * 64 + 8 * hi;
    h8 ones; { const f16 one = (l31 == 0) ? (f16)1.0f : (f16)0.0f; ones = (h8){one, one, one, one, one, one, one, one}; }
    if (tid < 128) ((LAS float*)(lds + DA_SUBG))[tid] = subg[tid];
    LAS unsigned* xch = (LAS unsigned*)(lds + DA_XCH + rg * 8192);
#define DA_DMA(ks_, vs_, kt_, kslot, vslot) do { const size_t go_ = (size_t)(kt_) * 64 * PW; const unsigned kd_ = (unsigned)__builtin_amdgcn_readfirstlane(kdst + (kslot)), vd_ = (unsigned)__builtin_amdgcn_readfirstlane(vdst + (vslot)); \
        glds16((ks_) + go_, kd_); glds16((ks_) + go_ + (size_t)32 * PW, kd_ + 8192); glds16((vs_) + go_, vd_); glds16((vs_) + go_ + (size_t)32 * PW, vd_ + 8192); } while (0)
#define DA_NEXT_K(s) ((s) == 2 * DA_KS ? 0 : (s) + DA_KS)
#define DA_NEXT_V(s) ((s) == 3 * DA_KS ? 0 : (s) + DA_KS)
    DaUnit U, Un; int ui = vcu;
    if (!da_decode(ui, U)) return;
    const GAS f16* ksrc = proj + ((size_t)U.b * SEQ) * PW + U.h * 128 + koff; const GAS f16* vsrc = proj + ((size_t)U.b * SEQ) * PW + U.h * 128 + voff;
    h8 qn[4];
    { const GAS f16* Qg = proj + ((size_t)U.b * SEQ + U.qt * 128) * PW + qoff + U.h * 128;
#pragma unroll
      for (int d0 = 0; d0 < 4; ++d0) qn[d0] = *(const GAS h8*)(Qg + 16 * d0); }
    asm volatile("" : "+v"(qn[0]), "+v"(qn[1]), "+v"(qn[2]), "+v"(qn[3]));
    DA_DMA(ksrc, vsrc, U.klo, 0, 0); DA_DMA(ksrc, vsrc, U.klo + 1, DA_KS, DA_KS);
    int ik = 2 * DA_KS, iv = 2 * DA_KS, ck = 0, cv = 0;
    for (;;) {
        const size_t rowbase = (size_t)U.b * SEQ;
        const int qw = U.qt * 128 + 32 * rg, t = qw + l31, lastt = qw >> 6, NT = 2 * U.qt + 2;
        const float cslope = exp2f(-2.0f * (float)(U.h + 1)) * LOG2E;
        const float cs64 = 64.0f * cslope, base0 = -cslope * (float)(t - 32 * hi) - mref;
        h8 qr[4];
#pragma unroll
        for (int d0 = 0; d0 < 4; ++d0) qr[d0] = qn[d0];
        const size_t grow = rowbase + qw + l31;
        const bool has_next = da_decode(ui + G, Un);
        const GAS f16* ksn = ksrc; const GAS f16* vsn = vsrc;
        if (has_next) { ksn = proj + ((size_t)Un.b * SEQ) * PW + Un.h * 128 + koff; vsn = proj + ((size_t)Un.b * SEQ) * PW + Un.h * 128 + voff; }
        f32x16 o[4]; o[0] = f32x16{}; o[1] = f32x16{}; o[2] = f32x16{}; o[3] = f32x16{};
        f32x16 osum = f32x16{};
        SW_BEGIN(2);
        for (int kt = U.klo; kt < NT; ++kt) {
            SW_BEGIN(3);
            if (kt + 1 < NT || has_next) WAIT_BAR(4); else WAIT_BAR(0);
            SW_END(3);
#define DA_ISSUE() do { if (kt + 2 < NT) { DA_DMA(ksrc, vsrc, kt + 2, ik, iv); ik = DA_NEXT_K(ik); iv = DA_NEXT_V(iv); } \
            else if (has_next) { DA_DMA(ksn, vsn, Un.klo + kt + 2 - NT, ik, iv); ik = DA_NEXT_K(ik); iv = DA_NEXT_V(iv); } } while (0)
            DA_ISSUE();
            if (kt <= lastt) {
                const LAS unsigned char* Ks = lds + ck;
                f32x16 p0, p1;
                const float basek = __builtin_fmaf(cs64, (float)kt, base0);
                __builtin_amdgcn_sched_barrier(0);
                asm volatile("s_nop 7" ::: "memory");
#define DA_INIT(r) p0[r] = fmamk_s<r>(cslope, basek); p1[r] = fmamk_s<16 + r>(cslope, basek);
                DA_INIT(0) DA_INIT(1) DA_INIT(2) DA_INIT(3) DA_INIT(4) DA_INIT(5) DA_INIT(6) DA_INIT(7) DA_INIT(8) DA_INIT(9) DA_INIT(10) DA_INIT(11) DA_INIT(12) DA_INIT(13) DA_INIT(14) DA_INIT(15)
#undef DA_INIT
                asm volatile("s_nop 3" : "+v"(p0), "+v"(p1));
                if (kt == lastt) {
                    const int kd = t - (64 * kt + 32 * hi);
                    const float m2 = -2.0f * mref;
                    asm volatile("" ::: "memory");
#pragma unroll
                    for (int r = 0; r < 16; ++r) { if (r > kd) p0[r] = m2 - p0[r]; if (16 + r > kd) p1[r] = m2 - p1[r]; }
                }
#pragma unroll
                for (int d0 = 0; d0 < 4; ++d0) { const h8 ka = *(const LAS h8*)(Ks + kfo[d0]), kb = *(const LAS h8*)(Ks + kfo[d0] + 4096); p0 = MFMA32(ka, qr[d0], p0); p1 = MFMA32(kb, qr[d0], p1); }
#pragma unroll
                for (int r = 0; r < 16; ++r) { p0[r] = __builtin_amdgcn_exp2f(p0[r]); p1[r] = __builtin_amdgcn_exp2f(p1[r]); }
                const h8 pq0 = pack8(p0, 0), pq1 = pack8(p0, 8), pq2 = pack8(p1, 0), pq3 = pack8(p1, 8);
                osum = MFMA32(ones, pq0, osum); osum = MFMA32(ones, pq1, osum); osum = MFMA32(ones, pq2, osum); osum = MFMA32(ones, pq3, osum);
                da_pv(o, lds + cv, vfo, pq0, pq1, pq2, pq3);
            }
            ck = DA_NEXT_K(ck); cv = DA_NEXT_V(cv);
        }
        asm volatile("s_nop 15\n\ts_nop 7" : "+v"(o[0]), "+v"(o[1]), "+v"(o[2]), "+v"(o[3]), "+v"(osum));
        SW_END(2);
        const int dlo = 2 * c;
        u32x4 gr[4];
        ld_groups_raw(proj + grow * PW + C_DAG + U.h * 128 + 32 * dlo, hi, gr);
        if (has_next) { const GAS f16* Qg = proj + ((size_t)Un.b * SEQ + Un.qt * 128) * PW + qoff + Un.h * 128;
#pragma unroll
            for (int d0 = 0; d0 < 4; ++d0) qn[d0] = *(const GAS h8*)(Qg + 16 * d0); }
        asm volatile("" ::: "memory");
        float lsum = osum[0];
        { const auto rr = __builtin_amdgcn_permlane32_swap(__float_as_uint(lsum), __float_as_uint(lsum), false, false); lsum = __uint_as_float(rr[0]) + __uint_as_float(rr[1]); }
        const float f = (c == 0 ? 1.0f : lam) / lsum;
        LAS unsigned* xw = xch + (c ^ 1) * 1024;
        LAS unsigned* xr = xch + c * 1024;
        f32x16 ya, yb;
        if (c == 0) {
#pragma unroll
            for (int r2 = 0; r2 < 8; ++r2) { xw[r2 * 64 + lane] = pkh(o[2][2 * r2] * f, o[2][2 * r2 + 1] * f); xw[(8 + r2) * 64 + lane] = pkh(o[3][2 * r2] * f, o[3][2 * r2 + 1] * f); }
            ya = o[0] * f; yb = o[1] * f;
        } else {
#pragma unroll
            for (int r2 = 0; r2 < 8; ++r2) { xw[r2 * 64 + lane] = pkh(o[0][2 * r2] * f, o[0][2 * r2 + 1] * f); xw[(8 + r2) * 64 + lane] = pkh(o[1][2 * r2] * f, o[1][2 * r2 + 1] * f); }
            ya = o[2] * f; yb = o[3] * f;
        }
        asm volatile("s_waitcnt lgkmcnt(0)\n\ts_barrier" ::: "memory");
        const float sgn = (c == 0) ? 1.0f : -1.0f;
        float ss = 0.f;
#pragma unroll
        for (int r2 = 0; r2 < 8; ++r2) {
            const h2 pa = __builtin_bit_cast(h2, xr[r2 * 64 + lane]), pb = __builtin_bit_cast(h2, xr[(8 + r2) * 64 + lane]);
            const float a0 = (ya[2 * r2] - (float)pa[0]) * sgn, a1 = (ya[2 * r2 + 1] - (float)pa[1]) * sgn, b0 = (yb[2 * r2] - (float)pb[0]) * sgn, b1 = (yb[2 * r2 + 1] - (float)pb[1]) * sgn;
            ya[2 * r2] = a0; ya[2 * r2 + 1] = a1; yb[2 * r2] = b0; yb[2 * r2 + 1] = b1; ss += (a0 * a0 + a1 * a1) + (b0 * b0 + b1 * b1);
        }
        { const auto rr = __builtin_amdgcn_permlane32_swap(__float_as_uint(ss), __float_as_uint(ss), false, false); ss = __uint_as_float(rr[0]) + __uint_as_float(rr[1]); }
        LAS float* ssx = (LAS float*)(lds + DA_SSX + rg * 256);
        if (hi == 0) ssx[c * 32 + l31] = ss;
        asm volatile("s_waitcnt lgkmcnt(0)\n\ts_barrier" ::: "memory");
        ss += ssx[(c ^ 1) * 32 + l31];
        const float rn = __builtin_amdgcn_rsqf(ss * (1.0f / 128.0f) + RMS_EPS) * osc;
        {
            const LAS float* sgl = (const LAS float*)(lds + DA_SUBG) + 32 * dlo + 4 * hi;
            GAS f16* Op = mixed + grow * DM + 512 + U.h * 128 + 32 * dlo;
            u32x2 gv[8]; unpack_groups(gr, gv);
#pragma unroll
            for (int pr = 0; pr < 2; ++pr) {
                u32x2 wv[2];
#pragma unroll
                for (int e = 0; e < 2; ++e) { const int rg4 = 2 * pr + e; const h4 g = __builtin_bit_cast(h4, gv[rg4]); const f32x4 sg = *(const LAS f32x4*)(sgl + 8 * rg4);
                    wv[e].x = pkh(ya[4 * rg4] * rn * sg[0] * (float)g[0], ya[4 * rg4 + 1] * rn * sg[1] * (float)g[1]);
                    wv[e].y = pkh(ya[4 * rg4 + 2] * rn * sg[2] * (float)g[2], ya[4 * rg4 + 3] * rn * sg[3] * (float)g[3]); }
                st_groups2(Op, hi, pr, wv[0], wv[1]);
            }
#pragma unroll
            for (int pr = 0; pr < 2; ++pr) {
                u32x2 wv[2];
#pragma unroll
                for (int e = 0; e < 2; ++e) { const int rg4 = 2 * pr + e; const h4 g = __builtin_bit_cast(h4, gv[4 + rg4]); const f32x4 sg = *(const LAS f32x4*)(sgl + 32 + 8 * rg4);
                    wv[e].x = pkh(yb[4 * rg4] * rn * sg[0] * (float)g[0], yb[4 * rg4 + 1] * rn * sg[1] * (float)g[1]);
                    wv[e].y = pkh(yb[4 * rg4 + 2] * rn * sg[2] * (float)g[2], yb[4 * rg4 + 3] * rn * sg[3] * (float)g[3]); }
                st_groups2(Op, hi, 2 + pr, wv[0], wv[1]);
            }
        }
        if (!has_next) break;
        U = Un; ui += G; ksrc = ksn; vsrc = vsn;
    }
#undef DA_DMA
#undef DA_ISSUE
#undef DA_NEXT_K
#undef DA_NEXT_V
    WAIT_BAR(0);
}
}

constexpr size_t MiB = 1u << 20;
constexpr size_t WS_CTL = 0, CTL_ZERO_BYTES = 64 * 1024;
constexpr size_t WS_WIN = 2 * MiB;
constexpr size_t WS_WOUT = 18 * MiB;
constexpr size_t WS_PART = 22 * MiB;
constexpr size_t WS_XB = 32 * MiB;
constexpr size_t WS_MIX = 96 * MiB;
constexpr size_t WS_PROJ = 160 * MiB;
constexpr size_t WS_END = 416 * MiB;
constexpr int CW_BAR = 4096;

constexpr int RING_OFF = 0, RING_BYTES = 131072;
constexpr int LDSCTL_OFF = 147456, MISC_OFF = LDSCTL_OFF + 320;
constexpr int LDS_BYTES = 163840;
constexpr int NWAVES = 8;

typedef GAS unsigned gu32;
#define LDS_WAIT() asm volatile("s_waitcnt lgkmcnt(0)" ::: "memory")

#define XB_TMO      128
#define XB_XCNT(j)  (256  + 64 * (j))
#define XB_XSUB(j)  (1280 + 64 * (j))
#define XB_XGEN(j)  (2304 + 64 * (j))
#define XB_TOP      3328
#define XB_TOPGEN   3392
#define XCD_BAR_WORDS 3456
#define XB_SPIN_CAP (1u << 18)
__device__ __forceinline__ unsigned xb_ld(unsigned* p)              { return __hip_atomic_load(p, __ATOMIC_RELAXED, __HIP_MEMORY_SCOPE_AGENT); }
__device__ __forceinline__ unsigned xb_add(unsigned* p, unsigned v) { return __hip_atomic_fetch_add(p, v, __ATOMIC_RELAXED, __HIP_MEMORY_SCOPE_AGENT); }
__device__ __forceinline__ unsigned xb_xcc_id() { return (unsigned)__builtin_amdgcn_s_getreg((3 << 11) | 20) & 0xFu; }
#define XB_SPIN(cond, bar) do { unsigned _sp = 0; while (cond) { __builtin_amdgcn_s_sleep(1); \
    if ((++_sp & 255u) == 0u) { if (xb_ld(&(bar)[XB_TMO])) break; if (_sp > XB_SPIN_CAP) { atomicAdd(&(bar)[XB_TMO], 1u); break; } } } } while (0)
struct XcdBarrier { unsigned* bar; unsigned x; volatile LAS unsigned* st; };
__device__ __forceinline__ XcdBarrier xcd_barrier_post(unsigned* bar, volatile LAS unsigned* st) {
    XcdBarrier b; b.bar = bar; b.x = xb_xcc_id(); b.st = st;
    if (threadIdx.x == 0) (void)xb_add(&bar[XB_XCNT(b.x)], 1u);
    return b;
}
__device__ __forceinline__ void xcd_barrier_complete(unsigned* bar, unsigned x, unsigned& nloc, unsigned& nx) {
    const unsigned G = gridDim.x * gridDim.y * gridDim.z;
    unsigned sum, cnt, mine, sp = 0u;
    for (;;) {
        sum = 0u; cnt = 0u; mine = 0u;
#pragma unroll
        for (unsigned j = 0; j < 16; ++j) { const unsigned c = xb_ld(&bar[XB_XCNT(j)]); sum += c; cnt += (c > 0u) ? 1u : 0u; mine = (j == x) ? c : mine; }
        if (sum == G) break;
        __builtin_amdgcn_s_sleep(1);
        if ((++sp & 255u) == 0u) { if (xb_ld(&bar[XB_TMO])) break; if (sp > XB_SPIN_CAP) { atomicAdd(&bar[XB_TMO], 1u); break; } }
    }
    nloc = mine > 0u ? mine : 1u; nx = cnt > 0u ? cnt : 1u;
}
__device__ __forceinline__ void xcd_barrier(const XcdBarrier& b) {
    asm volatile("s_waitcnt vmcnt(0)" ::: "memory");
    __syncthreads();
    if (threadIdx.x == 0) {
        unsigned* bar = b.bar;
        __builtin_amdgcn_s_waitcnt(0);
        unsigned nloc = b.st[0], nx = b.st[1];
        if (nloc == 0u) { xcd_barrier_complete(bar, b.x, nloc, nx); b.st[0] = nloc; b.st[1] = nx; }
        const unsigned old = xb_add(&bar[XB_XSUB(b.x)], 1u);
        const unsigned gen = old / nloc;
        if (old + 1u == (gen + 1u) * nloc) {
            __builtin_amdgcn_fence(__ATOMIC_RELEASE, "agent");
            asm volatile("s_waitcnt vmcnt(0)" ::: "memory");
            const unsigned og = xb_add(&bar[XB_TOP], 1u);
            const unsigned tg = og / nx;
            if (og + 1u == (tg + 1u) * nx) xb_add(&bar[XB_TOPGEN], 1u);
            else XB_SPIN(xb_ld(&bar[XB_TOPGEN]) == tg, bar);
            __builtin_amdgcn_fence(__ATOMIC_ACQUIRE, "agent");
            xb_add(&bar[XB_XGEN(b.x)], 1u);
            asm volatile("s_waitcnt vmcnt(0)" ::: "memory");
        } else {
            XB_SPIN(xb_ld(&bar[XB_XGEN(b.x)]) == gen, bar);
            __builtin_amdgcn_fence(__ATOMIC_ACQUIRE, "agent");
            asm volatile("s_waitcnt vmcnt(0)" ::: "memory");
        }
    }
    __syncthreads();
}

__device__ __forceinline__ void p0_transpose_item(const float* W, const float* g, int K, int N, f16* WT, LAS float* scr, int item, int lane) {
    const int nblk = N / 32, kb = item / nblk, nb = item % nblk, k0 = 32 * kb, n0 = 32 * nb;
    float v[16];
#pragma unroll
    for (int i = 0; i < 16; ++i) { const int kk = 2 * i + (lane >> 5); v[i] = __builtin_nontemporal_load(W + (size_t)(k0 + kk) * N + n0 + (lane & 31)); }
    if (g) {
#pragma unroll
        for (int i = 0; i < 16; ++i) v[i] *= g[k0 + 2 * i + (lane >> 5)];
    }
#pragma unroll
    for (int i = 0; i < 16; ++i) scr[(2 * i + (lane >> 5)) * 33 + (lane & 31)] = v[i];
    LDS_WAIT(); asm volatile("" ::: "memory");
    const int c = lane & 3;
#pragma unroll
    for (int j = 0; j < 2; ++j) { const int n = (lane >> 2) + 16 * j; const LAS float* sp = scr + (8 * c) * 33 + n;
        u32x4 o; o.x = pkh(sp[0 * 33], sp[1 * 33]); o.y = pkh(sp[2 * 33], sp[3 * 33]); o.z = pkh(sp[4 * 33], sp[5 * 33]); o.w = pkh(sp[6 * 33], sp[7 * 33]);
        *(GAS u32x4*)(WT + (size_t)(n0 + n) * K + k0 + 8 * c) = o; }
    LDS_WAIT(); asm volatile("" ::: "memory");
}
__device__ __forceinline__ void x_rows4(const float* x, f16* xb, float* part, int m0, int stride, int lane) {
    f32x4 v[4][4];
#pragma unroll
    for (int r = 0; r < 4; ++r) { const GAS f32x4* xr = (const GAS f32x4*)(x + (size_t)(m0 + r * stride) * DM) + lane;
#pragma unroll
        for (int j = 0; j < 4; ++j) v[r][j] = __builtin_nontemporal_load(xr + 64 * j); }
#pragma unroll
    for (int r = 0; r < 4; ++r) {
        float s = 0.f;
#pragma unroll
        for (int j = 0; j < 4; ++j) s += (v[r][j][0] * v[r][j][0] + v[r][j][1] * v[r][j][1]) + (v[r][j][2] * v[r][j][2] + v[r][j][3] * v[r][j][3]);
        s = att::wave_sum(s);
        const size_t row = (size_t)(m0 + r * stride);
        GAS u32x2* o8 = (GAS u32x2*)(xb + row * DM) + lane;
#pragma unroll
        for (int j = 0; j < 4; ++j) { u32x2 w; w.x = pkh(v[r][j][0], v[r][j][1]); w.y = pkh(v[r][j][2], v[r][j][3]); o8[64 * j] = w; }
        if (lane < 16) part[row * 16 + lane] = (lane == 0) ? s : 0.f;
    }
}

__device__ __forceinline__ void x_row1(const float* x, f16* xb, float* part, int m, int lane) {
    const GAS f32x4* xr = (const GAS f32x4*)(x + (size_t)m * DM) + lane;
    f32x4 v[4]; float s = 0.f;
#pragma unroll
    for (int j = 0; j < 4; ++j) { v[j] = xr[64 * j]; s += (v[j][0] * v[j][0] + v[j][1] * v[j][1]) + (v[j][2] * v[j][2] + v[j][3] * v[j][3]); }
    s = att::wave_sum(s);
    GAS u32x2* o8 = (GAS u32x2*)(xb + (size_t)m * DM) + lane;
#pragma unroll
    for (int j = 0; j < 4; ++j) { u32x2 w; w.x = pkh(v[j][0], v[j][1]); w.y = pkh(v[j][2], v[j][3]); o8[64 * j] = w; }
    if (lane < 16) part[(size_t)m * 16 + lane] = (lane == 0) ? s : 0.f;
}

struct Args { const float* in[11]; float* out; unsigned char* ws; };
__global__ void __launch_bounds__(NWAVES * 64, 2) hybrid_fwd(Args args) {
    extern __shared__ __attribute__((aligned(16))) unsigned char lds_raw[];
    LAS unsigned char* lds = (LAS unsigned char*)lds_raw;
    volatile LAS unsigned* MISC = (volatile LAS unsigned*)(lds + MISC_OFF);
    const int tid = threadIdx.x, lane = tid & 63, wave = __builtin_amdgcn_readfirstlane(tid >> 6);
    const int G = gridDim.x; const int bx = blockIdx.x; const int vcu = (G % 8 == 0) ? (bx % 8) * (G / 8) + bx / 8 : bx;
    unsigned char* ws = args.ws;
    gu32* ctl = (gu32*)(ws + WS_CTL);
    const float* x = args.in[0]; const float* norm_g = args.in[1]; const float* w_in = args.in[2]; const float* w_out = args.in[3];
    const float* q_norm_g = args.in[4]; const float* k_norm_g = args.in[5];
    const float* lq1 = args.in[6]; const float* lk1 = args.in[7]; const float* lq2 = args.in[8]; const float* lk2 = args.in[9]; const float* subln_g = args.in[10];
    float* out = args.out;
    GAS unsigned char* wsg = (GAS unsigned char*)ws;
    GAS f16* WIN = (GAS f16*)(wsg + WS_WIN); GAS f16* WOUT = (GAS f16*)(wsg + WS_WOUT); GAS float* PART = (GAS float*)(wsg + WS_PART);
    GAS f16* XB = (GAS f16*)(wsg + WS_XB); GAS f16* MIX = (GAS f16*)(wsg + WS_MIX); GAS f16* PROJ = (GAS f16*)(wsg + WS_PROJ);

    unsigned long long sw_acc = 0;
    for (int u = tid; u < (LDS_BYTES - LDSCTL_OFF) / 4; u += NWAVES * 64) ((LAS unsigned*)(lds + LDSCTL_OFF))[u] = 0u;
    __syncthreads();
    XcdBarrier bar = xcd_barrier_post((unsigned*)(ctl + CW_BAR), MISC + 8);

    SW_BEGIN(6);
    for (int rep = 0; rep < REP_PRO; ++rep) {
        LAS float* scr = (LAS float*)(lds + RING_OFF + wave * 16384);
        const int gw = vcu * NWAVES + wave, NGW = G * NWAVES;
        constexpr int I_IN = (DM / 32) * (PW / 32), I_OUT = (DM / 32) * (DM / 32);
        constexpr int NITEMS = DEPTH * (I_IN + I_OUT);
        SW_BEGIN(9);
        for (int it = gw; it < NITEMS; it += NGW) {
            int r = it; const int l = r / (I_IN + I_OUT); r -= l * (I_IN + I_OUT);
            if (r < I_IN) p0_transpose_item(w_in + (size_t)l * DM * PW, norm_g + l * DM, DM, PW, (f16*)WIN + (size_t)l * PW * DM, scr, r, lane);
            else p0_transpose_item(w_out + (size_t)l * DM * DM, nullptr, DM, DM, (f16*)WOUT + (size_t)l * DM * DM, scr, r - I_IN, lane);
        }
        SW_END(9);
        SW_BEGIN(10);
        { int m = gw; for (; m + 3 * NGW < MROWS; m += 4 * NGW) x_rows4(x, (f16*)XB, (float*)PART, m, NGW, lane); for (; m < MROWS; m += NGW) x_row1(x, (f16*)XB, (float*)PART, m, lane); }
        SW_END(10);
    }
    SW_END(6);
    { SW_BEGIN(7); xcd_barrier(bar); SW_END(7); }

    for (int l = 0; l < DEPTH; ++l) {
        { GAS unsigned char* wsl = wsg; asm volatile("" : "+s"(wsl)); WIN = (GAS f16*)(wsl + WS_WIN); WOUT = (GAS f16*)(wsl + WS_WOUT); PART = (GAS float*)(wsl + WS_PART); XB = (GAS f16*)(wsl + WS_XB); MIX = (GAS f16*)(wsl + WS_MIX); PROJ = (GAS f16*)(wsl + WS_PROJ);
          asm volatile("" : "+s"(out)); asm volatile("" : "+s"(x)); asm volatile("" : "+s"(subln_g)); asm volatile("" : "+s"(q_norm_g)); asm volatile("" : "+s"(k_norm_g)); asm volatile("" : "+s"(bar.bar)); }
        for (int rep = 0; rep < REP_G1; ++rep) {
            pg8::Gemm g{(const f16*)XB, (const f16*)WIN + (size_t)l * PW * DM, MROWS, PW, DM}; pg8::StaticOrder S; S.init(MROWS, PW, G, bx);
            pg8::EpiProj E{PROJ, PART, (const GAS float*)q_norm_g + l * 64, (const GAS float*)k_norm_g + l * 64, lds + RING_BYTES};
            SW_BEGIN(5);
            pg8::gemm_phase<pg8::EpiProj>(lds + RING_OFF, g, S, E, sw_acc);
            SW_END(5);
        }
        { SW_BEGIN(7); xcd_barrier(bar); SW_END(7); }
        {
            const float sa = att::wave_sum(lq1[l * 64 + lane] * lk1[l * 64 + lane]), sb = att::wave_sum(lq2[l * 64 + lane] * lk2[l * 64 + lane]);
            const float lam_init = 0.8f - 0.6f * __expf(-0.3f * (float)l);
            const float lam = __expf(sa) - __expf(sb) + lam_init;
            const float mgq = att::wave_max(fabsf(q_norm_g[l * 64 + lane])), mgk = att::wave_max(fabsf(k_norm_g[l * 64 + lane]));
            const float mref = 8.0f * LOG2E * mgq * mgk * 1.001f - 10.0f;
            __syncthreads();
            for (int rep = 0; rep < REP_DA; ++rep) { SW_BEGIN(1); att::da_phase(lds + RING_OFF, PROJ, MIX, vcu, G, lam, mref, (const GAS float*)subln_g + l * 128, 1.0f - lam_init, sw_acc); SW_END(1); }
            for (int rep = 0; rep < REP_SB; ++rep) { SW_BEGIN(4); att::sb_phase(lds + RING_OFF, PROJ, MIX, vcu, G, sw_acc); SW_END(4); }
        }
        { SW_BEGIN(7); xcd_barrier(bar); SW_END(7); }
        {
            pg8::Gemm g{(const f16*)MIX, (const f16*)WOUT + (size_t)l * DM * DM, MROWS, DM, DM}; pg8::StaticOrder S; S.init(MROWS, DM, G, bx);
            pg8::EpiOut E{(GAS float*)out, XB, PART, (l + 1 < DEPTH) ? 0 : 1};
            SW_BEGIN(8);
            pg8::gemm_phase<pg8::EpiOut>(lds + RING_OFF, g, S, E, sw_acc);
            SW_END(8);
        }
        if (l + 1 < DEPTH) { SW_BEGIN(7); xcd_barrier(bar); SW_END(7); }
    }
#if SW_ID
    if (wave == 0) { const unsigned long long t0 = __builtin_amdgcn_s_memrealtime(), span = (unsigned long long)SW_K * sw_acc; while (__builtin_amdgcn_s_memrealtime() - t0 < span) __builtin_amdgcn_s_sleep(8); }
#endif
}

extern "C" void kernel_launch(void* const* d_in, const int* in_sizes, int n_in, void* d_out, int out_size, void* d_ws, size_t ws_size, hipStream_t stream) {
    static int grid = 0;
    if (grid == 0) {
        if (n_in != 11 || in_sizes[0] != MROWS * DM || out_size != MROWS * DM || ws_size < WS_END) {
            fprintf(stderr, "kernel_launch: unexpected problem shape (n_in %d, in0 %d, out %d, ws %zu); nothing launched\n", n_in, n_in > 0 ? in_sizes[0] : -1, out_size, ws_size); grid = -1; return; }
        int dev = 0, cus = 0, per_cu = 0;
        if (hipGetDevice(&dev) != hipSuccess || hipDeviceGetAttribute(&cus, hipDeviceAttributeMultiprocessorCount, dev) != hipSuccess) { grid = -1; return; }
        if (hipFuncSetAttribute((const void*)hybrid_fwd, hipFuncAttributeMaxDynamicSharedMemorySize, LDS_BYTES) != hipSuccess) { fprintf(stderr, "kernel_launch: hipFuncSetAttribute failed\n"); grid = -1; return; }
        if (hipOccupancyMaxActiveBlocksPerMultiprocessor(&per_cu, (const void*)hybrid_fwd, NWAVES * 64, LDS_BYTES) != hipSuccess || per_cu < 1) {
            fprintf(stderr, "kernel_launch: occupancy query reports %d workgroups per CU; nothing launched\n", per_cu); (void)hipGetLastError(); grid = -1; return; }
        grid = cus;
    }
    if (grid < 0) return;
    if (hipMemsetAsync((char*)d_ws + WS_CTL, 0, CTL_ZERO_BYTES, stream) != hipSuccess) { fprintf(stderr, "kernel_launch: hipMemsetAsync failed\n"); return; }
    Args a{};
    for (int i = 0; i < 11; ++i) a.in[i] = (const float*)d_in[i];
    a.out = (float*)d_out; a.ws = (unsigned char*)d_ws;
    hipLaunchKernelGGL(hybrid_fwd, dim3(grid), dim3(NWAVES * 64), LDS_BYTES, stream, a);
    const hipError_t le = hipPeekAtLastError();
    if (le != hipSuccess) fprintf(stderr, "kernel_launch: launch failed: %s\n", hipGetErrorName(le));
}
```

```cpp
#include <hip/hip_runtime.h>
#include <cstdio>
#include <cstdint>

#ifndef SB_EARLY_EXIT
#define SB_EARLY_EXIT 1
#endif
#define SW_ID 0
#define SW_K 4
#define REP_PRO 1
#define REP_G1 1
#define REP_DA 1
#define REP_SB 1
#define REP_G2 1

#if SW_ID
#define SW_BEGIN(id) unsigned long long sw_t0_##id = 0; if (SW_ID == (id)) sw_t0_##id = __builtin_amdgcn_s_memrealtime()
#define SW_END(id) do { if (SW_ID == (id)) sw_acc += __builtin_amdgcn_s_memrealtime() - sw_t0_##id; } while (0)
#else
#define SW_BEGIN(id) do {} while (0)
#define SW_END(id) do {} while (0)
#endif
#define LAS __attribute__((address_space(3)))
#define GAS __attribute__((address_space(1)))
typedef _Float16 f16;
typedef _Float16 h8 __attribute__((ext_vector_type(8)));
typedef _Float16 h4 __attribute__((ext_vector_type(4)));
typedef _Float16 h2 __attribute__((ext_vector_type(2)));
typedef float f32x4 __attribute__((ext_vector_type(4)));
typedef float f32x16 __attribute__((ext_vector_type(16)));
typedef unsigned u32x4 __attribute__((ext_vector_type(4)));
typedef unsigned u32x2 __attribute__((ext_vector_type(2)));

constexpr int BATCH = 16, SEQ = 2048, DM = 1024, MROWS = BATCH * SEQ, PW = 4096, DEPTH = 2;
constexpr float RMS_EPS = 1e-6f;
constexpr float LOG2E = 1.4426950408889634f;
constexpr float QS = 0.125f * LOG2E;
constexpr int C_SBQ = 0, C_SBK = 512, C_SBV = 1024, C_SBG = 1536, C_DAQ = 2048, C_DAK = 2560, C_DAV = 3072, C_DAG = 3584;
constexpr int KVW = 2048, K_SBK = 0, K_SBV = 512, K_DAK = 1024, K_DAV = 1536;
constexpr int S_SBQ = 0, S_SBG = 1, S_DAQ = 2, S_DAG = 3;
constexpr size_t QG_SEC = (size_t)MROWS * 512;
__host__ __device__ __forceinline__ size_t bl1024(size_t row, int col) { return ((row >> 5) * 128 + (size_t)(col >> 3)) * 256 + (row & 31) * 8 + (col & 7); }
__host__ __device__ __forceinline__ size_t bl512(size_t row, int col) { return ((row >> 5) * 64 + (size_t)(col >> 3)) * 256 + (row & 31) * 8 + (col & 7); }

__device__ __forceinline__ unsigned pkh(float lo, float hi) { h2 v = {(f16)lo, (f16)hi}; return __builtin_bit_cast(unsigned, v); }
__device__ __forceinline__ unsigned pkh_rtz(float lo, float hi) { return __builtin_bit_cast(unsigned, __builtin_amdgcn_cvt_pkrtz(lo, hi)); }
__device__ __forceinline__ float row4_sum(float s) {
    { const auto r = __builtin_amdgcn_permlane16_swap(__float_as_uint(s), __float_as_uint(s), false, false); s = __uint_as_float(r[0]) + __uint_as_float(r[1]); }
    { const auto r = __builtin_amdgcn_permlane32_swap(__float_as_uint(s), __float_as_uint(s), false, false); s = __uint_as_float(r[0]) + __uint_as_float(r[1]); }
    return s;
}
__device__ __forceinline__ float silu_f(float v) { return v * __builtin_amdgcn_rcpf(1.0f + __builtin_amdgcn_exp2f(-v * LOG2E)); }

namespace pg8 {
constexpr int BM = 256, BK = 64, HALF = 128, HTB = HALF * BK * 2, STAGE_BYTES = 8 * HTB, NXCD = 8, WGM = 8;
__host__ __device__ __forceinline__ int lds_byte(int r, int c) { const int st = (r >> 4) * 2 + (c >> 5), rr = r & 15, cc = c & 31, ob = rr * 64 + cc * 2; return st * 1024 + (ob ^ (((ob >> 9) & 1) << 5)); }
__host__ __device__ __forceinline__ void stage_rc(int b, int& R, int& C) { const int st = b / 1024, sb = b % 1024, swz = sb ^ (((sb >> 9) & 1) << 5); R = (st >> 1) * 16 + swz / 64; C = (st & 1) * 32 + (swz % 64) / 2; }
__host__ __device__ __forceinline__ int perm32(int rho) { const int n = rho >> 4, i = rho & 15; return 8 * (i >> 2) + 4 * n + (i & 3); }

struct Unit { int pm, pn; };
struct Gemm { const f16* A; const f16* Bt; int M, N, K; };

struct StaticOrder {
    int nM, nN, nwg, G, c;
    __host__ __device__ void init(int M, int N, int G_, int c_) { nM = M / BM; nN = N / BM; nwg = nM * nN; G = G_; c = c_; }
    __host__ __device__ bool next(int i, Unit& u) const {
        const long L = (long)i * G + c; if (L >= nwg) return false;
        int wgid = (int)L; { const int q = nwg / NXCD, r = nwg % NXCD, xcd = wgid % NXCD, off = wgid / NXCD; wgid = (xcd < r ? xcd * (q + 1) : r * (q + 1) + (xcd - r) * q) + off; }
        const int nig = WGM * nN, gid = wgid / nig, fm = gid * WGM, gsz = (nM - fm) < WGM ? (nM - fm) : WGM;
        u.pm = fm + ((wgid % nig) % gsz); u.pn = (wgid % nig) / gsz; return true;
    }
};


struct EpiProj {
    static constexpr bool A_BLOCKED = false;
    GAS f16* KV; GAS f16* QG; const GAS float* part; const GAS float* gq; const GAS float* gk; LAS unsigned char* rsc;
    struct Pre { f32x4 a[2][2]; int pm[2]; };
    __device__ __forceinline__ void pre_load(Pre& R, const StaticOrder& S) const {
        Unit u0, u4; R.pm[0] = S.next(0, u0) ? u0.pm : -1; R.pm[1] = (S.next(4, u4) && u4.pm != R.pm[0]) ? u4.pm : -1;
        const int t = threadIdx.x, row = t >> 1, half = t & 1;
#pragma unroll
        for (int k = 0; k < 2; ++k) { const GAS f32x4* p = (const GAS f32x4*)(part + ((size_t)(R.pm[k] < 0 ? 0 : R.pm[k]) * BM + row) * 16 + half * 8); R.a[k][0] = p[0]; R.a[k][1] = p[1]; }
    }
    __device__ __forceinline__ void pre_finish(const Pre& R) const {
        const int t = threadIdx.x, row = t >> 1, half = t & 1;
#pragma unroll
        for (int k = 0; k < 2; ++k) {
            float sum = ((R.a[k][0][0] + R.a[k][0][1]) + (R.a[k][0][2] + R.a[k][0][3])) + ((R.a[k][1][0] + R.a[k][1][1]) + (R.a[k][1][2] + R.a[k][1][3]));
            sum += __shfl_xor(sum, 1);
            if (half == 0) ((LAS float*)rsc)[k * 256 + row] = __builtin_amdgcn_rsqf(sum * (1.0f / DM) + RMS_EPS);
        }
        if (t == 0) ((LAS int*)(rsc + 2048))[0] = R.pm[0];
        if (t == 1) ((LAS int*)(rsc + 2048))[1] = R.pm[1];
    }
    __device__ __forceinline__ void operator()(const f32x4 (&acc)[2][2][4][2], const Unit& u, int wr, int wc, int fr, int fq) const {
        const int sec = u.pn >> 1;
        const int row0 = u.pm * BM + wr * 64 + fr;
        const int cs = (u.pn & 1) * BM + wc * 64 + 8 * fq;
        const bool isqg = (sec == 0) || (sec == 3) || (sec == 4) || (sec == 7);
        const int dsec = isqg ? ((sec == 0) ? S_SBQ : (sec == 3) ? S_SBG : (sec == 4) ? S_DAQ : S_DAG) : ((sec == 1) ? 0 : (sec == 2) ? 1 : (sec == 5) ? 2 : 3);
        const int bjstep = isqg ? 1024 : 32;
        f32x4 gain[2][2];
        if (sec == 4 || sec == 5) {
            const GAS float* g = (sec == 4) ? gq : gk;
#pragma unroll
            for (int bj = 0; bj < 2; ++bj)
#pragma unroll
                for (int n = 0; n < 2; ++n) gain[bj][n] = *(const GAS f32x4*)(g + 32 * bj + 8 * fq + 4 * n);
        }
        const LAS int* tags = (const LAS int*)(rsc + 2048);
        const int slot = (tags[0] == u.pm) ? 0 : (tags[1] == u.pm) ? 1 : -1;
        const LAS float* rtab = (const LAS float*)rsc + (slot > 0 ? 256 : 0) + wr * 64 + fr;
#pragma unroll
        for (int ai = 0; ai < 2; ++ai)
#pragma unroll
            for (int m = 0; m < 4; ++m) {
                const int row = row0 + ai * HALF + m * 16;
                float rs;
                if (slot >= 0) rs = rtab[ai * HALF + m * 16];
                else {
                    const f32x4 pv = *(const GAS f32x4*)(part + (size_t)row * 16 + fq * 4);
                    float s = (pv[0] + pv[1]) + (pv[2] + pv[3]);
                    s = row4_sum(s);
                    rs = __builtin_amdgcn_rsqf(s * (1.0f / DM) + RMS_EPS);
                }
                f32x4 v[2][2];
#pragma unroll
                for (int bj = 0; bj < 2; ++bj)
#pragma unroll
                    for (int n = 0; n < 2; ++n) v[bj][n] = acc[ai][bj][m][n] * rs;
                if (sec == 4 || sec == 5) {
                    float ss = 0.f;
#pragma unroll
                    for (int bj = 0; bj < 2; ++bj)
#pragma unroll
                        for (int n = 0; n < 2; ++n) { const f32x4 x = v[bj][n]; ss += (x[0] * x[0] + x[1] * x[1]) + (x[2] * x[2] + x[3] * x[3]); }
                    ss = row4_sum(ss);
                    float rn = __builtin_amdgcn_rsqf(ss * (1.0f / 64.0f) + RMS_EPS);
                    if (sec == 4) rn *= QS;
#pragma unroll
                    for (int bj = 0; bj < 2; ++bj)
#pragma unroll
                        for (int n = 0; n < 2; ++n) v[bj][n] = v[bj][n] * rn * gain[bj][n];
                } else if (sec == 0) {
#pragma unroll
                    for (int bj = 0; bj < 2; ++bj)
#pragma unroll
                        for (int n = 0; n < 2; ++n) v[bj][n] = v[bj][n] * QS;
                } else if (sec == 3 || sec == 7) {
#pragma unroll
                    for (int bj = 0; bj < 2; ++bj)
#pragma unroll
                        for (int n = 0; n < 2; ++n)
#pragma unroll
                            for (int e = 0; e < 4; ++e) v[bj][n][e] = silu_f(v[bj][n][e]);
                }
                GAS f16* rowp = isqg ? QG + (size_t)dsec * QG_SEC + bl512((size_t)row, cs) : KV + (size_t)row * KVW + dsec * 512 + cs;
#pragma unroll
                for (int bj = 0; bj < 2; ++bj) {
                    u32x4 w; w.x = pkh(v[bj][0][0], v[bj][0][1]); w.y = pkh(v[bj][0][2], v[bj][0][3]); w.z = pkh(v[bj][1][0], v[bj][1][1]); w.w = pkh(v[bj][1][2], v[bj][1][3]);
                    *(GAS u32x4*)(rowp + bjstep * bj) = w;
                }
            }
    }
};

struct EpiOut {
    static constexpr bool A_BLOCKED = true;
    GAS float* out; GAS f16* xb; GAS float* part; int last;
    struct Pre {};
    __device__ __forceinline__ void pre_load(Pre&, const StaticOrder&) const {}
    __device__ __forceinline__ void pre_finish(const Pre&) const {}
    __device__ __forceinline__ void operator()(const f32x4 (&acc)[2][2][4][2], const Unit& u, int wr, int wc, int fr, int fq) const {
        const int row0 = u.pm * BM + wr * 64 + fr;
        const int colw = u.pn * BM + wc * 64 + 8 * fq;
#pragma unroll
        for (int ai = 0; ai < 2; ++ai) {
            h8 bs[4][2];
#pragma unroll
            for (int m = 0; m < 4; ++m)
#pragma unroll
                for (int bj = 0; bj < 2; ++bj) bs[m][bj] = *(const GAS h8*)(xb + (size_t)(row0 + ai * HALF + m * 16) * DM + colw + 32 * bj);
#pragma unroll
            for (int m = 0; m < 4; ++m) {
                const int row = row0 + ai * HALF + m * 16;
                const size_t off = (size_t)row * DM + colw;
                float ss = 0.f;
#pragma unroll
                for (int bj = 0; bj < 2; ++bj) {
                    const h8 b = bs[m][bj];
                    f32x4 o0 = acc[ai][bj][m][0], o1 = acc[ai][bj][m][1];
                    o0[0] += (float)b[0]; o0[1] += (float)b[1]; o0[2] += (float)b[2]; o0[3] += (float)b[3];
                    o1[0] += (float)b[4]; o1[1] += (float)b[5]; o1[2] += (float)b[6]; o1[3] += (float)b[7];
                    if (last) { *(GAS f32x4*)(out + off + 32 * bj) = o0; *(GAS f32x4*)(out + off + 32 * bj + 4) = o1; }
                    else {
                        ss += (o0[0] * o0[0] + o0[1] * o0[1]) + (o0[2] * o0[2] + o0[3] * o0[3]) + (o1[0] * o1[0] + o1[1] * o1[1]) + (o1[2] * o1[2] + o1[3] * o1[3]);
                        u32x4 w; w.x = pkh(o0[0], o0[1]); w.y = pkh(o0[2], o0[3]); w.z = pkh(o1[0], o1[1]); w.w = pkh(o1[2], o1[3]);
                        *(GAS u32x4*)(xb + off + 32 * bj) = w;
                    }
                }
                if (!last) {
                    ss = row4_sum(ss);
                    if (fq == 0) part[(size_t)row * 16 + u.pn * 4 + wc] = ss;
                }
            }
        }
    }
};

template <class Epi>
__device__ __forceinline__ void gemm_phase(LAS unsigned char* lds, const Gemm g, const StaticOrder& S, const Epi& E, unsigned long long& sw_acc) {
    int tid_ = threadIdx.x; asm volatile("" : "+v"(tid_));
    const int tid = tid_, wid = __builtin_amdgcn_readfirstlane(tid >> 6), lane = tid & 63, wr = wid >> 2, wc = wid & 3, fr = lane & 15, fq = lane >> 4;
    const int K = g.K, nt = K / BK;
    unsigned voffA[2], voffB[2];
#pragma unroll
    for (int i = 0; i < 2; ++i) { int R, C; stage_rc(tid * 16 + i * 8192, R, C);
        const int Rb = (R >> 5) * 64 + perm32(R & 31);
        voffA[i] = Epi::A_BLOCKED ? (unsigned)(((R >> 5) * (K >> 3) + (C >> 3)) * 256 + (R & 31) * 8) * 2u : (unsigned)(R * K + C) * 2u; voffB[i] = (unsigned)(Rb * K + C) * 2u; }
    const size_t kstep = (size_t)(BK * 2);
    const size_t kstepA = Epi::A_BLOCKED ? (size_t)(BK / 8) * 512 : kstep;
    const size_t hstep = (size_t)HALF * K * 2;
    const size_t hstepB = (size_t)32 * K * 2;
    const size_t tstep = 2 * hstep;
    const unsigned ldsw = (unsigned)wid * 1024u;
    const int aoff = lds_byte(wr * 64 + fr, fq * 8), boff = lds_byte(wc * 32 + fr, fq * 8);
#define PG8_SA(b, h) (((b) * 2 + (h)) * HTB)
#define PG8_SB(b, h) ((4 + (b) * 2 + (h)) * HTB)
#define PG8_STAGE(bufoff, gbase, voff) do { _Pragma("unroll") for (int _i = 0; _i < 2; ++_i) \
        __builtin_amdgcn_global_load_lds((const unsigned*)((const char*)(gbase) + (voff)[_i]), (LAS unsigned*)(lds + (bufoff) + ldsw + _i * 8192), 16, 0, 0); } while (0)
#define PG8_LDA(dst, b, h) do { _Pragma("unroll") for (int m = 0; m < 4; ++m) _Pragma("unroll") for (int k = 0; k < 2; ++k) dst[m][k] = *(const LAS h8*)(lds + PG8_SA(b, h) + aoff + m * 2048 + k * 1024); } while (0)
#define PG8_LDB(dst, b, h) do { _Pragma("unroll") for (int n = 0; n < 2; ++n) _Pragma("unroll") for (int k = 0; k < 2; ++k) dst[n][k] = *(const LAS h8*)(lds + PG8_SB(b, h) + boff + n * 2048 + k * 1024); } while (0)
#define PG8_MMA(ai, bj, At, Bt) do { __builtin_amdgcn_s_setprio(1); _Pragma("unroll") for (int m = 0; m < 4; ++m) _Pragma("unroll") for (int n = 0; n < 2; ++n) _Pragma("unroll") for (int k = 0; k < 2; ++k) \
        acc[ai][bj][m][n] = __builtin_amdgcn_mfma_f32_16x16x32_f16(Bt[n][k], At[m][k], acc[ai][bj][m][n], 0, 0, 0); __builtin_amdgcn_s_setprio(0); } while (0)
#define PG8_WAIT_V(n) asm volatile("s_waitcnt vmcnt(" #n ")" ::: "memory")
#define PG8_WAIT_L(n) asm volatile("s_waitcnt lgkmcnt(" #n ")" ::: "memory")
#define PG8_BAR __builtin_amdgcn_s_barrier()
#define PG8_SCHED __builtin_amdgcn_sched_barrier(0)
    Unit cur, nxt; int ui = 0;
    if (!S.next(0, cur)) return;
    f32x4 acc[2][2][4][2];
#pragma unroll
    for (int a = 0; a < 2; ++a)
#pragma unroll
        for (int b = 0; b < 2; ++b)
#pragma unroll
            for (int m = 0; m < 4; ++m)
#pragma unroll
                for (int n = 0; n < 2; ++n) acc[a][b][m][n] = (f32x4){0.f, 0.f, 0.f, 0.f};
    h8 At[4][2], B0[2][2], B1[2][2];
    const char* cA = (const char*)g.A + (size_t)cur.pm * tstep; const char* cB = (const char*)g.Bt + (size_t)cur.pn * tstep;
    PG8_STAGE(PG8_SB(0, 0), cB, voffB); PG8_STAGE(PG8_SB(0, 1), cB + hstepB, voffB); PG8_STAGE(PG8_SA(0, 0), cA, voffA); PG8_STAGE(PG8_SA(0, 1), cA + hstep, voffA);
    typename Epi::Pre pre; E.pre_load(pre, S);
    if (wr == 1) PG8_BAR;
    PG8_WAIT_V(2); PG8_BAR;
    E.pre_finish(pre);
    PG8_WAIT_L(0);
    PG8_STAGE(PG8_SB(1, 0), cB + kstep, voffB); PG8_STAGE(PG8_SA(1, 0), cA + kstepA, voffA); PG8_STAGE(PG8_SB(1, 1), cB + hstepB + kstep, voffB);
    PG8_WAIT_V(6); PG8_BAR;
    for (;;) {
        const bool has_next = S.next(ui + 1, nxt);
        const char* nA = has_next ? (const char*)g.A + (size_t)nxt.pm * tstep : cA; const char* nB = has_next ? (const char*)g.Bt + (size_t)nxt.pn * tstep : cB;
        for (int t = 0; t < nt; t += 2) {
            const bool last = (t == nt - 2);
            const char* a1 = cA + (size_t)(t + 1) * kstepA;
            const char* a2 = last ? nA : cA + (size_t)(t + 2) * kstepA; const char* b2 = last ? nB : cB + (size_t)(t + 2) * kstep;
            const char* a3 = a2 + kstepA; const char* b3 = b2 + kstep;
            PG8_LDB(B0, 0, 0); PG8_LDB(B1, 0, 1); PG8_SCHED; PG8_LDA(At, 0, 0); PG8_STAGE(PG8_SA(1, 1), a1 + hstep, voffA);
            PG8_WAIT_V(8); PG8_WAIT_L(0); PG8_BAR; PG8_MMA(0, 0, At, B0); PG8_MMA(0, 1, At, B1); PG8_BAR; PG8_SCHED;
            PG8_LDA(At, 0, 1); PG8_STAGE(PG8_SB(0, 0), b2, voffB); PG8_STAGE(PG8_SB(0, 1), b2 + hstepB, voffB); PG8_STAGE(PG8_SA(0, 0), a2, voffA);
            PG8_WAIT_V(8); PG8_WAIT_L(0); PG8_BAR; PG8_MMA(1, 0, At, B0); PG8_MMA(1, 1, At, B1); PG8_BAR; PG8_SCHED;
            PG8_LDB(B0, 1, 0); PG8_LDB(B1, 1, 1); PG8_SCHED; PG8_LDA(At, 1, 0); PG8_STAGE(PG8_SA(0, 1), a2 + hstep, voffA);
            PG8_WAIT_V(8); PG8_WAIT_L(0); PG8_BAR; PG8_MMA(0, 0, At, B0); PG8_MMA(0, 1, At, B1); PG8_BAR; PG8_SCHED;
            PG8_LDA(At, 1, 1); PG8_STAGE(PG8_SB(1, 0), b3, voffB); PG8_STAGE(PG8_SB(1, 1), b3 + hstepB, voffB); PG8_STAGE(PG8_SA(1, 0), a3, voffA);
            PG8_WAIT_V(8); PG8_WAIT_L(0); PG8_BAR; PG8_MMA(1, 0, At, B0); PG8_MMA(1, 1, At, B1); PG8_BAR; PG8_SCHED;
        }
        if (wr == 0) PG8_BAR;
        { SW_BEGIN(20); E(acc, cur, wr, wc, fr, fq); SW_END(20); }
        if (!has_next) break;
#pragma unroll
        for (int a = 0; a < 2; ++a)
#pragma unroll
            for (int b = 0; b < 2; ++b)
#pragma unroll
                for (int m = 0; m < 4; ++m)
#pragma unroll
                    for (int n = 0; n < 2; ++n) acc[a][b][m][n] = (f32x4){0.f, 0.f, 0.f, 0.f};
        cur = nxt; cA = nA; cB = nB; ++ui;
        if (wr == 1) PG8_BAR;
    }
    PG8_WAIT_V(0);
    PG8_BAR;
#undef PG8_SA
#undef PG8_SB
#undef PG8_STAGE
#undef PG8_LDA
#undef PG8_LDB
#undef PG8_MMA
#undef PG8_WAIT_V
#undef PG8_WAIT_L
#undef PG8_BAR
#undef PG8_SCHED
}
}

namespace att {
typedef short v4i16_t __attribute__((ext_vector_type(4)));
__device__ __forceinline__ int crow(int r, int hi) { return (r & 3) + 8 * (r >> 2) + 4 * hi; }
__device__ __forceinline__ int keyrow(int i) { return 32 * ((i >> 2) & 1) + (i & 3) + 4 * (i >> 3); }
__device__ __forceinline__ h4 vtr(const LAS unsigned char* p) { return __builtin_bit_cast(h4, __builtin_amdgcn_ds_read_tr16_b64_v4i16((LAS v4i16_t*)p)); }
__device__ __forceinline__ h8 cat8(h4 a, h4 b) { return (h8){a[0], a[1], a[2], a[3], b[0], b[1], b[2], b[3]}; }
#define MFMA32(a, b, c) __builtin_amdgcn_mfma_f32_32x32x16_f16(a, b, c, 0, 0, 0)
__device__ __forceinline__ h8 pack8(const f32x16& p, int b) {
    u32x4 w; w.x = pkh_rtz(p[b], p[b + 1]); w.y = pkh_rtz(p[b + 2], p[b + 3]); w.z = pkh_rtz(p[b + 4], p[b + 5]); w.w = pkh_rtz(p[b + 6], p[b + 7]);
    return __builtin_bit_cast(h8, w);
}
template <int KI> __device__ __forceinline__ float fmamk_s(float c, float base) {
    float r; asm volatile("v_fmamk_f32 %0, %1, %2, %3" : "=v"(r) : "v"(c), "i"(__builtin_bit_cast(int, (float)KI)), "v"(base)); return r; }
__device__ __forceinline__ void ld_groups_raw(const GAS f16* rowp  , int hi, u32x4 (&L)[4]) {
#pragma unroll
    for (int k = 0; k < 4; ++k) L[k] = *(const GAS u32x4*)(rowp + 16 * k + 8 * hi);
}
__device__ __forceinline__ void ld_groups_raw_bl(const GAS f16* p  , int hi, u32x4 (&L)[4]) {
#pragma unroll
    for (int k = 0; k < 4; ++k) L[k] = *(const GAS u32x4*)(p + (2 * k + hi) * 256);
}
__device__ __forceinline__ void unpack_groups(const u32x4 (&L)[4], u32x2 (&g)[8]) {
#pragma unroll
    for (int k = 0; k < 4; ++k) {
        const auto rx = __builtin_amdgcn_permlane32_swap(L[k].x, L[k].z, false, false), ry = __builtin_amdgcn_permlane32_swap(L[k].y, L[k].w, false, false);
        g[2 * k].x = rx[0]; g[2 * k].y = ry[0]; g[2 * k + 1].x = rx[1]; g[2 * k + 1].y = ry[1];
    }
}
__device__ __forceinline__ void st_groups2(GAS f16* rowp, int hi, int k, u32x2 a  , u32x2 b  ) {
    const auto rx = __builtin_amdgcn_permlane32_swap(a.x, b.x, false, false), ry = __builtin_amdgcn_permlane32_swap(a.y, b.y, false, false);
    u32x4 w; w.x = rx[0]; w.y = ry[0]; w.z = rx[1]; w.w = ry[1];
    *(GAS u32x4*)(rowp + 16 * k + 8 * hi) = w;
}
__device__ __forceinline__ void st_groups2_bl(GAS f16* p  , int hi, int k, u32x2 a, u32x2 b) {
    const auto rx = __builtin_amdgcn_permlane32_swap(a.x, b.x, false, false), ry = __builtin_amdgcn_permlane32_swap(a.y, b.y, false, false);
    u32x4 w; w.x = rx[0]; w.y = ry[0]; w.z = rx[1]; w.w = ry[1];
    *(GAS u32x4*)(p + (2 * k + hi) * 256) = w;
}
__device__ __forceinline__ float wave_sum(float v) {
#pragma unroll
    for (int o = 1; o < 64; o <<= 1) v += __shfl_xor(v, o);
    return v;
}
__device__ __forceinline__ float wave_max(float v) {
#pragma unroll
    for (int o = 1; o < 64; o <<= 1) v = fmaxf(v, __shfl_xor(v, o));
    return v;
}

__device__ __forceinline__ void glds16(const GAS void* g, unsigned lds_base) {
    unsigned sv; asm volatile("s_mov_b32 %0, m0\n\ts_mov_b32 m0, %2\n\ts_nop 0\n\tglobal_load_lds_dwordx4 %1, off\n\ts_mov_b32 m0, %0" : "=&s"(sv) : "v"(g), "s"(lds_base) : "memory"); }
#define WAIT_BAR(N) asm volatile("s_waitcnt vmcnt(" #N ") lgkmcnt(0)\n\ts_barrier" ::: "memory")
__device__ __forceinline__ void wait_bar_n(int n) {
    switch (n) { case 0: WAIT_BAR(0); break; case 2: WAIT_BAR(2); break; case 4: WAIT_BAR(4); break; case 6: WAIT_BAR(6); break; case 8: WAIT_BAR(8); break; case 10: WAIT_BAR(10); break;
                 case 12: WAIT_BAR(12); break; case 14: WAIT_BAR(14); break; case 16: WAIT_BAR(16); break; case 18: WAIT_BAR(18); break; case 20: WAIT_BAR(20); break; default: WAIT_BAR(0); break; }
}

constexpr int SB_SLOT = 65536, SB_FLG = 147456 + 2048;
__device__ __forceinline__ int keyrow16(int i) { return 16 * ((i >> 2) & 1) + (i & 3) + 4 * (i >> 3); }
struct SbUnit { int b, hg, cq; };
__device__ __forceinline__ bool sb_decode(int u, SbUnit& U) {
    if (u >= 1024) return false;
    const int r = u >> 8, v = u & 255, i = v & 15;
    U.b = v >> 4; U.hg = i & 1; U.cq = (i >> 1) + 8 * r; return true;
}
__device__ __forceinline__ void sb_phase(LAS unsigned char* lds, const GAS f16* __restrict__ kv, const GAS f16* __restrict__ qg, GAS f16* __restrict__ mixed, int vcu, int G, unsigned long long& sw_acc) {
    int tid_ = threadIdx.x; asm volatile("" : "+v"(tid_));
    const int tid = tid_, lane = tid & 63, l31 = lane & 31, hi = lane >> 5; const int w = __builtin_amdgcn_readfirstlane(tid >> 6);
    const int hh = w & 3, rgp = w >> 2;
    const unsigned lds0 = (unsigned)(uintptr_t)lds;
    const unsigned kdst = lds0 + w * 4096, vdst = lds0 + 32768 + w * 4096;
    int kfo[4];
    { const int kr = keyrow16(l31);
#pragma unroll
      for (int d0 = 0; d0 < 4; ++d0) kfo[d0] = kr * 512 + (((hh * 8 + 2 * d0 + hi) ^ (kr & 15)) * 16); }
    int vfo[2];
    { const int q_ = (lane & 15) >> 2;
#pragma unroll
      for (int d0 = 0; d0 < 2; ++d0) vfo[d0] = 32768 + (16 * hi + q_) * 512 + (((hh * 2 + d0) ^ q_) * 64) + ((lane >> 4) & 1) * 32 + (lane & 3) * 8; }
    LAS unsigned* flags = (LAS unsigned*)(lds + SB_FLG);
    size_t koff[4], voff[4];
#pragma unroll
    for (int i = 0; i < 4; ++i) { const int row = 8 * w + 2 * i + (lane >> 5), p = lane & 31;
        koff[i] = (size_t)row * KVW + K_SBK + ((p ^ (row & 15)) * 8);
        voff[i] = (size_t)row * KVW + K_SBV + ((((p >> 2) ^ (row & 3)) * 4 + (p & 3)) * 8); }
#define SB_DMA(base_, kt_, slot) do { const GAS f16* b_ = (base_) + (size_t)(kt_) * 64 * KVW; const unsigned kd_ = (unsigned)__builtin_amdgcn_readfirstlane(kdst + (slot)), vd_ = (unsigned)__builtin_amdgcn_readfirstlane(vdst + (slot)); \
        _Pragma("unroll") for (int i_ = 0; i_ < 4; ++i_) { glds16(b_ + koff[i_], kd_ + i_ * 1024); glds16(b_ + voff[i_], vd_ + i_ * 1024); } } while (0)
    SbUnit U, Un; int ui = vcu;
    if (!sb_decode(ui, U)) return;
    int islot = 0, cslot = 0;
    const GAS f16* tbase = kv + ((size_t)U.b * SEQ) * KVW + U.hg * 256;
    h8 qn[4]; u32x4 gn[4];
    { const size_t grow = (size_t)U.b * SEQ + U.cq * 64 + 32 * rgp + l31; const int h = 4 * U.hg + hh;
      const GAS f16* Qg = qg + S_SBQ * QG_SEC + bl512(grow, h * 64 + 8 * hi); const GAS f16* Gp = qg + S_SBG * QG_SEC + bl512(grow, h * 64);
#pragma unroll
      for (int d0 = 0; d0 < 4; ++d0) qn[d0] = *(const GAS h8*)(Qg + 512 * d0);
      ld_groups_raw_bl(Gp, hi, gn); }
    asm volatile("" : "+v"(qn[0]), "+v"(qn[1]), "+v"(qn[2]), "+v"(qn[3]));
    SB_DMA(tbase, U.cq, islot); islot ^= SB_SLOT;
    for (;;) {
        const size_t rowbase = (size_t)U.b * SEQ;
        const int qw = U.cq * 64 + 32 * rgp, t = qw + l31, NT = U.cq + 1, h = 4 * U.hg + hh;
        const size_t grow = rowbase + qw + l31;
        h8 qr[4]; u32x4 gr[4];
#pragma unroll
        for (int d0 = 0; d0 < 4; ++d0) qr[d0] = qn[d0];
#pragma unroll
        for (int i = 0; i < 4; ++i) gr[i] = gn[i];
        const bool has_next = sb_decode(ui + G, Un);
        f32x16 o[2]; o[0] = f32x16{}; o[1] = f32x16{};
        float carry = 1.f; int done = 0;
        SW_BEGIN(12);
        for (int j = 0; j < NT; ++j) {
            SW_BEGIN(13);
            WAIT_BAR(0);
            SW_END(13);
            if (j > 0) {
                const u32x4 f0 = *(const LAS u32x4*)(flags + ((j - 1) & 1) * 8), f1 = *(const LAS u32x4*)(flags + ((j - 1) & 1) * 8 + 4);
                const unsigned any = (f0.x | f0.y | f0.z | f0.w) | (f1.x | f1.y | f1.z | f1.w);
                if (!__builtin_amdgcn_readfirstlane(any)) break;
            }
            if (j + 1 < NT) { SB_DMA(tbase, U.cq - (j + 1), islot); islot ^= SB_SLOT; }
            const int kt = U.cq - j;
#pragma unroll
            for (int sub = 0; sub < 2; ++sub) {
                const int kb32 = sub == 0 ? 32 : 0;
                const bool diag = (j == 0) && (sub == (rgp == 1 ? 0 : 1));
                const bool skip = (j == 0) && (rgp == 0) && (sub == 0);
                if (!done && !skip) {
                    const LAS unsigned char* Sb = lds + cslot + kb32 * 512;
                    f32x16 p = f32x16{};
#pragma unroll
                    for (int d0 = 0; d0 < 4; ++d0) { const h8 k0 = *(const LAS h8*)(Sb + kfo[d0]); p = MFMA32(k0, qr[d0], p); }
#pragma unroll
                    for (int r = 0; r < 16; ++r) p[r] = __builtin_amdgcn_rcpf(1.0f + __builtin_amdgcn_exp2f(-p[r]));
                    if (diag) {
                        const int key0 = 64 * kt + kb32 + 16 * hi;
#pragma unroll
                        for (int r = 0; r < 16; ++r) if (key0 + r >= t) p[r] = 0.f;
                    }
                    float run = 1.f;
#pragma unroll
                    for (int r = 15; r >= 0; --r) { const float a = run * p[r]; run -= a; p[r] = a; }
                    const auto rr = __builtin_amdgcn_permlane32_swap(__float_as_uint(run), __float_as_uint(run), false, false);
                    const float T0 = __uint_as_float(rr[0]), T1 = __uint_as_float(rr[1]);
                    const float E = carry * (hi ? 1.0f : T1);
                    carry = carry * (T0 * T1);
#pragma unroll
                    for (int r = 0; r < 16; ++r) p[r] *= E;
                    const h8 pa0 = pack8(p, 0), pa1 = pack8(p, 8);
#pragma unroll
                    for (int d0 = 0; d0 < 2; ++d0) {
                        const LAS unsigned char* Vb = Sb + vfo[d0];
                        const h8 v0 = cat8(vtr(Vb), vtr(Vb + 2048));
                        const h8 v1 = cat8(vtr(Vb + 4096), vtr(Vb + 6144));
                        o[d0] = MFMA32(v0, pa0, o[d0]); o[d0] = MFMA32(v1, pa1, o[d0]);
                    }
#if SB_EARLY_EXIT
                    done = __builtin_amdgcn_readfirstlane(__all(carry < 1.0e-37f) ? 1 : 0);
#endif
                }
            }
            if (lane == 0) flags[(j & 1) * 8 + w] = done ? 0u : 1u;
            cslot ^= SB_SLOT;
        }
        asm volatile("s_nop 15\n\ts_nop 7" : "+v"(o[0]), "+v"(o[1]));
        SW_END(12);
        cslot = islot;
        if (has_next) {
            const size_t grown = (size_t)Un.b * SEQ + Un.cq * 64 + 32 * rgp + l31; const int hn = 4 * Un.hg + hh;
            const GAS f16* Qg = qg + S_SBQ * QG_SEC + bl512(grown, hn * 64 + 8 * hi); const GAS f16* Gp = qg + S_SBG * QG_SEC + bl512(grown, hn * 64);
#pragma unroll
            for (int d0 = 0; d0 < 4; ++d0) qn[d0] = *(const GAS h8*)(Qg + 512 * d0);
            ld_groups_raw_bl(Gp, hi, gn);
            asm volatile("" ::: "memory");
            tbase = kv + ((size_t)Un.b * SEQ) * KVW + Un.hg * 256;
            SB_DMA(tbase, Un.cq, islot); islot ^= SB_SLOT;
        }
        {
            GAS f16* Op = mixed + bl1024(grow, h * 64);
            u32x2 gv[8]; unpack_groups(gr, gv);
#pragma unroll
            for (int d0 = 0; d0 < 2; ++d0)
#pragma unroll
                for (int pr = 0; pr < 2; ++pr) {
                    u32x2 wv[2];
#pragma unroll
                    for (int e = 0; e < 2; ++e) { const int rg4 = 2 * pr + e; const h4 g = __builtin_bit_cast(h4, gv[d0 * 4 + rg4]);
                        wv[e].x = pkh(o[d0][4 * rg4] * (float)g[0], o[d0][4 * rg4 + 1] * (float)g[1]); wv[e].y = pkh(o[d0][4 * rg4 + 2] * (float)g[2], o[d0][4 * rg4 + 3] * (float)g[3]); }
                    st_groups2_bl(Op, hi, 2 * d0 + pr, wv[0], wv[1]);
                }
        }
        if (!has_next) break;
        U = Un; ui += G;
    }
#undef SB_DMA
    WAIT_BAR(0);
}

constexpr int DA_KS = 16384, DA_VRING = 49152, DA_XCH = 114688, DA_SUBG = 147456 + 1024, DA_SSX = 147456 + 3072;
struct DaUnit { int b, h, qt, klo; };
__device__ __forceinline__ int da_qt_of(int r, int i) {
    constexpr unsigned long long Q1 = 0xD69701EF58CA42B3ull, Q2 = 0xA185D6F4B972EC30ull, Q3 = 0x3E795A0B468D12CFull;
    return r == 0 ? i : (int)(((r == 1 ? Q1 : r == 2 ? Q2 : Q3) >> (4 * i)) & 15ull);
}
__device__ __forceinline__ int da_klo(int qt, int h) {
    const float cs = exp2f(-2.0f * (float)(h + 1)) * LOG2E;
    const int D = (int)ceilf(35.5f / cs), m = qt * 128 - D - 63;
    return m > 0 ? (m + 63) >> 6 : 0;
}
__device__ __forceinline__ bool da_decode(int u, DaUnit& U) {
    if (u >= 1024) return false;
    const int r = u >> 8, v = u & 255;
    U.b = v >> 4; U.h = r; U.qt = da_qt_of(r, v & 15); U.klo = da_klo(U.qt, U.h); return true;
}
__device__ __forceinline__ void da_pv(f32x16 (&o)[4], const LAS unsigned char* Vs, const int (&vfo)[4], h8 pa0, h8 pa1, h8 pa2, h8 pa3) {
    h8 f0, f1, f2, f3, g0, g1, g2, g3;
    { const LAS unsigned char* Vb = Vs + vfo[0]; f0 = cat8(vtr(Vb), vtr(Vb + 1024)); f1 = cat8(vtr(Vb + 2048), vtr(Vb + 3072)); f2 = cat8(vtr(Vb + 4096), vtr(Vb + 5120)); f3 = cat8(vtr(Vb + 6144), vtr(Vb + 7168)); }
#pragma unroll
    for (int d0 = 0; d0 < 4; ++d0) {
        if (d0 < 3) { const LAS unsigned char* Vb = Vs + vfo[d0 + 1]; g0 = cat8(vtr(Vb), vtr(Vb + 1024)); g1 = cat8(vtr(Vb + 2048), vtr(Vb + 3072)); g2 = cat8(vtr(Vb + 4096), vtr(Vb + 5120)); g3 = cat8(vtr(Vb + 6144), vtr(Vb + 7168)); }
        o[d0] = MFMA32(f0, pa0, o[d0]); o[d0] = MFMA32(f1, pa1, o[d0]); o[d0] = MFMA32(f2, pa2, o[d0]); o[d0] = MFMA32(f3, pa3, o[d0]);
        if (d0 < 3) { f0 = g0; f1 = g1; f2 = g2; f3 = g3; }
    }
}
__device__ __forceinline__ void da_phase(LAS unsigned char* lds, const GAS f16* __restrict__ kv, const GAS f16* __restrict__ qg, GAS f16* __restrict__ mixed, int vcu, int G,
                                         float lam, float mref, const GAS float* __restrict__ subg, float osc, unsigned long long& sw_acc) {
    int tid_ = threadIdx.x; asm volatile("" : "+v"(tid_));
    const int tid = tid_, lane = tid & 63, l31 = lane & 31, hi = lane >> 5; const int w = __builtin_amdgcn_readfirstlane(tid >> 6);
    const int c = w >> 2, rg = w & 3;
    const unsigned lds0 = (unsigned)(uintptr_t)lds;
    const unsigned kdst = lds0 + w * 1024, vdst = lds0 + DA_VRING + w * 1024;
    int kfo[4];
    { const int kr = keyrow(l31);
#pragma unroll
      for (int d0 = 0; d0 < 4; ++d0) kfo[d0] = kr * 256 + (((8 * c + 2 * d0 + hi) ^ (kr & 15)) * 16); }
    int vfo[4];
    { const int q_ = (lane & 15) >> 2;
#pragma unroll
      for (int d0 = 0; d0 < 4; ++d0) vfo[d0] = DA_VRING + (32 * hi + q_) * 256 + ((d0 ^ q_) * 64) + ((lane >> 4) & 1) * 32 + (lane & 3) * 8; }
    const int srow = 4 * w + (lane >> 4);
    const size_t koff = (size_t)srow * KVW + K_DAK + (((lane & 15) ^ (srow & 15)) * 8);
    const size_t voff = (size_t)srow * KVW + K_DAV + (((((lane & 15) >> 2) ^ (srow & 3)) * 4 + (lane & 3)) * 8);
    const size_t qoff = S_DAQ * QG_SEC + bl512((size_t)(32 * rg + l31), c * 64 + 8 * hi);
    h8 ones; { const f16 one = (l31 == 0) ? (f16)1.0f : (f16)0.0f; ones = (h8){one, one, one, one, one, one, one, one}; }
    if (tid < 128) ((LAS float*)(lds + DA_SUBG))[tid] = subg[tid];
    LAS unsigned* xch = (LAS unsigned*)(lds + DA_XCH + rg * 8192);
#define DA_DMA(ks_, vs_, kt_, kslot, vslot) do { const size_t go_ = (size_t)(kt_) * 64 * KVW; const unsigned kd_ = (unsigned)__builtin_amdgcn_readfirstlane(kdst + (kslot)), vd_ = (unsigned)__builtin_amdgcn_readfirstlane(vdst + (vslot)); \
        glds16((ks_) + go_, kd_); glds16((ks_) + go_ + (size_t)32 * KVW, kd_ + 8192); glds16((vs_) + go_, vd_); glds16((vs_) + go_ + (size_t)32 * KVW, vd_ + 8192); } while (0)
#define DA_NEXT_K(s) ((s) == 2 * DA_KS ? 0 : (s) + DA_KS)
#define DA_NEXT_V(s) ((s) == 3 * DA_KS ? 0 : (s) + DA_KS)
    DaUnit U, Un; int ui = vcu;
    if (!da_decode(ui, U)) return;
    const GAS f16* ksrc = kv + ((size_t)U.b * SEQ) * KVW + U.h * 128 + koff; const GAS f16* vsrc = kv + ((size_t)U.b * SEQ) * KVW + U.h * 128 + voff;
    h8 qn[4];
    { const GAS f16* Qg = qg + bl512((size_t)U.b * SEQ + U.qt * 128, U.h * 128) + qoff;
#pragma unroll
      for (int d0 = 0; d0 < 4; ++d0) qn[d0] = *(const GAS h8*)(Qg + 512 * d0); }
    asm volatile("" : "+v"(qn[0]), "+v"(qn[1]), "+v"(qn[2]), "+v"(qn[3]));
    DA_DMA(ksrc, vsrc, U.klo, 0, 0); DA_DMA(ksrc, vsrc, U.klo + 1, DA_KS, DA_KS);
    int ik = 2 * DA_KS, iv = 2 * DA_KS, ck = 0, cv = 0;
    for (;;) {
        const size_t rowbase = (size_t)U.b * SEQ;
        const int qw = U.qt * 128 + 32 * rg, t = qw + l31, lastt = qw >> 6, NT = 2 * U.qt + 2;
        const float cslope = exp2f(-2.0f * (float)(U.h + 1)) * LOG2E;
        const float cs64 = 64.0f * cslope, base0 = -cslope * (float)(t - 32 * hi) - mref;
        h8 qr[4];
#pragma unroll
        for (int d0 = 0; d0 < 4; ++d0) qr[d0] = qn[d0];
        const size_t grow = rowbase + qw + l31;
        const bool has_next = da_decode(ui + G, Un);
        const GAS f16* ksn = ksrc; const GAS f16* vsn = vsrc;
        if (has_next) { ksn = kv + ((size_t)Un.b * SEQ) * KVW + Un.h * 128 + koff; vsn = kv + ((size_t)Un.b * SEQ) * KVW + Un.h * 128 + voff; }
        f32x16 o[4]; o[0] = f32x16{}; o[1] = f32x16{}; o[2] = f32x16{}; o[3] = f32x16{};
        f32x16 osum = f32x16{};
        SW_BEGIN(2);
        for (int kt = U.klo; kt < NT; ++kt) {
            SW_BEGIN(3);
            if (kt + 1 < NT || has_next) WAIT_BAR(4); else WAIT_BAR(0);
            SW_END(3);
#define DA_ISSUE() do { if (kt + 2 < NT) { DA_DMA(ksrc, vsrc, kt + 2, ik, iv); ik = DA_NEXT_K(ik); iv = DA_NEXT_V(iv); } \
            else if (has_next) { DA_DMA(ksn, vsn, Un.klo + kt + 2 - NT, ik, iv); ik = DA_NEXT_K(ik); iv = DA_NEXT_V(iv); } } while (0)
            DA_ISSUE();
            if (kt <= lastt) {
                const LAS unsigned char* Ks = lds + ck;
                f32x16 p0, p1;
                const float basek = __builtin_fmaf(cs64, (float)kt, base0);
                __builtin_amdgcn_sched_barrier(0);
                asm volatile("s_nop 7" ::: "memory");
#define DA_INIT(r) p0[r] = fmamk_s<r>(cslope, basek); p1[r] = fmamk_s<16 + r>(cslope, basek);
                DA_INIT(0) DA_INIT(1) DA_INIT(2) DA_INIT(3) DA_INIT(4) DA_INIT(5) DA_INIT(6) DA_INIT(7) DA_INIT(8) DA_INIT(9) DA_INIT(10) DA_INIT(11) DA_INIT(12) DA_INIT(13) DA_INIT(14) DA_INIT(15)
#undef DA_INIT
                asm volatile("s_nop 3" : "+v"(p0), "+v"(p1));
                if (kt == lastt) {
                    const int kd = t - (64 * kt + 32 * hi);
                    const float m2 = -2.0f * mref;
                    asm volatile("" ::: "memory");
#pragma unroll
                    for (int r = 0; r < 16; ++r) { if (r > kd) p0[r] = m2 - p0[r]; if (16 + r > kd) p1[r] = m2 - p1[r]; }
                }
#pragma unroll
                for (int d0 = 0; d0 < 4; ++d0) { const h8 ka = *(const LAS h8*)(Ks + kfo[d0]), kb = *(const LAS h8*)(Ks + kfo[d0] + 4096); p0 = MFMA32(ka, qr[d0], p0); p1 = MFMA32(kb, qr[d0], p1); }
#pragma unroll
                for (int r = 0; r < 16; ++r) { p0[r] = __builtin_amdgcn_exp2f(p0[r]); p1[r] = __builtin_amdgcn_exp2f(p1[r]); }
                const h8 pq0 = pack8(p0, 0), pq1 = pack8(p0, 8), pq2 = pack8(p1, 0), pq3 = pack8(p1, 8);
                osum = MFMA32(ones, pq0, osum); osum = MFMA32(ones, pq1, osum); osum = MFMA32(ones, pq2, osum); osum = MFMA32(ones, pq3, osum);
                da_pv(o, lds + cv, vfo, pq0, pq1, pq2, pq3);
            }
            ck = DA_NEXT_K(ck); cv = DA_NEXT_V(cv);
        }
        asm volatile("s_nop 15\n\ts_nop 7" : "+v"(o[0]), "+v"(o[1]), "+v"(o[2]), "+v"(o[3]), "+v"(osum));
        SW_END(2);
        const int dlo = 2 * c;
        u32x4 gr[4];
        ld_groups_raw_bl(qg + S_DAG * QG_SEC + bl512(grow, U.h * 128 + 32 * dlo), hi, gr);
        if (has_next) { const GAS f16* Qg = qg + bl512((size_t)Un.b * SEQ + Un.qt * 128, Un.h * 128) + qoff;
#pragma unroll
            for (int d0 = 0; d0 < 4; ++d0) qn[d0] = *(const GAS h8*)(Qg + 512 * d0); }
        asm volatile("" ::: "memory");
        float lsum = osum[0];
        { const auto rr = __builtin_amdgcn_permlane32_swap(__float_as_uint(lsum), __float_as_uint(lsum), false, false); lsum = __uint_as_float(rr[0]) + __uint_as_float(rr[1]); }
        const float f = (c == 0 ? 1.0f : lam) / lsum;
        LAS unsigned* xw = xch + (c ^ 1) * 1024;
        LAS unsigned* xr = xch + c * 1024;
        f32x16 ya, yb;
        if (c == 0) {
#pragma unroll
            for (int r2 = 0; r2 < 8; ++r2) { xw[r2 * 64 + lane] = pkh(o[2][2 * r2] * f, o[2][2 * r2 + 1] * f); xw[(8 + r2) * 64 + lane] = pkh(o[3][2 * r2] * f, o[3][2 * r2 + 1] * f); }
            ya = o[0] * f; yb = o[1] * f;
        } else {
#pragma unroll
            for (int r2 = 0; r2 < 8; ++r2) { xw[r2 * 64 + lane] = pkh(o[0][2 * r2] * f, o[0][2 * r2 + 1] * f); xw[(8 + r2) * 64 + lane] = pkh(o[1][2 * r2] * f, o[1][2 * r2 + 1] * f); }
            ya = o[2] * f; yb = o[3] * f;
        }
        asm volatile("s_waitcnt lgkmcnt(0)\n\ts_barrier" ::: "memory");
        const float sgn = (c == 0) ? 1.0f : -1.0f;
        float ss = 0.f;
#pragma unroll
        for (int r2 = 0; r2 < 8; ++r2) {
            const h2 pa = __builtin_bit_cast(h2, xr[r2 * 64 + lane]), pb = __builtin_bit_cast(h2, xr[(8 + r2) * 64 + lane]);
            const float a0 = (ya[2 * r2] - (float)pa[0]) * sgn, a1 = (ya[2 * r2 + 1] - (float)pa[1]) * sgn, b0 = (yb[2 * r2] - (float)pb[0]) * sgn, b1 = (yb[2 * r2 + 1] - (float)pb[1]) * sgn;
            ya[2 * r2] = a0; ya[2 * r2 + 1] = a1; yb[2 * r2] = b0; yb[2 * r2 + 1] = b1; ss += (a0 * a0 + a1 * a1) + (b0 * b0 + b1 * b1);
        }
        { const auto rr = __builtin_amdgcn_permlane32_swap(__float_as_uint(ss), __float_as_uint(ss), false, false); ss = __uint_as_float(rr[0]) + __uint_as_float(rr[1]); }
        LAS float* ssx = (LAS float*)(lds + DA_SSX + rg * 256);
        if (hi == 0) ssx[c * 32 + l31] = ss;
        asm volatile("s_waitcnt lgkmcnt(0)\n\ts_barrier" ::: "memory");
        ss += ssx[(c ^ 1) * 32 + l31];
        const float rn = __builtin_amdgcn_rsqf(ss * (1.0f / 128.0f) + RMS_EPS) * osc;
        {
            const LAS float* sgl = (const LAS float*)(lds + DA_SUBG) + 32 * dlo + 4 * hi;
            GAS f16* Op = mixed + bl1024(grow, 512 + U.h * 128 + 32 * dlo);
            u32x2 gv[8]; unpack_groups(gr, gv);
#pragma unroll
            for (int pr = 0; pr < 2; ++pr) {
                u32x2 wv[2];
#pragma unroll
                for (int e = 0; e < 2; ++e) { const int rg4 = 2 * pr + e; const h4 g = __builtin_bit_cast(h4, gv[rg4]); const f32x4 sg = *(const LAS f32x4*)(sgl + 8 * rg4);
                    wv[e].x = pkh(ya[4 * rg4] * rn * sg[0] * (float)g[0], ya[4 * rg4 + 1] * rn * sg[1] * (float)g[1]);
                    wv[e].y = pkh(ya[4 * rg4 + 2] * rn * sg[2] * (float)g[2], ya[4 * rg4 + 3] * rn * sg[3] * (float)g[3]); }
                st_groups2_bl(Op, hi, pr, wv[0], wv[1]);
            }
#pragma unroll
            for (int pr = 0; pr < 2; ++pr) {
                u32x2 wv[2];
#pragma unroll
                for (int e = 0; e < 2; ++e) { const int rg4 = 2 * pr + e; const h4 g = __builtin_bit_cast(h4, gv[4 + rg4]); const f32x4 sg = *(const LAS f32x4*)(sgl + 32 + 8 * rg4);
                    wv[e].x = pkh(yb[4 * rg4] * rn * sg[0] * (float)g[0], yb[4 * rg4 + 1] * rn * sg[1] * (float)g[1]);
                    wv[e].y = pkh(yb[4 * rg4 + 2] * rn * sg[2] * (float)g[2], yb[4 * rg4 + 3] * rn * sg[3] * (float)g[3]); }
                st_groups2_bl(Op, hi, 2 + pr, wv[0], wv[1]);
            }
        }
        if (!has_next) break;
        U = Un; ui += G; ksrc = ksn; vsrc = vsn;
    }
#undef DA_DMA
#undef DA_ISSUE
#undef DA_NEXT_K
#undef DA_NEXT_V
    WAIT_BAR(0);
}
}

constexpr size_t MiB = 1u << 20;
constexpr size_t WS_CTL = 0, CTL_ZERO_BYTES = 64 * 1024;
constexpr size_t WS_WIN = 2 * MiB;
constexpr size_t WS_WOUT = 18 * MiB;
constexpr size_t WS_PART = 22 * MiB;
constexpr size_t WS_XB = 32 * MiB;
constexpr size_t WS_MIX = 96 * MiB;
constexpr size_t WS_PROJ = 160 * MiB;
constexpr size_t WS_END = 416 * MiB;
constexpr int CW_BAR = 4096;

constexpr int RING_OFF = 0, RING_BYTES = 131072;
constexpr int LDSCTL_OFF = 147456, MISC_OFF = LDSCTL_OFF + 320;
constexpr int LDS_BYTES = 163840;
constexpr int NWAVES = 8;

typedef GAS unsigned gu32;
#define LDS_WAIT() asm volatile("s_waitcnt lgkmcnt(0)" ::: "memory")

#define XB_TMO      128
#define XB_XCNT(j)  (256  + 64 * (j))
#define XB_XSUB(j)  (1280 + 64 * (j))
#define XB_XGEN(j)  (2304 + 64 * (j))
#define XB_TOP      3328
#define XB_TOPGEN   3392
#define XCD_BAR_WORDS 3456
#define XB_SPIN_CAP (1u << 18)
__device__ __forceinline__ unsigned xb_ld(unsigned* p)              { return __hip_atomic_load(p, __ATOMIC_RELAXED, __HIP_MEMORY_SCOPE_AGENT); }
__device__ __forceinline__ unsigned xb_add(unsigned* p, unsigned v) { return __hip_atomic_fetch_add(p, v, __ATOMIC_RELAXED, __HIP_MEMORY_SCOPE_AGENT); }
__device__ __forceinline__ unsigned xb_xcc_id() { return (unsigned)__builtin_amdgcn_s_getreg((3 << 11) | 20) & 0xFu; }
#define XB_SPIN(cond, bar) do { unsigned _sp = 0; while (cond) { __builtin_amdgcn_s_sleep(1); \
    if ((++_sp & 255u) == 0u) { if (xb_ld(&(bar)[XB_TMO])) break; if (_sp > XB_SPIN_CAP) { atomicAdd(&(bar)[XB_TMO], 1u); break; } } } } while (0)
struct XcdBarrier { unsigned* bar; unsigned x; volatile LAS unsigned* st; };
__device__ __forceinline__ XcdBarrier xcd_barrier_post(unsigned* bar, volatile LAS unsigned* st) {
    XcdBarrier b; b.bar = bar; b.x = xb_xcc_id(); b.st = st;
    if (threadIdx.x == 0) (void)xb_add(&bar[XB_XCNT(b.x)], 1u);
    return b;
}
__device__ __forceinline__ void xcd_barrier_complete(unsigned* bar, unsigned x, unsigned& nloc, unsigned& nx) {
    const unsigned G = gridDim.x * gridDim.y * gridDim.z;
    unsigned sum, cnt, mine, sp = 0u;
    for (;;) {
        sum = 0u; cnt = 0u; mine = 0u;
#pragma unroll
        for (unsigned j = 0; j < 16; ++j) { const unsigned c = xb_ld(&bar[XB_XCNT(j)]); sum += c; cnt += (c > 0u) ? 1u : 0u; mine = (j == x) ? c : mine; }
        if (sum == G) break;
        __builtin_amdgcn_s_sleep(1);
        if ((++sp & 255u) == 0u) { if (xb_ld(&bar[XB_TMO])) break; if (sp > XB_SPIN_CAP) { atomicAdd(&bar[XB_TMO], 1u); break; } }
    }
    nloc = mine > 0u ? mine : 1u; nx = cnt > 0u ? cnt : 1u;
}
__device__ __forceinline__ void xcd_barrier(const XcdBarrier& b) {
    asm volatile("s_waitcnt vmcnt(0)" ::: "memory");
    __syncthreads();
    if (threadIdx.x == 0) {
        unsigned* bar = b.bar;
        __builtin_amdgcn_s_waitcnt(0);
        unsigned nloc = b.st[0], nx = b.st[1];
        if (nloc == 0u) { xcd_barrier_complete(bar, b.x, nloc, nx); b.st[0] = nloc; b.st[1] = nx; }
        const unsigned old = xb_add(&bar[XB_XSUB(b.x)], 1u);
        const unsigned gen = old / nloc;
        if (old + 1u == (gen + 1u) * nloc) {
            __builtin_amdgcn_fence(__ATOMIC_RELEASE, "agent");
            asm volatile("s_waitcnt vmcnt(0)" ::: "memory");
            const unsigned og = xb_add(&bar[XB_TOP], 1u);
            const unsigned tg = og / nx;
            if (og + 1u == (tg + 1u) * nx) xb_add(&bar[XB_TOPGEN], 1u);
            else XB_SPIN(xb_ld(&bar[XB_TOPGEN]) == tg, bar);
            __builtin_amdgcn_fence(__ATOMIC_ACQUIRE, "agent");
            xb_add(&bar[XB_XGEN(b.x)], 1u);
            asm volatile("s_waitcnt vmcnt(0)" ::: "memory");
        } else {
            XB_SPIN(xb_ld(&bar[XB_XGEN(b.x)]) == gen, bar);
            __builtin_amdgcn_fence(__ATOMIC_ACQUIRE, "agent");
            asm volatile("s_waitcnt vmcnt(0)" ::: "memory");
        }
    }
    __syncthreads();
}

__device__ __forceinline__ void p0_transpose_item(const float* W, const float* g, int K, int N, f16* WT, LAS float* scr, int item, int lane) {
    const int nblk = N / 32, kb = item / nblk, nb = item % nblk, k0 = 32 * kb, n0 = 32 * nb;
    float v[16];
#pragma unroll
    for (int i = 0; i < 16; ++i) { const int kk = 2 * i + (lane >> 5); v[i] = __builtin_nontemporal_load(W + (size_t)(k0 + kk) * N + n0 + (lane & 31)); }
    if (g) {
#pragma unroll
        for (int i = 0; i < 16; ++i) v[i] *= g[k0 + 2 * i + (lane >> 5)];
    }
#pragma unroll
    for (int i = 0; i < 16; ++i) scr[(2 * i + (lane >> 5)) * 33 + (lane & 31)] = v[i];
    LDS_WAIT(); asm volatile("" ::: "memory");
    const int c = lane & 3;
#pragma unroll
    for (int j = 0; j < 2; ++j) { const int n = (lane >> 2) + 16 * j; const LAS float* sp = scr + (8 * c) * 33 + n;
        u32x4 o; o.x = pkh(sp[0 * 33], sp[1 * 33]); o.y = pkh(sp[2 * 33], sp[3 * 33]); o.z = pkh(sp[4 * 33], sp[5 * 33]); o.w = pkh(sp[6 * 33], sp[7 * 33]);
        *(GAS u32x4*)(WT + (size_t)(n0 + n) * K + k0 + 8 * c) = o; }
    LDS_WAIT(); asm volatile("" ::: "memory");
}
__device__ __forceinline__ void x_rows4(const float* x, f16* xb, float* part, int m0, int stride, int lane) {
    f32x4 v[4][4];
#pragma unroll
    for (int r = 0; r < 4; ++r) { const GAS f32x4* xr = (const GAS f32x4*)(x + (size_t)(m0 + r * stride) * DM) + lane;
#pragma unroll
        for (int j = 0; j < 4; ++j) v[r][j] = __builtin_nontemporal_load(xr + 64 * j); }
#pragma unroll
    for (int r = 0; r < 4; ++r) {
        float s = 0.f;
#pragma unroll
        for (int j = 0; j < 4; ++j) s += (v[r][j][0] * v[r][j][0] + v[r][j][1] * v[r][j][1]) + (v[r][j][2] * v[r][j][2] + v[r][j][3] * v[r][j][3]);
        s = att::wave_sum(s);
        const size_t row = (size_t)(m0 + r * stride);
        GAS u32x2* o8 = (GAS u32x2*)(xb + row * DM) + lane;
#pragma unroll
        for (int j = 0; j < 4; ++j) { u32x2 w; w.x = pkh(v[r][j][0], v[r][j][1]); w.y = pkh(v[r][j][2], v[r][j][3]); o8[64 * j] = w; }
        if (lane < 16) part[row * 16 + lane] = (lane == 0) ? s : 0.f;
    }
}

__device__ __forceinline__ void x_row1(const float* x, f16* xb, float* part, int m, int lane) {
    const GAS f32x4* xr = (const GAS f32x4*)(x + (size_t)m * DM) + lane;
    f32x4 v[4]; float s = 0.f;
#pragma unroll
    for (int j = 0; j < 4; ++j) { v[j] = xr[64 * j]; s += (v[j][0] * v[j][0] + v[j][1] * v[j][1]) + (v[j][2] * v[j][2] + v[j][3] * v[j][3]); }
    s = att::wave_sum(s);
    GAS u32x2* o8 = (GAS u32x2*)(xb + (size_t)m * DM) + lane;
#pragma unroll
    for (int j = 0; j < 4; ++j) { u32x2 w; w.x = pkh(v[j][0], v[j][1]); w.y = pkh(v[j][2], v[j][3]); o8[64 * j] = w; }
    if (lane < 16) part[(size_t)m * 16 + lane] = (lane == 0) ? s : 0.f;
}

struct Args { const float* in[11]; float* out; unsigned char* ws; };
__global__ void __launch_bounds__(NWAVES * 64, 2) hybrid_fwd(Args args) {
    extern __shared__ __attribute__((aligned(16))) unsigned char lds_raw[];
    LAS unsigned char* lds = (LAS unsigned char*)lds_raw;
    volatile LAS unsigned* MISC = (volatile LAS unsigned*)(lds + MISC_OFF);
    const int tid = threadIdx.x, lane = tid & 63, wave = __builtin_amdgcn_readfirstlane(tid >> 6);
    const int G = gridDim.x; const int bx = blockIdx.x; const int vcu = (G % 8 == 0) ? (bx % 8) * (G / 8) + bx / 8 : bx;
    unsigned char* ws = args.ws;
    gu32* ctl = (gu32*)(ws + WS_CTL);
    const float* x = args.in[0]; const float* norm_g = args.in[1]; const float* w_in = args.in[2]; const float* w_out = args.in[3];
    const float* q_norm_g = args.in[4]; const float* k_norm_g = args.in[5];
    const float* lq1 = args.in[6]; const float* lk1 = args.in[7]; const float* lq2 = args.in[8]; const float* lk2 = args.in[9]; const float* subln_g = args.in[10];
    float* out = args.out;
    GAS unsigned char* wsg = (GAS unsigned char*)ws;
    GAS f16* WIN = (GAS f16*)(wsg + WS_WIN); GAS f16* WOUT = (GAS f16*)(wsg + WS_WOUT); GAS float* PART = (GAS float*)(wsg + WS_PART);
    GAS f16* XB = (GAS f16*)(wsg + WS_XB); GAS f16* MIX = (GAS f16*)(wsg + WS_MIX); GAS f16* PROJ = (GAS f16*)(wsg + WS_PROJ);

    unsigned long long sw_acc = 0;
    for (int u = tid; u < (LDS_BYTES - LDSCTL_OFF) / 4; u += NWAVES * 64) ((LAS unsigned*)(lds + LDSCTL_OFF))[u] = 0u;
    __syncthreads();
    XcdBarrier bar = xcd_barrier_post((unsigned*)(ctl + CW_BAR), MISC + 8);

    SW_BEGIN(6);
    for (int rep = 0; rep < REP_PRO; ++rep) {
        LAS float* scr = (LAS float*)(lds + RING_OFF + wave * 16384);
        const int gw = vcu * NWAVES + wave, NGW = G * NWAVES;
        constexpr int I_IN = (DM / 32) * (PW / 32), I_OUT = (DM / 32) * (DM / 32);
        constexpr int NITEMS = DEPTH * (I_IN + I_OUT);
        SW_BEGIN(9);
        for (int it = gw; it < NITEMS; it += NGW) {
            int r = it; const int l = r / (I_IN + I_OUT); r -= l * (I_IN + I_OUT);
            if (r < I_IN) p0_transpose_item(w_in + (size_t)l * DM * PW, norm_g + l * DM, DM, PW, (f16*)WIN + (size_t)l * PW * DM, scr, r, lane);
            else p0_transpose_item(w_out + (size_t)l * DM * DM, nullptr, DM, DM, (f16*)WOUT + (size_t)l * DM * DM, scr, r - I_IN, lane);
        }
        SW_END(9);
        SW_BEGIN(10);
        { int m = gw; for (; m + 3 * NGW < MROWS; m += 4 * NGW) x_rows4(x, (f16*)XB, (float*)PART, m, NGW, lane); for (; m < MROWS; m += NGW) x_row1(x, (f16*)XB, (float*)PART, m, lane); }
        SW_END(10);
    }
    SW_END(6);
    { SW_BEGIN(7); xcd_barrier(bar); SW_END(7); }

    for (int l = 0; l < DEPTH; ++l) {
        { GAS unsigned char* wsl = wsg; asm volatile("" : "+s"(wsl)); WIN = (GAS f16*)(wsl + WS_WIN); WOUT = (GAS f16*)(wsl + WS_WOUT); PART = (GAS float*)(wsl + WS_PART); XB = (GAS f16*)(wsl + WS_XB); MIX = (GAS f16*)(wsl + WS_MIX); PROJ = (GAS f16*)(wsl + WS_PROJ);
          asm volatile("" : "+s"(out)); asm volatile("" : "+s"(x)); asm volatile("" : "+s"(subln_g)); asm volatile("" : "+s"(q_norm_g)); asm volatile("" : "+s"(k_norm_g)); asm volatile("" : "+s"(bar.bar)); }
        for (int rep = 0; rep < REP_G1; ++rep) {
            pg8::Gemm g{(const f16*)XB, (const f16*)WIN + (size_t)l * PW * DM, MROWS, PW, DM}; pg8::StaticOrder S; S.init(MROWS, PW, G, bx);
            pg8::EpiProj E{PROJ, PROJ + (size_t)MROWS * KVW, PART, (const GAS float*)q_norm_g + l * 64, (const GAS float*)k_norm_g + l * 64, lds + RING_BYTES};
            SW_BEGIN(5);
            pg8::gemm_phase<pg8::EpiProj>(lds + RING_OFF, g, S, E, sw_acc);
            SW_END(5);
        }
        { SW_BEGIN(7); xcd_barrier(bar); SW_END(7); }
        {
            const float sa = att::wave_sum(lq1[l * 64 + lane] * lk1[l * 64 + lane]), sb = att::wave_sum(lq2[l * 64 + lane] * lk2[l * 64 + lane]);
            const float lam_init = 0.8f - 0.6f * __expf(-0.3f * (float)l);
            const float lam = __expf(sa) - __expf(sb) + lam_init;
            const float mgq = att::wave_max(fabsf(q_norm_g[l * 64 + lane])), mgk = att::wave_max(fabsf(k_norm_g[l * 64 + lane]));
            const float mref = 8.0f * LOG2E * mgq * mgk * 1.001f - 10.0f;
            __syncthreads();
            for (int rep = 0; rep < REP_DA; ++rep) { SW_BEGIN(1); att::da_phase(lds + RING_OFF, PROJ, PROJ + (size_t)MROWS * KVW, MIX, vcu, G, lam, mref, (const GAS float*)subln_g + l * 128, 1.0f - lam_init, sw_acc); SW_END(1); }
            for (int rep = 0; rep < REP_SB; ++rep) { SW_BEGIN(4); att::sb_phase(lds + RING_OFF, PROJ, PROJ + (size_t)MROWS * KVW, MIX, vcu, G, sw_acc); SW_END(4); }
        }
        { SW_BEGIN(7); xcd_barrier(bar); SW_END(7); }
        {
            pg8::Gemm g{(const f16*)MIX, (const f16*)WOUT + (size_t)l * DM * DM, MROWS, DM, DM}; pg8::StaticOrder S; S.init(MROWS, DM, G, bx);
            pg8::EpiOut E{(GAS float*)out, XB, PART, (l + 1 < DEPTH) ? 0 : 1};
            SW_BEGIN(8);
            pg8::gemm_phase<pg8::EpiOut>(lds + RING_OFF, g, S, E, sw_acc);
            SW_END(8);
        }
        if (l + 1 < DEPTH) { SW_BEGIN(7); xcd_barrier(bar); SW_END(7); }
    }
#if SW_ID
    if (wave == 0) { const unsigned long long t0 = __builtin_amdgcn_s_memrealtime(), span = (unsigned long long)SW_K * sw_acc; while (__builtin_amdgcn_s_memrealtime() - t0 < span) __builtin_amdgcn_s_sleep(8); }
#endif
}

extern "C" void kernel_launch(void* const* d_in, const int* in_sizes, int n_in, void* d_out, int out_size, void* d_ws, size_t ws_size, hipStream_t stream) {
    static int grid = 0;
    if (grid == 0) {
        if (n_in != 11 || in_sizes[0] != MROWS * DM || out_size != MROWS * DM || ws_size < WS_END) {
            fprintf(stderr, "kernel_launch: unexpected problem shape (n_in %d, in0 %d, out %d, ws %zu); nothing launched\n", n_in, n_in > 0 ? in_sizes[0] : -1, out_size, ws_size); grid = -1; return; }
        int dev = 0, cus = 0, per_cu = 0;
        if (hipGetDevice(&dev) != hipSuccess || hipDeviceGetAttribute(&cus, hipDeviceAttributeMultiprocessorCount, dev) != hipSuccess) { grid = -1; return; }
        if (hipFuncSetAttribute((const void*)hybrid_fwd, hipFuncAttributeMaxDynamicSharedMemorySize, LDS_BYTES) != hipSuccess) { fprintf(stderr, "kernel_launch: hipFuncSetAttribute failed\n"); grid = -1; return; }
        if (hipOccupancyMaxActiveBlocksPerMultiprocessor(&per_cu, (const void*)hybrid_fwd, NWAVES * 64, LDS_BYTES) != hipSuccess || per_cu < 1) {
            fprintf(stderr, "kernel_launch: occupancy query reports %d workgroups per CU; nothing launched\n", per_cu); (void)hipGetLastError(); grid = -1; return; }
        grid = cus;
    }
    if (grid < 0) return;
    if (hipMemsetAsync((char*)d_ws + WS_CTL, 0, CTL_ZERO_BYTES, stream) != hipSuccess) { fprintf(stderr, "kernel_launch: hipMemsetAsync failed\n"); return; }
    Args a{};
    for (int i = 0; i < 11; ++i) a.in[i] = (const float*)d_in[i];
    a.out = (float*)d_out; a.ws = (unsigned char*)d_ws;
    hipLaunchKernelGGL(hybrid_fwd, dim3(grid), dim3(NWAVES * 64), LDS_BYTES, stream, a);
    const hipError_t le = hipPeekAtLastError();
    if (le != hipSuccess) fprintf(stderr, "kernel_launch: launch failed: %s\n", hipGetErrorName(le));
}
```

```cpp
#include <hip/hip_runtime.h>
#include <cstdio>
#include <cstdint>

#ifndef SB_EARLY_EXIT
#define SB_EARLY_EXIT 1
#endif
#define SW_ID 0
#define SW_K 4
#define REP_PRO 1
#define REP_G1 1
#define REP_DA 1
#define REP_SB 1
#define REP_G2 1

#if SW_ID
#define SW_BEGIN(id) unsigned long long sw_t0_##id = 0; if (SW_ID == (id)) sw_t0_##id = __builtin_amdgcn_s_memrealtime()
#define SW_END(id) do { if (SW_ID == (id)) sw_acc += __builtin_amdgcn_s_memrealtime() - sw_t0_##id; } while (0)
#else
#define SW_BEGIN(id) do {} while (0)
#define SW_END(id) do {} while (0)
#endif
#define LAS __attribute__((address_space(3)))
#define GAS __attribute__((address_space(1)))
typedef _Float16 f16;
typedef _Float16 h8 __attribute__((ext_vector_type(8)));
typedef _Float16 h4 __attribute__((ext_vector_type(4)));
typedef _Float16 h2 __attribute__((ext_vector_type(2)));
typedef float f32x4 __attribute__((ext_vector_type(4)));
typedef float f32x16 __attribute__((ext_vector_type(16)));
typedef unsigned u32x4 __attribute__((ext_vector_type(4)));
typedef unsigned u32x2 __attribute__((ext_vector_type(2)));

constexpr int BATCH = 16, SEQ = 2048, DM = 1024, MROWS = BATCH * SEQ, PW = 4096, DEPTH = 2;
constexpr float RMS_EPS = 1e-6f;
constexpr float LOG2E = 1.4426950408889634f;
constexpr float QS = 0.125f * LOG2E;
constexpr int C_SBQ = 0, C_SBK = 512, C_SBV = 1024, C_SBG = 1536, C_DAQ = 2048, C_DAK = 2560, C_DAV = 3072, C_DAG = 3584;
constexpr unsigned long long G1_CPERM = 0xDC325410BA98FE76ull;
constexpr int KVW = 2048, K_SBK = 0, K_SBV = 512, K_DAK = 1024, K_DAV = 1536;
constexpr int S_SBQ = 0, S_SBG = 1, S_DAQ = 2, S_DAG = 3;
constexpr size_t QG_SEC = (size_t)MROWS * 512;
__host__ __device__ __forceinline__ size_t bl1024(size_t row, int col) { return ((row >> 5) * 128 + (size_t)(col >> 3)) * 256 + (row & 31) * 8 + (col & 7); }
__host__ __device__ __forceinline__ size_t bl512(size_t row, int col) { return ((row >> 5) * 64 + (size_t)(col >> 3)) * 256 + (row & 31) * 8 + (col & 7); }

__device__ __forceinline__ unsigned pkh(float lo, float hi) { h2 v = {(f16)lo, (f16)hi}; return __builtin_bit_cast(unsigned, v); }
__device__ __forceinline__ unsigned pkh_rtz(float lo, float hi) { return __builtin_bit_cast(unsigned, __builtin_amdgcn_cvt_pkrtz(lo, hi)); }
__device__ __forceinline__ float row4_sum(float s) {
    { const auto r = __builtin_amdgcn_permlane16_swap(__float_as_uint(s), __float_as_uint(s), false, false); s = __uint_as_float(r[0]) + __uint_as_float(r[1]); }
    { const auto r = __builtin_amdgcn_permlane32_swap(__float_as_uint(s), __float_as_uint(s), false, false); s = __uint_as_float(r[0]) + __uint_as_float(r[1]); }
    return s;
}
__device__ __forceinline__ float silu_f(float v) { return v * __builtin_amdgcn_rcpf(1.0f + __builtin_amdgcn_exp2f(-v * LOG2E)); }

namespace pg8 {
constexpr int BM = 256, BK = 64, HALF = 128, HTB = HALF * BK * 2, STAGE_BYTES = 8 * HTB, NXCD = 8, WGM = 8;
__host__ __device__ __forceinline__ int lds_byte(int r, int c) { const int st = (r >> 4) * 2 + (c >> 5), rr = r & 15, cc = c & 31, ob = rr * 64 + cc * 2; return st * 1024 + (ob ^ (((ob >> 9) & 1) << 5)); }
__host__ __device__ __forceinline__ void stage_rc(int b, int& R, int& C) { const int st = b / 1024, sb = b % 1024, swz = sb ^ (((sb >> 9) & 1) << 5); R = (st >> 1) * 16 + swz / 64; C = (st & 1) * 32 + (swz % 64) / 2; }
__host__ __device__ __forceinline__ int perm32(int rho) { const int n = rho >> 4, i = rho & 15; return 8 * (i >> 2) + 4 * n + (i & 3); }

struct Unit { int pm, pn; };
struct Gemm { const f16* A; const f16* Bt; int M, N, K; };

struct StaticOrder {
    int nM, nN, nwg, G, c; unsigned long long cperm;
    int grp;
    __host__ __device__ void init(int M, int N, int G_, int c_, unsigned long long cperm_ = 0ull, int grp_ = 0) { nM = M / BM; nN = N / BM; nwg = nM * nN; G = G_; c = c_; cperm = cperm_; grp = grp_; }
    __host__ __device__ bool next(int i, Unit& u) const {
        if (grp) {
            const int j = c >> 3, m = j & 15, batch = 2 * (c & 7) + (j >> 4);
            if (i >= nN / 2) return false;
            u.pm = batch * 8 + 4 * (i & 1) + (m & 3); u.pn = 4 * (i >> 1) + (m >> 2); if (cperm) u.pn = (int)((cperm >> (4 * u.pn)) & 15ull); return true;
        }
        const long L = (long)i * G + c; if (L >= nwg) return false;
        int wgid = (int)L; { const int q = nwg / NXCD, r = nwg % NXCD, xcd = wgid % NXCD, off = wgid / NXCD; wgid = (xcd < r ? xcd * (q + 1) : r * (q + 1) + (xcd - r) * q) + off; }
        const int nig = WGM * nN, gid = wgid / nig, fm = gid * WGM, gsz = (nM - fm) < WGM ? (nM - fm) : WGM;
        u.pm = fm + ((wgid % nig) % gsz); u.pn = (wgid % nig) / gsz; if (cperm) u.pn = (int)((cperm >> (4 * u.pn)) & 15ull); return true;
    }
};


struct EpiProj {
    static constexpr bool A_BLOCKED = false;
    GAS f16* KV; GAS f16* QG; const GAS float* part; const GAS float* gq; const GAS float* gk; LAS unsigned char* rsc;
    struct Pre { f32x4 a[2][2]; int pm[2]; };
    __device__ __forceinline__ void pre_load(Pre& R, const StaticOrder& S) const {
        Unit u0, u4; R.pm[0] = S.next(0, u0) ? u0.pm : -1; R.pm[1] = (S.next(S.grp ? 1 : 4, u4) && u4.pm != R.pm[0]) ? u4.pm : -1;
        const int t = threadIdx.x, row = t >> 1, half = t & 1;
#pragma unroll
        for (int k = 0; k < 2; ++k) { const GAS f32x4* p = (const GAS f32x4*)(part + ((size_t)(R.pm[k] < 0 ? 0 : R.pm[k]) * BM + row) * 16 + half * 8); R.a[k][0] = p[0]; R.a[k][1] = p[1]; }
    }
    __device__ __forceinline__ void pre_finish(const Pre& R) const {
        const int t = threadIdx.x, row = t >> 1, half = t & 1;
#pragma unroll
        for (int k = 0; k < 2; ++k) {
            float sum = ((R.a[k][0][0] + R.a[k][0][1]) + (R.a[k][0][2] + R.a[k][0][3])) + ((R.a[k][1][0] + R.a[k][1][1]) + (R.a[k][1][2] + R.a[k][1][3]));
            sum += __shfl_xor(sum, 1);
            if (half == 0) ((LAS float*)rsc)[k * 256 + row] = __builtin_amdgcn_rsqf(sum * (1.0f / DM) + RMS_EPS);
        }
        if (t == 0) ((LAS int*)(rsc + 2048))[0] = R.pm[0];
        if (t == 1) ((LAS int*)(rsc + 2048))[1] = R.pm[1];
    }
    __device__ __forceinline__ void operator()(const f32x4 (&acc)[2][2][4][2], const Unit& u, int wr, int wc, int fr, int fq) const {
        const int sec = u.pn >> 1;
        const int row0 = u.pm * BM + wr * 64 + fr;
        const int cs = (u.pn & 1) * BM + wc * 64 + 8 * fq;
        const bool isqg = (sec == 0) || (sec == 3) || (sec == 4) || (sec == 7);
        const int dsec = isqg ? ((sec == 0) ? S_SBQ : (sec == 3) ? S_SBG : (sec == 4) ? S_DAQ : S_DAG) : ((sec == 1) ? 0 : (sec == 2) ? 1 : (sec == 5) ? 2 : 3);
        const int bjstep = isqg ? 1024 : 32;
        f32x4 gain[2][2];
        if (sec == 4 || sec == 5) {
            const GAS float* g = (sec == 4) ? gq : gk;
#pragma unroll
            for (int bj = 0; bj < 2; ++bj)
#pragma unroll
                for (int n = 0; n < 2; ++n) gain[bj][n] = *(const GAS f32x4*)(g + 32 * bj + 8 * fq + 4 * n);
        }
        const LAS int* tags = (const LAS int*)(rsc + 2048);
        const int slot = (tags[0] == u.pm) ? 0 : (tags[1] == u.pm) ? 1 : -1;
        const LAS float* rtab = (const LAS float*)rsc + (slot > 0 ? 256 : 0) + wr * 64 + fr;
#pragma unroll
        for (int ai = 0; ai < 2; ++ai)
#pragma unroll
            for (int m = 0; m < 4; ++m) {
                const int row = row0 + ai * HALF + m * 16;
                float rs;
                if (slot >= 0) rs = rtab[ai * HALF + m * 16];
                else {
                    const f32x4 pv = *(const GAS f32x4*)(part + (size_t)row * 16 + fq * 4);
                    float s = (pv[0] + pv[1]) + (pv[2] + pv[3]);
                    s = row4_sum(s);
                    rs = __builtin_amdgcn_rsqf(s * (1.0f / DM) + RMS_EPS);
                }
                f32x4 v[2][2];
#pragma unroll
                for (int bj = 0; bj < 2; ++bj)
#pragma unroll
                    for (int n = 0; n < 2; ++n) v[bj][n] = acc[ai][bj][m][n] * rs;
                if (sec == 4 || sec == 5) {
                    float ss = 0.f;
#pragma unroll
                    for (int bj = 0; bj < 2; ++bj)
#pragma unroll
                        for (int n = 0; n < 2; ++n) { const f32x4 x = v[bj][n]; ss += (x[0] * x[0] + x[1] * x[1]) + (x[2] * x[2] + x[3] * x[3]); }
                    ss = row4_sum(ss);
                    float rn = __builtin_amdgcn_rsqf(ss * (1.0f / 64.0f) + RMS_EPS);
                    if (sec == 4) rn *= QS;
#pragma unroll
                    for (int bj = 0; bj < 2; ++bj)
#pragma unroll
                        for (int n = 0; n < 2; ++n) v[bj][n] = v[bj][n] * rn * gain[bj][n];
                } else if (sec == 0) {
#pragma unroll
                    for (int bj = 0; bj < 2; ++bj)
#pragma unroll
                        for (int n = 0; n < 2; ++n) v[bj][n] = v[bj][n] * QS;
                } else if (sec == 3 || sec == 7) {
#pragma unroll
                    for (int bj = 0; bj < 2; ++bj)
#pragma unroll
                        for (int n = 0; n < 2; ++n)
#pragma unroll
                            for (int e = 0; e < 4; ++e) v[bj][n][e] = silu_f(v[bj][n][e]);
                }
                GAS f16* rowp = isqg ? QG + (size_t)dsec * QG_SEC + bl512((size_t)row, cs) : KV + (size_t)row * KVW + dsec * 512 + cs;
#pragma unroll
                for (int bj = 0; bj < 2; ++bj) {
                    u32x4 w; w.x = pkh(v[bj][0][0], v[bj][0][1]); w.y = pkh(v[bj][0][2], v[bj][0][3]); w.z = pkh(v[bj][1][0], v[bj][1][1]); w.w = pkh(v[bj][1][2], v[bj][1][3]);
                    *(GAS u32x4*)(rowp + bjstep * bj) = w;
                }
            }
    }
};

struct EpiOut {
    static constexpr bool A_BLOCKED = true;
    GAS float* out; GAS f16* xb; GAS float* part; int last;
    struct Pre {};
    __device__ __forceinline__ void pre_load(Pre&, const StaticOrder&) const {}
    __device__ __forceinline__ void pre_finish(const Pre&) const {}
    __device__ __forceinline__ void operator()(const f32x4 (&acc)[2][2][4][2], const Unit& u, int wr, int wc, int fr, int fq) const {
        const int row0 = u.pm * BM + wr * 64 + fr;
        const int colw = u.pn * BM + wc * 64 + 8 * fq;
#pragma unroll
        for (int ai = 0; ai < 2; ++ai) {
            h8 bs[4][2];
#pragma unroll
            for (int m = 0; m < 4; ++m)
#pragma unroll
                for (int bj = 0; bj < 2; ++bj) bs[m][bj] = *(const GAS h8*)(xb + (size_t)(row0 + ai * HALF + m * 16) * DM + colw + 32 * bj);
#pragma unroll
            for (int m = 0; m < 4; ++m) {
                const int row = row0 + ai * HALF + m * 16;
                const size_t off = (size_t)row * DM + colw;
                float ss = 0.f;
#pragma unroll
                for (int bj = 0; bj < 2; ++bj) {
                    const h8 b = bs[m][bj];
                    f32x4 o0 = acc[ai][bj][m][0], o1 = acc[ai][bj][m][1];
                    o0[0] += (float)b[0]; o0[1] += (float)b[1]; o0[2] += (float)b[2]; o0[3] += (float)b[3];
                    o1[0] += (float)b[4]; o1[1] += (float)b[5]; o1[2] += (float)b[6]; o1[3] += (float)b[7];
                    if (last) { *(GAS f32x4*)(out + off + 32 * bj) = o0; *(GAS f32x4*)(out + off + 32 * bj + 4) = o1; }
                    else {
                        ss += (o0[0] * o0[0] + o0[1] * o0[1]) + (o0[2] * o0[2] + o0[3] * o0[3]) + (o1[0] * o1[0] + o1[1] * o1[1]) + (o1[2] * o1[2] + o1[3] * o1[3]);
                        u32x4 w; w.x = pkh(o0[0], o0[1]); w.y = pkh(o0[2], o0[3]); w.z = pkh(o1[0], o1[1]); w.w = pkh(o1[2], o1[3]);
                        *(GAS u32x4*)(xb + off + 32 * bj) = w;
                    }
                }
                if (!last) {
                    ss = row4_sum(ss);
                    if (fq == 0) part[(size_t)row * 16 + u.pn * 4 + wc] = ss;
                }
            }
        }
    }
};

template <class Epi>
__device__ __forceinline__ void gemm_phase(LAS unsigned char* lds, const Gemm g, const StaticOrder& S, const Epi& E, unsigned long long& sw_acc) {
    int tid_ = threadIdx.x; asm volatile("" : "+v"(tid_));
    const int tid = tid_, wid = __builtin_amdgcn_readfirstlane(tid >> 6), lane = tid & 63, wr = wid >> 2, wc = wid & 3, fr = lane & 15, fq = lane >> 4;
    const int K = g.K, nt = K / BK;
    unsigned voffA[2], voffB[2];
#pragma unroll
    for (int i = 0; i < 2; ++i) { int R, C; stage_rc(tid * 16 + i * 8192, R, C);
        const int Rb = (R >> 5) * 64 + perm32(R & 31);
        voffA[i] = Epi::A_BLOCKED ? (unsigned)(((R >> 5) * (K >> 3) + (C >> 3)) * 256 + (R & 31) * 8) * 2u : (unsigned)(R * K + C) * 2u; voffB[i] = (unsigned)(Rb * K + C) * 2u; }
    const size_t kstep = (size_t)(BK * 2);
    const size_t kstepA = Epi::A_BLOCKED ? (size_t)(BK / 8) * 512 : kstep;
    const size_t hstep = (size_t)HALF * K * 2;
    const size_t hstepB = (size_t)32 * K * 2;
    const size_t tstep = 2 * hstep;
    const unsigned ldsw = (unsigned)wid * 1024u;
    const int aoff = lds_byte(wr * 64 + fr, fq * 8), boff = lds_byte(wc * 32 + fr, fq * 8);
#define PG8_SA(b, h) (((b) * 2 + (h)) * HTB)
#define PG8_SB(b, h) ((4 + (b) * 2 + (h)) * HTB)
#define PG8_STAGE(bufoff, gbase, voff) do { _Pragma("unroll") for (int _i = 0; _i < 2; ++_i) \
        __builtin_amdgcn_global_load_lds((const unsigned*)((const char*)(gbase) + (voff)[_i]), (LAS unsigned*)(lds + (bufoff) + ldsw + _i * 8192), 16, 0, 0); } while (0)
#define PG8_LDA(dst, b, h) do { _Pragma("unroll") for (int m = 0; m < 4; ++m) _Pragma("unroll") for (int k = 0; k < 2; ++k) dst[m][k] = *(const LAS h8*)(lds + PG8_SA(b, h) + aoff + m * 2048 + k * 1024); } while (0)
#define PG8_LDB(dst, b, h) do { _Pragma("unroll") for (int n = 0; n < 2; ++n) _Pragma("unroll") for (int k = 0; k < 2; ++k) dst[n][k] = *(const LAS h8*)(lds + PG8_SB(b, h) + boff + n * 2048 + k * 1024); } while (0)
#define PG8_MMA(ai, bj, At, Bt) do { __builtin_amdgcn_s_setprio(1); _Pragma("unroll") for (int m = 0; m < 4; ++m) _Pragma("unroll") for (int n = 0; n < 2; ++n) _Pragma("unroll") for (int k = 0; k < 2; ++k) \
        acc[ai][bj][m][n] = __builtin_amdgcn_mfma_f32_16x16x32_f16(Bt[n][k], At[m][k], acc[ai][bj][m][n], 0, 0, 0); __builtin_amdgcn_s_setprio(0); } while (0)
#define PG8_WAIT_V(n) asm volatile("s_waitcnt vmcnt(" #n ")" ::: "memory")
#define PG8_WAIT_L(n) asm volatile("s_waitcnt lgkmcnt(" #n ")" ::: "memory")
#define PG8_BAR __builtin_amdgcn_s_barrier()
#define PG8_SCHED __builtin_amdgcn_sched_barrier(0)
    Unit cur, nxt; int ui = 0;
    if (!S.next(0, cur)) return;
    f32x4 acc[2][2][4][2];
#pragma unroll
    for (int a = 0; a < 2; ++a)
#pragma unroll
        for (int b = 0; b < 2; ++b)
#pragma unroll
            for (int m = 0; m < 4; ++m)
#pragma unroll
                for (int n = 0; n < 2; ++n) acc[a][b][m][n] = (f32x4){0.f, 0.f, 0.f, 0.f};
    h8 At[4][2], B0[2][2], B1[2][2];
    const char* cA = (const char*)g.A + (size_t)cur.pm * tstep; const char* cB = (const char*)g.Bt + (size_t)cur.pn * tstep;
    PG8_STAGE(PG8_SB(0, 0), cB, voffB); PG8_STAGE(PG8_SB(0, 1), cB + hstepB, voffB); PG8_STAGE(PG8_SA(0, 0), cA, voffA); PG8_STAGE(PG8_SA(0, 1), cA + hstep, voffA);
    typename Epi::Pre pre; E.pre_load(pre, S);
    if (wr == 1) PG8_BAR;
    PG8_WAIT_V(2); PG8_BAR;
    E.pre_finish(pre);
    PG8_WAIT_L(0);
    PG8_STAGE(PG8_SB(1, 0), cB + kstep, voffB); PG8_STAGE(PG8_SA(1, 0), cA + kstepA, voffA); PG8_STAGE(PG8_SB(1, 1), cB + hstepB + kstep, voffB);
    PG8_WAIT_V(6); PG8_BAR;
    for (;;) {
        const bool has_next = S.next(ui + 1, nxt);
        const char* nA = has_next ? (const char*)g.A + (size_t)nxt.pm * tstep : cA; const char* nB = has_next ? (const char*)g.Bt + (size_t)nxt.pn * tstep : cB;
        for (int t = 0; t < nt; t += 2) {
            const bool last = (t == nt - 2);
            const char* a1 = cA + (size_t)(t + 1) * kstepA;
            const char* a2 = last ? nA : cA + (size_t)(t + 2) * kstepA; const char* b2 = last ? nB : cB + (size_t)(t + 2) * kstep;
            const char* a3 = a2 + kstepA; const char* b3 = b2 + kstep;
            PG8_LDB(B0, 0, 0); PG8_LDB(B1, 0, 1); PG8_SCHED; PG8_LDA(At, 0, 0); PG8_STAGE(PG8_SA(1, 1), a1 + hstep, voffA);
            PG8_WAIT_V(8); PG8_WAIT_L(0); PG8_BAR; PG8_MMA(0, 0, At, B0); PG8_MMA(0, 1, At, B1); PG8_BAR; PG8_SCHED;
            PG8_LDA(At, 0, 1); PG8_STAGE(PG8_SB(0, 0), b2, voffB); PG8_STAGE(PG8_SB(0, 1), b2 + hstepB, voffB); PG8_STAGE(PG8_SA(0, 0), a2, voffA);
            PG8_WAIT_V(8); PG8_WAIT_L(0); PG8_BAR; PG8_MMA(1, 0, At, B0); PG8_MMA(1, 1, At, B1); PG8_BAR; PG8_SCHED;
            PG8_LDB(B0, 1, 0); PG8_LDB(B1, 1, 1); PG8_SCHED; PG8_LDA(At, 1, 0); PG8_STAGE(PG8_SA(0, 1), a2 + hstep, voffA);
            PG8_WAIT_V(8); PG8_WAIT_L(0); PG8_BAR; PG8_MMA(0, 0, At, B0); PG8_MMA(0, 1, At, B1); PG8_BAR; PG8_SCHED;
            PG8_LDA(At, 1, 1); PG8_STAGE(PG8_SB(1, 0), b3, voffB); PG8_STAGE(PG8_SB(1, 1), b3 + hstepB, voffB); PG8_STAGE(PG8_SA(1, 0), a3, voffA);
            PG8_WAIT_V(8); PG8_WAIT_L(0); PG8_BAR; PG8_MMA(1, 0, At, B0); PG8_MMA(1, 1, At, B1); PG8_BAR; PG8_SCHED;
        }
        if (wr == 0) PG8_BAR;
        { SW_BEGIN(20); E(acc, cur, wr, wc, fr, fq); SW_END(20); }
        if (!has_next) break;
#pragma unroll
        for (int a = 0; a < 2; ++a)
#pragma unroll
            for (int b = 0; b < 2; ++b)
#pragma unroll
                for (int m = 0; m < 4; ++m)
#pragma unroll
                    for (int n = 0; n < 2; ++n) acc[a][b][m][n] = (f32x4){0.f, 0.f, 0.f, 0.f};
        cur = nxt; cA = nA; cB = nB; ++ui;
        if (wr == 1) PG8_BAR;
    }
    PG8_WAIT_V(0);
    PG8_BAR;
#undef PG8_SA
#undef PG8_SB
#undef PG8_STAGE
#undef PG8_LDA
#undef PG8_LDB
#undef PG8_MMA
#undef PG8_WAIT_V
#undef PG8_WAIT_L
#undef PG8_BAR
#undef PG8_SCHED
}
}

namespace att {
typedef short v4i16_t __attribute__((ext_vector_type(4)));
__device__ __forceinline__ int crow(int r, int hi) { return (r & 3) + 8 * (r >> 2) + 4 * hi; }
__device__ __forceinline__ int keyrow(int i) { return 32 * ((i >> 2) & 1) + (i & 3) + 4 * (i >> 3); }
__device__ __forceinline__ h4 vtr(const LAS unsigned char* p) { return __builtin_bit_cast(h4, __builtin_amdgcn_ds_read_tr16_b64_v4i16((LAS v4i16_t*)p)); }
__device__ __forceinline__ h8 cat8(h4 a, h4 b) { return (h8){a[0], a[1], a[2], a[3], b[0], b[1], b[2], b[3]}; }
#define MFMA32(a, b, c) __builtin_amdgcn_mfma_f32_32x32x16_f16(a, b, c, 0, 0, 0)
__device__ __forceinline__ h8 pack8(const f32x16& p, int b) {
    u32x4 w; w.x = pkh_rtz(p[b], p[b + 1]); w.y = pkh_rtz(p[b + 2], p[b + 3]); w.z = pkh_rtz(p[b + 4], p[b + 5]); w.w = pkh_rtz(p[b + 6], p[b + 7]);
    return __builtin_bit_cast(h8, w);
}
template <int KI> __device__ __forceinline__ float fmamk_s(float c, float base) {
    float r; asm volatile("v_fmamk_f32 %0, %1, %2, %3" : "=v"(r) : "v"(c), "i"(__builtin_bit_cast(int, (float)KI)), "v"(base)); return r; }
__device__ __forceinline__ void ld_groups_raw(const GAS f16* rowp  , int hi, u32x4 (&L)[4]) {
#pragma unroll
    for (int k = 0; k < 4; ++k) L[k] = *(const GAS u32x4*)(rowp + 16 * k + 8 * hi);
}
__device__ __forceinline__ void ld_groups_raw_bl(const GAS f16* p  , int hi, u32x4 (&L)[4]) {
#pragma unroll
    for (int k = 0; k < 4; ++k) L[k] = *(const GAS u32x4*)(p + (2 * k + hi) * 256);
}
__device__ __forceinline__ void unpack_groups(const u32x4 (&L)[4], u32x2 (&g)[8]) {
#pragma unroll
    for (int k = 0; k < 4; ++k) {
        const auto rx = __builtin_amdgcn_permlane32_swap(L[k].x, L[k].z, false, false), ry = __builtin_amdgcn_permlane32_swap(L[k].y, L[k].w, false, false);
        g[2 * k].x = rx[0]; g[2 * k].y = ry[0]; g[2 * k + 1].x = rx[1]; g[2 * k + 1].y = ry[1];
    }
}
__device__ __forceinline__ void st_groups2(GAS f16* rowp, int hi, int k, u32x2 a  , u32x2 b  ) {
    const auto rx = __builtin_amdgcn_permlane32_swap(a.x, b.x, false, false), ry = __builtin_amdgcn_permlane32_swap(a.y, b.y, false, false);
    u32x4 w; w.x = rx[0]; w.y = ry[0]; w.z = rx[1]; w.w = ry[1];
    *(GAS u32x4*)(rowp + 16 * k + 8 * hi) = w;
}
__device__ __forceinline__ void st_groups2_bl(GAS f16* p  , int hi, int k, u32x2 a, u32x2 b) {
    const auto rx = __builtin_amdgcn_permlane32_swap(a.x, b.x, false, false), ry = __builtin_amdgcn_permlane32_swap(a.y, b.y, false, false);
    u32x4 w; w.x = rx[0]; w.y = ry[0]; w.z = rx[1]; w.w = ry[1];
    *(GAS u32x4*)(p + (2 * k + hi) * 256) = w;
}
__device__ __forceinline__ float wave_sum(float v) {
#pragma unroll
    for (int o = 1; o < 64; o <<= 1) v += __shfl_xor(v, o);
    return v;
}
__device__ __forceinline__ float wave_max(float v) {
#pragma unroll
    for (int o = 1; o < 64; o <<= 1) v = fmaxf(v, __shfl_xor(v, o));
    return v;
}

__device__ __forceinline__ void glds16(const GAS void* g, unsigned lds_base) {
    unsigned sv; asm volatile("s_mov_b32 %0, m0\n\ts_mov_b32 m0, %2\n\ts_nop 0\n\tglobal_load_lds_dwordx4 %1, off\n\ts_mov_b32 m0, %0" : "=&s"(sv) : "v"(g), "s"(lds_base) : "memory"); }
#define WAIT_BAR(N) asm volatile("s_waitcnt vmcnt(" #N ") lgkmcnt(0)\n\ts_barrier" ::: "memory")
__device__ __forceinline__ void wait_bar_n(int n) {
    switch (n) { case 0: WAIT_BAR(0); break; case 2: WAIT_BAR(2); break; case 4: WAIT_BAR(4); break; case 6: WAIT_BAR(6); break; case 8: WAIT_BAR(8); break; case 10: WAIT_BAR(10); break;
                 case 12: WAIT_BAR(12); break; case 14: WAIT_BAR(14); break; case 16: WAIT_BAR(16); break; case 18: WAIT_BAR(18); break; case 20: WAIT_BAR(20); break; default: WAIT_BAR(0); break; }
}

constexpr int SB_SLOT = 65536, SB_FLG = 147456 + 2048, SB_SPEC_J = 2;
__device__ __forceinline__ int keyrow16(int i) { return 16 * ((i >> 2) & 1) + (i & 3) + 4 * (i >> 3); }
struct SbUnit { int b, hg, cq; };
__device__ __forceinline__ bool sb_decode(int u, SbUnit& U) {
    if (u >= 1024) return false;
    const int r = u >> 8, v = u & 255, i = v & 15;
    U.b = v >> 4; U.hg = i & 1; U.cq = (i >> 1) + 8 * r; return true;
}
__device__ __forceinline__ void sb_phase(LAS unsigned char* lds, const GAS f16* __restrict__ kv, const GAS f16* __restrict__ qg, GAS f16* __restrict__ mixed, int vcu, int G, unsigned long long& sw_acc) {
    int tid_ = threadIdx.x; asm volatile("" : "+v"(tid_));
    const int tid = tid_, lane = tid & 63, l31 = lane & 31, hi = lane >> 5; const int w = __builtin_amdgcn_readfirstlane(tid >> 6);
    const int rgp = w >> 2, hh = (w + 2 * rgp) & 3;
    const unsigned lds0 = (unsigned)(uintptr_t)lds;
    const unsigned kdst = lds0 + w * 4096, vdst = lds0 + 32768 + w * 4096;
    int kfo[4];
    { const int kr = keyrow16(l31);
#pragma unroll
      for (int d0 = 0; d0 < 4; ++d0) kfo[d0] = kr * 512 + (((hh * 8 + 2 * d0 + hi) ^ (kr & 15)) * 16); }
    int vfo[2];
    { const int q_ = (lane & 15) >> 2;
#pragma unroll
      for (int d0 = 0; d0 < 2; ++d0) vfo[d0] = 32768 + (16 * hi + q_) * 512 + (((hh * 2 + d0) ^ q_) * 64) + ((lane >> 4) & 1) * 32 + (lane & 3) * 8; }
    LAS unsigned* flags = (LAS unsigned*)(lds + SB_FLG);
    size_t koff[4], voff[4];
#pragma unroll
    for (int i = 0; i < 4; ++i) { const int row = 8 * w + 2 * i + (lane >> 5), p = lane & 31;
        koff[i] = (size_t)row * KVW + K_SBK + ((p ^ (row & 15)) * 8);
        voff[i] = (size_t)row * KVW + K_SBV + ((((p >> 2) ^ (row & 3)) * 4 + (p & 3)) * 8); }
#define SB_DMA(base_, kt_, slot) do { const GAS f16* b_ = (base_) + (size_t)(kt_) * 64 * KVW; const unsigned kd_ = (unsigned)__builtin_amdgcn_readfirstlane(kdst + (slot)), vd_ = (unsigned)__builtin_amdgcn_readfirstlane(vdst + (slot)); \
        _Pragma("unroll") for (int i_ = 0; i_ < 4; ++i_) { glds16(b_ + koff[i_], kd_ + i_ * 1024); glds16(b_ + voff[i_], vd_ + i_ * 1024); } } while (0)
    SbUnit U, Un; int ui = vcu;
    if (!sb_decode(ui, U)) return;
    if (w >= 4) __builtin_amdgcn_s_setprio(1);
    int islot = 0, cslot = 0;
    const GAS f16* tbase = kv + ((size_t)U.b * SEQ) * KVW + U.hg * 256;
    h8 qn[4]; u32x4 gn[4];
    { const size_t grow = (size_t)U.b * SEQ + U.cq * 64 + 32 * rgp + l31; const int h = 4 * U.hg + hh;
      const GAS f16* Qg = qg + S_SBQ * QG_SEC + bl512(grow, h * 64 + 8 * hi); const GAS f16* Gp = qg + S_SBG * QG_SEC + bl512(grow, h * 64);
#pragma unroll
      for (int d0 = 0; d0 < 4; ++d0) qn[d0] = *(const GAS h8*)(Qg + 512 * d0);
      ld_groups_raw_bl(Gp, hi, gn); }
    asm volatile("" : "+v"(qn[0]), "+v"(qn[1]), "+v"(qn[2]), "+v"(qn[3]));
    SB_DMA(tbase, U.cq, islot); islot ^= SB_SLOT;
    for (;;) {
        const size_t rowbase = (size_t)U.b * SEQ;
        const int qw = U.cq * 64 + 32 * rgp, t = qw + l31, NT = U.cq + 1, h = 4 * U.hg + hh;
        const size_t grow = rowbase + qw + l31;
        h8 qr[4]; u32x4 gr[4];
#pragma unroll
        for (int d0 = 0; d0 < 4; ++d0) qr[d0] = qn[d0];
#pragma unroll
        for (int i = 0; i < 4; ++i) gr[i] = gn[i];
        asm volatile("" : "+v"(gr[0]), "+v"(gr[1]), "+v"(gr[2]), "+v"(gr[3]));
        const bool has_next = sb_decode(ui + G, Un);
        f32x16 o[2]; o[0] = f32x16{}; o[1] = f32x16{};
        float carry = 1.f; int done = 0;
        bool spec = false, late = false; int nslot = 0;
        const GAS f16* tbn = has_next ? kv + ((size_t)Un.b * SEQ) * KVW + Un.hg * 256 : tbase;
        SW_BEGIN(12);
        for (int j = 0; j < NT; ++j) {
            SW_BEGIN(13);
            WAIT_BAR(0);
            SW_END(13);
            if (j > 0) {
                const u32x4 f0 = *(const LAS u32x4*)(flags + ((j - 1) & 1) * 8), f1 = *(const LAS u32x4*)(flags + ((j - 1) & 1) * 8 + 4);
                const unsigned any = (f0.x | f0.y | f0.z | f0.w) | (f1.x | f1.y | f1.z | f1.w);
                if (!__builtin_amdgcn_readfirstlane(any)) break;
            }
            if (late) {
                SB_DMA(tbase, U.cq - j, cslot);
                WAIT_BAR(0);
            } else if (has_next && (j + 1 == NT || j == SB_SPEC_J)) {
                SB_DMA(tbn, Un.cq, islot); nslot = islot; spec = true; late = true;
            } else if (j + 1 < NT) { SB_DMA(tbase, U.cq - (j + 1), islot); islot ^= SB_SLOT; }
            const int kt = U.cq - j;
#pragma unroll
            for (int sub = 0; sub < 2; ++sub) {
                const int kb32 = sub == 0 ? 32 : 0;
                const bool diag = (j == 0) && (sub == (rgp == 1 ? 0 : 1));
                const bool skip = (j == 0) && (rgp == 0) && (sub == 0);
                if (!done && !skip) {
                    const LAS unsigned char* Sb = lds + cslot + kb32 * 512;
                    f32x16 p = f32x16{};
#pragma unroll
                    for (int d0 = 0; d0 < 4; ++d0) { const h8 k0 = *(const LAS h8*)(Sb + kfo[d0]); p = MFMA32(k0, qr[d0], p); }
                    h8 vf[2][2];
#pragma unroll
                    for (int d0 = 0; d0 < 2; ++d0) { const LAS unsigned char* Vb = Sb + vfo[d0]; vf[d0][0] = cat8(vtr(Vb), vtr(Vb + 2048)); vf[d0][1] = cat8(vtr(Vb + 4096), vtr(Vb + 6144)); }
                    __builtin_amdgcn_sched_barrier(0);
#pragma unroll
                    for (int r = 0; r < 16; ++r) p[r] = __builtin_amdgcn_rcpf(1.0f + __builtin_amdgcn_exp2f(-p[r]));
                    if (diag) {
                        const int key0 = 64 * kt + kb32 + 16 * hi;
#pragma unroll
                        for (int r = 0; r < 16; ++r) if (key0 + r >= t) p[r] = 0.f;
                    }
                    float run = 1.f;
#pragma unroll
                    for (int r = 15; r >= 0; --r) { const float a = run * p[r]; run -= a; p[r] = a; }
                    const auto rr = __builtin_amdgcn_permlane32_swap(__float_as_uint(run), __float_as_uint(run), false, false);
                    const float T0 = __uint_as_float(rr[0]), T1 = __uint_as_float(rr[1]);
                    const float E = carry * (hi ? 1.0f : T1);
                    carry = carry * (T0 * T1);
#pragma unroll
                    for (int r = 0; r < 16; ++r) p[r] *= E;
                    const h8 pa0 = pack8(p, 0), pa1 = pack8(p, 8);
#pragma unroll
                    for (int d0 = 0; d0 < 2; ++d0) {
                        o[d0] = MFMA32(vf[d0][0], pa0, o[d0]); o[d0] = MFMA32(vf[d0][1], pa1, o[d0]);
                    }
#if SB_EARLY_EXIT
                    done = __builtin_amdgcn_readfirstlane(__all(carry < 1.0e-37f) ? 1 : 0);
#endif
                }
            }
            if (lane == 0) flags[(j & 1) * 8 + w] = done ? 0u : 1u;
            if (!late) cslot ^= SB_SLOT;
        }
        asm volatile("s_nop 15\n\ts_nop 7" : "+v"(o[0]), "+v"(o[1]));
        SW_END(12);
        if (spec) { cslot = nslot; islot = nslot ^ SB_SLOT; }
        else cslot = islot;
        if (has_next) {
            const size_t grown = (size_t)Un.b * SEQ + Un.cq * 64 + 32 * rgp + l31; const int hn = 4 * Un.hg + hh;
            const GAS f16* Qg = qg + S_SBQ * QG_SEC + bl512(grown, hn * 64 + 8 * hi); const GAS f16* Gp = qg + S_SBG * QG_SEC + bl512(grown, hn * 64);
#pragma unroll
            for (int d0 = 0; d0 < 4; ++d0) qn[d0] = *(const GAS h8*)(Qg + 512 * d0);
            ld_groups_raw_bl(Gp, hi, gn);
            asm volatile("" ::: "memory");
            tbase = kv + ((size_t)Un.b * SEQ) * KVW + Un.hg * 256;
            if (!spec) { SB_DMA(tbase, Un.cq, islot); islot ^= SB_SLOT; }
        }
        {
            GAS f16* Op = mixed + bl1024(grow, h * 64);
            u32x2 gv[8]; unpack_groups(gr, gv);
#pragma unroll
            for (int d0 = 0; d0 < 2; ++d0)
#pragma unroll
                for (int pr = 0; pr < 2; ++pr) {
                    u32x2 wv[2];
#pragma unroll
                    for (int e = 0; e < 2; ++e) { const int rg4 = 2 * pr + e; const h4 g = __builtin_bit_cast(h4, gv[d0 * 4 + rg4]);
                        wv[e].x = pkh(o[d0][4 * rg4] * (float)g[0], o[d0][4 * rg4 + 1] * (float)g[1]); wv[e].y = pkh(o[d0][4 * rg4 + 2] * (float)g[2], o[d0][4 * rg4 + 3] * (float)g[3]); }
                    st_groups2_bl(Op, hi, 2 * d0 + pr, wv[0], wv[1]);
                }
        }
        if (!has_next) break;
        U = Un; ui += G;
    }
#undef SB_DMA
    WAIT_BAR(0);
    __builtin_amdgcn_s_setprio(0);
}

constexpr int DA_KS = 16384, DA_VRING = 49152, DA_XCH = 114688, DA_SUBG = 147456 + 1024, DA_SSX = 147456 + 3072;
struct DaUnit { int b, h, qt, klo; };
__device__ __forceinline__ int da_qt_of(int r, int i) {
    constexpr unsigned long long Q1 = 0x8956ABC4EF12730Dull, Q2 = 0x82691530EDACFB47ull, Q3 = 0x6C85D9BE017324FAull;
    return r == 0 ? i : (int)(((r == 1 ? Q1 : r == 2 ? Q2 : Q3) >> (4 * i)) & 15ull);
}
__device__ __forceinline__ int da_klo(int qt, int h) {
    const float cs = exp2f(-2.0f * (float)(h + 1)) * LOG2E;
    const int D = (int)ceilf(34.5f / cs), m = qt * 128 - D - 63;
    return m > 0 ? (m + 63) >> 6 : 0;
}
__device__ __forceinline__ bool da_decode(int u, DaUnit& U) {
    if (u >= 1024) return false;
    const int r = u >> 8, v = u & 255;
    U.b = v >> 4; U.h = r; U.qt = da_qt_of(r, v & 15); U.klo = da_klo(U.qt, U.h); return true;
}
__device__ __forceinline__ void da_pv(f32x16 (&o)[4], const LAS unsigned char* Vs, const int (&vfo)[4], h8 pa0, h8 pa1, h8 pa2, h8 pa3) {
    h8 f0, f1, f2, f3, g0, g1, g2, g3;
    { const LAS unsigned char* Vb = Vs + vfo[0]; f0 = cat8(vtr(Vb), vtr(Vb + 1024)); f1 = cat8(vtr(Vb + 2048), vtr(Vb + 3072)); f2 = cat8(vtr(Vb + 4096), vtr(Vb + 5120)); f3 = cat8(vtr(Vb + 6144), vtr(Vb + 7168)); }
#pragma unroll
    for (int d0 = 0; d0 < 4; ++d0) {
        if (d0 < 3) { const LAS unsigned char* Vb = Vs + vfo[d0 + 1]; g0 = cat8(vtr(Vb), vtr(Vb + 1024)); g1 = cat8(vtr(Vb + 2048), vtr(Vb + 3072)); g2 = cat8(vtr(Vb + 4096), vtr(Vb + 5120)); g3 = cat8(vtr(Vb + 6144), vtr(Vb + 7168)); }
        o[d0] = MFMA32(f0, pa0, o[d0]); o[d0] = MFMA32(f1, pa1, o[d0]); o[d0] = MFMA32(f2, pa2, o[d0]); o[d0] = MFMA32(f3, pa3, o[d0]);
        if (d0 < 3) { f0 = g0; f1 = g1; f2 = g2; f3 = g3; }
    }
}
__device__ __forceinline__ void da_pv_g(f32x16 (&o)[4], const LAS unsigned char* Vs, const int (&vfo)[4], const int g, h8 pa) {
    h8 f[4];
#pragma unroll
    for (int d0 = 0; d0 < 4; ++d0) { const LAS unsigned char* Vb = Vs + vfo[d0] + 2048 * g; f[d0] = cat8(vtr(Vb), vtr(Vb + 1024)); }
#pragma unroll
    for (int d0 = 0; d0 < 4; ++d0) o[d0] = MFMA32(f[d0], pa, o[d0]);
}
__device__ __forceinline__ void da_phase(LAS unsigned char* lds, const GAS f16* __restrict__ kv, const GAS f16* __restrict__ qg, GAS f16* __restrict__ mixed, int vcu, int G,
                                         float lam, float mref, const GAS float* __restrict__ subg, float osc, unsigned long long& sw_acc) {
    int tid_ = threadIdx.x; asm volatile("" : "+v"(tid_));
    const int tid = tid_, lane = tid & 63, l31 = lane & 31, hi = lane >> 5; const int w = __builtin_amdgcn_readfirstlane(tid >> 6);
    const int c = w >> 2, rg = (w + 2 * c) & 3;
    const unsigned lds0 = (unsigned)(uintptr_t)lds;
    const unsigned kdst = lds0 + w * 1024, vdst = lds0 + DA_VRING + w * 1024;
    int kfo[4];
    { const int kr = keyrow(l31);
#pragma unroll
      for (int d0 = 0; d0 < 4; ++d0) kfo[d0] = kr * 256 + (((8 * c + 2 * d0 + hi) ^ (kr & 15)) * 16); }
    int vfo[4];
    { const int q_ = (lane & 15) >> 2;
#pragma unroll
      for (int d0 = 0; d0 < 4; ++d0) vfo[d0] = DA_VRING + (32 * hi + q_) * 256 + ((d0 ^ q_) * 64) + ((lane >> 4) & 1) * 32 + (lane & 3) * 8; }
    const int srow = 4 * w + (lane >> 4);
    const size_t koff = (size_t)srow * KVW + K_DAK + (((lane & 15) ^ (srow & 15)) * 8);
    const size_t voff = (size_t)srow * KVW + K_DAV + (((((lane & 15) >> 2) ^ (srow & 3)) * 4 + (lane & 3)) * 8);
    const size_t qoff = S_DAQ * QG_SEC + bl512((size_t)(32 * rg + l31), c * 64 + 8 * hi);
    h8 ones; { const f16 one = ((lane & 15) == ((lane >> 4) & 1)) ? (f16)1.0f : (f16)0.0f; ones = (h8){one, one, one, one, one, one, one, one}; }
    h8 ba0, ba1; { const f16 z = (f16)0.0f, one = hi ? z : (f16)1.0f, k0 = hi ? z : (f16)(float)keyrow(l31), k1 = hi ? z : (f16)(float)(keyrow(l31) + 16);
                   ba0 = (h8){one, one, k0, k0, z, z, z, z}; ba1 = (h8){one, one, k1, k1, z, z, z, z}; }
    if (tid < 128) ((LAS float*)(lds + DA_SUBG))[tid] = subg[tid];
    LAS unsigned* xch = (LAS unsigned*)(lds + DA_XCH + rg * 8192);
#define DA_DMA(ks_, vs_, kt_, kslot, vslot) do { const size_t go_ = (size_t)(kt_) * 64 * KVW; const unsigned kd_ = (unsigned)__builtin_amdgcn_readfirstlane(kdst + (kslot)), vd_ = (unsigned)__builtin_amdgcn_readfirstlane(vdst + (vslot)); \
        glds16((ks_) + go_, kd_); glds16((ks_) + go_ + (size_t)32 * KVW, kd_ + 8192); glds16((vs_) + go_, vd_); glds16((vs_) + go_ + (size_t)32 * KVW, vd_ + 8192); } while (0)
#define DA_NEXT_K(s) ((s) == 2 * DA_KS ? 0 : (s) + DA_KS)
#define DA_NEXT_V(s) ((s) == 3 * DA_KS ? 0 : (s) + DA_KS)
    DaUnit U, Un; int ui = vcu;
    if (!da_decode(ui, U)) return;
    const GAS f16* ksrc = kv + ((size_t)U.b * SEQ) * KVW + U.h * 128 + koff; const GAS f16* vsrc = kv + ((size_t)U.b * SEQ) * KVW + U.h * 128 + voff;
    h8 qn[4];
    { const GAS f16* Qg = qg + bl512((size_t)U.b * SEQ + U.qt * 128, U.h * 128) + qoff;
#pragma unroll
      for (int d0 = 0; d0 < 4; ++d0) qn[d0] = *(const GAS h8*)(Qg + 512 * d0); }
    asm volatile("" : "+v"(qn[0]), "+v"(qn[1]), "+v"(qn[2]), "+v"(qn[3]));
    DA_DMA(ksrc, vsrc, U.klo, 0, 0); DA_DMA(ksrc, vsrc, U.klo + 1, DA_KS, DA_KS);
    int ik = 2 * DA_KS, iv = 2 * DA_KS, ck = 0, cv = 0;
    for (;;) {
        const size_t rowbase = (size_t)U.b * SEQ;
        const int qw = U.qt * 128 + 32 * rg, t = qw + l31, lastt = qw >> 6, NT = 2 * U.qt + 2;
        const int kfirst = U.klo + ((rg >> 1) & (U.klo > 0 ? 1 : 0));
        const float cslope = exp2f(-2.0f * (float)(U.h + 1)) * LOG2E;
        const float cs64 = 64.0f * cslope, base0 = -cslope * (float)(t - 32 * hi) - mref;
        const float bt0 = -cslope * (float)t - mref;
        const f16 c_hi = hi ? (f16)0.0f : (f16)cslope, c_lo = hi ? (f16)0.0f : (f16)(cslope - (float)(f16)cslope);
        h8 qr[4];
#pragma unroll
        for (int d0 = 0; d0 < 4; ++d0) qr[d0] = qn[d0];
        const size_t grow = rowbase + qw + l31;
        const bool has_next = da_decode(ui + G, Un);
        const GAS f16* ksn = ksrc; const GAS f16* vsn = vsrc;
        if (has_next) { ksn = kv + ((size_t)Un.b * SEQ) * KVW + Un.h * 128 + koff; vsn = kv + ((size_t)Un.b * SEQ) * KVW + Un.h * 128 + voff; }
        f32x16 o[4]; o[0] = f32x16{}; o[1] = f32x16{}; o[2] = f32x16{}; o[3] = f32x16{};
        f32x4 osum = (f32x4){0.f, 0.f, 0.f, 0.f};
        SW_BEGIN(2);
        for (int kt = U.klo; kt < NT; ++kt) {
            SW_BEGIN(3);
            if (kt + 1 < NT || has_next) WAIT_BAR(4); else WAIT_BAR(0);
            SW_END(3);
#define DA_ISSUE() do { if (kt + 2 < NT) { DA_DMA(ksrc, vsrc, kt + 2, ik, iv); ik = DA_NEXT_K(ik); iv = DA_NEXT_V(iv); } \
            else if (has_next) { DA_DMA(ksn, vsn, Un.klo + kt + 2 - NT, ik, iv); ik = DA_NEXT_K(ik); iv = DA_NEXT_V(iv); } } while (0)
            DA_ISSUE();
            if (kt <= lastt && kt >= kfirst) {
                const LAS unsigned char* Ks = lds + ck;
                f32x16 p0, p1;
                if (kt == lastt) {
                    asm volatile("" ::: "memory");
                    float kdf = (float)(t - (64 * kt + 32 * hi)); const float nm = -mref, ncs = -cslope;
                    asm volatile("" : "+v"(kdf));
#pragma unroll
                    for (int r = 0; r < 16; ++r) { p0[r] = __builtin_fmaf(ncs, __builtin_fabsf(kdf - (float)r), nm); p1[r] = __builtin_fmaf(ncs, __builtin_fabsf(kdf - (float)(16 + r)), nm); }
                } else {
                    const float bb = __builtin_fmaf(cs64, (float)kt, bt0);
                    const f16 b_hi = (f16)bb, b_lo = (f16)(bb - (float)b_hi), z = (f16)0.0f;
                    const h8 bq = hi ? (h8){z, z, z, z, z, z, z, z} : (h8){b_hi, b_lo, c_hi, c_lo, z, z, z, z};
                    p0 = MFMA32(ba0, bq, f32x16{}); p1 = MFMA32(ba1, bq, f32x16{});
                }
                h8 ka[4], kb[4];
#pragma unroll
                for (int d0 = 0; d0 < 4; ++d0) { ka[d0] = *(const LAS h8*)(Ks + kfo[d0]); kb[d0] = *(const LAS h8*)(Ks + kfo[d0] + 4096); }
                __builtin_amdgcn_sched_barrier(0);
#pragma unroll
                for (int d0 = 0; d0 < 4; ++d0) p0 = MFMA32(ka[d0], qr[d0], p0);
#pragma unroll
                for (int d0 = 0; d0 < 4; ++d0) p1 = MFMA32(kb[d0], qr[d0], p1);
#pragma unroll
                for (int r = 0; r < 16; ++r) p0[r] = __builtin_amdgcn_exp2f(p0[r]);
                const h8 pq0 = pack8(p0, 0), pq1 = pack8(p0, 8);
#pragma unroll
                for (int r = 0; r < 16; ++r) p1[r] = __builtin_amdgcn_exp2f(p1[r]);
                osum = __builtin_amdgcn_mfma_f32_16x16x32_f16(ones, pq0, osum, 0, 0, 0); osum = __builtin_amdgcn_mfma_f32_16x16x32_f16(ones, pq1, osum, 0, 0, 0);
                da_pv_g(o, lds + cv, vfo, 0, pq0); da_pv_g(o, lds + cv, vfo, 1, pq1);
                const h8 pq2 = pack8(p1, 0), pq3 = pack8(p1, 8);
                osum = __builtin_amdgcn_mfma_f32_16x16x32_f16(ones, pq2, osum, 0, 0, 0); osum = __builtin_amdgcn_mfma_f32_16x16x32_f16(ones, pq3, osum, 0, 0, 0);
                da_pv_g(o, lds + cv, vfo, 2, pq2); da_pv_g(o, lds + cv, vfo, 3, pq3);
            }
            ck = DA_NEXT_K(ck); cv = DA_NEXT_V(cv);
        }
        asm volatile("s_nop 15\n\ts_nop 7" : "+v"(o[0]), "+v"(o[1]), "+v"(o[2]), "+v"(o[3]), "+v"(osum));
        SW_END(2);
        const int dlo = 2 * c;
        u32x4 gr[4];
        ld_groups_raw_bl(qg + S_DAG * QG_SEC + bl512(grow, U.h * 128 + 32 * dlo), hi, gr);
        if (has_next) { const GAS f16* Qg = qg + bl512((size_t)Un.b * SEQ + Un.qt * 128, Un.h * 128) + qoff;
#pragma unroll
            for (int d0 = 0; d0 < 4; ++d0) qn[d0] = *(const GAS h8*)(Qg + 512 * d0); }
        asm volatile("" ::: "memory");
        float lsum; { const float s0 = __shfl(osum[0], l31 & 15), s1 = __shfl(osum[1], l31 & 15); lsum = (l31 < 16) ? s0 : s1; }
        const float f = (c == 0 ? 1.0f : lam) / lsum;
        LAS unsigned* xw = xch + (c ^ 1) * 1024;
        LAS unsigned* xr = xch + c * 1024;
        f32x16 ya, yb;
        if (c == 0) {
#pragma unroll
            for (int r2 = 0; r2 < 8; ++r2) { xw[r2 * 64 + lane] = pkh(o[2][2 * r2] * f, o[2][2 * r2 + 1] * f); xw[(8 + r2) * 64 + lane] = pkh(o[3][2 * r2] * f, o[3][2 * r2 + 1] * f); }
            ya = o[0] * f; yb = o[1] * f;
        } else {
#pragma unroll
            for (int r2 = 0; r2 < 8; ++r2) { xw[r2 * 64 + lane] = pkh(o[0][2 * r2] * f, o[0][2 * r2 + 1] * f); xw[(8 + r2) * 64 + lane] = pkh(o[1][2 * r2] * f, o[1][2 * r2 + 1] * f); }
            ya = o[2] * f; yb = o[3] * f;
        }
        asm volatile("s_waitcnt lgkmcnt(0)\n\ts_barrier" ::: "memory");
        const float sgn = (c == 0) ? 1.0f : -1.0f;
        float ss = 0.f;
#pragma unroll
        for (int r2 = 0; r2 < 8; ++r2) {
            const h2 pa = __builtin_bit_cast(h2, xr[r2 * 64 + lane]), pb = __builtin_bit_cast(h2, xr[(8 + r2) * 64 + lane]);
            const float a0 = (ya[2 * r2] - (float)pa[0]) * sgn, a1 = (ya[2 * r2 + 1] - (float)pa[1]) * sgn, b0 = (yb[2 * r2] - (float)pb[0]) * sgn, b1 = (yb[2 * r2 + 1] - (float)pb[1]) * sgn;
            ya[2 * r2] = a0; ya[2 * r2 + 1] = a1; yb[2 * r2] = b0; yb[2 * r2 + 1] = b1; ss += (a0 * a0 + a1 * a1) + (b0 * b0 + b1 * b1);
        }
        { const auto rr = __builtin_amdgcn_permlane32_swap(__float_as_uint(ss), __float_as_uint(ss), false, false); ss = __uint_as_float(rr[0]) + __uint_as_float(rr[1]); }
        LAS float* ssx = (LAS float*)(lds + DA_SSX + rg * 256);
        if (hi == 0) ssx[c * 32 + l31] = ss;
        asm volatile("s_waitcnt lgkmcnt(0)\n\ts_barrier" ::: "memory");
        ss += ssx[(c ^ 1) * 32 + l31];
        const float rn = __builtin_amdgcn_rsqf(ss * (1.0f / 128.0f) + RMS_EPS) * osc;
        {
            const LAS float* sgl = (const LAS float*)(lds + DA_SUBG) + 32 * dlo + 4 * hi;
            GAS f16* Op = mixed + bl1024(grow, 512 + U.h * 128 + 32 * dlo);
            u32x2 gv[8]; unpack_groups(gr, gv);
#pragma unroll
            for (int pr = 0; pr < 2; ++pr) {
                u32x2 wv[2];
#pragma unroll
                for (int e = 0; e < 2; ++e) { const int rg4 = 2 * pr + e; const h4 g = __builtin_bit_cast(h4, gv[rg4]); const f32x4 sg = *(const LAS f32x4*)(sgl + 8 * rg4);
                    wv[e].x = pkh(ya[4 * rg4] * rn * sg[0] * (float)g[0], ya[4 * rg4 + 1] * rn * sg[1] * (float)g[1]);
                    wv[e].y = pkh(ya[4 * rg4 + 2] * rn * sg[2] * (float)g[2], ya[4 * rg4 + 3] * rn * sg[3] * (float)g[3]); }
                st_groups2_bl(Op, hi, pr, wv[0], wv[1]);
            }
#pragma unroll
            for (int pr = 0; pr < 2; ++pr) {
                u32x2 wv[2];
#pragma unroll
                for (int e = 0; e < 2; ++e) { const int rg4 = 2 * pr + e; const h4 g = __builtin_bit_cast(h4, gv[4 + rg4]); const f32x4 sg = *(const LAS f32x4*)(sgl + 32 + 8 * rg4);
                    wv[e].x = pkh(yb[4 * rg4] * rn * sg[0] * (float)g[0], yb[4 * rg4 + 1] * rn * sg[1] * (float)g[1]);
                    wv[e].y = pkh(yb[4 * rg4 + 2] * rn * sg[2] * (float)g[2], yb[4 * rg4 + 3] * rn * sg[3] * (float)g[3]); }
                st_groups2_bl(Op, hi, 2 + pr, wv[0], wv[1]);
            }
        }
        if (!has_next) break;
        U = Un; ui += G; ksrc = ksn; vsrc = vsn;
    }
#undef DA_DMA
#undef DA_ISSUE
#undef DA_NEXT_K
#undef DA_NEXT_V
    WAIT_BAR(0);
}
}

constexpr size_t MiB = 1u << 20;
constexpr size_t WS_CTL = 0, CTL_ZERO_BYTES = 128 * 1024;
constexpr size_t WS_WIN = 2 * MiB;
constexpr size_t WS_WOUT = 18 * MiB;
constexpr size_t WS_PART = 22 * MiB;
constexpr size_t WS_XB = 32 * MiB;
constexpr size_t WS_MIX = 96 * MiB;
constexpr size_t WS_PROJ = 160 * MiB;
constexpr size_t WS_END = 416 * MiB;
constexpr int CW_BAR = 4096;

constexpr int RING_OFF = 0, RING_BYTES = 131072;
constexpr int LDSCTL_OFF = 147456, MISC_OFF = LDSCTL_OFF + 320;
constexpr int LDS_BYTES = 163840;
constexpr int NWAVES = 8;

typedef GAS unsigned gu32;
#define LDS_WAIT() asm volatile("s_waitcnt lgkmcnt(0)" ::: "memory")

#define XB_TMO      128
#define XB_XCNT(j)  (256  + 64 * (j))
#define XB_XSUB(j)  (1280 + 64 * (j))
#define XB_XGEN(j)  (2304 + 64 * (j))
#define XB_TOP      3328
#define XB_TOPGEN   3392
#define XCD_BAR_WORDS 3456
#define XB_SPIN_CAP (1u << 18)
__device__ __forceinline__ unsigned xb_ld(unsigned* p)              { return __hip_atomic_load(p, __ATOMIC_RELAXED, __HIP_MEMORY_SCOPE_AGENT); }
__device__ __forceinline__ unsigned xb_add(unsigned* p, unsigned v) { return __hip_atomic_fetch_add(p, v, __ATOMIC_RELAXED, __HIP_MEMORY_SCOPE_AGENT); }
__device__ __forceinline__ unsigned xb_xcc_id() { return (unsigned)__builtin_amdgcn_s_getreg((3 << 11) | 20) & 0xFu; }
#define XB_SPIN(cond, bar) do { unsigned _sp = 0; while (cond) { __builtin_amdgcn_s_sleep(1); \
    if ((++_sp & 255u) == 0u) { if (xb_ld(&(bar)[XB_TMO])) break; if (_sp > XB_SPIN_CAP) { atomicAdd(&(bar)[XB_TMO], 1u); break; } } } } while (0)
struct XcdBarrier { unsigned* bar; unsigned x; volatile LAS unsigned* st; };
__device__ __forceinline__ XcdBarrier xcd_barrier_post(unsigned* bar, volatile LAS unsigned* st) {
    XcdBarrier b; b.bar = bar; b.x = xb_xcc_id(); b.st = st;
    if (threadIdx.x == 0) (void)xb_add(&bar[XB_XCNT(b.x)], 1u);
    return b;
}
__device__ __forceinline__ void xcd_barrier_complete(unsigned* bar, unsigned x, unsigned& nloc, unsigned& nx) {
    const unsigned G = gridDim.x * gridDim.y * gridDim.z;
    unsigned sum, cnt, mine, sp = 0u;
    for (;;) {
        sum = 0u; cnt = 0u; mine = 0u;
#pragma unroll
        for (unsigned j = 0; j < 16; ++j) { const unsigned c = xb_ld(&bar[XB_XCNT(j)]); sum += c; cnt += (c > 0u) ? 1u : 0u; mine = (j == x) ? c : mine; }
        if (sum == G) break;
        __builtin_amdgcn_s_sleep(1);
        if ((++sp & 255u) == 0u) { if (xb_ld(&bar[XB_TMO])) break; if (sp > XB_SPIN_CAP) { atomicAdd(&bar[XB_TMO], 1u); break; } }
    }
    nloc = mine > 0u ? mine : 1u; nx = cnt > 0u ? cnt : 1u;
}
__device__ __forceinline__ void xcd_barrier(const XcdBarrier& b) {
    asm volatile("s_waitcnt vmcnt(0)" ::: "memory");
    __syncthreads();
    if (threadIdx.x == 0) {
        unsigned* bar = b.bar;
        __builtin_amdgcn_s_waitcnt(0);
        unsigned nloc = b.st[0], nx = b.st[1];
        if (nloc == 0u) { xcd_barrier_complete(bar, b.x, nloc, nx); b.st[0] = nloc; b.st[1] = nx; }
        const unsigned old = xb_add(&bar[XB_XSUB(b.x)], 1u);
        const unsigned gen = old / nloc;
        if (old + 1u == (gen + 1u) * nloc) {
            __builtin_amdgcn_fence(__ATOMIC_RELEASE, "agent");
            asm volatile("s_waitcnt vmcnt(0)" ::: "memory");
            const unsigned og = xb_add(&bar[XB_TOP], 1u);
            const unsigned tg = og / nx;
            if (og + 1u == (tg + 1u) * nx) xb_add(&bar[XB_TOPGEN], 1u);
            else XB_SPIN(xb_ld(&bar[XB_TOPGEN]) == tg, bar);
            __builtin_amdgcn_fence(__ATOMIC_ACQUIRE, "agent");
            xb_add(&bar[XB_XGEN(b.x)], 1u);
            asm volatile("s_waitcnt vmcnt(0)" ::: "memory");
        } else {
            XB_SPIN(xb_ld(&bar[XB_XGEN(b.x)]) == gen, bar);
            __builtin_amdgcn_fence(__ATOMIC_ACQUIRE, "agent");
            asm volatile("s_waitcnt vmcnt(0)" ::: "memory");
        }
    }
    __syncthreads();
}

#define CB_IDX(x, k)   (16 * ((x) * 16 + (k)))
#define CB_CNT(x, k)   (4096 + CB_IDX(x, k))
#define CB_SUB(x, k)   (4096 + 4096 + CB_IDX(x, k))
#define CB_GEN(x, k)   (4096 + 8192 + CB_IDX(x, k))
#define CB_TOP(k)      (4096 + 12288 + 16 * (k))
#define CB_TOPGEN(k)   (4096 + 12288 + 256 + 16 * (k))
__device__ __forceinline__ void cls_barrier_post(const XcdBarrier& b, unsigned k) { if (threadIdx.x == 0) (void)xb_add(&b.bar[CB_CNT(b.x, k)], 1u); }
__device__ __forceinline__ void cls_barrier(const XcdBarrier& b, unsigned k, unsigned csize) {
    asm volatile("s_waitcnt vmcnt(0)" ::: "memory");
    __syncthreads();
    if (threadIdx.x == 0) {
        unsigned* bar = b.bar;
        __builtin_amdgcn_s_waitcnt(0);
        unsigned nloc = b.st[2], nx = b.st[3];
        if (nloc == 0u) {
            unsigned sum, cnt, mine, sp = 0u;
            for (;;) {
                sum = 0u; cnt = 0u; mine = 0u;
#pragma unroll
                for (unsigned j = 0; j < 16; ++j) { const unsigned c = xb_ld(&bar[CB_CNT(j, k)]); sum += c; cnt += (c > 0u) ? 1u : 0u; mine = (j == b.x) ? c : mine; }
                if (sum == csize) break;
                __builtin_amdgcn_s_sleep(1);
                if ((++sp & 255u) == 0u) { if (xb_ld(&bar[XB_TMO])) break; if (sp > XB_SPIN_CAP) { atomicAdd(&bar[XB_TMO], 1u); break; } }
            }
            nloc = mine > 0u ? mine : 1u; nx = cnt > 0u ? cnt : 1u; b.st[2] = nloc; b.st[3] = nx;
        }
        const unsigned old = xb_add(&bar[CB_SUB(b.x, k)], 1u);
        const unsigned gen = old / nloc;
        if (old + 1u == (gen + 1u) * nloc) {
            if (nx > 1u) __builtin_amdgcn_fence(__ATOMIC_RELEASE, "agent");
            asm volatile("s_waitcnt vmcnt(0)" ::: "memory");
            if (nx > 1u) {
                const unsigned og = xb_add(&bar[CB_TOP(k)], 1u);
                const unsigned tg = og / nx;
                if (og + 1u == (tg + 1u) * nx) xb_add(&bar[CB_TOPGEN(k)], 1u);
                else XB_SPIN(xb_ld(&bar[CB_TOPGEN(k)]) == tg, bar);
            }
            __builtin_amdgcn_fence(__ATOMIC_ACQUIRE, "agent");
            xb_add(&bar[CB_GEN(b.x, k)], 1u);
            asm volatile("s_waitcnt vmcnt(0)" ::: "memory");
        } else {
            XB_SPIN(xb_ld(&bar[CB_GEN(b.x, k)]) == gen, bar);
            __builtin_amdgcn_fence(__ATOMIC_ACQUIRE, "agent");
            asm volatile("s_waitcnt vmcnt(0)" ::: "memory");
        }
    }
    __syncthreads();
}

__device__ __forceinline__ void p0_transpose_item(const float* W, const float* g, int K, int N, f16* WT, LAS float* scr, int item, int lane) {
    const int nblk = N / 32, kb = item / nblk, nb = item % nblk, k0 = 32 * kb, n0 = 32 * nb;
    float v[16];
#pragma unroll
    for (int i = 0; i < 16; ++i) { const int kk = 2 * i + (lane >> 5); v[i] = __builtin_nontemporal_load(W + (size_t)(k0 + kk) * N + n0 + (lane & 31)); }
    if (g) {
#pragma unroll
        for (int i = 0; i < 16; ++i) v[i] *= g[k0 + 2 * i + (lane >> 5)];
    }
#pragma unroll
    for (int i = 0; i < 16; ++i) scr[(2 * i + (lane >> 5)) * 33 + (lane & 31)] = v[i];
    LDS_WAIT(); asm volatile("" ::: "memory");
    const int c = lane & 3;
#pragma unroll
    for (int j = 0; j < 2; ++j) { const int n = (lane >> 2) + 16 * j; const LAS float* sp = scr + (8 * c) * 33 + n;
        u32x4 o; o.x = pkh(sp[0 * 33], sp[1 * 33]); o.y = pkh(sp[2 * 33], sp[3 * 33]); o.z = pkh(sp[4 * 33], sp[5 * 33]); o.w = pkh(sp[6 * 33], sp[7 * 33]);
        *(GAS u32x4*)(WT + (size_t)(n0 + n) * K + k0 + 8 * c) = o; }
    LDS_WAIT(); asm volatile("" ::: "memory");
}
__device__ __forceinline__ void x_rows4(const float* x, f16* xb, float* part, int m0, int stride, int lane) {
    f32x4 v[4][4];
#pragma unroll
    for (int r = 0; r < 4; ++r) { const GAS f32x4* xr = (const GAS f32x4*)(x + (size_t)(m0 + r * stride) * DM) + lane;
#pragma unroll
        for (int j = 0; j < 4; ++j) v[r][j] = __builtin_nontemporal_load(xr + 64 * j); }
#pragma unroll
    for (int r = 0; r < 4; ++r) {
        float s = 0.f;
#pragma unroll
        for (int j = 0; j < 4; ++j) s += (v[r][j][0] * v[r][j][0] + v[r][j][1] * v[r][j][1]) + (v[r][j][2] * v[r][j][2] + v[r][j][3] * v[r][j][3]);
        s = att::wave_sum(s);
        const size_t row = (size_t)(m0 + r * stride);
        GAS u32x2* o8 = (GAS u32x2*)(xb + row * DM) + lane;
#pragma unroll
        for (int j = 0; j < 4; ++j) { u32x2 w; w.x = pkh(v[r][j][0], v[r][j][1]); w.y = pkh(v[r][j][2], v[r][j][3]); o8[64 * j] = w; }
        if (lane < 16) part[row * 16 + lane] = (lane == 0) ? s : 0.f;
    }
}

__device__ __forceinline__ void x_row1(const float* x, f16* xb, float* part, int m, int lane) {
    const GAS f32x4* xr = (const GAS f32x4*)(x + (size_t)m * DM) + lane;
    f32x4 v[4]; float s = 0.f;
#pragma unroll
    for (int j = 0; j < 4; ++j) { v[j] = xr[64 * j]; s += (v[j][0] * v[j][0] + v[j][1] * v[j][1]) + (v[j][2] * v[j][2] + v[j][3] * v[j][3]); }
    s = att::wave_sum(s);
    GAS u32x2* o8 = (GAS u32x2*)(xb + (size_t)m * DM) + lane;
#pragma unroll
    for (int j = 0; j < 4; ++j) { u32x2 w; w.x = pkh(v[j][0], v[j][1]); w.y = pkh(v[j][2], v[j][3]); o8[64 * j] = w; }
    if (lane < 16) part[(size_t)m * 16 + lane] = (lane == 0) ? s : 0.f;
}

struct Args { const float* in[11]; float* out; unsigned char* ws; };
__global__ void __launch_bounds__(NWAVES * 64, 2) hybrid_fwd(Args args) {
    extern __shared__ __attribute__((aligned(16))) unsigned char lds_raw[];
    LAS unsigned char* lds = (LAS unsigned char*)lds_raw;
    volatile LAS unsigned* MISC = (volatile LAS unsigned*)(lds + MISC_OFF);
    const int tid = threadIdx.x, lane = tid & 63, wave = __builtin_amdgcn_readfirstlane(tid >> 6);
    const int G = gridDim.x; const int bx = blockIdx.x; const int vcu = (G % 8 == 0) ? (bx % 8) * (G / 8) + bx / 8 : bx;
    unsigned char* ws = args.ws;
    gu32* ctl = (gu32*)(ws + WS_CTL);
    const float* x = args.in[0]; const float* norm_g = args.in[1]; const float* w_in = args.in[2]; const float* w_out = args.in[3];
    const float* q_norm_g = args.in[4]; const float* k_norm_g = args.in[5];
    const float* lq1 = args.in[6]; const float* lk1 = args.in[7]; const float* lq2 = args.in[8]; const float* lk2 = args.in[9]; const float* subln_g = args.in[10];
    float* out = args.out;
    GAS unsigned char* wsg = (GAS unsigned char*)ws;
    GAS f16* WIN = (GAS f16*)(wsg + WS_WIN); GAS f16* WOUT = (GAS f16*)(wsg + WS_WOUT); GAS float* PART = (GAS float*)(wsg + WS_PART);
    GAS f16* XB = (GAS f16*)(wsg + WS_XB); GAS f16* MIX = (GAS f16*)(wsg + WS_MIX); GAS f16* PROJ = (GAS f16*)(wsg + WS_PROJ);

    unsigned long long sw_acc = 0;
    for (int u = tid; u < (LDS_BYTES - LDSCTL_OFF) / 4; u += NWAVES * 64) ((LAS unsigned*)(lds + LDSCTL_OFF))[u] = 0u;
    __syncthreads();
    XcdBarrier bar = xcd_barrier_post((unsigned*)(ctl + CW_BAR), MISC + 8);
    const bool cls = (G == 256);
    const unsigned grp_id = 2u * ((unsigned)bx & 7u) + ((unsigned)bx >> 7), grp_sz = 16u;
    cls_barrier_post(bar, grp_id);
#define PHASE_BARRIER() do { SW_BEGIN(7); if (cls) cls_barrier(bar, grp_id, grp_sz); else xcd_barrier(bar); SW_END(7); } while (0)

    SW_BEGIN(6);
    for (int rep = 0; rep < REP_PRO; ++rep) {
        LAS float* scr = (LAS float*)(lds + RING_OFF + wave * 16384);
        const int gw = vcu * NWAVES + wave, NGW = G * NWAVES;
        constexpr int I_IN = (DM / 32) * (PW / 32), I_OUT = (DM / 32) * (DM / 32);
        constexpr int NITEMS = DEPTH * (I_IN + I_OUT);
        SW_BEGIN(9);
        for (int it = gw; it < NITEMS; it += NGW) {
            int r = it; const int l = r / (I_IN + I_OUT); r -= l * (I_IN + I_OUT);
            if (r < I_IN) p0_transpose_item(w_in + (size_t)l * DM * PW, norm_g + l * DM, DM, PW, (f16*)WIN + (size_t)l * PW * DM, scr, r, lane);
            else p0_transpose_item(w_out + (size_t)l * DM * DM, nullptr, DM, DM, (f16*)WOUT + (size_t)l * DM * DM, scr, r - I_IN, lane);
        }
        SW_END(9);
        SW_BEGIN(10);
        { int m = gw; for (; m + 3 * NGW < MROWS; m += 4 * NGW) x_rows4(x, (f16*)XB, (float*)PART, m, NGW, lane); for (; m < MROWS; m += NGW) x_row1(x, (f16*)XB, (float*)PART, m, lane); }
        SW_END(10);
    }
    SW_END(6);
    { SW_BEGIN(7); xcd_barrier(bar); SW_END(7); }

    for (int l = 0; l < DEPTH; ++l) {
        { GAS unsigned char* wsl = wsg; asm volatile("" : "+s"(wsl)); WIN = (GAS f16*)(wsl + WS_WIN); WOUT = (GAS f16*)(wsl + WS_WOUT); PART = (GAS float*)(wsl + WS_PART); XB = (GAS f16*)(wsl + WS_XB); MIX = (GAS f16*)(wsl + WS_MIX); PROJ = (GAS f16*)(wsl + WS_PROJ);
          asm volatile("" : "+s"(out)); asm volatile("" : "+s"(x)); asm volatile("" : "+s"(subln_g)); asm volatile("" : "+s"(q_norm_g)); asm volatile("" : "+s"(k_norm_g)); asm volatile("" : "+s"(bar.bar)); }
        for (int rep = 0; rep < REP_G1; ++rep) {
            pg8::Gemm g{(const f16*)XB, (const f16*)WIN + (size_t)l * PW * DM, MROWS, PW, DM}; pg8::StaticOrder S; S.init(MROWS, PW, G, bx, G1_CPERM, cls ? 1 : 0);
            pg8::EpiProj E{PROJ, PROJ + (size_t)MROWS * KVW, PART, (const GAS float*)q_norm_g + l * 64, (const GAS float*)k_norm_g + l * 64, lds + RING_BYTES};
            if (cls && l == 0 && (bx & 1)) asm volatile("s_sleep 127\n\ts_sleep 64" ::: "memory");
            if (cls && l == 0 && (bx >> 7)) asm volatile("s_sleep 127\n\ts_sleep 127\n\ts_sleep 127" ::: "memory");
            SW_BEGIN(5);
            pg8::gemm_phase<pg8::EpiProj>(lds + RING_OFF, g, S, E, sw_acc);
            SW_END(5);
        }
        PHASE_BARRIER();
        {
            const float sa = att::wave_sum(lq1[l * 64 + lane] * lk1[l * 64 + lane]), sb = att::wave_sum(lq2[l * 64 + lane] * lk2[l * 64 + lane]);
            const float lam_init = 0.8f - 0.6f * __expf(-0.3f * (float)l);
            const float lam = __expf(sa) - __expf(sb) + lam_init;
            const float mgq = att::wave_max(fabsf(q_norm_g[l * 64 + lane])), mgk = att::wave_max(fabsf(k_norm_g[l * 64 + lane]));
            const float mref = 8.0f * LOG2E * mgq * mgk * 1.001f - 10.0f;
            __syncthreads();
            for (int rep = 0; rep < REP_DA; ++rep) { SW_BEGIN(1); att::da_phase(lds + RING_OFF, PROJ, PROJ + (size_t)MROWS * KVW, MIX, vcu, G, lam, mref, (const GAS float*)subln_g + l * 128, 1.0f - lam_init, sw_acc); SW_END(1); }
            for (int rep = 0; rep < REP_SB; ++rep) { SW_BEGIN(4); att::sb_phase(lds + RING_OFF, PROJ, PROJ + (size_t)MROWS * KVW, MIX, vcu, G, sw_acc); SW_END(4); }
        }
        PHASE_BARRIER();
        {
            pg8::Gemm g{(const f16*)MIX, (const f16*)WOUT + (size_t)l * DM * DM, MROWS, DM, DM}; pg8::StaticOrder S; S.init(MROWS, DM, G, bx, 0ull, cls ? 1 : 0);
            pg8::EpiOut E{(GAS float*)out, XB, PART, (l + 1 < DEPTH) ? 0 : 1};
            SW_BEGIN(8);
            pg8::gemm_phase<pg8::EpiOut>(lds + RING_OFF, g, S, E, sw_acc);
            SW_END(8);
        }
        if (l + 1 < DEPTH) PHASE_BARRIER();
    }
#if SW_ID
    if (wave == 0) { const unsigned long long t0 = __builtin_amdgcn_s_memrealtime(), span = (unsigned long long)SW_K * sw_acc; while (__builtin_amdgcn_s_memrealtime() - t0 < span) __builtin_amdgcn_s_sleep(8); }
#endif
}

extern "C" void kernel_launch(void* const* d_in, const int* in_sizes, int n_in, void* d_out, int out_size, void* d_ws, size_t ws_size, hipStream_t stream) {
    static int grid = 0;
    if (grid == 0) {
        if (n_in != 11 || in_sizes[0] != MROWS * DM || out_size != MROWS * DM || ws_size < WS_END) {
            fprintf(stderr, "kernel_launch: unexpected problem shape (n_in %d, in0 %d, out %d, ws %zu); nothing launched\n", n_in, n_in > 0 ? in_sizes[0] : -1, out_size, ws_size); grid = -1; return; }
        int dev = 0, cus = 0, per_cu = 0;
        if (hipGetDevice(&dev) != hipSuccess || hipDeviceGetAttribute(&cus, hipDeviceAttributeMultiprocessorCount, dev) != hipSuccess) { grid = -1; return; }
        if (hipFuncSetAttribute((const void*)hybrid_fwd, hipFuncAttributeMaxDynamicSharedMemorySize, LDS_BYTES) != hipSuccess) { fprintf(stderr, "kernel_launch: hipFuncSetAttribute failed\n"); grid = -1; return; }
        if (hipOccupancyMaxActiveBlocksPerMultiprocessor(&per_cu, (const void*)hybrid_fwd, NWAVES * 64, LDS_BYTES) != hipSuccess || per_cu < 1) {
            fprintf(stderr, "kernel_launch: occupancy query reports %d workgroups per CU; nothing launched\n", per_cu); (void)hipGetLastError(); grid = -1; return; }
        grid = cus;
    }
    if (grid < 0) return;
    if (hipMemsetAsync((char*)d_ws + WS_CTL, 0, CTL_ZERO_BYTES, stream) != hipSuccess) { fprintf(stderr, "kernel_launch: hipMemsetAsync failed\n"); return; }
    Args a{};
    for (int i = 0; i < 11; ++i) a.in[i] = (const float*)d_in[i];
    a.out = (float*)d_out; a.ws = (unsigned char*)d_ws;
    hipLaunchKernelGGL(hybrid_fwd, dim3(grid), dim3(NWAVES * 64), LDS_BYTES, stream, a);
    const hipError_t le = hipPeekAtLastError();
    if (le != hipSuccess) fprintf(stderr, "kernel_launch: launch failed: %s\n", hipGetErrorName(le));
}
```
